# Optimizing an MI355X kernel written in HIP

```python
import jax, jax.numpy as jnp
from jax import lax
import numpy as np

D_MODEL = 1024
BATCH = 8
SEQ = 4096
DEPTH = 2

GRID_W = 64
CTX_LEN = 256
N_EVEN = (DEPTH + 1) // 2
N_ODD = DEPTH // 2
RMS_EPS = 1e-6

HEAD_DIM = 64
CONV_CH = D_MODEL // 2
CONV_K = 3
ATT_Q_HEADS = (D_MODEL // 2) // HEAD_DIM
ATT_KV_HEADS = ATT_Q_HEADS // 4
ATT_GROUP = ATT_Q_HEADS // ATT_KV_HEADS
ATT_Q_DIM = ATT_Q_HEADS * HEAD_DIM
ATT_KV_DIM = ATT_KV_HEADS * HEAD_DIM
IN_SPLITS = (CONV_CH, 2 * CONV_CH, 3 * CONV_CH, 3 * CONV_CH + ATT_Q_DIM, 3 * CONV_CH + ATT_Q_DIM + ATT_KV_DIM)
IN_PROJ_DIM = 3 * CONV_CH + ATT_Q_DIM + 2 * ATT_KV_DIM
Q_BLOCK = 128
ATT_SCALE = HEAD_DIM ** -0.5
ROPE_THETA = 10000.0
ROPE_AXIS_DIM = HEAD_DIM // 2

RWKV_HEAD = 64
RWKV_HEADS = D_MODEL // RWKV_HEAD
DECAY_LORA = 64
ICLR_LORA = 64
GATE_LORA = 128
GN_EPS = 64e-5
L2_EPS = 1e-12

PEER_HEADS = 8
PEER_NKEYS = 128
PEER_EXPERTS = PEER_NKEYS * PEER_NKEYS
PEER_TOPK = 16
PEER_QDIM = 256
PEER_HALF = PEER_QDIM // 2
PEER_CHUNK = 128

kernel_name = 'hybrid_conv_gqa_rwkv7_peer_dit'


def rms_norm(x, gain):
    xf = x.astype(jnp.float32)
    y = xf * lax.rsqrt(jnp.mean(xf * xf, axis=-1, keepdims=True) + RMS_EPS)
    return (y * gain.astype(jnp.float32)).astype(x.dtype)


def modulate(x, shift, scale):
    return x * (1 + scale) + shift


def rope_2d_tables(seq_len):
    t = jnp.arange(seq_len, dtype=jnp.int32)
    row = (t // GRID_W).astype(jnp.float32)
    col = (t % GRID_W).astype(jnp.float32)
    inv_freq = ROPE_THETA ** (-jnp.arange(0, ROPE_AXIS_DIM, 2, dtype=jnp.float32) / ROPE_AXIS_DIM)
    ang = jnp.concatenate([row[:, None] * inv_freq, col[:, None] * inv_freq], axis=-1)
    return jnp.cos(ang), jnp.sin(ang)


def apply_rope(x, cos, sin):
    shp = x.shape
    xf = x.astype(jnp.float32).reshape(shp[:-1] + (shp[-1] // 2, 2))
    x1, x2 = xf[..., 0], xf[..., 1]
    bshape = (cos.shape[0],) + (1,) * (x.ndim - 3) + (cos.shape[1],)
    c, s = cos.reshape(bshape), sin.reshape(bshape)
    out = jnp.stack([x1 * c - x2 * s, x1 * s + x2 * c], axis=-1)
    return out.reshape(shp).astype(x.dtype)


def short_conv(x, w):
    T = x.shape[1]
    pad = CONV_K // 2
    xp = jnp.pad(x, ((0, 0), (pad, pad), (0, 0)))
    return sum(xp[:, j:j + T] * w[j] for j in range(CONV_K))


def block_attention(q, k, v):
    B, T = q.shape[:2]
    nb = T // Q_BLOCK
    qb = jnp.moveaxis(q.reshape(B, nb, Q_BLOCK, ATT_KV_HEADS, ATT_GROUP, HEAD_DIM), 1, 0)

    def one_block(qblk):
        s = jnp.einsum('bqkgd,bskd->bkgqs', qblk, k, preferred_element_type=jnp.float32) * ATT_SCALE
        p = jax.nn.softmax(s, axis=-1).astype(v.dtype)
        return jnp.einsum('bkgqs,bskd->bqkgd', p, v)

    out = lax.map(one_block, qb)
    return jnp.moveaxis(out, 0, 1).reshape(B, T, ATT_Q_DIM)


def conv_attn_mixer(xn_c, xn_l, w_in, conv_w, q_gain, k_gain, w_out, rope_cos, rope_sin, need_ctx_out):
    B, S, _ = xn_l.shape
    L = xn_c.shape[1]
    h_l, gb_l, gc_l, q_l, k_l, v_l = jnp.split(xn_l @ w_in, IN_SPLITS, axis=-1)
    h_c, gb_c, gc_c, q_c, k_c, v_c = jnp.split(xn_c @ w_in, IN_SPLITS, axis=-1)
    k_l = apply_rope(rms_norm(k_l.reshape(B, S, ATT_KV_HEADS, HEAD_DIM), k_gain), rope_cos, rope_sin)
    k_c = rms_norm(k_c.reshape(B, L, ATT_KV_HEADS, HEAD_DIM), k_gain)
    v_l = v_l.reshape(B, S, ATT_KV_HEADS, HEAD_DIM)
    v_c = v_c.reshape(B, L, ATT_KV_HEADS, HEAD_DIM)
    q_l = apply_rope(rms_norm(q_l.reshape(B, S, ATT_Q_HEADS, HEAD_DIM), q_gain), rope_cos, rope_sin)
    att_l = block_attention(q_l.reshape(B, S, ATT_KV_HEADS, ATT_GROUP, HEAD_DIM),
                            jnp.concatenate([k_c, k_l], axis=1), jnp.concatenate([v_c, v_l], axis=1))
    conv_l = gb_l * short_conv(gc_l * h_l, conv_w)
    y_l = jnp.concatenate([conv_l, att_l], axis=-1) @ w_out
    y_c = None
    if need_ctx_out:
        q_c = rms_norm(q_c.reshape(B, L, ATT_Q_HEADS, HEAD_DIM), q_gain)
        att_c = block_attention(q_c.reshape(B, L, ATT_KV_HEADS, ATT_GROUP, HEAD_DIM), k_c, v_c)
        conv_c = gb_c * short_conv(gc_c * h_c, conv_w)
        y_c = jnp.concatenate([conv_c, att_c], axis=-1) @ w_out
    return y_l, y_c


def shift_latent(x):
    B, S, D = x.shape
    rows = S // GRID_W
    q = D // 4
    g = x.reshape(B, rows, GRID_W, D)
    left = jnp.pad(g[:, :, :-1, 0:q], ((0, 0), (0, 0), (1, 0), (0, 0)))
    right = jnp.pad(g[:, :, 1:, q:2 * q], ((0, 0), (0, 0), (0, 1), (0, 0)))
    up = jnp.pad(g[:, :-1, :, 2 * q:3 * q], ((0, 0), (1, 0), (0, 0), (0, 0)))
    down = jnp.pad(g[:, 1:, :, 3 * q:], ((0, 0), (0, 1), (0, 0), (0, 0)))
    return jnp.concatenate([left, right, up, down], axis=-1).reshape(B, S, D)


def shift_context(x):
    h = x.shape[-1] // 2
    prev = jnp.pad(x[:, :-1, :h], ((0, 0), (1, 0), (0, 0)))
    nxt = jnp.pad(x[:, 1:, h:], ((0, 0), (0, 1), (0, 0)))
    return jnp.concatenate([prev, nxt], axis=-1)


def _heads(t):
    return t.reshape(t.shape[0], t.shape[1], RWKV_HEADS, RWKV_HEAD)


def rwkv_project(xn, shifted, mu, w_r, w_k, w_v, g1, g2, k_k, k_a, w0, w1, w2, a0, a1, a2):
    f32 = jnp.float32
    xx = shifted - xn
    xr, xw, xk, xv, xa, xg = [xn + xx * mu[m] for m in range(6)]
    r = xr @ w_r
    k = xk @ w_k
    v = xv @ w_v
    g = jax.nn.sigmoid(xg @ g1) @ g2
    kk = _heads((k * k_k).astype(f32))
    kk = kk * lax.rsqrt(jnp.sum(kk * kk, axis=-1, keepdims=True) + L2_EPS)
    per_dir = []
    for d in range(2):
        logw = -jax.nn.softplus(-(w0[d] + jnp.tanh(xw @ w1[d]) @ w2[d]).astype(f32)) - 0.5
        decay = jnp.exp(-jnp.exp(logw))
        a = jax.nn.sigmoid((a0[d] + (xa @ a1[d]) @ a2[d]).astype(f32))
        kd = k.astype(f32) * (1 + (a - 1) * k_a)
        per_dir.append((_heads(decay), _heads(a), _heads(kd)))
    return _heads(r.astype(f32)), _heads(v.astype(f32)), g, kk, per_dir


def wkv_scan(r, decay, k, v, kk, a, state0, reverse, need_out):
    tm = lambda t: jnp.swapaxes(t, 0, 1)

    def step(S, inp):
        r_t, w_t, k_t, v_t, kk_t, a_t = inp
        sa = jnp.einsum('bhij,bhj->bhi', S, -kk_t)
        S = S * w_t[:, :, None, :] + sa[..., :, None] * (kk_t * a_t)[..., None, :] + v_t[..., :, None] * k_t[..., None, :]
        y = jnp.einsum('bhij,bhj->bhi', S, r_t) if need_out else None
        return S, y

    s_fin, ys = lax.scan(step, state0, (tm(r), tm(decay), tm(k), tm(v), tm(kk), tm(a)), reverse=reverse)
    return s_fin, (tm(ys) if need_out else None)


def rwkv7_bidir(xn_c, xn_l, mu, w_r, w_k, w_v, w_o, g1, g2, k_k, k_a, r_k, w0, w1, w2, a0, a1, a2, gn_w, gn_b, need_ctx_out):
    r_c, v_c, g_c, kk_c, dirs_c = rwkv_project(xn_c, shift_context(xn_c), mu, w_r, w_k, w_v, g1, g2, k_k, k_a, w0, w1, w2, a0, a1, a2)
    r_l, v_l, g_l, kk_l, dirs_l = rwkv_project(xn_l, shift_latent(xn_l), mu, w_r, w_k, w_v, g1, g2, k_k, k_a, w0, w1, w2, a0, a1, a2)
    B = xn_l.shape[0]
    state0 = jnp.zeros((B, RWKV_HEADS, RWKV_HEAD, RWKV_HEAD), jnp.float32)
    ys_l, ys_c = [], []
    for d, rev in enumerate((False, True)):
        dec_c, a_c, kd_c = dirs_c[d]
        s_ctx, y_cd = wkv_scan(r_c, dec_c, kd_c, v_c, kk_c, a_c, state0, rev, need_ctx_out)
        dec_l, a_l, kd_l = dirs_l[d]
        _, y_ld = wkv_scan(r_l, dec_l, kd_l, v_l, kk_l, a_l, s_ctx, rev, True)
        ys_l.append(y_ld)
        ys_c.append(y_cd)

    def readout(y_sum, r, v, g, k_sum):
        Bq, Tq = y_sum.shape[:2]
        mean = jnp.mean(y_sum, axis=-1, keepdims=True)
        var = jnp.mean(jnp.square(y_sum - mean), axis=-1, keepdims=True)
        yn = ((y_sum - mean) * lax.rsqrt(var + GN_EPS)).reshape(Bq, Tq, D_MODEL) * gn_w + gn_b
        bonus = (jnp.sum(r * k_sum * r_k, axis=-1, keepdims=True) * v).reshape(Bq, Tq, D_MODEL)
        return ((yn + bonus).astype(g.dtype) * g) @ w_o

    y_l = readout(ys_l[0] + ys_l[1], r_l, v_l, g_l, dirs_l[0][2] + dirs_l[1][2])
    y_c = None
    if need_ctx_out:
        y_c = readout(ys_c[0] + ys_c[1], r_c, v_c, g_c, dirs_c[0][2] + dirs_c[1][2])
    return y_l, y_c


def peer_ffn(xn, w_q, sub_keys, u_tab, v_tab):
    B, T, D = xn.shape
    chunks = xn.reshape(-1, PEER_CHUNK, D)

    def chunk_fn(xc):
        n = xc.shape[0]
        q = (xc @ w_q).reshape(n, PEER_HEADS, 2, PEER_HALF)
        s = jnp.einsum('nhpd,hpkd->nhpk', q, sub_keys, preferred_element_type=jnp.float32)
        s1, i1 = lax.top_k(s[:, :, 0], PEER_TOPK)
        s2, i2 = lax.top_k(s[:, :, 1], PEER_TOPK)
        cand_s = (s1[..., :, None] + s2[..., None, :]).reshape(n, PEER_HEADS, PEER_TOPK * PEER_TOPK)
        cand_i = (i1[..., :, None] * PEER_NKEYS + i2[..., None, :]).reshape(n, PEER_HEADS, PEER_TOPK * PEER_TOPK)
        top_s, pos = lax.top_k(cand_s, PEER_TOPK)
        idx = jnp.take_along_axis(cand_i, pos, axis=-1)
        gate = jax.nn.softmax(top_s, axis=-1)
        u = u_tab[idx]
        v = v_tab[idx]
        act = jax.nn.gelu(jnp.einsum('nd,nhkd->nhk', xc, u, preferred_element_type=jnp.float32), approximate=False)
        return jnp.einsum('nhk,nhkd->nd', (gate * act).astype(v.dtype), v)

    return lax.map(chunk_fn, chunks).reshape(B, T, D)


def setup_inputs(seed: int = 0) -> dict:
    key = jax.random.key(seed)
    ks = list(jax.random.split(key, 40))
    it = iter(ks)
    D = D_MODEL

    def nrm(shape, scale):
        return scale * jax.random.normal(next(it), shape, jnp.float32)

    inp = {}
    inp['x'] = nrm((BATCH, SEQ, D), 1.0)
    inp['c'] = nrm((BATCH, D), 1.0)
    inp['ctx'] = nrm((BATCH, CTX_LEN, D), 1.0)
    inp['c_ctx'] = nrm((D,), 1.0)
    inp['ada_w'] = nrm((DEPTH, D, 6 * D), 0.5 * D ** -0.5)
    inp['ada_b'] = nrm((DEPTH, 6 * D), 0.02)
    inp['norm1_g'] = 1.0 + nrm((DEPTH, D), 0.02)
    inp['norm2_g'] = 1.0 + nrm((DEPTH, D), 0.02)
    inp['ev_w_in'] = nrm((N_EVEN, D, IN_PROJ_DIM), D ** -0.5)
    inp['ev_conv_w'] = nrm((N_EVEN, CONV_K, CONV_CH), CONV_K ** -0.5)
    inp['ev_q_gain'] = 1.0 + nrm((N_EVEN, HEAD_DIM), 0.02)
    inp['ev_k_gain'] = 1.0 + nrm((N_EVEN, HEAD_DIM), 0.02)
    inp['ev_w_out'] = nrm((N_EVEN, D, D), D ** -0.5)
    inp['od_mu'] = jax.random.uniform(next(it), (N_ODD, 6, D), jnp.float32)
    inp['od_w_r'] = nrm((N_ODD, D, D), D ** -0.5)
    inp['od_w_k'] = nrm((N_ODD, D, D), D ** -0.5)
    inp['od_w_v'] = nrm((N_ODD, D, D), D ** -0.5)
    inp['od_w_o'] = nrm((N_ODD, D, D), D ** -0.5)
    inp['od_g1'] = nrm((N_ODD, D, GATE_LORA), D ** -0.5)
    inp['od_g2'] = nrm((N_ODD, GATE_LORA, D), GATE_LORA ** -0.5)
    inp['od_k_k'] = 0.85 + nrm((N_ODD, D), 0.02)
    inp['od_k_a'] = 1.0 + nrm((N_ODD, D), 0.02)
    inp['od_r_k'] = nrm((N_ODD, RWKV_HEADS, RWKV_HEAD), 0.1)
    inp['od_w0'] = -0.6 + nrm((N_ODD, 2, D), 0.3)
    inp['od_w1'] = nrm((N_ODD, 2, D, DECAY_LORA), D ** -0.5)
    inp['od_w2'] = nrm((N_ODD, 2, DECAY_LORA, D), 0.5 * DECAY_LORA ** -0.5)
    inp['od_a0'] = nrm((N_ODD, 2, D), 0.02)
    inp['od_a1'] = nrm((N_ODD, 2, D, ICLR_LORA), D ** -0.5)
    inp['od_a2'] = nrm((N_ODD, 2, ICLR_LORA, D), ICLR_LORA ** -0.5)
    inp['od_gn_w'] = 1.0 + nrm((N_ODD, D), 0.02)
    inp['od_gn_b'] = nrm((N_ODD, D), 0.02)
    inp['peer_wq'] = nrm((DEPTH, D, PEER_HEADS * PEER_QDIM), D ** -0.5)
    inp['peer_keys'] = nrm((DEPTH, PEER_HEADS, 2, PEER_NKEYS, PEER_HALF), PEER_HALF ** -0.5)
    inp['peer_u'] = nrm((DEPTH, PEER_EXPERTS, D), D ** -0.5)
    inp['peer_v'] = nrm((DEPTH, PEER_EXPERTS, D), PEER_HEADS ** -0.5)
    return inp


def reference(x, c, ctx, c_ctx, ada_w, ada_b, norm1_g, norm2_g, ev_w_in, ev_conv_w, ev_q_gain, ev_k_gain, ev_w_out,
              od_mu, od_w_r, od_w_k, od_w_v, od_w_o, od_g1, od_g2, od_k_k, od_k_a, od_r_k, od_w0, od_w1, od_w2,
              od_a0, od_a1, od_a2, od_gn_w, od_gn_b, peer_wq, peer_keys, peer_u, peer_v):
    rope_cos, rope_sin = rope_2d_tables(x.shape[1])
    silu_c = jax.nn.silu(c)
    silu_cc = jax.nn.silu(c_ctx)
    hx, hc = x, ctx
    for i in range(DEPTH):
        last = i == DEPTH - 1
        j = i // 2
        mod_l = jnp.split((silu_c @ ada_w[i] + ada_b[i])[:, None, :], 6, axis=-1)
        mod_c = jnp.split(silu_cc @ ada_w[i] + ada_b[i], 6, axis=-1)
        xn_l = modulate(rms_norm(hx, norm1_g[i]), mod_l[0], mod_l[1])
        xn_c = modulate(rms_norm(hc, norm1_g[i]), mod_c[0], mod_c[1])
        if i % 2 == 0:
            y_l, y_c = conv_attn_mixer(xn_c, xn_l, ev_w_in[j], ev_conv_w[j], ev_q_gain[j], ev_k_gain[j], ev_w_out[j],
                                       rope_cos, rope_sin, not last)
        else:
            y_l, y_c = rwkv7_bidir(xn_c, xn_l, od_mu[j], od_w_r[j], od_w_k[j], od_w_v[j], od_w_o[j], od_g1[j], od_g2[j],
                                   od_k_k[j], od_k_a[j], od_r_k[j], od_w0[j], od_w1[j], od_w2[j], od_a0[j], od_a1[j],
                                   od_a2[j], od_gn_w[j], od_gn_b[j], not last)
        hx = hx + mod_l[2] * y_l.astype(hx.dtype)
        hx = hx + mod_l[5] * peer_ffn(modulate(rms_norm(hx, norm2_g[i]), mod_l[3], mod_l[4]),
                                      peer_wq[i], peer_keys[i], peer_u[i], peer_v[i])
        if not last:
            hc = hc + mod_c[2] * y_c.astype(hc.dtype)
            hc = hc + mod_c[5] * peer_ffn(modulate(rms_norm(hc, norm2_g[i]), mod_c[3], mod_c[4]),
                                          peer_wq[i], peer_keys[i], peer_u[i], peer_v[i])
    return hx
```

```cpp
#include <hip/hip_runtime.h>
#include <hip/hip_cooperative_groups.h>
#include <cstdio>
namespace cg = cooperative_groups;

#ifndef N_LAUNCH_MODE
#define N_LAUNCH_MODE 0
#endif

typedef unsigned short u16;
typedef unsigned char u8;
typedef __attribute__((ext_vector_type(8))) short bf16x8;
typedef __attribute__((ext_vector_type(16))) float f32x16;

#define NT 512
#define TTOK 34816
#define NLAT 32768
#define DM 1024
#define LDSS 72
#define LDS_BYTES 114688
#define NPHASE 22
#ifndef REPEAT_MASK
#define REPEAT_MASK 0
#endif
#ifndef PHASE_MASK
#define PHASE_MASK 0x3FFFFF
#endif

static constexpr size_t MiB = 1048576;
static constexpr size_t O_WIN = 0;
static constexpr size_t O_WOUT = O_WIN + 4718592;
static constexpr size_t O_WR = O_WOUT + 2097152;
static constexpr size_t O_WK = O_WR + 2097152;
static constexpr size_t O_WV = O_WK + 2097152;
static constexpr size_t O_WO = O_WV + 2097152;
static constexpr size_t O_G1 = O_WO + 2097152;
static constexpr size_t O_G2 = O_G1 + 262144;
static constexpr size_t O_W1 = O_G2 + 262144;
static constexpr size_t O_A1 = O_W1 + 262144;
static constexpr size_t O_W2 = O_A1 + 262144;
static constexpr size_t O_A2 = O_W2 + 262144;
static constexpr size_t O_WQ = O_A2 + 262144;
static constexpr size_t O_KEYS = O_WQ + 8388608;
static constexpr size_t O_MOD = O_KEYS + 1048576;
static constexpr size_t O_ROPE = O_MOD + 442368;
static constexpr size_t SZ = 68 * MiB;
static constexpr size_t O_A1R = 26 * MiB;
static constexpr size_t O_A2R = O_A1R + SZ;
static constexpr size_t O_A3R = O_A2R + SZ;
static constexpr size_t O_A4R = O_A3R + SZ;
static constexpr size_t O_A5R = O_A4R + SZ;
static constexpr size_t O_A6R = O_A5R + SZ;
static constexpr size_t O_A7R = O_A6R + SZ;
static constexpr size_t O_LORA = O_A7R;
static constexpr size_t O_BONUS = O_A7R + 26 * MiB;
static constexpr size_t WS_END = O_BONUS + 4 * MiB;
static constexpr size_t O_XN = O_A1R;
static constexpr size_t O_HGG = O_A2R;
static constexpr size_t O_Q = O_A2R + 102 * MiB;
static constexpr size_t O_KB = O_A4R;
static constexpr size_t O_VT = O_A4R + 9 * MiB;
static constexpr size_t O_PQ0 = O_A2R;
static constexpr size_t O_TAB0 = O_A5R;
static constexpr size_t O_IDX0 = O_A6R;
static constexpr size_t O_GATE0 = O_A6R + 17 * MiB;
static constexpr size_t O_HC = O_A6R + 34 * MiB;
static constexpr size_t O_COEF0 = O_A6R + 42 * MiB;
static constexpr size_t O_R = O_A2R, O_K = O_A3R, O_V = O_A4R;
static constexpr size_t O_WA0 = O_A5R, O_WA1 = O_A6R;
static constexpr size_t O_G = O_A1R;
static constexpr size_t O_Z = O_A2R;
static constexpr size_t O_TAB1 = O_A3R;
static constexpr size_t O_PQ1 = O_A5R;
static constexpr size_t O_IDX1 = O_A4R;
static constexpr size_t O_GATE1 = O_A4R + 17 * MiB;
static constexpr size_t O_COEF1 = O_A4R + 34 * MiB;

struct P {
  const float* in[35];
  float* out;
  char* ws;
  int ph_lo, ph_hi;
};

typedef __bf16 bf16x2_t __attribute__((ext_vector_type(2)));
typedef float f32x2_t __attribute__((ext_vector_type(2)));
__device__ __forceinline__ u16 f2bf(float f) {
  __bf16 b = (__bf16)f;
  return __builtin_bit_cast(u16, b);
}
__device__ __forceinline__ float bf2f(u16 h) { return __uint_as_float(((unsigned)h) << 16); }
__device__ __forceinline__ float bflo(unsigned w) { return __uint_as_float(w << 16); }
__device__ __forceinline__ float bfhi(unsigned w) { return __uint_as_float(w & 0xFFFF0000u); }
__device__ __forceinline__ unsigned pack2(float a, float b) { f32x2_t v = {a, b}; bf16x2_t r = __builtin_convertvector(v, bf16x2_t); return __builtin_bit_cast(unsigned, r); }

__device__ __forceinline__ int tid_() { int t = __builtin_amdgcn_workitem_id_x(); asm volatile("" : "+v"(t)); return t; }
template <int CTRL>
__device__ __forceinline__ float dppf(float v) {
  return __builtin_bit_cast(float, __builtin_amdgcn_update_dpp(0, __builtin_bit_cast(int, v), CTRL, 0xF, 0xF, true));
}
__device__ __forceinline__ float red8(float v) {
  v += dppf<0xB1>(v); v += dppf<0x4E>(v); v += dppf<0x141>(v); return v;
}
__device__ __forceinline__ float red16(float v) { v = red8(v); v += dppf<0x140>(v); return v; }
__device__ __forceinline__ float swapsum32(float a, float b) {
  auto r = __builtin_amdgcn_permlane32_swap(__float_as_uint(a), __float_as_uint(b), false, false);
  return __uint_as_float(r[0]) + __uint_as_float(r[1]);
}
__device__ __forceinline__ float swapsum16(float a, float b) {
  auto r = __builtin_amdgcn_permlane16_swap(__float_as_uint(a), __float_as_uint(b), false, false);
  return __uint_as_float(r[0]) + __uint_as_float(r[1]);
}
__device__ __forceinline__ float swapmax32(float a) {
  auto r = __builtin_amdgcn_permlane32_swap(__float_as_uint(a), __float_as_uint(a), false, false);
  return fmaxf(__uint_as_float(r[0]), __uint_as_float(r[1]));
}
__device__ __forceinline__ float swapmax16(float a) {
  auto r = __builtin_amdgcn_permlane16_swap(__float_as_uint(a), __float_as_uint(a), false, false);
  return fmaxf(__uint_as_float(r[0]), __uint_as_float(r[1]));
}
__device__ __forceinline__ float wave_sum(float v) {
  v = red16(v);
  v = swapsum16(v, v); v = swapsum32(v, v);
  return v;
}
__device__ __forceinline__ float sigmoidf_(float x) { return 1.f / (1.f + __expf(-x)); }

template <bool MIX, class Epi>
__device__ __forceinline__ void gemm_tile(const u16* __restrict__ A, int lda, const float* __restrict__ mu,
                                          const u16* __restrict__ B, int ldb, int K, int row0, Epi epi, u16* lds) {
  u16* sA = lds;
  u16* sB = lds + 256 * LDSS;
  const int tid = tid_(), lane = tid & 63, wave = tid >> 6;
  const int wm = wave & 3, wn = wave >> 2;
  const int r = lane & 31, h = lane >> 5;
  const int kc = tid & 7, lr = tid >> 3;
  f32x16 acc[2][2];
#pragma unroll
  for (int i = 0; i < 2; ++i)
#pragma unroll
    for (int j = 0; j < 2; ++j)
#pragma unroll
      for (int g = 0; g < 16; ++g) acc[i][j][g] = 0.f;
  uint4 pa0, pa1, pa2, pa3, ps0, ps1, ps2, ps3, pb0, pb1;
  ps0 = ps1 = ps2 = ps3 = make_uint4(0, 0, 0, 0);
  float4 m0 = make_float4(0, 0, 0, 0), m1 = m0;
  auto nbr = [&](int row, int kg) -> int {
    if (row < NLAT) {
      int t = row & 4095; int gc = t & 63, gr = t >> 6; int qd = kg >> 8;
      if (qd == 0) return gc > 0 ? row - 1 : -1;
      if (qd == 1) return gc < 63 ? row + 1 : -1;
      if (qd == 2) return gr > 0 ? row - 64 : -1;
      return gr < 63 ? row + 64 : -1;
    } else {
      int t = (row - NLAT) & 255;
      if (kg < 512) return t > 0 ? row - 1 : -1;
      return t < 255 ? row + 1 : -1;
    }
  };
  auto ldA = [&](int i, int k0, uint4& a, uint4& sx) {
    int row = row0 + lr + 64 * i;
    a = *(const uint4*)(A + (size_t)row * lda + k0 + kc * 8);
    if (MIX) {
      int nr = nbr(row, k0 + kc * 8);
      if (nr >= 0) sx = *(const uint4*)(A + (size_t)nr * lda + k0 + kc * 8);
      else sx = make_uint4(0, 0, 0, 0);
    }
  };
  auto gload = [&](int k0) {
    ldA(0, k0, pa0, ps0); ldA(1, k0, pa1, ps1); ldA(2, k0, pa2, ps2); ldA(3, k0, pa3, ps3);
    if (MIX) {
      m0 = *(const float4*)(mu + k0 + kc * 8);
      m1 = *(const float4*)(mu + k0 + kc * 8 + 4);
    }
    pb0 = *(const uint4*)(B + (size_t)lr * ldb + k0 + kc * 8);
    pb1 = *(const uint4*)(B + (size_t)(lr + 64) * ldb + k0 + kc * 8);
  };
  auto mixw = [&](unsigned x, unsigned s, float ma, float mb) -> unsigned {
    float x0 = bflo(x), x1 = bfhi(x), s0 = bflo(s), s1 = bfhi(s);
    return pack2(x0 + (s0 - x0) * ma, x1 + (s1 - x1) * mb);
  };
  auto stA = [&](int i, uint4 a, uint4 sx) {
    uint4 v = a;
    if (MIX) {
      v.x = mixw(a.x, sx.x, m0.x, m0.y);
      v.y = mixw(a.y, sx.y, m0.z, m0.w);
      v.z = mixw(a.z, sx.z, m1.x, m1.y);
      v.w = mixw(a.w, sx.w, m1.z, m1.w);
    }
    *(uint4*)(sA + (lr + 64 * i) * LDSS + kc * 8) = v;
  };
  auto lstore = [&]() {
    stA(0, pa0, ps0); stA(1, pa1, ps1); stA(2, pa2, ps2); stA(3, pa3, ps3);
    *(uint4*)(sB + lr * LDSS + kc * 8) = pb0;
    *(uint4*)(sB + (lr + 64) * LDSS + kc * 8) = pb1;
  };
  gload(0);
  for (int k0 = 0; k0 < K; k0 += 64) {
    lstore();
    __syncthreads();
    if (k0 + 64 < K) gload(k0 + 64);
#pragma unroll
    for (int kk = 0; kk < 4; ++kk) {
      bf16x8 af[2], bfr[2];
#pragma unroll
      for (int i = 0; i < 2; ++i) af[i] = *(const bf16x8*)(sA + (wm * 64 + i * 32 + r) * LDSS + kk * 16 + h * 8);
#pragma unroll
      for (int j = 0; j < 2; ++j) bfr[j] = *(const bf16x8*)(sB + (wn * 64 + j * 32 + r) * LDSS + kk * 16 + h * 8);
#pragma unroll
      for (int i = 0; i < 2; ++i)
#pragma unroll
        for (int j = 0; j < 2; ++j) acc[i][j] = __builtin_amdgcn_mfma_f32_32x32x16_bf16(af[i], bfr[j], acc[i][j], 0, 0, 0);
    }
    __syncthreads();
  }
#pragma unroll
  for (int i = 0; i < 2; ++i)
#pragma unroll
    for (int j = 0; j < 2; ++j)
#pragma unroll
      for (int g4 = 0; g4 < 4; ++g4) {
        int row = row0 + wm * 64 + i * 32 + 8 * g4 + 4 * h;
        int col = wn * 64 + j * 32 + r;
        epi(row, col, acc[i][j][g4 * 4 + 0], acc[i][j][g4 * 4 + 1], acc[i][j][g4 * 4 + 2], acc[i][j][g4 * 4 + 3]);
      }
}

__constant__ int TJOBS[18][5] = {
    {8, 0, 1024, 2304, (int)O_WIN},
    {12, 0, 1024, 1024, (int)O_WOUT},
    {14, 0, 1024, 1024, (int)O_WR},
    {15, 0, 1024, 1024, (int)O_WK},
    {16, 0, 1024, 1024, (int)O_WV},
    {17, 0, 1024, 1024, (int)O_WO},
    {18, 0, 1024, 128, (int)O_G1},
    {19, 0, 128, 1024, (int)O_G2},
    {24, 0, 1024, 64, (int)O_W1},
    {24, 65536, 1024, 64, (int)(O_W1 + 131072)},
    {27, 0, 1024, 64, (int)O_A1},
    {27, 65536, 1024, 64, (int)(O_A1 + 131072)},
    {25, 0, 64, 1024, (int)O_W2},
    {25, 65536, 64, 1024, (int)(O_W2 + 131072)},
    {28, 0, 64, 1024, (int)O_A2},
    {28, 65536, 64, 1024, (int)(O_A2 + 131072)},
    {31, 0, 1024, 2048, (int)O_WQ},
    {31, 2097152, 1024, 2048, (int)(O_WQ + 4194304)},
};

__device__ __forceinline__ void convert_bf16(const float* __restrict__ src, u16* __restrict__ dst, size_t n) {
  size_t n4 = n >> 2;
  for (size_t i = (size_t)blockIdx.x * NT + tid_(); i < n4; i += (size_t)gridDim.x * NT) {
    float4 v = ((const float4*)src)[i];
    uint2 o; o.x = pack2(v.x, v.y); o.y = pack2(v.z, v.w);
    ((uint2*)dst)[i] = o;
  }
}

__device__ __forceinline__ void convert_tab_fp8(const float* __restrict__ U, const float* __restrict__ V, char* tab);
__device__ __forceinline__ void phase_prep(const P& p, char* lds) {
  const int tid = tid_();
  float* fl = (float*)lds;
  for (int task = blockIdx.x; task < 192; task += gridDim.x) {
    int l = task / 96, cg_ = task % 96;
    float* sv = fl;
    float* red = fl + 9216;
    for (int i = tid; i < 9216; i += NT) {
      int v = i >> 10, k = i & 1023;
      float x = v < 8 ? p.in[1][v * 1024 + k] : p.in[3][k];
      sv[i] = x / (1.f + __expf(-x));
    }
    __syncthreads();
    int col = cg_ * 64 + (tid & 63), kg = tid >> 6;
    float acc[9];
#pragma unroll
    for (int v = 0; v < 9; ++v) acc[v] = 0.f;
    const float* W = p.in[4] + (size_t)l * 1024 * 6144 + col;
    for (int k = kg * 128; k < kg * 128 + 128; ++k) {
      float w = W[(size_t)k * 6144];
#pragma unroll
      for (int v = 0; v < 9; ++v) acc[v] += sv[v * 1024 + k] * w;
    }
#pragma unroll
    for (int v = 0; v < 9; ++v) red[(kg * 9 + v) * 64 + (tid & 63)] = acc[v];
    __syncthreads();
    if (tid < 576) {
      int v = tid >> 6, c = tid & 63;
      float s = p.in[5][l * 6144 + cg_ * 64 + c];
#pragma unroll
      for (int g = 0; g < 8; ++g) s += red[(g * 9 + v) * 64 + c];
      ((float*)(p.ws + O_MOD))[(l * 9 + v) * 6144 + cg_ * 64 + c] = s;
    }
    __syncthreads();
  }
  {
    int base = 0;
    for (int j = 0; j < 18; ++j) {
      int K = TJOBS[j][2], N = TJOBS[j][3];
      int tk = K >> 6, tn = N >> 6, nt = tk * tn;
      const float* src = p.in[TJOBS[j][0]] + TJOBS[j][1];
      u16* dst = (u16*)(p.ws + (size_t)(unsigned)TJOBS[j][4]);
      int first = (blockIdx.x + gridDim.x - (base % gridDim.x)) % gridDim.x;
      for (int t = first; t < nt; t += gridDim.x) {
        int k0 = (t / tn) * 64, n0 = (t % tn) * 64;
#pragma unroll
        for (int rep = 0; rep < 8; ++rep) {
          int idx = tid + NT * rep; int i = idx >> 6, jj = idx & 63;
          fl[i * 65 + jj] = src[(size_t)(k0 + i) * N + n0 + jj];
        }
        __syncthreads();
        int n = tid >> 3, c8 = tid & 7;
        uint4 o;
        o.x = pack2(fl[(c8 * 8 + 0) * 65 + n], fl[(c8 * 8 + 1) * 65 + n]);
        o.y = pack2(fl[(c8 * 8 + 2) * 65 + n], fl[(c8 * 8 + 3) * 65 + n]);
        o.z = pack2(fl[(c8 * 8 + 4) * 65 + n], fl[(c8 * 8 + 5) * 65 + n]);
        o.w = pack2(fl[(c8 * 8 + 6) * 65 + n], fl[(c8 * 8 + 7) * 65 + n]);
        *(uint4*)(dst + (size_t)(n0 + n) * K + k0 + c8 * 8) = o;
        __syncthreads();
      }
      base += nt;
    }
  }
  convert_bf16(p.in[32], (u16*)(p.ws + O_KEYS), (size_t)2 * 8 * 2 * 128 * 128);
  convert_tab_fp8(p.in[33], p.in[34], p.ws + O_TAB0);
  if (blockIdx.x == 0) {
    float* rope = (float*)(p.ws + O_ROPE);
    for (int i = tid; i < 1024; i += NT) {
      int pos = i >> 4, f = i & 15;
      float inv = exp2f(-(float)f * (13.287712379549449f / 16.f));
      float ang = (float)pos * inv;
      rope[i * 2] = cosf(ang);
      rope[i * 2 + 1] = sinf(ang);
    }
  }
}

__device__ __forceinline__ void phase_norm(const P& p, const float* srcL, const float* srcC, const float* gain, int layer, int shift_idx,
                           int nrows, u16* dst) {
  const int lane = tid_() & 63;
  const int gw = blockIdx.x * 8 + (tid_() >> 6), nw = gridDim.x * 8;
  const float* mod = (const float*)(p.ws + O_MOD) + (size_t)layer * 9 * 6144;
  for (int row = gw; row < nrows; row += nw) {
    const float* src = row < NLAT ? srcL + (size_t)row * DM : srcC + (size_t)(row - NLAT) * DM;
    int mi = row < NLAT ? (row >> 12) : 8;
    const float* sh = mod + mi * 6144 + shift_idx * 1024;
    const float* sc = sh + 1024;
    float4 v[4];
    float ss = 0.f;
#pragma unroll
    for (int i = 0; i < 4; ++i) {
      v[i] = *(const float4*)(src + i * 256 + lane * 4);
      ss += v[i].x * v[i].x + v[i].y * v[i].y + v[i].z * v[i].z + v[i].w * v[i].w;
    }
    ss = wave_sum(ss);
    float rs = rsqrtf(ss * (1.f / 1024.f) + 1e-6f);
#pragma unroll
    for (int i = 0; i < 4; ++i) {
      int c = i * 256 + lane * 4;
      float4 g = *(const float4*)(gain + c);
      float4 s1 = *(const float4*)(sc + c);
      float4 s0 = *(const float4*)(sh + c);
      float a = v[i].x * rs * g.x * (1.f + s1.x) + s0.x;
      float b = v[i].y * rs * g.y * (1.f + s1.y) + s0.y;
      float cc = v[i].z * rs * g.z * (1.f + s1.z) + s0.z;
      float d = v[i].w * rs * g.w * (1.f + s1.w) + s0.w;
      uint2 o; o.x = pack2(a, b); o.y = pack2(cc, d);
      *(uint2*)(dst + (size_t)row * DM + c) = o;
    }
  }
}

__device__ __forceinline__ void phase_conv_qk(const P& p) {
  const u16* hgg = (const u16*)(p.ws + O_HGG);
  u16* mix = (u16*)(p.ws + O_XN);
  const float* cw = p.in[9];
  const size_t gt = (size_t)blockIdx.x * NT + tid_(), gn = (size_t)gridDim.x * NT;
  for (size_t it = gt; it < (size_t)TTOK * 64; it += gn) {
    int row = (int)(it >> 6), c0 = (int)(it & 63) * 8;
    int t, len;
    if (row < NLAT) { t = row & 4095; len = 4096; } else { t = (row - NLAT) & 255; len = 256; }
    float pm[8], pc[8], pp[8];
    {
      const u16* b = hgg + (size_t)row * 1536;
      uint4 hh = *(const uint4*)(b + c0), gc = *(const uint4*)(b + 1024 + c0);
      pc[0] = bflo(hh.x) * bflo(gc.x); pc[1] = bfhi(hh.x) * bfhi(gc.x);
      pc[2] = bflo(hh.y) * bflo(gc.y); pc[3] = bfhi(hh.y) * bfhi(gc.y);
      pc[4] = bflo(hh.z) * bflo(gc.z); pc[5] = bfhi(hh.z) * bfhi(gc.z);
      pc[6] = bflo(hh.w) * bflo(gc.w); pc[7] = bfhi(hh.w) * bfhi(gc.w);
    }
    if (t > 0) {
      const u16* b = hgg + (size_t)(row - 1) * 1536;
      uint4 hh = *(const uint4*)(b + c0), gc = *(const uint4*)(b + 1024 + c0);
      pm[0] = bflo(hh.x) * bflo(gc.x); pm[1] = bfhi(hh.x) * bfhi(gc.x);
      pm[2] = bflo(hh.y) * bflo(gc.y); pm[3] = bfhi(hh.y) * bfhi(gc.y);
      pm[4] = bflo(hh.z) * bflo(gc.z); pm[5] = bfhi(hh.z) * bfhi(gc.z);
      pm[6] = bflo(hh.w) * bflo(gc.w); pm[7] = bfhi(hh.w) * bfhi(gc.w);
    } else {
#pragma unroll
      for (int e = 0; e < 8; ++e) pm[e] = 0.f;
    }
    if (t < len - 1) {
      const u16* b = hgg + (size_t)(row + 1) * 1536;
      uint4 hh = *(const uint4*)(b + c0), gc = *(const uint4*)(b + 1024 + c0);
      pp[0] = bflo(hh.x) * bflo(gc.x); pp[1] = bfhi(hh.x) * bfhi(gc.x);
      pp[2] = bflo(hh.y) * bflo(gc.y); pp[3] = bfhi(hh.y) * bfhi(gc.y);
      pp[4] = bflo(hh.z) * bflo(gc.z); pp[5] = bfhi(hh.z) * bfhi(gc.z);
      pp[6] = bflo(hh.w) * bflo(gc.w); pp[7] = bfhi(hh.w) * bfhi(gc.w);
    } else {
#pragma unroll
      for (int e = 0; e < 8; ++e) pp[e] = 0.f;
    }
    uint4 gbv = *(const uint4*)(hgg + (size_t)row * 1536 + 512 + c0);
    float gb[8] = {bflo(gbv.x), bfhi(gbv.x), bflo(gbv.y), bfhi(gbv.y), bflo(gbv.z), bfhi(gbv.z), bflo(gbv.w), bfhi(gbv.w)};
    float o[8];
#pragma unroll
    for (int e = 0; e < 8; ++e)
      o[e] = gb[e] * (cw[c0 + e] * pm[e] + cw[512 + c0 + e] * pc[e] + cw[1024 + c0 + e] * pp[e]);
    uint4 ov; ov.x = pack2(o[0], o[1]); ov.y = pack2(o[2], o[3]); ov.z = pack2(o[4], o[5]); ov.w = pack2(o[6], o[7]);
    *(uint4*)(mix + (size_t)row * DM + c0) = ov;
  }
  u16* Q = (u16*)(p.ws + O_Q);
  u16* KBp = (u16*)(p.ws + O_KB);
  const float* rope = (const float*)(p.ws + O_ROPE);
  const size_t ngroups = (size_t)TTOK * 10;
  for (size_t it = gt; it < ngroups * 8; it += gn) {
    size_t grp = it >> 3; int sub = (int)(it & 7);
    int row = (int)(grp / 10), hd = (int)(grp % 10);
    u16* ptr; const float* gain;
    if (hd < 8) { ptr = Q + (size_t)row * 512 + hd * 64 + sub * 8; gain = p.in[10]; }
    else { ptr = KBp + (size_t)row * 128 + (hd - 8) * 64 + sub * 8; gain = p.in[11]; }
    uint4 v = *(const uint4*)ptr;
    float x[8] = {bflo(v.x), bfhi(v.x), bflo(v.y), bfhi(v.y), bflo(v.z), bfhi(v.z), bflo(v.w), bfhi(v.w)};
    float ss = 0.f;
#pragma unroll
    for (int e = 0; e < 8; ++e) ss += x[e] * x[e];
    ss = red8(ss);
    float rs = rsqrtf(ss * (1.f / 64.f) + 1e-6f);
#pragma unroll
    for (int e = 0; e < 8; ++e) x[e] = x[e] * rs * gain[sub * 8 + e];
    if (row < NLAT) {
      int t = row & 4095; int gr = t >> 6, gc = t & 63;
#pragma unroll
      for (int e = 0; e < 4; ++e) {
        int pi = sub * 4 + e;
        int pos = pi < 16 ? gr : gc; int f = pi & 15;
        float c = rope[(pos * 16 + f) * 2], s = rope[(pos * 16 + f) * 2 + 1];
        float a = x[2 * e], b = x[2 * e + 1];
        x[2 * e] = a * c - b * s;
        x[2 * e + 1] = a * s + b * c;
      }
    }
    uint4 ov; ov.x = pack2(x[0], x[1]); ov.y = pack2(x[2], x[3]); ov.z = pack2(x[4], x[5]); ov.w = pack2(x[6], x[7]);
    *(uint4*)ptr = ov;
  }
}

__device__ __forceinline__ void phase_attn(const P& p, char* lds) {
  u16* sK = (u16*)lds;
  u16* sV = sK + 64 * LDSS;
  const u16* Q = (const u16*)(p.ws + O_Q);
  const u16* KBp = (const u16*)(p.ws + O_KB);
  const u16* VT = (const u16*)(p.ws + O_VT);
  u16* mix = (u16*)(p.ws + O_XN);
  const int tid = tid_(), lane = tid & 63, wave = tid >> 6;
  const int r = lane & 31, h = lane >> 5;
  const float cs = 0.125f * 1.4426950408889634f;
  for (int item = blockIdx.x; item < 1088; item += gridDim.x) {
    int b, qh, qrow0, nkt;
    if (item < 1024) { b = item >> 7; qh = (item >> 4) & 7; qrow0 = b * 4096 + (item & 15) * 256; nkt = 68; }
    else { int i2 = item - 1024; b = i2 >> 3; qh = i2 & 7; qrow0 = NLAT + b * 256; nkt = 4; }
    const int kvh = qh >> 2;
    const int qrow = qrow0 + wave * 32 + r;
    bf16x8 qf[4];
#pragma unroll
    for (int kk = 0; kk < 4; ++kk) qf[kk] = *(const bf16x8*)(Q + (size_t)qrow * 512 + qh * 64 + kk * 16 + h * 8);
    f32x16 o[2];
#pragma unroll
    for (int g = 0; g < 16; ++g) { o[0][g] = 0.f; o[1][g] = 0.f; }
    float m = -INFINITY, l = 0.f;
    const int lkey = tid >> 3, lch = tid & 7;
    uint4 ka, va;
    auto gl = [&](int kt) {
      int pos = kt * 64 + lkey;
      int krow = pos < 256 ? NLAT + b * 256 + pos : b * 4096 + pos - 256;
      ka = *(const uint4*)(KBp + (size_t)krow * 128 + kvh * 64 + lch * 8);
      va = *(const uint4*)(VT + ((size_t)((b * 2 + kvh) * 64 + lkey)) * 4352 + kt * 64 + lch * 8);
    };
    gl(0);
    for (int kt = 0; kt < nkt; ++kt) {
      *(uint4*)(sK + lkey * LDSS + lch * 8) = ka;
      *(uint4*)(sV + lkey * LDSS + lch * 8) = va;
      __syncthreads();
      if (kt + 1 < nkt) gl(kt + 1);
      f32x16 s[2];
#pragma unroll
      for (int g = 0; g < 16; ++g) { s[0][g] = 0.f; s[1][g] = 0.f; }
#pragma unroll
      for (int kb = 0; kb < 2; ++kb)
#pragma unroll
        for (int kk = 0; kk < 4; ++kk) {
          bf16x8 a = *(const bf16x8*)(sK + (kb * 32 + r) * LDSS + kk * 16 + h * 8);
          s[kb] = __builtin_amdgcn_mfma_f32_32x32x16_bf16(a, qf[kk], s[kb], 0, 0, 0);
        }
      float mx = s[0][0];
#pragma unroll
      for (int g = 0; g < 16; ++g) { mx = fmaxf(mx, s[0][g]); mx = fmaxf(mx, s[1][g]); }
      mx = swapmax32(mx);
      float mn = fmaxf(m, mx);
      float alpha = __builtin_amdgcn_exp2f((m - mn) * cs);
      m = mn;
      float mc = mn * cs, ps = 0.f;
#pragma unroll
      for (int kb = 0; kb < 2; ++kb)
#pragma unroll
        for (int g = 0; g < 16; ++g) { float e = __builtin_amdgcn_exp2f(s[kb][g] * cs - mc); s[kb][g] = e; ps += e; }
      l = l * alpha + ps;
#pragma unroll
      for (int g = 0; g < 16; ++g) { o[0][g] *= alpha; o[1][g] *= alpha; }
      bf16x8 pb[2][2];
#pragma unroll
      for (int kb = 0; kb < 2; ++kb)
#pragma unroll
        for (int c = 0; c < 2; ++c) {
          uint4 pk;
          pk.x = pack2(s[kb][8 * c + 0], s[kb][8 * c + 1]); pk.y = pack2(s[kb][8 * c + 2], s[kb][8 * c + 3]);
          pk.z = pack2(s[kb][8 * c + 4], s[kb][8 * c + 5]); pk.w = pack2(s[kb][8 * c + 6], s[kb][8 * c + 7]);
          pb[kb][c] = __builtin_bit_cast(bf16x8, pk);
        }
#pragma unroll
      for (int db = 0; db < 2; ++db)
#pragma unroll
        for (int kb = 0; kb < 2; ++kb)
#pragma unroll
          for (int c = 0; c < 2; ++c) {
            const u16* vp = sV + (db * 32 + r) * LDSS + kb * 32 + 16 * c + 4 * h;
            uint2 lo = *(const uint2*)vp, hi = *(const uint2*)(vp + 8);
            uint4 av = make_uint4(lo.x, lo.y, hi.x, hi.y);
            o[db] = __builtin_amdgcn_mfma_f32_32x32x16_bf16(__builtin_bit_cast(bf16x8, av), pb[kb][c], o[db], 0, 0, 0);
          }
      __syncthreads();
    }
    l = swapsum32(l, l);
    float inv = 1.f / l;
#pragma unroll
    for (int db = 0; db < 2; ++db)
#pragma unroll
      for (int g4 = 0; g4 < 4; ++g4) {
        int d = db * 32 + 8 * g4 + 4 * h;
        uint2 ov;
        ov.x = pack2(o[db][g4 * 4 + 0] * inv, o[db][g4 * 4 + 1] * inv);
        ov.y = pack2(o[db][g4 * 4 + 2] * inv, o[db][g4 * 4 + 3] * inv);
        *(uint2*)(mix + (size_t)qrow * DM + 512 + qh * 64 + d) = ov;
      }
  }
}

__device__ __forceinline__ int fkey(float f) { int b = __float_as_int(f); return b ^ ((b >> 31) & 0x7FFFFFFF); }
__device__ __forceinline__ float keyf(int k) { return __int_as_float(k ^ ((k >> 31) & 0x7FFFFFFF)); }

#define CE_DESC(a, b) { int hi__ = max(a, b); int lo__ = min(a, b); a = hi__; b = lo__; }
#define BITONIC_SORT16(r)                                                          \
  _Pragma("unroll") for (int k_ = 2; k_ <= 16; k_ <<= 1)                           \
    _Pragma("unroll") for (int j_ = k_ >> 1; j_ > 0; j_ >>= 1)                     \
      _Pragma("unroll") for (int i_ = 0; i_ < 16; ++i_) {                          \
        const int l_ = i_ ^ j_;                                                    \
        if (l_ > i_) { if ((i_ & k_) == 0) CE_DESC(r[i_], r[l_]) else CE_DESC(r[l_], r[i_]) } \
      }
#define BITONIC_MERGE16(r)                                                         \
  _Pragma("unroll") for (int j_ = 8; j_ > 0; j_ >>= 1)                             \
    _Pragma("unroll") for (int i_ = 0; i_ < 16; ++i_) {                            \
      const int l_ = i_ ^ j_;                                                      \
      if (l_ > i_) CE_DESC(r[i_], r[l_])                                           \
    }
#define XLANE_MERGE16(r, CTRL)                                                     \
  {                                                                                \
    int o_[16];                                                                    \
    _Pragma("unroll") for (int i_ = 0; i_ < 16; ++i_) o_[i_] = __builtin_amdgcn_update_dpp(0, r[15 - i_], CTRL, 0xF, 0xF, true); \
    _Pragma("unroll") for (int i_ = 0; i_ < 16; ++i_) r[i_] = max(r[i_], o_[i_]);  \
    BITONIC_MERGE16(r)                                                             \
  }
#define SCS 132
__device__ __forceinline__ void phase_peer_topk(const P& p, int layer, const u16* PQ, int ntok, int* IDX, float* GATE, char* lds) {
  float* sc = (float*)lds;
  int* lists = (int*)(lds + 2 * 64 * SCS * 4);
  const int tid = tid_(), lane = tid & 63, wave = tid >> 6;
  const int r = lane & 31, h = lane >> 5;
  const u16* keys = (const u16*)(p.ws + O_KEYS) + (size_t)layer * 8 * 2 * 128 * 128;
  const int ntile = (ntok >> 6) * 8;
  for (int tile = blockIdx.x; tile < ntile; tile += gridDim.x) {
    int hd = tile & 7, row0 = (tile >> 3) * 64;
    {
      int pp = wave >> 2, kb = wave & 3;
      f32x16 acc[2];
#pragma unroll
      for (int g = 0; g < 16; ++g) { acc[0][g] = 0.f; acc[1][g] = 0.f; }
      const u16* kp = keys + ((size_t)(hd * 2 + pp) * 128 + kb * 32 + r) * 128 + h * 8;
      const u16* qp = PQ + (size_t)(row0 + r) * 2048 + hd * 256 + pp * 128 + h * 8;
#pragma unroll
      for (int kk = 0; kk < 8; ++kk) {
        bf16x8 bfr = *(const bf16x8*)(kp + kk * 16);
        bf16x8 a0 = *(const bf16x8*)(qp + kk * 16);
        bf16x8 a1 = *(const bf16x8*)(qp + (size_t)32 * 2048 + kk * 16);
        acc[0] = __builtin_amdgcn_mfma_f32_32x32x16_bf16(a0, bfr, acc[0], 0, 0, 0);
        acc[1] = __builtin_amdgcn_mfma_f32_32x32x16_bf16(a1, bfr, acc[1], 0, 0, 0);
      }
#pragma unroll
      for (int mb = 0; mb < 2; ++mb)
#pragma unroll
        for (int g = 0; g < 16; ++g) {
          int tok = mb * 32 + (g & 3) + 8 * (g >> 2) + 4 * h;
          sc[(pp * 64 + tok) * SCS + kb * 32 + r] = acc[mb][g];
        }
    }
    __syncthreads();
    {
      const int row = tid >> 2, qd = tid & 3;
      const float* rowp = sc + row * SCS + qd;
      int A[16], B[16];
#pragma unroll
      for (int m = 0; m < 16; ++m) {
        A[m] = (fkey(rowp[4 * m]) & ~0x7F) | (127 - (4 * m + qd));
        B[m] = (fkey(rowp[64 + 4 * m]) & ~0x7F) | (127 - (64 + 4 * m + qd));
      }
      BITONIC_SORT16(A)
      BITONIC_SORT16(B)
#pragma unroll
      for (int i = 0; i < 16; ++i) A[i] = max(A[i], B[15 - i]);
      BITONIC_MERGE16(A)
      XLANE_MERGE16(A, 0xB1)
      XLANE_MERGE16(A, 0x4E)
      if (qd == 0) {
#pragma unroll
        for (int i = 0; i < 16; i += 4) *(int4*)(lists + row * 16 + i) = make_int4(A[i], A[i + 1], A[i + 2], A[i + 3]);
      }
    }
    __syncthreads();
    if (tid < 256) {
      const int tok = tid >> 2, q = tid & 3;
      float bq[16];
#pragma unroll
      for (int j = 0; j < 16; ++j) bq[j] = keyf(lists[(64 + tok) * 16 + j] & ~0x7F);
      int R[16];
#pragma unroll
      for (int i = 0; i < 16; ++i) R[i] = (int)0x80000000;
#pragma unroll
      for (int m = 0; m < 4; ++m) {
        const int i = q + 4 * m;
        const float ai = keyf(lists[tok * 16 + i] & ~0x7F);
        const int jmax = 16 / (i + 1);
        const int nj = m == 0 ? 16 : (m == 1 ? 3 : 1);
#pragma unroll
        for (int j = 0; j < nj; ++j) {
          int x = (fkey(ai + bq[j]) & ~0xFF) | (255 - (i * 16 + j));
          x = j < jmax ? x : (int)0x80000000;
#pragma unroll
          for (int t = 0; t < 16; ++t) { int hi_ = max(R[t], x); x = min(R[t], x); R[t] = hi_; }
        }
      }
      XLANE_MERGE16(R, 0xB1)
      XLANE_MERGE16(R, 0x4E)
      float sv[16];
      float mx = keyf(R[0] & ~0xFF), sum = 0.f;
#pragma unroll
      for (int t = 0; t < 16; ++t) { sv[t] = __expf(keyf(R[t] & ~0xFF) - mx); sum += sv[t]; }
      float inv = 1.f / sum;
      size_t ob = (size_t)(row0 + tok) * 128 + hd * 16;
#pragma unroll
      for (int t = 0; t < 16; ++t) {
        if ((t >> 2) == q) {
          int pos = 255 - (R[t] & 0xFF);
          int i1 = 127 - (lists[tok * 16 + (pos >> 4)] & 0x7F);
          int i2 = 127 - (lists[(64 + tok) * 16 + (pos & 15)] & 0x7F);
          IDX[ob + t] = i1 * 128 + i2;
          GATE[ob + t] = sv[t] * inv;
        }
      }
    }
    __syncthreads();
  }
}

typedef __attribute__((ext_vector_type(2))) float f2;
#define TAB_V8 (16 * MiB)
#define TAB_SU (32 * MiB)
#define TAB_SV (32 * MiB + 65536)
__device__ __forceinline__ float wave_max(float v) {
  v = fmaxf(v, dppf<0xB1>(v)); v = fmaxf(v, dppf<0x4E>(v)); v = fmaxf(v, dppf<0x141>(v)); v = fmaxf(v, dppf<0x140>(v));
  v = swapmax16(v); v = swapmax32(v);
  return v;
}
__device__ __forceinline__ void convert_tab_fp8(const float* __restrict__ U, const float* __restrict__ V, char* tab) {
  const int lane = tid_() & 63;
  const int gw = blockIdx.x * 8 + (tid_() >> 6), nw = gridDim.x * 8;
  for (int rr = gw; rr < 32768; rr += nw) {
    const int isv = rr >> 14, e = rr & 16383;
    const float* src = (isv ? V : U) + (size_t)e * 1024 + lane * 16;
    float4 v0 = *(const float4*)src, v1 = *(const float4*)(src + 4), v2 = *(const float4*)(src + 8), v3 = *(const float4*)(src + 12);
    float am = fmaxf(fmaxf(fmaxf(fabsf(v0.x), fabsf(v0.y)), fmaxf(fabsf(v0.z), fabsf(v0.w))),
                     fmaxf(fmaxf(fabsf(v1.x), fabsf(v1.y)), fmaxf(fabsf(v1.z), fabsf(v1.w))));
    am = fmaxf(am, fmaxf(fmaxf(fmaxf(fabsf(v2.x), fabsf(v2.y)), fmaxf(fabsf(v2.z), fabsf(v2.w))),
                         fmaxf(fmaxf(fabsf(v3.x), fabsf(v3.y)), fmaxf(fabsf(v3.z), fabsf(v3.w)))));
    am = wave_max(am);
    float sc = am > 0.f ? 448.f / am : 1.f;
    uint4 o;
    int t = 0;
    t = __builtin_amdgcn_cvt_pk_fp8_f32(v0.x * sc, v0.y * sc, t, false); t = __builtin_amdgcn_cvt_pk_fp8_f32(v0.z * sc, v0.w * sc, t, true); o.x = t;
    t = __builtin_amdgcn_cvt_pk_fp8_f32(v1.x * sc, v1.y * sc, t, false); t = __builtin_amdgcn_cvt_pk_fp8_f32(v1.z * sc, v1.w * sc, t, true); o.y = t;
    t = __builtin_amdgcn_cvt_pk_fp8_f32(v2.x * sc, v2.y * sc, t, false); t = __builtin_amdgcn_cvt_pk_fp8_f32(v2.z * sc, v2.w * sc, t, true); o.z = t;
    t = __builtin_amdgcn_cvt_pk_fp8_f32(v3.x * sc, v3.y * sc, t, false); t = __builtin_amdgcn_cvt_pk_fp8_f32(v3.z * sc, v3.w * sc, t, true); o.w = t;
    if (!isv) {
      *(uint4*)(tab + (size_t)e * 1024 + lane * 16) = o;
      if (lane == 0) ((float*)(tab + TAB_SU))[e] = am > 0.f ? am / 448.f : 1.f;
    } else {
      *(uint4*)(tab + TAB_V8 + ((size_t)(lane >> 3) * 16384 + e) * 128 + (lane & 7) * 16) = o;
      if (lane == 0) ((float*)(tab + TAB_SV))[e] = am > 0.f ? am / 448.f : 1.f;
    }
  }
}
__device__ __forceinline__ f2 dec8(unsigned w, bool hi) { return hi ? __builtin_amdgcn_cvt_pk_f32_fp8((int)w, true) : __builtin_amdgcn_cvt_pk_f32_fp8((int)w, false); }

__device__ __forceinline__ float dot16(uint4 w, f2 a0, f2 a1, f2 a2, f2 a3, f2 a4, f2 a5, f2 a6, f2 a7) {
  f2 a = f2{0.f, 0.f};
  a = __builtin_elementwise_fma(dec8(w.x, false), a0, a); a = __builtin_elementwise_fma(dec8(w.x, true), a1, a);
  a = __builtin_elementwise_fma(dec8(w.y, false), a2, a); a = __builtin_elementwise_fma(dec8(w.y, true), a3, a);
  a = __builtin_elementwise_fma(dec8(w.z, false), a4, a); a = __builtin_elementwise_fma(dec8(w.z, true), a5, a);
  a = __builtin_elementwise_fma(dec8(w.w, false), a6, a); a = __builtin_elementwise_fma(dec8(w.w, true), a7, a);
  return a.x + a.y;
}
#define DOT16(W) dot16(W, xf0, xf1, xf2, xf3, xf4, xf5, xf6, xf7)
__device__ __forceinline__ void phase_peer_act(const P& p, const u16* XN2, const char* tab, const int* IDX, const float* GATE, float* COEF, int ntok, char* lds) {
  const int tid = tid_(), lane = tid & 63, wave = tid >> 6;
  int* le = (int*)(lds + wave * 1536);
  float* lg = (float*)(le + 128);
  int* ls = le + 256;
  const int part = blockIdx.x & 7;
  const int wv = (blockIdx.x >> 3) * 8 + wave, nwv = (gridDim.x >> 3) * 8;
  const float* SU = (const float*)(tab + TAB_SU);
  const float* SV = (const float*)(tab + TAB_SV);
  const int q = lane >> 4;
  const bool hi = (lane & 32) != 0, b4 = (lane & 16) != 0;
  int i0 = 0, i1 = 0; float g0 = 0.f, g1 = 0.f; uint4 x0 = make_uint4(0, 0, 0, 0), x1 = x0;
  if (wv < ntok) {
    i0 = IDX[(size_t)wv * 128 + lane]; i1 = IDX[(size_t)wv * 128 + 64 + lane];
    g0 = GATE[(size_t)wv * 128 + lane]; g1 = GATE[(size_t)wv * 128 + 64 + lane];
    const u16* xr = XN2 + (size_t)wv * DM + lane * 16;
    x0 = *(const uint4*)xr; x1 = *(const uint4*)(xr + 8);
  }
  for (int tok = wv; tok < ntok; tok += nwv) {
    int ni0 = 0, ni1 = 0; float ng0 = 0.f, ng1 = 0.f; uint4 nx0 = make_uint4(0, 0, 0, 0), nx1 = nx0;
    const int nt = tok + nwv;
    if (nt < ntok) {
      ni0 = IDX[(size_t)nt * 128 + lane]; ni1 = IDX[(size_t)nt * 128 + 64 + lane];
      ng0 = GATE[(size_t)nt * 128 + lane]; ng1 = GATE[(size_t)nt * 128 + 64 + lane];
      const u16* xr = XN2 + (size_t)nt * DM + lane * 16;
      nx0 = *(const uint4*)xr; nx1 = *(const uint4*)(xr + 8);
    }
    const bool s0 = (i0 >> 11) == part, s1 = (i1 >> 11) == part;
    const unsigned long long m0 = __ballot(s0), m1 = __ballot(s1);
    const int c0 = __popcll(m0), cnt = c0 + __popcll(m1);
    const int p0 = __builtin_amdgcn_mbcnt_hi((unsigned)(m0 >> 32), __builtin_amdgcn_mbcnt_lo((unsigned)m0, 0));
    const int p1 = c0 + __builtin_amdgcn_mbcnt_hi((unsigned)(m1 >> 32), __builtin_amdgcn_mbcnt_lo((unsigned)m1, 0));
    if (s0) { le[p0] = i0; lg[p0] = g0; ls[p0] = lane; }
    if (s1) { le[p1] = i1; lg[p1] = g1; ls[p1] = 64 + lane; }
    const int cntp = (cnt + 3) & ~3;
    if (lane < cntp - cnt) { le[cnt + lane] = part << 11; lg[cnt + lane] = 0.f; ls[cnt + lane] = -1; }
    const f2 xf0 = f2{bflo(x0.x), bfhi(x0.x)}, xf1 = f2{bflo(x0.y), bfhi(x0.y)}, xf2 = f2{bflo(x0.z), bfhi(x0.z)}, xf3 = f2{bflo(x0.w), bfhi(x0.w)};
    const f2 xf4 = f2{bflo(x1.x), bfhi(x1.x)}, xf5 = f2{bflo(x1.y), bfhi(x1.y)}, xf6 = f2{bflo(x1.z), bfhi(x1.z)}, xf7 = f2{bflo(x1.w), bfhi(x1.w)};
    for (int base = 0; base < cntp; base += 24) {
      uint4 w[24];
      const int evl = le[base + (lane < 24 ? lane : 0)];
#pragma unroll
      for (int gq = 0; gq < 6; ++gq) {
        if (base + 4 * gq < cntp) {
#pragma unroll
          for (int k = 0; k < 4; ++k) {
            int e = __builtin_amdgcn_readlane(evl, 4 * gq + k);
            w[4 * gq + k] = *(const uint4*)(tab + (size_t)e * 1024 + lane * 16);
          }
        } else {
#pragma unroll
          for (int k = 0; k < 4; ++k) w[4 * gq + k] = make_uint4(0, 0, 0, 0);
        }
      }
#pragma unroll
      for (int gq = 0; gq < 6; ++gq) {
        if (base + 4 * gq < cntp) {
          float d0 = DOT16(w[4 * gq]), d1 = DOT16(w[4 * gq + 1]), d2 = DOT16(w[4 * gq + 2]), d3 = DOT16(w[4 * gq + 3]);
          float kA = swapsum32(d0, d2), kB = swapsum32(d1, d3);
          float kC = swapsum16(kA, kB);
          kC = red16(kC);
          const int j = base + 4 * gq + q;
          const int e = le[j]; const float gt = lg[j]; const int slot = ls[j];
          float act = kC * SU[e];
          float coef = gt * 0.5f * act * (1.f + erff(act * 0.70710678118654752f)) * SV[e];
          if ((lane & 15) == 0 && slot >= 0) COEF[(size_t)tok * 128 + slot] = coef;
        }
      }
    }
    i0 = ni0; i1 = ni1; g0 = ng0; g1 = ng1; x0 = nx0; x1 = nx1;
  }
}

__device__ __forceinline__ void phase_peer_sum(const P& p, int layer, const char* tab, const int* IDX, const float* COEF, int ntok, float* dummy_dst) {
  const int tid = tid_(), lane = tid & 63, wave = tid >> 6;
  const int sl = blockIdx.x & 7;
  const int wv = (blockIdx.x >> 3) * 8 + wave, nwv = (gridDim.x >> 3) * 8;
  const int g = lane >> 3, ch = lane & 7;
  const char* V8 = tab + TAB_V8 + (size_t)sl * 16384 * 128 + ch * 16;
  const float* mod = (const float*)(p.ws + O_MOD) + (size_t)layer * 9 * 6144;
  float* HC = (float*)(p.ws + O_HC);
  const bool b5 = (lane & 32) != 0, b4 = (lane & 16) != 0, b3 = (lane & 8) != 0;
  const int c = sl * 128 + ch * 16 + (b5 ? 8 : 0) + (b4 ? 4 : 0) + (b3 ? 2 : 0);
  uint4 ia, ib, ic, id; float4 ca, cb, cc, cd;
  ia = ib = ic = id = make_uint4(0, 0, 0, 0); ca = cb = cc = cd = make_float4(0, 0, 0, 0);
  if (wv < ntok) {
    const int* ip = IDX + (size_t)wv * 128 + g * 16;
    const float* cp = COEF + (size_t)wv * 128 + g * 16;
    ia = *(const uint4*)ip; ib = *(const uint4*)(ip + 4); ic = *(const uint4*)(ip + 8); id = *(const uint4*)(ip + 12);
    ca = *(const float4*)cp; cb = *(const float4*)(cp + 4); cc = *(const float4*)(cp + 8); cd = *(const float4*)(cp + 12);
  }
  for (int tok = wv; tok < ntok; tok += nwv) {
    const unsigned ev[16] = {ia.x, ia.y, ia.z, ia.w, ib.x, ib.y, ib.z, ib.w, ic.x, ic.y, ic.z, ic.w, id.x, id.y, id.z, id.w};
    const float cv[16] = {ca.x, ca.y, ca.z, ca.w, cb.x, cb.y, cb.z, cb.w, cc.x, cc.y, cc.z, cc.w, cd.x, cd.y, cd.z, cd.w};
    uint4 w[16];
#pragma unroll
    for (int i = 0; i < 16; ++i) w[i] = *(const uint4*)(V8 + (size_t)ev[i] * 128);
    float* dst = (dummy_dst ? dummy_dst + (size_t)tok * DM : (tok < NLAT ? p.out + (size_t)tok * DM : HC + (size_t)(tok - NLAT) * DM)) + c;
    float2 o = *(float2*)dst;
    const int nt = tok + nwv;
    if (nt < ntok) {
      const int* ip = IDX + (size_t)nt * 128 + g * 16;
      const float* cp = COEF + (size_t)nt * 128 + g * 16;
      ia = *(const uint4*)ip; ib = *(const uint4*)(ip + 4); ic = *(const uint4*)(ip + 8); id = *(const uint4*)(ip + 12);
      ca = *(const float4*)cp; cb = *(const float4*)(cp + 4); cc = *(const float4*)(cp + 8); cd = *(const float4*)(cp + 12);
    }
    f2 acc[8];
#pragma unroll
    for (int k = 0; k < 8; ++k) acc[k] = f2{0.f, 0.f};
#pragma unroll
    for (int i = 0; i < 16; ++i) {
      f2 c2 = f2{cv[i], cv[i]};
      acc[0] = __builtin_elementwise_fma(dec8(w[i].x, false), c2, acc[0]); acc[1] = __builtin_elementwise_fma(dec8(w[i].x, true), c2, acc[1]);
      acc[2] = __builtin_elementwise_fma(dec8(w[i].y, false), c2, acc[2]); acc[3] = __builtin_elementwise_fma(dec8(w[i].y, true), c2, acc[3]);
      acc[4] = __builtin_elementwise_fma(dec8(w[i].z, false), c2, acc[4]); acc[5] = __builtin_elementwise_fma(dec8(w[i].z, true), c2, acc[5]);
      acc[6] = __builtin_elementwise_fma(dec8(w[i].w, false), c2, acc[6]); acc[7] = __builtin_elementwise_fma(dec8(w[i].w, true), c2, acc[7]);
    }
    float r8[8];
#pragma unroll
    for (int k = 0; k < 4; ++k) {
      r8[2 * k] = swapsum32(acc[k].x, acc[4 + k].x);
      r8[2 * k + 1] = swapsum32(acc[k].y, acc[4 + k].y);
    }
    float r4[4];
#pragma unroll
    for (int k = 0; k < 4; ++k) r4[k] = swapsum16(r8[k], r8[4 + k]);
    float r2[2];
#pragma unroll
    for (int k = 0; k < 2; ++k) {
      float kx = b3 ? r4[2 + k] : r4[k], sx = b3 ? r4[k] : r4[2 + k];
      r2[k] = kx + dppf<0x128>(sx);
    }
    const int mi = tok < NLAT ? (tok >> 12) : 8;
    const float2 mv = *(const float2*)(mod + mi * 6144 + 5 * 1024 + c);
    o.x += mv.x * r2[0]; o.y += mv.y * r2[1];
    *(float2*)dst = o;
  }
}

__device__ __forceinline__ void phase_scan(const P& p, char* lds, bool dummy) {
  float* buf = (float*)lds;
  float* vbuf = (float*)(lds + 81920);
  u16* ybuf = (u16*)(lds + 81920 + 16384);
  const int tid = tid_(), lane = tid & 63, wave = tid >> 6;
  const int c = lane & 7, irow = wave * 8 + (lane >> 3);
  const u16* R = (const u16*)(p.ws + O_R);
  const u16* Kp = (const u16*)(p.ws + O_K);
  const u16* Vp = (const u16*)(p.ws + O_V);
  const int ps = tid >> 4, col4 = (tid & 15) * 4;
  for (int item = blockIdx.x; item < 256; item += gridDim.x) {
    const int dir = item & 1, hh = (item >> 1) & 15, b = item >> 5;
    char* WA = p.ws + (dir ? O_WA1 : O_WA0);
    float* BON = (float*)(p.ws + O_BONUS) + (size_t)dir * NLAT * 16;
    float kkc[4], kac[4], rkc[4];
#pragma unroll
    for (int e = 0; e < 4; ++e) {
      kkc[e] = p.in[20][hh * 64 + col4 + e];
      kac[e] = p.in[21][hh * 64 + col4 + e];
      rkc[e] = p.in[22][hh * 64 + col4 + e];
    }
    auto rowof = [&](int s) -> int {
      if (s < 256) { int pos = dir ? 255 - s : s; return NLAT + b * 256 + pos; }
      int u = s - 256; int pos = dir ? 4095 - u : u; return b * 4096 + pos;
    };
    uint2 pr, pk, pv; unsigned pw, pa; int prow;
    auto gload = [&](int ch) {
      prow = rowof(ch * 32 + ps);
      size_t o = (size_t)prow * 1024 + hh * 64 + col4;
      pr = *(const uint2*)(R + o); pk = *(const uint2*)(Kp + o); pv = *(const uint2*)(Vp + o);
      const char* wp = WA + (size_t)prow * 2048 + hh * 128;
      pw = *(const unsigned*)(wp + col4); pa = *(const unsigned*)(wp + 64 + col4);
    };
    auto prep = [&](int bi) {
      float rr[4] = {bflo(pr.x), bfhi(pr.x), bflo(pr.y), bfhi(pr.y)};
      float kq[4] = {bflo(pk.x), bfhi(pk.x), bflo(pk.y), bfhi(pk.y)};
      float4 vv = make_float4(bflo(pv.x), bfhi(pv.x), bflo(pv.y), bfhi(pv.y));
      float w[4], a[4], kr[4], kk[4], bb[4], kd[4];
      float ss = 0.f;
#pragma unroll
      for (int e = 0; e < 4; ++e) {
        w[e] = 0.5f + (float)((pw >> (8 * e)) & 255u) * (1.f / 510.f);
        a[e] = (float)((pa >> (8 * e)) & 255u) * (1.f / 255.f);
        kr[e] = kq[e] * kkc[e];
        ss += kr[e] * kr[e];
      }
      ss = red16(ss);
      float inv = rsqrtf(ss + 1e-12f);
      float bn = 0.f;
#pragma unroll
      for (int e = 0; e < 4; ++e) {
        kk[e] = kr[e] * inv;
        bb[e] = kk[e] * a[e];
        kd[e] = kq[e] * (1.f + (a[e] - 1.f) * kac[e]);
        bn += rr[e] * kd[e] * rkc[e];
      }
      bn = red16(bn);
      if ((tid & 15) == 0 && prow < NLAT) BON[(size_t)prow * 16 + hh] = bn;
      float* d = buf + bi * 10240 + ((ps * 8 + (col4 >> 3)) * 5) * 8 + (col4 & 7);
      *(float4*)(d) = make_float4(rr[0], rr[1], rr[2], rr[3]);
      *(float4*)(d + 8) = make_float4(w[0], w[1], w[2], w[3]);
      *(float4*)(d + 16) = make_float4(kk[0], kk[1], kk[2], kk[3]);
      *(float4*)(d + 24) = make_float4(bb[0], bb[1], bb[2], bb[3]);
      *(float4*)(d + 32) = make_float4(kd[0], kd[1], kd[2], kd[3]);
      *(float4*)(vbuf + bi * 2048 + ps * 64 + col4) = vv;
    };
    float S[8];
#pragma unroll
    for (int j = 0; j < 8; ++j) S[j] = 0.f;
    gload(0);
    prep(0);
    __syncthreads();
    for (int ch = 0; ch < 136; ++ch) {
      const int cur = ch & 1;
      if (ch + 1 < 136) gload(ch + 1);
      const float* bq = buf + cur * 10240 + c * 40;
      const float* vq = vbuf + cur * 2048 + irow;
      float4 nr0, nr1, nw0, nw1, nk0, nk1, nb0, nb1, nd0, nd1; float nvi;
      {
        const float* q = bq;
        nr0 = *(const float4*)(q); nr1 = *(const float4*)(q + 4); nw0 = *(const float4*)(q + 8); nw1 = *(const float4*)(q + 12);
        nk0 = *(const float4*)(q + 16); nk1 = *(const float4*)(q + 20); nb0 = *(const float4*)(q + 24); nb1 = *(const float4*)(q + 28);
        nd0 = *(const float4*)(q + 32); nd1 = *(const float4*)(q + 36); nvi = vq[0];
      }
#pragma unroll 4
      for (int t = 0; t < 32; ++t) {
        const float4 r0 = nr0, r1 = nr1, w0 = nw0, w1 = nw1, k0 = nk0, k1 = nk1, b0 = nb0, b1 = nb1, d0 = nd0, d1 = nd1;
        const float vi = nvi;
        if (t + 1 < 32) {
          const float* q = bq + (t + 1) * 320;
          nr0 = *(const float4*)(q); nr1 = *(const float4*)(q + 4); nw0 = *(const float4*)(q + 8); nw1 = *(const float4*)(q + 12);
          nk0 = *(const float4*)(q + 16); nk1 = *(const float4*)(q + 20); nb0 = *(const float4*)(q + 24); nb1 = *(const float4*)(q + 28);
          nd0 = *(const float4*)(q + 32); nd1 = *(const float4*)(q + 36); nvi = vq[(t + 1) * 64];
        }
        float sa = (S[0] * k0.x + S[1] * k0.y) + (S[2] * k0.z + S[3] * k0.w) + ((S[4] * k1.x + S[5] * k1.y) + (S[6] * k1.z + S[7] * k1.w));
        sa = red8(sa);
        S[0] = fmaf(S[0], w0.x, fmaf(-sa, b0.x, vi * d0.x));
        S[1] = fmaf(S[1], w0.y, fmaf(-sa, b0.y, vi * d0.y));
        S[2] = fmaf(S[2], w0.z, fmaf(-sa, b0.z, vi * d0.z));
        S[3] = fmaf(S[3], w0.w, fmaf(-sa, b0.w, vi * d0.w));
        S[4] = fmaf(S[4], w1.x, fmaf(-sa, b1.x, vi * d1.x));
        S[5] = fmaf(S[5], w1.y, fmaf(-sa, b1.y, vi * d1.y));
        S[6] = fmaf(S[6], w1.z, fmaf(-sa, b1.z, vi * d1.z));
        S[7] = fmaf(S[7], w1.w, fmaf(-sa, b1.w, vi * d1.w));
        float y = (S[0] * r0.x + S[1] * r0.y) + (S[2] * r0.z + S[3] * r0.w) + ((S[4] * r1.x + S[5] * r1.y) + (S[6] * r1.z + S[7] * r1.w));
        y = red8(y);
        if (c == 0) ybuf[t * 64 + irow] = f2bf(y);
      }
      __syncthreads();
      if (ch >= 8 && !dummy) {
        int row = rowof(ch * 32 + ps);
        uint2 yv = *(const uint2*)(ybuf + ps * 64 + col4);
        *(uint2*)(WA + (size_t)row * 2048 + hh * 128 + col4 * 2) = yv;
      }
      if (ch + 1 < 136) prep(cur ^ 1);
      __syncthreads();
    }
  }
}

__device__ __forceinline__ void phase_readout(const P& p) {
  const u16* Vp = (const u16*)(p.ws + O_V);
  const u16* G = (const u16*)(p.ws + O_G);
  u16* Z = (u16*)(p.ws + O_Z);
  const float* BON = (const float*)(p.ws + O_BONUS);
  const size_t gt = (size_t)blockIdx.x * NT + tid_(), gn = (size_t)gridDim.x * NT;
  for (size_t it = gt; it < (size_t)NLAT * 16 * 8; it += gn) {
    int sub = (int)(it & 7); size_t grp = it >> 3;
    int hh = (int)(grp & 15); int row = (int)(grp >> 4);
    uint4 y0 = *(const uint4*)(p.ws + O_WA0 + (size_t)row * 2048 + hh * 128 + sub * 16);
    uint4 y1 = *(const uint4*)(p.ws + O_WA1 + (size_t)row * 2048 + hh * 128 + sub * 16);
    float y[8] = {bflo(y0.x) + bflo(y1.x), bfhi(y0.x) + bfhi(y1.x), bflo(y0.y) + bflo(y1.y), bfhi(y0.y) + bfhi(y1.y),
                  bflo(y0.z) + bflo(y1.z), bfhi(y0.z) + bfhi(y1.z), bflo(y0.w) + bflo(y1.w), bfhi(y0.w) + bfhi(y1.w)};
    float s = 0.f;
#pragma unroll
    for (int e = 0; e < 8; ++e) s += y[e];
    float mean = red8(s) * (1.f / 64.f);
    float vs = 0.f;
#pragma unroll
    for (int e = 0; e < 8; ++e) { y[e] -= mean; vs += y[e] * y[e]; }
    float var = red8(vs) * (1.f / 64.f);
    float rs = rsqrtf(var + 64e-5f);
    float bonus = BON[(size_t)row * 16 + hh] + BON[(size_t)NLAT * 16 + (size_t)row * 16 + hh];
    int col = hh * 64 + sub * 8;
    uint4 vv = *(const uint4*)(Vp + (size_t)row * DM + col);
    uint4 gg = *(const uint4*)(G + (size_t)row * DM + col);
    float vf[8] = {bflo(vv.x), bfhi(vv.x), bflo(vv.y), bfhi(vv.y), bflo(vv.z), bfhi(vv.z), bflo(vv.w), bfhi(vv.w)};
    float gf[8] = {bflo(gg.x), bfhi(gg.x), bflo(gg.y), bfhi(gg.y), bflo(gg.z), bfhi(gg.z), bflo(gg.w), bfhi(gg.w)};
    float z[8];
#pragma unroll
    for (int e = 0; e < 8; ++e) z[e] = (y[e] * rs * p.in[29][col + e] + p.in[30][col + e] + bonus * vf[e]) * gf[e];
    uint4 ov; ov.x = pack2(z[0], z[1]); ov.y = pack2(z[2], z[3]); ov.z = pack2(z[4], z[5]); ov.w = pack2(z[6], z[7]);
    *(uint4*)(Z + (size_t)row * DM + col) = ov;
  }
}

__global__ void __launch_bounds__(NT) fwd_kernel(P p) {
  extern __shared__ __attribute__((aligned(16))) char lds[];
  cg::grid_group grid = cg::this_grid();
  char* ws = p.ws;
  const float* mod0 = (const float*)(ws + O_MOD);
  const float* mod1 = mod0 + 9 * 6144;
  for (int ph = p.ph_lo; ph < p.ph_hi; ++ph) {
    if (ph > p.ph_lo) grid.sync();
    if (!((PHASE_MASK >> ph) & 1)) continue;
    const int nrep = ((REPEAT_MASK >> ph) & 1) ? 2 : 1;
    for (int rep = 0; rep < nrep; ++rep) {
    const bool dummy = rep + 1 < nrep;
    if (rep) grid.sync();
    switch (ph) {
      case 0: phase_prep(p, lds); break;
      case 1: phase_norm(p, p.in[0], p.in[2], p.in[6], 0, 0, TTOK, (u16*)(ws + O_XN)); break;
      case 2: {
        u16* hgg = (u16*)(ws + O_HGG); u16* Q = (u16*)(ws + O_Q); u16* KBp = (u16*)(ws + O_KB); u16* VT = (u16*)(ws + O_VT);
        for (int t = blockIdx.x; t < 136 * 18; t += gridDim.x) {
          int mt = t / 18, nt = t % 18;
          int n0 = nt * 128;
          auto epi = [&](int row, int col, float v0, float v1, float v2, float v3) {
            int n = n0 + col;
            float v[4] = {v0, v1, v2, v3};
            if (n < 1536) {
#pragma unroll
              for (int j = 0; j < 4; ++j) hgg[(size_t)(row + j) * 1536 + n] = f2bf(v[j]);
            } else if (n < 2048) {
#pragma unroll
              for (int j = 0; j < 4; ++j) Q[(size_t)(row + j) * 512 + n - 1536] = f2bf(v[j]);
            } else if (n < 2176) {
#pragma unroll
              for (int j = 0; j < 4; ++j) KBp[(size_t)(row + j) * 128 + n - 2048] = f2bf(v[j]);
            } else {
              int kvh = (n - 2176) >> 6, d = (n - 2176) & 63;
              int b, pos;
              if (row < NLAT) { b = row >> 12; pos = 256 + (row & 4095); } else { b = (row - NLAT) >> 8; pos = (row - NLAT) & 255; }
              uint2 o; o.x = pack2(v0, v1); o.y = pack2(v2, v3);
              *(uint2*)(VT + ((size_t)((b * 2 + kvh) * 64 + d)) * 4352 + pos) = o;
            }
          };
          gemm_tile<false>((const u16*)(ws + O_XN), 1024, nullptr, (const u16*)(ws + O_WIN) + (size_t)n0 * 1024, 1024, 1024,
                           mt * 256, epi, (u16*)lds);
        }
      } break;
      case 3: phase_conv_qk(p); break;
      case 4: phase_attn(p, lds); break;
      case 5: {
        float* HC = (float*)(ws + O_HC);
        for (int t = blockIdx.x; t < 136 * 8; t += gridDim.x) {
          int mt = t / 8, nt = t % 8;
          int n0 = nt * 128;
          auto epi = [&](int row, int col, float v0, float v1, float v2, float v3) {
            int n = n0 + col;
            float v[4] = {v0, v1, v2, v3};
#pragma unroll
            for (int j = 0; j < 4; ++j) {
              int rw = row + j;
              if (rw < NLAT) {
                float g = mod0[(rw >> 12) * 6144 + 2048 + n];
                p.out[(size_t)rw * DM + n] = p.in[0][(size_t)rw * DM + n] + g * v[j];
              } else {
                float g = mod0[8 * 6144 + 2048 + n];
                HC[(size_t)(rw - NLAT) * DM + n] = p.in[2][(size_t)(rw - NLAT) * DM + n] + g * v[j];
              }
            }
          };
          gemm_tile<false>((const u16*)(ws + O_XN), 1024, nullptr, (const u16*)(ws + O_WOUT) + (size_t)n0 * 1024, 1024, 1024,
                           mt * 256, epi, (u16*)lds);
        }
      } break;
      case 6: phase_norm(p, p.out, (const float*)(ws + O_HC), p.in[7], 0, 3, TTOK, (u16*)(ws + O_XN)); break;
      case 7: case 18: {
        int layer = ph == 7 ? 0 : 1;
        int mtiles = layer == 0 ? 136 : 128;
        u16* PQ = (u16*)(ws + (layer == 0 ? O_PQ0 : O_PQ1));
        const u16* Wq = (const u16*)(ws + O_WQ) + (size_t)layer * 2048 * 1024;
        for (int t = blockIdx.x; t < mtiles * 16; t += gridDim.x) {
          int mt = t / 16, nt = t % 16;
          int n0 = nt * 128;
          auto epi = [&](int row, int col, float v0, float v1, float v2, float v3) {
            int n = n0 + col;
            float v[4] = {v0, v1, v2, v3};
#pragma unroll
            for (int j = 0; j < 4; ++j) PQ[(size_t)(row + j) * 2048 + n] = f2bf(v[j]);
          };
          gemm_tile<false>((const u16*)(ws + O_XN), 1024, nullptr, Wq + (size_t)n0 * 1024, 1024, 1024, mt * 256, epi, (u16*)lds);
        }
      } break;
      case 8: phase_peer_topk(p, 0, (const u16*)(ws + O_PQ0), TTOK, (int*)(ws + O_IDX0), (float*)(ws + O_GATE0), lds); break;
      case 9: phase_peer_act(p, (const u16*)(ws + O_XN), ws + O_TAB0, (const int*)(ws + O_IDX0), (const float*)(ws + O_GATE0),
                             (float*)(ws + O_COEF0), TTOK, lds); break;
      case 10: phase_peer_sum(p, 0, ws + O_TAB0, (const int*)(ws + O_IDX0), (const float*)(ws + O_COEF0), TTOK, dummy ? (float*)(ws + O_A2R) : nullptr); break;
      case 11: phase_norm(p, p.out, (const float*)(ws + O_HC), p.in[6] + 1024, 1, 0, TTOK, (u16*)(ws + O_XN)); break;
      case 12: {
        u16* LORA = (u16*)(ws + O_LORA);
        for (int t = blockIdx.x; t < 136 * 27; t += gridDim.x) {
          int mt = t / 27, nt = t % 27;
          const u16* Bp; int mixi; u16* dstp = nullptr; int kind;
          if (nt < 8) { Bp = (const u16*)(ws + O_WR) + (size_t)nt * 128 * 1024; mixi = 0; dstp = (u16*)(ws + O_R) + nt * 128; kind = 0; }
          else if (nt < 16) { Bp = (const u16*)(ws + O_WK) + (size_t)(nt - 8) * 128 * 1024; mixi = 2; dstp = (u16*)(ws + O_K) + (nt - 8) * 128; kind = 0; }
          else if (nt < 24) { Bp = (const u16*)(ws + O_WV) + (size_t)(nt - 16) * 128 * 1024; mixi = 3; dstp = (u16*)(ws + O_V) + (nt - 16) * 128; kind = 0; }
          else if (nt == 24) { Bp = (const u16*)(ws + O_W1); mixi = 1; kind = 1; }
          else if (nt == 25) { Bp = (const u16*)(ws + O_A1); mixi = 4; kind = 2; }
          else { Bp = (const u16*)(ws + O_G1); mixi = 5; kind = 3; }
          auto epi = [&](int row, int col, float v0, float v1, float v2, float v3) {
            float v[4] = {v0, v1, v2, v3};
            if (kind == 0) {
#pragma unroll
              for (int j = 0; j < 4; ++j) dstp[(size_t)(row + j) * 1024 + col] = f2bf(v[j]);
            } else if (kind == 1) {
#pragma unroll
              for (int j = 0; j < 4; ++j) LORA[(size_t)(row + j) * 384 + col] = f2bf(tanhf(v[j]));
            } else if (kind == 2) {
#pragma unroll
              for (int j = 0; j < 4; ++j) LORA[(size_t)(row + j) * 384 + 128 + col] = f2bf(v[j]);
            } else {
#pragma unroll
              for (int j = 0; j < 4; ++j) LORA[(size_t)(row + j) * 384 + 256 + col] = f2bf(sigmoidf_(v[j]));
            }
          };
          gemm_tile<true>((const u16*)(ws + O_XN), 1024, p.in[13] + mixi * 1024, Bp, 1024, 1024, mt * 256, epi, (u16*)lds);
        }
      } break;
      case 13: {
        const u16* LORA = (const u16*)(ws + O_LORA);
        u16* G = (u16*)(ws + O_G);
        for (int t = blockIdx.x; t < 136 * 40; t += gridDim.x) {
          int mt = t / 40, nt = t % 40;
          int grp = nt >> 3, n0 = (nt & 7) * 128;
          const u16* Ap; const u16* Bp; int K, ldb;
          if (grp < 2) { Ap = LORA + grp * 64; Bp = (const u16*)(ws + O_W2) + (size_t)grp * 65536 + (size_t)n0 * 64; K = 64; ldb = 64; }
          else if (grp < 4) { Ap = LORA + 128 + (grp - 2) * 64; Bp = (const u16*)(ws + O_A2) + (size_t)(grp - 2) * 65536 + (size_t)n0 * 64; K = 64; ldb = 64; }
          else { Ap = LORA + 256; Bp = (const u16*)(ws + O_G2) + (size_t)n0 * 128; K = 128; ldb = 128; }
          int d = grp & 1;
          u8* WA = (u8*)(ws + (d ? O_WA1 : O_WA0));
          auto epi = [&](int row, int col, float v0, float v1, float v2, float v3) {
            int n = n0 + col;
            float v[4] = {v0, v1, v2, v3};
            if (grp < 2) {
              float w0 = p.in[23][d * 1024 + n];
#pragma unroll
              for (int j = 0; j < 4; ++j) {
                float x = w0 + v[j];
                float dec = __expf(-0.6065306597126334f * sigmoidf_(x));
                float q = rintf((dec - 0.5f) * 510.f);
                q = fminf(fmaxf(q, 0.f), 255.f);
                WA[(size_t)(row + j) * 2048 + (n >> 6) * 128 + (n & 63)] = (u8)q;
              }
            } else if (grp < 4) {
              float a0 = p.in[26][d * 1024 + n];
#pragma unroll
              for (int j = 0; j < 4; ++j) {
                float a = sigmoidf_(a0 + v[j]);
                float q = fminf(fmaxf(rintf(a * 255.f), 0.f), 255.f);
                WA[(size_t)(row + j) * 2048 + (n >> 6) * 128 + 64 + (n & 63)] = (u8)q;
              }
            } else {
#pragma unroll
              for (int j = 0; j < 4; ++j) G[(size_t)(row + j) * 1024 + n] = f2bf(v[j]);
            }
          };
          gemm_tile<false>(Ap, 384, nullptr, Bp, ldb, K, mt * 256, epi, (u16*)lds);
        }
      } break;
      case 14: phase_scan(p, lds, dummy); break;
      case 15:
        phase_readout(p);
        convert_tab_fp8(p.in[33] + (size_t)16384 * 1024, p.in[34] + (size_t)16384 * 1024, ws + O_TAB1);
        break;
      case 16: {
        for (int t = blockIdx.x; t < 128 * 8; t += gridDim.x) {
          int mt = t / 8, nt = t % 8;
          int n0 = nt * 128;
          auto epi = [&](int row, int col, float v0, float v1, float v2, float v3) {
            int n = n0 + col;
            float v[4] = {v0, v1, v2, v3};
#pragma unroll
            for (int j = 0; j < 4; ++j) {
              int rw = row + j;
              float g = mod1[(rw >> 12) * 6144 + 2048 + n];
              p.out[(size_t)rw * DM + n] += g * v[j];
            }
          };
          gemm_tile<false>((const u16*)(ws + O_Z), 1024, nullptr, (const u16*)(ws + O_WO) + (size_t)n0 * 1024, 1024, 1024,
                           mt * 256, epi, (u16*)lds);
        }
      } break;
      case 17: phase_norm(p, p.out, nullptr, p.in[7] + 1024, 1, 3, NLAT, (u16*)(ws + O_XN)); break;
      case 19: phase_peer_topk(p, 1, (const u16*)(ws + O_PQ1), NLAT, (int*)(ws + O_IDX1), (float*)(ws + O_GATE1), lds); break;
      case 20: phase_peer_act(p, (const u16*)(ws + O_XN), ws + O_TAB1, (const int*)(ws + O_IDX1), (const float*)(ws + O_GATE1),
                              (float*)(ws + O_COEF1), NLAT, lds); break;
      case 21: phase_peer_sum(p, 1, ws + O_TAB1, (const int*)(ws + O_IDX1), (const float*)(ws + O_COEF1), NLAT, dummy ? (float*)(ws + O_A5R) : nullptr); break;
      default: break;
    }
    }
  }
}

extern "C" void kernel_launch(void* const* d_in, const int* in_sizes, int n_in, void* d_out, int out_size, void* d_ws,
                              size_t ws_size, hipStream_t stream) {
  static int grid = 0;
  if (grid == 0) {
    if (n_in != 35 || ws_size < WS_END) {
      fprintf(stderr, "kernel_launch: unexpected n_in %d or ws_size %zu (need %zu)\n", n_in, ws_size, (size_t)WS_END);
      grid = -1;
      return;
    }
    int dev = 0, cus = 0, per_cu = 0;
    hipGetDevice(&dev);
    hipDeviceGetAttribute(&cus, hipDeviceAttributeMultiprocessorCount, dev);
    hipFuncSetAttribute((const void*)fwd_kernel, hipFuncAttributeMaxDynamicSharedMemorySize, LDS_BYTES);
    hipOccupancyMaxActiveBlocksPerMultiprocessor(&per_cu, (const void*)fwd_kernel, NT, LDS_BYTES);
    (void)hipGetLastError();
    if (per_cu < 1) per_cu = 1;
    grid = (cus / 8) * 8;
    if (grid > cus * per_cu) grid = cus * per_cu;
  }
  if (grid < 0) return;
  P p{};
  for (int i = 0; i < 35; ++i) p.in[i] = (const float*)d_in[i];
  p.out = (float*)d_out;
  p.ws = (char*)d_ws;
#if N_LAUNCH_MODE == 0
  p.ph_lo = 0; p.ph_hi = NPHASE;
  void* args[] = {&p};
  hipError_t e = hipLaunchCooperativeKernel((const void*)fwd_kernel, dim3(grid), dim3(NT), args, LDS_BYTES, stream);
  if (e != hipSuccess) fprintf(stderr, "cooperative launch failed: %s (grid %d)\n", hipGetErrorString(e), grid);
#else
  for (int ph = 0; ph < NPHASE; ++ph) {
    p.ph_lo = ph; p.ph_hi = ph + 1;
    hipLaunchKernelGGL(fwd_kernel, dim3(grid), dim3(NT), LDS_BYTES, stream, p);
  }
#endif
}
```

```cpp
#include <hip/hip_runtime.h>
#include <hip/hip_cooperative_groups.h>
#include <cstdio>
namespace cg = cooperative_groups;

#ifndef N_LAUNCH_MODE
#define N_LAUNCH_MODE 0
#endif

typedef unsigned short u16;
typedef unsigned char u8;
typedef __attribute__((ext_vector_type(8))) short bf16x8;
typedef __attribute__((ext_vector_type(16))) float f32x16;

#define NT 512
#define TTOK 34816
#define NLAT 32768
#define DM 1024
#define LDSS 72
#define LDS_BYTES 114688
#define NPHASE 22
#ifndef REPEAT_MASK
#define REPEAT_MASK 0
#endif
#ifndef PHASE_MASK
#define PHASE_MASK 0x3FFFFF
#endif

static constexpr size_t MiB = 1048576;
static constexpr size_t O_WIN = 0;
static constexpr size_t O_WOUT = O_WIN + 4718592;
static constexpr size_t O_WR = O_WOUT + 2097152;
static constexpr size_t O_WK = O_WR + 2097152;
static constexpr size_t O_WV = O_WK + 2097152;
static constexpr size_t O_WO = O_WV + 2097152;
static constexpr size_t O_G1 = O_WO + 2097152;
static constexpr size_t O_G2 = O_G1 + 262144;
static constexpr size_t O_W1 = O_G2 + 262144;
static constexpr size_t O_A1 = O_W1 + 262144;
static constexpr size_t O_W2 = O_A1 + 262144;
static constexpr size_t O_A2 = O_W2 + 262144;
static constexpr size_t O_WQ = O_A2 + 262144;
static constexpr size_t O_KEYS = O_WQ + 8388608;
static constexpr size_t O_MOD = O_KEYS + 1048576;
static constexpr size_t O_ROPE = O_MOD + 442368;
static constexpr size_t SZ = 68 * MiB;
static constexpr size_t O_A1R = 26 * MiB;
static constexpr size_t O_A2R = O_A1R + SZ;
static constexpr size_t O_A3R = O_A2R + SZ;
static constexpr size_t O_A4R = O_A3R + SZ;
static constexpr size_t O_A5R = O_A4R + SZ;
static constexpr size_t O_A6R = O_A5R + SZ;
static constexpr size_t O_A7R = O_A6R + SZ;
static constexpr size_t O_LORA = O_A7R;
static constexpr size_t O_BONUS = O_A7R + 26 * MiB;
static constexpr size_t WS_END = O_BONUS + 4 * MiB;
static constexpr size_t O_XN = O_A1R;
static constexpr size_t O_HGG = O_A2R;
static constexpr size_t O_Q = O_A2R + 102 * MiB;
static constexpr size_t O_KB = O_A4R;
static constexpr size_t O_VT = O_A4R + 9 * MiB;
static constexpr size_t O_PQ0 = O_A2R;
static constexpr size_t O_TAB0 = O_A5R;
static constexpr size_t O_IDX0 = O_A6R;
static constexpr size_t O_GATE0 = O_A6R + 17 * MiB;
static constexpr size_t O_HC = O_A6R + 34 * MiB;
static constexpr size_t O_COEF0 = O_A6R + 42 * MiB;
static constexpr size_t O_R = O_A2R, O_K = O_A3R, O_V = O_A4R;
static constexpr size_t O_WA0 = O_A5R, O_WA1 = O_A6R;
static constexpr size_t O_G = O_A1R;
static constexpr size_t O_Z = O_A2R;
static constexpr size_t O_TAB1 = O_A3R;
static constexpr size_t O_PQ1 = O_A5R;
static constexpr size_t O_IDX1 = O_A4R;
static constexpr size_t O_GATE1 = O_A4R + 17 * MiB;
static constexpr size_t O_COEF1 = O_A4R + 34 * MiB;

struct P {
  const float* in[35];
  float* out;
  char* ws;
  int ph_lo, ph_hi;
};

typedef __bf16 bf16x2_t __attribute__((ext_vector_type(2)));
typedef float f32x2_t __attribute__((ext_vector_type(2)));
__device__ __forceinline__ u16 f2bf(float f) {
  __bf16 b = (__bf16)f;
  return __builtin_bit_cast(u16, b);
}
__device__ __forceinline__ float bf2f(u16 h) { return __uint_as_float(((unsigned)h) << 16); }
__device__ __forceinline__ float bflo(unsigned w) { return __uint_as_float(w << 16); }
__device__ __forceinline__ float bfhi(unsigned w) { return __uint_as_float(w & 0xFFFF0000u); }
__device__ __forceinline__ unsigned pack2(float a, float b) { f32x2_t v = {a, b}; bf16x2_t r = __builtin_convertvector(v, bf16x2_t); return __builtin_bit_cast(unsigned, r); }

__device__ __forceinline__ int tid_() { int t = __builtin_amdgcn_workitem_id_x(); asm volatile("" : "+v"(t)); return t; }
template <int CTRL>
__device__ __forceinline__ float dppf(float v) {
  return __builtin_bit_cast(float, __builtin_amdgcn_update_dpp(0, __builtin_bit_cast(int, v), CTRL, 0xF, 0xF, true));
}
__device__ __forceinline__ float red8(float v) {
  v += dppf<0xB1>(v); v += dppf<0x4E>(v); v += dppf<0x141>(v); return v;
}
__device__ __forceinline__ float red16(float v) { v = red8(v); v += dppf<0x140>(v); return v; }
__device__ __forceinline__ float swapsum32(float a, float b) {
  auto r = __builtin_amdgcn_permlane32_swap(__float_as_uint(a), __float_as_uint(b), false, false);
  return __uint_as_float(r[0]) + __uint_as_float(r[1]);
}
__device__ __forceinline__ float swapsum16(float a, float b) {
  auto r = __builtin_amdgcn_permlane16_swap(__float_as_uint(a), __float_as_uint(b), false, false);
  return __uint_as_float(r[0]) + __uint_as_float(r[1]);
}
__device__ __forceinline__ float swapmax32(float a) {
  auto r = __builtin_amdgcn_permlane32_swap(__float_as_uint(a), __float_as_uint(a), false, false);
  return fmaxf(__uint_as_float(r[0]), __uint_as_float(r[1]));
}
__device__ __forceinline__ float swapmax16(float a) {
  auto r = __builtin_amdgcn_permlane16_swap(__float_as_uint(a), __float_as_uint(a), false, false);
  return fmaxf(__uint_as_float(r[0]), __uint_as_float(r[1]));
}
__device__ __forceinline__ float wave_sum(float v) {
  v = red16(v);
  v = swapsum16(v, v); v = swapsum32(v, v);
  return v;
}
__device__ __forceinline__ float sigmoidf_(float x) { return 1.f / (1.f + __expf(-x)); }

template <bool MIX, int OM, class Epi, class Dst>
__device__ __forceinline__ void gemm_tile(const u16* __restrict__ A, int lda, const float* __restrict__ mu,
                                          const u16* __restrict__ B, int ldb, int K, int row0, Epi epi, Dst dstf, u16* lds) {
  u16* sA = lds;
  u16* sB = lds + 256 * LDSS;
  const int tid = tid_(), lane = tid & 63, wave = tid >> 6;
  const int wm = wave & 3, wn = wave >> 2;
  const int r = lane & 31, h = lane >> 5;
  const int kc = tid & 7, lr = tid >> 3;
  f32x16 acc[2][2];
#pragma unroll
  for (int i = 0; i < 2; ++i)
#pragma unroll
    for (int j = 0; j < 2; ++j)
#pragma unroll
      for (int g = 0; g < 16; ++g) acc[i][j][g] = 0.f;
  uint4 pa0, pa1, pa2, pa3, ps0, ps1, ps2, ps3, pb0, pb1;
  ps0 = ps1 = ps2 = ps3 = make_uint4(0, 0, 0, 0);
  float4 m0 = make_float4(0, 0, 0, 0), m1 = m0;
  auto nbr = [&](int row, int kg) -> int {
    if (row < NLAT) {
      int t = row & 4095; int gc = t & 63, gr = t >> 6; int qd = kg >> 8;
      if (qd == 0) return gc > 0 ? row - 1 : -1;
      if (qd == 1) return gc < 63 ? row + 1 : -1;
      if (qd == 2) return gr > 0 ? row - 64 : -1;
      return gr < 63 ? row + 64 : -1;
    } else {
      int t = (row - NLAT) & 255;
      if (kg < 512) return t > 0 ? row - 1 : -1;
      return t < 255 ? row + 1 : -1;
    }
  };
  auto ldA = [&](int i, int k0, uint4& a, uint4& sx) {
    int row = row0 + lr + 64 * i;
    a = *(const uint4*)(A + (size_t)row * lda + k0 + kc * 8);
    if (MIX) {
      int nr = nbr(row, k0 + kc * 8);
      if (nr >= 0) sx = *(const uint4*)(A + (size_t)nr * lda + k0 + kc * 8);
      else sx = make_uint4(0, 0, 0, 0);
    }
  };
  auto gload = [&](int k0) {
    ldA(0, k0, pa0, ps0); ldA(1, k0, pa1, ps1); ldA(2, k0, pa2, ps2); ldA(3, k0, pa3, ps3);
    if (MIX) {
      m0 = *(const float4*)(mu + k0 + kc * 8);
      m1 = *(const float4*)(mu + k0 + kc * 8 + 4);
    }
    pb0 = *(const uint4*)(B + (size_t)lr * ldb + k0 + kc * 8);
    pb1 = *(const uint4*)(B + (size_t)(lr + 64) * ldb + k0 + kc * 8);
  };
  auto mixw = [&](unsigned x, unsigned s, float ma, float mb) -> unsigned {
    float x0 = bflo(x), x1 = bfhi(x), s0 = bflo(s), s1 = bfhi(s);
    return pack2(x0 + (s0 - x0) * ma, x1 + (s1 - x1) * mb);
  };
  auto stA = [&](int i, uint4 a, uint4 sx) {
    uint4 v = a;
    if (MIX) {
      v.x = mixw(a.x, sx.x, m0.x, m0.y);
      v.y = mixw(a.y, sx.y, m0.z, m0.w);
      v.z = mixw(a.z, sx.z, m1.x, m1.y);
      v.w = mixw(a.w, sx.w, m1.z, m1.w);
    }
    *(uint4*)(sA + (lr + 64 * i) * LDSS + kc * 8) = v;
  };
  auto lstore = [&]() {
    stA(0, pa0, ps0); stA(1, pa1, ps1); stA(2, pa2, ps2); stA(3, pa3, ps3);
    *(uint4*)(sB + lr * LDSS + kc * 8) = pb0;
    *(uint4*)(sB + (lr + 64) * LDSS + kc * 8) = pb1;
  };
  gload(0);
  for (int k0 = 0; k0 < K; k0 += 64) {
    lstore();
    __syncthreads();
    if (k0 + 64 < K) gload(k0 + 64);
#pragma unroll
    for (int kk = 0; kk < 4; ++kk) {
      bf16x8 af[2], bfr[2];
#pragma unroll
      for (int i = 0; i < 2; ++i) af[i] = *(const bf16x8*)(sA + (wm * 64 + i * 32 + r) * LDSS + kk * 16 + h * 8);
#pragma unroll
      for (int j = 0; j < 2; ++j) bfr[j] = *(const bf16x8*)(sB + (wn * 64 + j * 32 + r) * LDSS + kk * 16 + h * 8);
#pragma unroll
      for (int i = 0; i < 2; ++i)
#pragma unroll
        for (int j = 0; j < 2; ++j) {
          if (OM == 0) acc[i][j] = __builtin_amdgcn_mfma_f32_32x32x16_bf16(af[i], bfr[j], acc[i][j], 0, 0, 0);
          else acc[i][j] = __builtin_amdgcn_mfma_f32_32x32x16_bf16(bfr[j], af[i], acc[i][j], 0, 0, 0);
        }
    }
    __syncthreads();
  }
  if constexpr (OM == 0) {
#pragma unroll
    for (int i = 0; i < 2; ++i)
#pragma unroll
      for (int j = 0; j < 2; ++j)
#pragma unroll
        for (int g4 = 0; g4 < 4; ++g4) {
          int row = row0 + wm * 64 + i * 32 + 8 * g4 + 4 * h;
          int col = wn * 64 + j * 32 + r;
          epi(row, col, acc[i][j][g4 * 4 + 0], acc[i][j][g4 * 4 + 1], acc[i][j][g4 * 4 + 2], acc[i][j][g4 * 4 + 3]);
        }
  } else if constexpr (OM == 1) {
    u16* st = lds;
#pragma unroll
    for (int i = 0; i < 2; ++i)
#pragma unroll
      for (int j = 0; j < 2; ++j)
#pragma unroll
        for (int g4 = 0; g4 < 4; ++g4) {
          const int rl = wm * 64 + i * 32 + r, c0 = wn * 64 + j * 32 + 8 * g4 + 4 * h;
          uint2 o;
          o.x = pack2(epi(acc[i][j][g4 * 4 + 0], row0 + rl, c0 + 0), epi(acc[i][j][g4 * 4 + 1], row0 + rl, c0 + 1));
          o.y = pack2(epi(acc[i][j][g4 * 4 + 2], row0 + rl, c0 + 2), epi(acc[i][j][g4 * 4 + 3], row0 + rl, c0 + 3));
          *(uint2*)(st + rl * 136 + c0) = o;
        }
    __syncthreads();
#pragma unroll
    for (int q = 0; q < 8; ++q) {
      const int id = tid + NT * q, rl = id >> 4, c8 = id & 15;
      const uint4 v = *(const uint4*)(st + rl * 136 + c8 * 8);
      *(uint4*)(dstf(row0 + rl) + c8 * 8) = v;
    }
    __syncthreads();
  } else {
    u8* st = (u8*)lds;
#pragma unroll
    for (int i = 0; i < 2; ++i)
#pragma unroll
      for (int j = 0; j < 2; ++j)
#pragma unroll
        for (int g4 = 0; g4 < 4; ++g4) {
          const int rl = wm * 64 + i * 32 + r, c0 = wn * 64 + j * 32 + 8 * g4 + 4 * h;
          unsigned o = epi(acc[i][j][g4 * 4 + 0], row0 + rl, c0 + 0) | (epi(acc[i][j][g4 * 4 + 1], row0 + rl, c0 + 1) << 8) |
                       (epi(acc[i][j][g4 * 4 + 2], row0 + rl, c0 + 2) << 16) | (epi(acc[i][j][g4 * 4 + 3], row0 + rl, c0 + 3) << 24);
          *(unsigned*)(st + rl * 144 + c0) = o;
        }
    __syncthreads();
#pragma unroll
    for (int q = 0; q < 4; ++q) {
      const int id = tid + NT * q, rl = id >> 3, c16 = id & 7;
      const uint4 v = *(const uint4*)(st + rl * 144 + c16 * 16);
      *(uint4*)(dstf(row0 + rl, c16)) = v;
    }
    __syncthreads();
  }
}

template <bool MIX, class Epi, class Dst>
__device__ __forceinline__ void gemm_tile256(const u16* __restrict__ A, int lda, const float* __restrict__ mu,
                                             const u16* __restrict__ B, int ldb, int K, int row0, Epi epi, Dst dstf, u16* lds) {
  u16* sA = lds;
  u16* sB = lds + 256 * LDSS;
  const int tid = tid_(), lane = tid & 63, wave = tid >> 6;
  const int wm = wave & 1, wn = wave >> 1;
  const int r = lane & 31, h = lane >> 5;
  const int kc = tid & 7, lr = tid >> 3;
  f32x16 acc[4][2];
#pragma unroll
  for (int i = 0; i < 4; ++i)
#pragma unroll
    for (int j = 0; j < 2; ++j)
#pragma unroll
      for (int g = 0; g < 16; ++g) acc[i][j][g] = 0.f;
  uint4 pa0, pa1, pa2, pa3, ps0, ps1, ps2, ps3, pb0, pb1, pb2, pb3;
  ps0 = ps1 = ps2 = ps3 = make_uint4(0, 0, 0, 0);
  float4 m0 = make_float4(0, 0, 0, 0), m1 = m0;
  auto nbr = [&](int row, int kg) -> int {
    if (row < NLAT) {
      int t = row & 4095; int gc = t & 63, gr = t >> 6; int qd = kg >> 8;
      if (qd == 0) return gc > 0 ? row - 1 : -1;
      if (qd == 1) return gc < 63 ? row + 1 : -1;
      if (qd == 2) return gr > 0 ? row - 64 : -1;
      return gr < 63 ? row + 64 : -1;
    } else {
      int t = (row - NLAT) & 255;
      if (kg < 512) return t > 0 ? row - 1 : -1;
      return t < 255 ? row + 1 : -1;
    }
  };
  auto ldA = [&](int i, int k0, uint4& a, uint4& sx) {
    int row = row0 + lr + 64 * i;
    a = *(const uint4*)(A + (size_t)row * lda + k0 + kc * 8);
    if (MIX) {
      int nr = nbr(row, k0 + kc * 8);
      if (nr >= 0) sx = *(const uint4*)(A + (size_t)nr * lda + k0 + kc * 8);
      else sx = make_uint4(0, 0, 0, 0);
    }
  };
  auto gload = [&](int k0) {
    ldA(0, k0, pa0, ps0); ldA(1, k0, pa1, ps1); ldA(2, k0, pa2, ps2); ldA(3, k0, pa3, ps3);
    if (MIX) {
      m0 = *(const float4*)(mu + k0 + kc * 8);
      m1 = *(const float4*)(mu + k0 + kc * 8 + 4);
    }
    pb0 = *(const uint4*)(B + (size_t)lr * ldb + k0 + kc * 8);
    pb1 = *(const uint4*)(B + (size_t)(lr + 64) * ldb + k0 + kc * 8);
    pb2 = *(const uint4*)(B + (size_t)(lr + 128) * ldb + k0 + kc * 8);
    pb3 = *(const uint4*)(B + (size_t)(lr + 192) * ldb + k0 + kc * 8);
  };
  auto mixw = [&](unsigned x, unsigned s_, float ma, float mb) -> unsigned {
    float x0 = bflo(x), x1 = bfhi(x), s0 = bflo(s_), s1 = bfhi(s_);
    return pack2(x0 + (s0 - x0) * ma, x1 + (s1 - x1) * mb);
  };
  auto stA = [&](int i, uint4 a, uint4 sx) {
    uint4 v = a;
    if (MIX) {
      v.x = mixw(a.x, sx.x, m0.x, m0.y);
      v.y = mixw(a.y, sx.y, m0.z, m0.w);
      v.z = mixw(a.z, sx.z, m1.x, m1.y);
      v.w = mixw(a.w, sx.w, m1.z, m1.w);
    }
    *(uint4*)(sA + (lr + 64 * i) * LDSS + kc * 8) = v;
  };
  auto lstore = [&]() {
    stA(0, pa0, ps0); stA(1, pa1, ps1); stA(2, pa2, ps2); stA(3, pa3, ps3);
    *(uint4*)(sB + lr * LDSS + kc * 8) = pb0;
    *(uint4*)(sB + (lr + 64) * LDSS + kc * 8) = pb1;
    *(uint4*)(sB + (lr + 128) * LDSS + kc * 8) = pb2;
    *(uint4*)(sB + (lr + 192) * LDSS + kc * 8) = pb3;
  };
  gload(0);
  for (int k0 = 0; k0 < K; k0 += 64) {
    lstore();
    __syncthreads();
    if (k0 + 64 < K) gload(k0 + 64);
#pragma unroll
    for (int kk = 0; kk < 4; ++kk) {
      bf16x8 af[4], bfr[2];
#pragma unroll
      for (int i = 0; i < 4; ++i) af[i] = *(const bf16x8*)(sA + (wm * 128 + i * 32 + r) * LDSS + kk * 16 + h * 8);
#pragma unroll
      for (int j = 0; j < 2; ++j) bfr[j] = *(const bf16x8*)(sB + (wn * 64 + j * 32 + r) * LDSS + kk * 16 + h * 8);
#pragma unroll
      for (int i = 0; i < 4; ++i)
#pragma unroll
        for (int j = 0; j < 2; ++j) acc[i][j] = __builtin_amdgcn_mfma_f32_32x32x16_bf16(bfr[j], af[i], acc[i][j], 0, 0, 0);
    }
    __syncthreads();
  }
  u16* st = lds;
#pragma unroll
  for (int half = 0; half < 2; ++half) {
    if ((wn >> 1) == half) {
#pragma unroll
      for (int i = 0; i < 4; ++i)
#pragma unroll
        for (int j = 0; j < 2; ++j)
#pragma unroll
          for (int g4 = 0; g4 < 4; ++g4) {
            const int rl = wm * 128 + i * 32 + r, cl = (wn & 1) * 64 + j * 32 + 8 * g4 + 4 * h, c0 = half * 128 + cl;
            uint2 o;
            o.x = pack2(epi(acc[i][j][g4 * 4 + 0], row0 + rl, c0 + 0), epi(acc[i][j][g4 * 4 + 1], row0 + rl, c0 + 1));
            o.y = pack2(epi(acc[i][j][g4 * 4 + 2], row0 + rl, c0 + 2), epi(acc[i][j][g4 * 4 + 3], row0 + rl, c0 + 3));
            *(uint2*)(st + rl * 136 + cl) = o;
          }
    }
    __syncthreads();
#pragma unroll
    for (int q = 0; q < 8; ++q) {
      const int id = tid + NT * q, rl = id >> 4, c8 = id & 15;
      const uint4 v = *(const uint4*)(st + rl * 136 + c8 * 8);
      *(uint4*)(dstf(row0 + rl) + half * 128 + c8 * 8) = v;
    }
    __syncthreads();
  }
}

__constant__ int TJOBS[18][5] = {
    {8, 0, 1024, 2304, (int)O_WIN},
    {12, 0, 1024, 1024, (int)O_WOUT},
    {14, 0, 1024, 1024, (int)O_WR},
    {15, 0, 1024, 1024, (int)O_WK},
    {16, 0, 1024, 1024, (int)O_WV},
    {17, 0, 1024, 1024, (int)O_WO},
    {18, 0, 1024, 128, (int)O_G1},
    {19, 0, 128, 1024, (int)O_G2},
    {24, 0, 1024, 64, (int)O_W1},
    {24, 65536, 1024, 64, (int)(O_W1 + 131072)},
    {27, 0, 1024, 64, (int)O_A1},
    {27, 65536, 1024, 64, (int)(O_A1 + 131072)},
    {25, 0, 64, 1024, (int)O_W2},
    {25, 65536, 64, 1024, (int)(O_W2 + 131072)},
    {28, 0, 64, 1024, (int)O_A2},
    {28, 65536, 64, 1024, (int)(O_A2 + 131072)},
    {31, 0, 1024, 2048, (int)O_WQ},
    {31, 2097152, 1024, 2048, (int)(O_WQ + 4194304)},
};

__device__ __forceinline__ void convert_bf16(const float* __restrict__ src, u16* __restrict__ dst, size_t n) {
  size_t n4 = n >> 2;
  for (size_t i = (size_t)blockIdx.x * NT + tid_(); i < n4; i += (size_t)gridDim.x * NT) {
    float4 v = ((const float4*)src)[i];
    uint2 o; o.x = pack2(v.x, v.y); o.y = pack2(v.z, v.w);
    ((uint2*)dst)[i] = o;
  }
}

__device__ __forceinline__ void convert_tab_fp8(const float* __restrict__ U, const float* __restrict__ V, char* tab);
__device__ __forceinline__ void phase_prep(const P& p, char* lds) {
  const int tid = tid_();
  float* fl = (float*)lds;
  for (int task = blockIdx.x; task < 192; task += gridDim.x) {
    int l = task / 96, cg_ = task % 96;
    float* sv = fl;
    float* red = fl + 9216;
    for (int i = tid; i < 9216; i += NT) {
      int v = i >> 10, k = i & 1023;
      float x = v < 8 ? p.in[1][v * 1024 + k] : p.in[3][k];
      sv[i] = x / (1.f + __expf(-x));
    }
    __syncthreads();
    int col = cg_ * 64 + (tid & 63), kg = tid >> 6;
    float acc[9];
#pragma unroll
    for (int v = 0; v < 9; ++v) acc[v] = 0.f;
    const float* W = p.in[4] + (size_t)l * 1024 * 6144 + col;
    for (int k = kg * 128; k < kg * 128 + 128; ++k) {
      float w = W[(size_t)k * 6144];
#pragma unroll
      for (int v = 0; v < 9; ++v) acc[v] += sv[v * 1024 + k] * w;
    }
#pragma unroll
    for (int v = 0; v < 9; ++v) red[(kg * 9 + v) * 64 + (tid & 63)] = acc[v];
    __syncthreads();
    if (tid < 576) {
      int v = tid >> 6, c = tid & 63;
      float s = p.in[5][l * 6144 + cg_ * 64 + c];
#pragma unroll
      for (int g = 0; g < 8; ++g) s += red[(g * 9 + v) * 64 + c];
      ((float*)(p.ws + O_MOD))[(l * 9 + v) * 6144 + cg_ * 64 + c] = s;
    }
    __syncthreads();
  }
  {
    int base = 0;
    for (int j = 0; j < 18; ++j) {
      int K = TJOBS[j][2], N = TJOBS[j][3];
      int tk = K >> 6, tn = N >> 6, nt = tk * tn;
      const float* src = p.in[TJOBS[j][0]] + TJOBS[j][1];
      u16* dst = (u16*)(p.ws + (size_t)(unsigned)TJOBS[j][4]);
      int first = (blockIdx.x + gridDim.x - (base % gridDim.x)) % gridDim.x;
      for (int t = first; t < nt; t += gridDim.x) {
        int k0 = (t / tn) * 64, n0 = (t % tn) * 64;
#pragma unroll
        for (int rep = 0; rep < 8; ++rep) {
          int idx = tid + NT * rep; int i = idx >> 6, jj = idx & 63;
          fl[i * 65 + jj] = src[(size_t)(k0 + i) * N + n0 + jj];
        }
        __syncthreads();
        int n = tid >> 3, c8 = tid & 7;
        uint4 o;
        o.x = pack2(fl[(c8 * 8 + 0) * 65 + n], fl[(c8 * 8 + 1) * 65 + n]);
        o.y = pack2(fl[(c8 * 8 + 2) * 65 + n], fl[(c8 * 8 + 3) * 65 + n]);
        o.z = pack2(fl[(c8 * 8 + 4) * 65 + n], fl[(c8 * 8 + 5) * 65 + n]);
        o.w = pack2(fl[(c8 * 8 + 6) * 65 + n], fl[(c8 * 8 + 7) * 65 + n]);
        *(uint4*)(dst + (size_t)(n0 + n) * K + k0 + c8 * 8) = o;
        __syncthreads();
      }
      base += nt;
    }
  }
  convert_bf16(p.in[32], (u16*)(p.ws + O_KEYS), (size_t)2 * 8 * 2 * 128 * 128);
  convert_tab_fp8(p.in[33], p.in[34], p.ws + O_TAB0);
  if (blockIdx.x == 0) {
    float* rope = (float*)(p.ws + O_ROPE);
    for (int i = tid; i < 1024; i += NT) {
      int pos = i >> 4, f = i & 15;
      float inv = exp2f(-(float)f * (13.287712379549449f / 16.f));
      float ang = (float)pos * inv;
      rope[i * 2] = cosf(ang);
      rope[i * 2 + 1] = sinf(ang);
    }
  }
}

__device__ __forceinline__ void phase_norm(const P& p, const float* srcL, const float* srcC, const float* gain, int layer, int shift_idx,
                           int nrows, u16* dst) {
  const int lane = tid_() & 63;
  const int gw = blockIdx.x * 8 + (tid_() >> 6), nw = gridDim.x * 8;
  const float* mod = (const float*)(p.ws + O_MOD) + (size_t)layer * 9 * 6144;
  for (int row = gw; row < nrows; row += nw) {
    const float* src = row < NLAT ? srcL + (size_t)row * DM : srcC + (size_t)(row - NLAT) * DM;
    int mi = row < NLAT ? (row >> 12) : 8;
    const float* sh = mod + mi * 6144 + shift_idx * 1024;
    const float* sc = sh + 1024;
    float4 v[4];
    float ss = 0.f;
#pragma unroll
    for (int i = 0; i < 4; ++i) {
      v[i] = *(const float4*)(src + i * 256 + lane * 4);
      ss += v[i].x * v[i].x + v[i].y * v[i].y + v[i].z * v[i].z + v[i].w * v[i].w;
    }
    ss = wave_sum(ss);
    float rs = rsqrtf(ss * (1.f / 1024.f) + 1e-6f);
#pragma unroll
    for (int i = 0; i < 4; ++i) {
      int c = i * 256 + lane * 4;
      float4 g = *(const float4*)(gain + c);
      float4 s1 = *(const float4*)(sc + c);
      float4 s0 = *(const float4*)(sh + c);
      float a = v[i].x * rs * g.x * (1.f + s1.x) + s0.x;
      float b = v[i].y * rs * g.y * (1.f + s1.y) + s0.y;
      float cc = v[i].z * rs * g.z * (1.f + s1.z) + s0.z;
      float d = v[i].w * rs * g.w * (1.f + s1.w) + s0.w;
      uint2 o; o.x = pack2(a, b); o.y = pack2(cc, d);
      *(uint2*)(dst + (size_t)row * DM + c) = o;
    }
  }
}

__device__ __forceinline__ void phase_conv_qk(const P& p) {
  const u16* hgg = (const u16*)(p.ws + O_HGG);
  u16* mix = (u16*)(p.ws + O_XN);
  const float* cw = p.in[9];
  const size_t gt = (size_t)blockIdx.x * NT + tid_(), gn = (size_t)gridDim.x * NT;
  for (size_t it = gt; it < (size_t)TTOK * 64; it += gn) {
    int row = (int)(it >> 6), c0 = (int)(it & 63) * 8;
    int t, len;
    if (row < NLAT) { t = row & 4095; len = 4096; } else { t = (row - NLAT) & 255; len = 256; }
    float pm[8], pc[8], pp[8];
    {
      const u16* b = hgg + (size_t)row * 1536;
      uint4 hh = *(const uint4*)(b + c0), gc = *(const uint4*)(b + 1024 + c0);
      pc[0] = bflo(hh.x) * bflo(gc.x); pc[1] = bfhi(hh.x) * bfhi(gc.x);
      pc[2] = bflo(hh.y) * bflo(gc.y); pc[3] = bfhi(hh.y) * bfhi(gc.y);
      pc[4] = bflo(hh.z) * bflo(gc.z); pc[5] = bfhi(hh.z) * bfhi(gc.z);
      pc[6] = bflo(hh.w) * bflo(gc.w); pc[7] = bfhi(hh.w) * bfhi(gc.w);
    }
    if (t > 0) {
      const u16* b = hgg + (size_t)(row - 1) * 1536;
      uint4 hh = *(const uint4*)(b + c0), gc = *(const uint4*)(b + 1024 + c0);
      pm[0] = bflo(hh.x) * bflo(gc.x); pm[1] = bfhi(hh.x) * bfhi(gc.x);
      pm[2] = bflo(hh.y) * bflo(gc.y); pm[3] = bfhi(hh.y) * bfhi(gc.y);
      pm[4] = bflo(hh.z) * bflo(gc.z); pm[5] = bfhi(hh.z) * bfhi(gc.z);
      pm[6] = bflo(hh.w) * bflo(gc.w); pm[7] = bfhi(hh.w) * bfhi(gc.w);
    } else {
#pragma unroll
      for (int e = 0; e < 8; ++e) pm[e] = 0.f;
    }
    if (t < len - 1) {
      const u16* b = hgg + (size_t)(row + 1) * 1536;
      uint4 hh = *(const uint4*)(b + c0), gc = *(const uint4*)(b + 1024 + c0);
      pp[0] = bflo(hh.x) * bflo(gc.x); pp[1] = bfhi(hh.x) * bfhi(gc.x);
      pp[2] = bflo(hh.y) * bflo(gc.y); pp[3] = bfhi(hh.y) * bfhi(gc.y);
      pp[4] = bflo(hh.z) * bflo(gc.z); pp[5] = bfhi(hh.z) * bfhi(gc.z);
      pp[6] = bflo(hh.w) * bflo(gc.w); pp[7] = bfhi(hh.w) * bfhi(gc.w);
    } else {
#pragma unroll
      for (int e = 0; e < 8; ++e) pp[e] = 0.f;
    }
    uint4 gbv = *(const uint4*)(hgg + (size_t)row * 1536 + 512 + c0);
    float gb[8] = {bflo(gbv.x), bfhi(gbv.x), bflo(gbv.y), bfhi(gbv.y), bflo(gbv.z), bfhi(gbv.z), bflo(gbv.w), bfhi(gbv.w)};
    float o[8];
#pragma unroll
    for (int e = 0; e < 8; ++e)
      o[e] = gb[e] * (cw[c0 + e] * pm[e] + cw[512 + c0 + e] * pc[e] + cw[1024 + c0 + e] * pp[e]);
    uint4 ov; ov.x = pack2(o[0], o[1]); ov.y = pack2(o[2], o[3]); ov.z = pack2(o[4], o[5]); ov.w = pack2(o[6], o[7]);
    *(uint4*)(mix + (size_t)row * DM + c0) = ov;
  }
  u16* Q = (u16*)(p.ws + O_Q);
  u16* KBp = (u16*)(p.ws + O_KB);
  const float* rope = (const float*)(p.ws + O_ROPE);
  const size_t ngroups = (size_t)TTOK * 10;
  for (size_t it = gt; it < ngroups * 8; it += gn) {
    size_t grp = it >> 3; int sub = (int)(it & 7);
    int row = (int)(grp / 10), hd = (int)(grp % 10);
    u16* ptr; const float* gain;
    if (hd < 8) { ptr = Q + (size_t)row * 512 + hd * 64 + sub * 8; gain = p.in[10]; }
    else { ptr = KBp + (size_t)row * 128 + (hd - 8) * 64 + sub * 8; gain = p.in[11]; }
    uint4 v = *(const uint4*)ptr;
    float x[8] = {bflo(v.x), bfhi(v.x), bflo(v.y), bfhi(v.y), bflo(v.z), bfhi(v.z), bflo(v.w), bfhi(v.w)};
    float ss = 0.f;
#pragma unroll
    for (int e = 0; e < 8; ++e) ss += x[e] * x[e];
    ss = red8(ss);
    float rs = rsqrtf(ss * (1.f / 64.f) + 1e-6f);
#pragma unroll
    for (int e = 0; e < 8; ++e) x[e] = x[e] * rs * gain[sub * 8 + e];
    if (row < NLAT) {
      int t = row & 4095; int gr = t >> 6, gc = t & 63;
#pragma unroll
      for (int e = 0; e < 4; ++e) {
        int pi = sub * 4 + e;
        int pos = pi < 16 ? gr : gc; int f = pi & 15;
        float c = rope[(pos * 16 + f) * 2], s = rope[(pos * 16 + f) * 2 + 1];
        float a = x[2 * e], b = x[2 * e + 1];
        x[2 * e] = a * c - b * s;
        x[2 * e + 1] = a * s + b * c;
      }
    }
    uint4 ov; ov.x = pack2(x[0], x[1]); ov.y = pack2(x[2], x[3]); ov.z = pack2(x[4], x[5]); ov.w = pack2(x[6], x[7]);
    *(uint4*)ptr = ov;
  }
}

__device__ __forceinline__ void phase_attn(const P& p, char* lds) {
  u16* sK = (u16*)lds;
  u16* sV = sK + 64 * LDSS;
  const u16* Q = (const u16*)(p.ws + O_Q);
  const u16* KBp = (const u16*)(p.ws + O_KB);
  const u16* VT = (const u16*)(p.ws + O_VT);
  u16* mix = (u16*)(p.ws + O_XN);
  const int tid = tid_(), lane = tid & 63, wave = tid >> 6;
  const int r = lane & 31, h = lane >> 5;
  const float cs = 0.125f * 1.4426950408889634f;
  for (int item = blockIdx.x; item < 1088; item += gridDim.x) {
    int b, qh, qrow0, nkt;
    if (item < 1024) { b = item >> 7; qh = (item >> 4) & 7; qrow0 = b * 4096 + (item & 15) * 256; nkt = 68; }
    else { int i2 = item - 1024; b = i2 >> 3; qh = i2 & 7; qrow0 = NLAT + b * 256; nkt = 4; }
    const int kvh = qh >> 2;
    const int qrow = qrow0 + wave * 32 + r;
    bf16x8 qf[4];
#pragma unroll
    for (int kk = 0; kk < 4; ++kk) qf[kk] = *(const bf16x8*)(Q + (size_t)qrow * 512 + qh * 64 + kk * 16 + h * 8);
    f32x16 o[2];
#pragma unroll
    for (int g = 0; g < 16; ++g) { o[0][g] = 0.f; o[1][g] = 0.f; }
    float m = -INFINITY, l = 0.f;
    const int lkey = tid >> 3, lch = tid & 7;
    uint4 ka, va;
    auto gl = [&](int kt) {
      int pos = kt * 64 + lkey;
      int krow = pos < 256 ? NLAT + b * 256 + pos : b * 4096 + pos - 256;
      ka = *(const uint4*)(KBp + (size_t)krow * 128 + kvh * 64 + lch * 8);
      va = *(const uint4*)(VT + ((size_t)((b * 2 + kvh) * 64 + lkey)) * 4352 + kt * 64 + lch * 8);
    };
    gl(0);
    for (int kt = 0; kt < nkt; ++kt) {
      *(uint4*)(sK + lkey * LDSS + lch * 8) = ka;
      *(uint4*)(sV + lkey * LDSS + lch * 8) = va;
      __syncthreads();
      if (kt + 1 < nkt) gl(kt + 1);
      f32x16 s[2];
#pragma unroll
      for (int g = 0; g < 16; ++g) { s[0][g] = 0.f; s[1][g] = 0.f; }
#pragma unroll
      for (int kb = 0; kb < 2; ++kb)
#pragma unroll
        for (int kk = 0; kk < 4; ++kk) {
          bf16x8 a = *(const bf16x8*)(sK + (kb * 32 + r) * LDSS + kk * 16 + h * 8);
          s[kb] = __builtin_amdgcn_mfma_f32_32x32x16_bf16(a, qf[kk], s[kb], 0, 0, 0);
        }
      float mx = s[0][0];
#pragma unroll
      for (int g = 0; g < 16; ++g) { mx = fmaxf(mx, s[0][g]); mx = fmaxf(mx, s[1][g]); }
      mx = swapmax32(mx);
      float mn = fmaxf(m, mx);
      float alpha = __builtin_amdgcn_exp2f((m - mn) * cs);
      m = mn;
      float mc = mn * cs, ps = 0.f;
#pragma unroll
      for (int kb = 0; kb < 2; ++kb)
#pragma unroll
        for (int g = 0; g < 16; ++g) { float e = __builtin_amdgcn_exp2f(s[kb][g] * cs - mc); s[kb][g] = e; ps += e; }
      l = l * alpha + ps;
#pragma unroll
      for (int g = 0; g < 16; ++g) { o[0][g] *= alpha; o[1][g] *= alpha; }
      bf16x8 pb[2][2];
#pragma unroll
      for (int kb = 0; kb < 2; ++kb)
#pragma unroll
        for (int c = 0; c < 2; ++c) {
          uint4 pk;
          pk.x = pack2(s[kb][8 * c + 0], s[kb][8 * c + 1]); pk.y = pack2(s[kb][8 * c + 2], s[kb][8 * c + 3]);
          pk.z = pack2(s[kb][8 * c + 4], s[kb][8 * c + 5]); pk.w = pack2(s[kb][8 * c + 6], s[kb][8 * c + 7]);
          pb[kb][c] = __builtin_bit_cast(bf16x8, pk);
        }
#pragma unroll
      for (int db = 0; db < 2; ++db)
#pragma unroll
        for (int kb = 0; kb < 2; ++kb)
#pragma unroll
          for (int c = 0; c < 2; ++c) {
            const u16* vp = sV + (db * 32 + r) * LDSS + kb * 32 + 16 * c + 4 * h;
            uint2 lo = *(const uint2*)vp, hi = *(const uint2*)(vp + 8);
            uint4 av = make_uint4(lo.x, lo.y, hi.x, hi.y);
            o[db] = __builtin_amdgcn_mfma_f32_32x32x16_bf16(__builtin_bit_cast(bf16x8, av), pb[kb][c], o[db], 0, 0, 0);
          }
      __syncthreads();
    }
    l = swapsum32(l, l);
    float inv = 1.f / l;
#pragma unroll
    for (int db = 0; db < 2; ++db)
#pragma unroll
      for (int g4 = 0; g4 < 4; ++g4) {
        int d = db * 32 + 8 * g4 + 4 * h;
        uint2 ov;
        ov.x = pack2(o[db][g4 * 4 + 0] * inv, o[db][g4 * 4 + 1] * inv);
        ov.y = pack2(o[db][g4 * 4 + 2] * inv, o[db][g4 * 4 + 3] * inv);
        *(uint2*)(mix + (size_t)qrow * DM + 512 + qh * 64 + d) = ov;
      }
  }
}

__device__ __forceinline__ int fkey(float f) { int b = __float_as_int(f); return b ^ ((b >> 31) & 0x7FFFFFFF); }
__device__ __forceinline__ float keyf(int k) { return __int_as_float(k ^ ((k >> 31) & 0x7FFFFFFF)); }

#define CE_DESC(a, b) { int hi__ = max(a, b); int lo__ = min(a, b); a = hi__; b = lo__; }
#define BITONIC_SORT16(r)                                                          \
  _Pragma("unroll") for (int k_ = 2; k_ <= 16; k_ <<= 1)                           \
    _Pragma("unroll") for (int j_ = k_ >> 1; j_ > 0; j_ >>= 1)                     \
      _Pragma("unroll") for (int i_ = 0; i_ < 16; ++i_) {                          \
        const int l_ = i_ ^ j_;                                                    \
        if (l_ > i_) { if ((i_ & k_) == 0) CE_DESC(r[i_], r[l_]) else CE_DESC(r[l_], r[i_]) } \
      }
#define BITONIC_MERGE16(r)                                                         \
  _Pragma("unroll") for (int j_ = 8; j_ > 0; j_ >>= 1)                             \
    _Pragma("unroll") for (int i_ = 0; i_ < 16; ++i_) {                            \
      const int l_ = i_ ^ j_;                                                      \
      if (l_ > i_) CE_DESC(r[i_], r[l_])                                           \
    }
#define XLANE_MERGE16(r, CTRL)                                                     \
  {                                                                                \
    int o_[16];                                                                    \
    _Pragma("unroll") for (int i_ = 0; i_ < 16; ++i_) o_[i_] = __builtin_amdgcn_update_dpp(0, r[15 - i_], CTRL, 0xF, 0xF, true); \
    _Pragma("unroll") for (int i_ = 0; i_ < 16; ++i_) r[i_] = max(r[i_], o_[i_]);  \
    BITONIC_MERGE16(r)                                                             \
  }
#define SCS 132
__device__ __forceinline__ void phase_peer_topk(const P& p, int layer, const u16* PQ, int ntok, int* IDX, float* GATE, char* lds) {
  float* sc = (float*)lds;
  int* lists = (int*)(lds + 2 * 64 * SCS * 4);
  const int tid = tid_(), lane = tid & 63, wave = tid >> 6;
  const int r = lane & 31, h = lane >> 5;
  const u16* keys = (const u16*)(p.ws + O_KEYS) + (size_t)layer * 8 * 2 * 128 * 128;
  const int ntile = (ntok >> 6) * 8;
  for (int tile = blockIdx.x; tile < ntile; tile += gridDim.x) {
    int hd = tile & 7, row0 = (tile >> 3) * 64;
    {
      int pp = wave >> 2, kb = wave & 3;
      f32x16 acc[2];
#pragma unroll
      for (int g = 0; g < 16; ++g) { acc[0][g] = 0.f; acc[1][g] = 0.f; }
      const u16* kp = keys + ((size_t)(hd * 2 + pp) * 128 + kb * 32 + r) * 128 + h * 8;
      const u16* qp = PQ + (size_t)(row0 + r) * 2048 + hd * 256 + pp * 128 + h * 8;
#pragma unroll
      for (int kk = 0; kk < 8; ++kk) {
        bf16x8 bfr = *(const bf16x8*)(kp + kk * 16);
        bf16x8 a0 = *(const bf16x8*)(qp + kk * 16);
        bf16x8 a1 = *(const bf16x8*)(qp + (size_t)32 * 2048 + kk * 16);
        acc[0] = __builtin_amdgcn_mfma_f32_32x32x16_bf16(a0, bfr, acc[0], 0, 0, 0);
        acc[1] = __builtin_amdgcn_mfma_f32_32x32x16_bf16(a1, bfr, acc[1], 0, 0, 0);
      }
#pragma unroll
      for (int mb = 0; mb < 2; ++mb)
#pragma unroll
        for (int g = 0; g < 16; ++g) {
          int tok = mb * 32 + (g & 3) + 8 * (g >> 2) + 4 * h;
          sc[(pp * 64 + tok) * SCS + kb * 32 + r] = acc[mb][g];
        }
    }
    __syncthreads();
    {
      const int row = tid >> 2, qd = tid & 3;
      const float* rowp = sc + row * SCS + qd;
      int A[16], B[16];
#pragma unroll
      for (int m = 0; m < 16; ++m) {
        A[m] = (fkey(rowp[4 * m]) & ~0x7F) | (127 - (4 * m + qd));
        B[m] = (fkey(rowp[64 + 4 * m]) & ~0x7F) | (127 - (64 + 4 * m + qd));
      }
      BITONIC_SORT16(A)
      BITONIC_SORT16(B)
#pragma unroll
      for (int i = 0; i < 16; ++i) A[i] = max(A[i], B[15 - i]);
      BITONIC_MERGE16(A)
      XLANE_MERGE16(A, 0xB1)
      XLANE_MERGE16(A, 0x4E)
      if (qd == 0) {
#pragma unroll
        for (int i = 0; i < 16; i += 4) *(int4*)(lists + row * 16 + i) = make_int4(A[i], A[i + 1], A[i + 2], A[i + 3]);
      }
    }
    __syncthreads();
    if (tid < 256) {
      const int tok = tid >> 2, q = tid & 3;
      float bq[16];
#pragma unroll
      for (int j = 0; j < 16; ++j) bq[j] = keyf(lists[(64 + tok) * 16 + j] & ~0x7F);
      int R[16];
#pragma unroll
      for (int i = 0; i < 16; ++i) R[i] = (int)0x80000000;
#pragma unroll
      for (int m = 0; m < 4; ++m) {
        const int i = q + 4 * m;
        const float ai = keyf(lists[tok * 16 + i] & ~0x7F);
        const int jmax = 16 / (i + 1);
        const int nj = m == 0 ? 16 : (m == 1 ? 3 : 1);
#pragma unroll
        for (int j = 0; j < nj; ++j) {
          int x = (fkey(ai + bq[j]) & ~0xFF) | (255 - (i * 16 + j));
          x = j < jmax ? x : (int)0x80000000;
#pragma unroll
          for (int t = 0; t < 16; ++t) { int hi_ = max(R[t], x); x = min(R[t], x); R[t] = hi_; }
        }
      }
      XLANE_MERGE16(R, 0xB1)
      XLANE_MERGE16(R, 0x4E)
      float sv[16];
      float mx = keyf(R[0] & ~0xFF), sum = 0.f;
#pragma unroll
      for (int t = 0; t < 16; ++t) { sv[t] = __expf(keyf(R[t] & ~0xFF) - mx); sum += sv[t]; }
      float inv = 1.f / sum;
      size_t ob = (size_t)(row0 + tok) * 128 + hd * 16;
#pragma unroll
      for (int t = 0; t < 16; ++t) {
        if ((t >> 2) == q) {
          int pos = 255 - (R[t] & 0xFF);
          int i1 = 127 - (lists[tok * 16 + (pos >> 4)] & 0x7F);
          int i2 = 127 - (lists[(64 + tok) * 16 + (pos & 15)] & 0x7F);
          IDX[ob + t] = i1 * 128 + i2;
          GATE[ob + t] = sv[t] * inv;
        }
      }
    }
    __syncthreads();
  }
}

typedef __attribute__((ext_vector_type(2))) float f2;
#define TAB_V8 (16 * MiB)
#define TAB_SU (32 * MiB)
#define TAB_SV (32 * MiB + 65536)
__device__ __forceinline__ float wave_max(float v) {
  v = fmaxf(v, dppf<0xB1>(v)); v = fmaxf(v, dppf<0x4E>(v)); v = fmaxf(v, dppf<0x141>(v)); v = fmaxf(v, dppf<0x140>(v));
  v = swapmax16(v); v = swapmax32(v);
  return v;
}
__device__ __forceinline__ void convert_tab_fp8(const float* __restrict__ U, const float* __restrict__ V, char* tab) {
  const int lane = tid_() & 63;
  const int gw = blockIdx.x * 8 + (tid_() >> 6), nw = gridDim.x * 8;
  for (int rr = gw; rr < 32768; rr += nw) {
    const int isv = rr >> 14, e = rr & 16383;
    const float* src = (isv ? V : U) + (size_t)e * 1024 + lane * 16;
    float4 v0 = *(const float4*)src, v1 = *(const float4*)(src + 4), v2 = *(const float4*)(src + 8), v3 = *(const float4*)(src + 12);
    float am = fmaxf(fmaxf(fmaxf(fabsf(v0.x), fabsf(v0.y)), fmaxf(fabsf(v0.z), fabsf(v0.w))),
                     fmaxf(fmaxf(fabsf(v1.x), fabsf(v1.y)), fmaxf(fabsf(v1.z), fabsf(v1.w))));
    am = fmaxf(am, fmaxf(fmaxf(fmaxf(fabsf(v2.x), fabsf(v2.y)), fmaxf(fabsf(v2.z), fabsf(v2.w))),
                         fmaxf(fmaxf(fabsf(v3.x), fabsf(v3.y)), fmaxf(fabsf(v3.z), fabsf(v3.w)))));
    am = wave_max(am);
    float sc = am > 0.f ? 448.f / am : 1.f;
    uint4 o;
    int t = 0;
    t = __builtin_amdgcn_cvt_pk_fp8_f32(v0.x * sc, v0.y * sc, t, false); t = __builtin_amdgcn_cvt_pk_fp8_f32(v0.z * sc, v0.w * sc, t, true); o.x = t;
    t = __builtin_amdgcn_cvt_pk_fp8_f32(v1.x * sc, v1.y * sc, t, false); t = __builtin_amdgcn_cvt_pk_fp8_f32(v1.z * sc, v1.w * sc, t, true); o.y = t;
    t = __builtin_amdgcn_cvt_pk_fp8_f32(v2.x * sc, v2.y * sc, t, false); t = __builtin_amdgcn_cvt_pk_fp8_f32(v2.z * sc, v2.w * sc, t, true); o.z = t;
    t = __builtin_amdgcn_cvt_pk_fp8_f32(v3.x * sc, v3.y * sc, t, false); t = __builtin_amdgcn_cvt_pk_fp8_f32(v3.z * sc, v3.w * sc, t, true); o.w = t;
    if (!isv) {
      *(uint4*)(tab + (size_t)e * 1024 + lane * 16) = o;
      if (lane == 0) ((float*)(tab + TAB_SU))[e] = am > 0.f ? am / 448.f : 1.f;
    } else {
      *(uint4*)(tab + TAB_V8 + ((size_t)(lane >> 3) * 16384 + e) * 128 + (lane & 7) * 16) = o;
      if (lane == 0) ((float*)(tab + TAB_SV))[e] = am > 0.f ? am / 448.f : 1.f;
    }
  }
}
__device__ __forceinline__ f2 dec8(unsigned w, bool hi) { return hi ? __builtin_amdgcn_cvt_pk_f32_fp8((int)w, true) : __builtin_amdgcn_cvt_pk_f32_fp8((int)w, false); }

__device__ __forceinline__ float dot16(uint4 w, f2 a0, f2 a1, f2 a2, f2 a3, f2 a4, f2 a5, f2 a6, f2 a7) {
  f2 a = f2{0.f, 0.f};
  a = __builtin_elementwise_fma(dec8(w.x, false), a0, a); a = __builtin_elementwise_fma(dec8(w.x, true), a1, a);
  a = __builtin_elementwise_fma(dec8(w.y, false), a2, a); a = __builtin_elementwise_fma(dec8(w.y, true), a3, a);
  a = __builtin_elementwise_fma(dec8(w.z, false), a4, a); a = __builtin_elementwise_fma(dec8(w.z, true), a5, a);
  a = __builtin_elementwise_fma(dec8(w.w, false), a6, a); a = __builtin_elementwise_fma(dec8(w.w, true), a7, a);
  return a.x + a.y;
}
#define DOT16(W) dot16(W, xf0, xf1, xf2, xf3, xf4, xf5, xf6, xf7)
__device__ __forceinline__ void phase_peer_act(const P& p, const u16* XN2, const char* tab, const int* IDX, const float* GATE, float* COEF, int ntok, char* lds) {
  const int tid = tid_(), lane = tid & 63, wave = tid >> 6;
  int* le = (int*)(lds + wave * 1536);
  float* lg = (float*)(le + 128);
  int* ls = le + 256;
  const int part = blockIdx.x & 7;
  const int wv = (blockIdx.x >> 3) * 8 + wave, nwv = (gridDim.x >> 3) * 8;
  const float* SU = (const float*)(tab + TAB_SU);
  const float* SV = (const float*)(tab + TAB_SV);
  const int q = lane >> 4;
  const bool hi = (lane & 32) != 0, b4 = (lane & 16) != 0;
  int i0 = 0, i1 = 0; float g0 = 0.f, g1 = 0.f; uint4 x0 = make_uint4(0, 0, 0, 0), x1 = x0;
  if (wv < ntok) {
    i0 = IDX[(size_t)wv * 128 + lane]; i1 = IDX[(size_t)wv * 128 + 64 + lane];
    g0 = GATE[(size_t)wv * 128 + lane]; g1 = GATE[(size_t)wv * 128 + 64 + lane];
    const u16* xr = XN2 + (size_t)wv * DM + lane * 16;
    x0 = *(const uint4*)xr; x1 = *(const uint4*)(xr + 8);
  }
  for (int tok = wv; tok < ntok; tok += nwv) {
    int ni0 = 0, ni1 = 0; float ng0 = 0.f, ng1 = 0.f; uint4 nx0 = make_uint4(0, 0, 0, 0), nx1 = nx0;
    const int nt = tok + nwv;
    if (nt < ntok) {
      ni0 = IDX[(size_t)nt * 128 + lane]; ni1 = IDX[(size_t)nt * 128 + 64 + lane];
      ng0 = GATE[(size_t)nt * 128 + lane]; ng1 = GATE[(size_t)nt * 128 + 64 + lane];
      const u16* xr = XN2 + (size_t)nt * DM + lane * 16;
      nx0 = *(const uint4*)xr; nx1 = *(const uint4*)(xr + 8);
    }
    const bool s0 = (i0 >> 11) == part, s1 = (i1 >> 11) == part;
    const unsigned long long m0 = __ballot(s0), m1 = __ballot(s1);
    const int c0 = __popcll(m0), cnt = c0 + __popcll(m1);
    const int p0 = __builtin_amdgcn_mbcnt_hi((unsigned)(m0 >> 32), __builtin_amdgcn_mbcnt_lo((unsigned)m0, 0));
    const int p1 = c0 + __builtin_amdgcn_mbcnt_hi((unsigned)(m1 >> 32), __builtin_amdgcn_mbcnt_lo((unsigned)m1, 0));
    if (s0) { le[p0] = i0; lg[p0] = g0; ls[p0] = lane; }
    if (s1) { le[p1] = i1; lg[p1] = g1; ls[p1] = 64 + lane; }
    const int cntp = (cnt + 3) & ~3;
    if (lane < cntp - cnt) { le[cnt + lane] = part << 11; lg[cnt + lane] = 0.f; ls[cnt + lane] = -1; }
    const f2 xf0 = f2{bflo(x0.x), bfhi(x0.x)}, xf1 = f2{bflo(x0.y), bfhi(x0.y)}, xf2 = f2{bflo(x0.z), bfhi(x0.z)}, xf3 = f2{bflo(x0.w), bfhi(x0.w)};
    const f2 xf4 = f2{bflo(x1.x), bfhi(x1.x)}, xf5 = f2{bflo(x1.y), bfhi(x1.y)}, xf6 = f2{bflo(x1.z), bfhi(x1.z)}, xf7 = f2{bflo(x1.w), bfhi(x1.w)};
    for (int base = 0; base < cntp; base += 24) {
      uint4 w[24];
      const int evl = le[base + (lane < 24 ? lane : 0)];
#pragma unroll
      for (int gq = 0; gq < 6; ++gq) {
        if (base + 4 * gq < cntp) {
#pragma unroll
          for (int k = 0; k < 4; ++k) {
            int e = __builtin_amdgcn_readlane(evl, 4 * gq + k);
            w[4 * gq + k] = *(const uint4*)(tab + (size_t)e * 1024 + lane * 16);
          }
        } else {
#pragma unroll
          for (int k = 0; k < 4; ++k) w[4 * gq + k] = make_uint4(0, 0, 0, 0);
        }
      }
#pragma unroll
      for (int gq = 0; gq < 6; ++gq) {
        if (base + 4 * gq < cntp) {
          float d0 = DOT16(w[4 * gq]), d1 = DOT16(w[4 * gq + 1]), d2 = DOT16(w[4 * gq + 2]), d3 = DOT16(w[4 * gq + 3]);
          float kA = swapsum32(d0, d2), kB = swapsum32(d1, d3);
          float kC = swapsum16(kA, kB);
          kC = red16(kC);
          const int j = base + 4 * gq + q;
          const int e = le[j]; const float gt = lg[j]; const int slot = ls[j];
          float act = kC * SU[e];
          float coef = gt * 0.5f * act * (1.f + erff(act * 0.70710678118654752f)) * SV[e];
          if ((lane & 15) == 0 && slot >= 0) COEF[(size_t)tok * 128 + slot] = coef;
        }
      }
    }
    i0 = ni0; i1 = ni1; g0 = ng0; g1 = ng1; x0 = nx0; x1 = nx1;
  }
}

__device__ __forceinline__ void phase_peer_sum(const P& p, int layer, const char* tab, const int* IDX, const float* COEF, int ntok, float* dummy_dst) {
  const int tid = tid_(), lane = tid & 63, wave = tid >> 6;
  const int sl = blockIdx.x & 7;
  const int wv = (blockIdx.x >> 3) * 8 + wave, nwv = (gridDim.x >> 3) * 8;
  const int g = lane >> 3, ch = lane & 7;
  const char* V8 = tab + TAB_V8 + (size_t)sl * 16384 * 128 + ch * 16;
  const float* mod = (const float*)(p.ws + O_MOD) + (size_t)layer * 9 * 6144;
  float* HC = (float*)(p.ws + O_HC);
  const bool b5 = (lane & 32) != 0, b4 = (lane & 16) != 0, b3 = (lane & 8) != 0;
  const int c = sl * 128 + ch * 16 + (b5 ? 8 : 0) + (b4 ? 4 : 0) + (b3 ? 2 : 0);
  uint4 ia, ib, ic, id; float4 ca, cb, cc, cd;
  ia = ib = ic = id = make_uint4(0, 0, 0, 0); ca = cb = cc = cd = make_float4(0, 0, 0, 0);
  if (wv < ntok) {
    const int* ip = IDX + (size_t)wv * 128 + g * 16;
    const float* cp = COEF + (size_t)wv * 128 + g * 16;
    ia = *(const uint4*)ip; ib = *(const uint4*)(ip + 4); ic = *(const uint4*)(ip + 8); id = *(const uint4*)(ip + 12);
    ca = *(const float4*)cp; cb = *(const float4*)(cp + 4); cc = *(const float4*)(cp + 8); cd = *(const float4*)(cp + 12);
  }
  for (int tok = wv; tok < ntok; tok += nwv) {
    const unsigned ev[16] = {ia.x, ia.y, ia.z, ia.w, ib.x, ib.y, ib.z, ib.w, ic.x, ic.y, ic.z, ic.w, id.x, id.y, id.z, id.w};
    const float cv[16] = {ca.x, ca.y, ca.z, ca.w, cb.x, cb.y, cb.z, cb.w, cc.x, cc.y, cc.z, cc.w, cd.x, cd.y, cd.z, cd.w};
    uint4 w[16];
#pragma unroll
    for (int i = 0; i < 16; ++i) w[i] = *(const uint4*)(V8 + (size_t)ev[i] * 128);
    float* dst = (dummy_dst ? dummy_dst + (size_t)tok * DM : (tok < NLAT ? p.out + (size_t)tok * DM : HC + (size_t)(tok - NLAT) * DM)) + c;
    float2 o = *(float2*)dst;
    const int nt = tok + nwv;
    if (nt < ntok) {
      const int* ip = IDX + (size_t)nt * 128 + g * 16;
      const float* cp = COEF + (size_t)nt * 128 + g * 16;
      ia = *(const uint4*)ip; ib = *(const uint4*)(ip + 4); ic = *(const uint4*)(ip + 8); id = *(const uint4*)(ip + 12);
      ca = *(const float4*)cp; cb = *(const float4*)(cp + 4); cc = *(const float4*)(cp + 8); cd = *(const float4*)(cp + 12);
    }
    f2 acc[8];
#pragma unroll
    for (int k = 0; k < 8; ++k) acc[k] = f2{0.f, 0.f};
#pragma unroll
    for (int i = 0; i < 16; ++i) {
      f2 c2 = f2{cv[i], cv[i]};
      acc[0] = __builtin_elementwise_fma(dec8(w[i].x, false), c2, acc[0]); acc[1] = __builtin_elementwise_fma(dec8(w[i].x, true), c2, acc[1]);
      acc[2] = __builtin_elementwise_fma(dec8(w[i].y, false), c2, acc[2]); acc[3] = __builtin_elementwise_fma(dec8(w[i].y, true), c2, acc[3]);
      acc[4] = __builtin_elementwise_fma(dec8(w[i].z, false), c2, acc[4]); acc[5] = __builtin_elementwise_fma(dec8(w[i].z, true), c2, acc[5]);
      acc[6] = __builtin_elementwise_fma(dec8(w[i].w, false), c2, acc[6]); acc[7] = __builtin_elementwise_fma(dec8(w[i].w, true), c2, acc[7]);
    }
    float r8[8];
#pragma unroll
    for (int k = 0; k < 4; ++k) {
      r8[2 * k] = swapsum32(acc[k].x, acc[4 + k].x);
      r8[2 * k + 1] = swapsum32(acc[k].y, acc[4 + k].y);
    }
    float r4[4];
#pragma unroll
    for (int k = 0; k < 4; ++k) r4[k] = swapsum16(r8[k], r8[4 + k]);
    float r2[2];
#pragma unroll
    for (int k = 0; k < 2; ++k) {
      float kx = b3 ? r4[2 + k] : r4[k], sx = b3 ? r4[k] : r4[2 + k];
      r2[k] = kx + dppf<0x128>(sx);
    }
    const int mi = tok < NLAT ? (tok >> 12) : 8;
    const float2 mv = *(const float2*)(mod + mi * 6144 + 5 * 1024 + c);
    o.x += mv.x * r2[0]; o.y += mv.y * r2[1];
    *(float2*)dst = o;
  }
}

__device__ __forceinline__ void phase_scan(const P& p, char* lds, bool dummy) {
  float* buf = (float*)lds;
  float* vbuf = (float*)(lds + 81920);
  u16* ybuf = (u16*)(lds + 81920 + 16384);
  const int tid = tid_(), lane = tid & 63, wave = tid >> 6;
  const int c = lane & 7, irow = wave * 8 + (lane >> 3);
  const u16* R = (const u16*)(p.ws + O_R);
  const u16* Kp = (const u16*)(p.ws + O_K);
  const u16* Vp = (const u16*)(p.ws + O_V);
  const int ps = tid >> 4, col4 = (tid & 15) * 4;
  for (int item = blockIdx.x; item < 256; item += gridDim.x) {
    const int dir = item & 1, hh = (item >> 1) & 15, b = item >> 5;
    char* WA = p.ws + (dir ? O_WA1 : O_WA0);
    float* BON = (float*)(p.ws + O_BONUS) + (size_t)dir * NLAT * 16;
    float kkc[4], kac[4], rkc[4];
#pragma unroll
    for (int e = 0; e < 4; ++e) {
      kkc[e] = p.in[20][hh * 64 + col4 + e];
      kac[e] = p.in[21][hh * 64 + col4 + e];
      rkc[e] = p.in[22][hh * 64 + col4 + e];
    }
    auto rowof = [&](int s) -> int {
      if (s < 256) { int pos = dir ? 255 - s : s; return NLAT + b * 256 + pos; }
      int u = s - 256; int pos = dir ? 4095 - u : u; return b * 4096 + pos;
    };
    uint2 pr, pk, pv; unsigned pw, pa; int prow;
    auto gload = [&](int ch) {
      prow = rowof(ch * 32 + ps);
      size_t o = (size_t)prow * 1024 + hh * 64 + col4;
      pr = *(const uint2*)(R + o); pk = *(const uint2*)(Kp + o); pv = *(const uint2*)(Vp + o);
      const char* wp = WA + (size_t)prow * 2048 + hh * 128;
      pw = *(const unsigned*)(wp + col4); pa = *(const unsigned*)(wp + 64 + col4);
    };
    auto prep = [&](int bi) {
      float rr[4] = {bflo(pr.x), bfhi(pr.x), bflo(pr.y), bfhi(pr.y)};
      float kq[4] = {bflo(pk.x), bfhi(pk.x), bflo(pk.y), bfhi(pk.y)};
      float4 vv = make_float4(bflo(pv.x), bfhi(pv.x), bflo(pv.y), bfhi(pv.y));
      float w[4], a[4], kr[4], kk[4], bb[4], kd[4];
      float ss = 0.f;
#pragma unroll
      for (int e = 0; e < 4; ++e) {
        w[e] = 0.5f + (float)((pw >> (8 * e)) & 255u) * (1.f / 510.f);
        a[e] = (float)((pa >> (8 * e)) & 255u) * (1.f / 255.f);
        kr[e] = kq[e] * kkc[e];
        ss += kr[e] * kr[e];
      }
      ss = red16(ss);
      float inv = rsqrtf(ss + 1e-12f);
      float bn = 0.f;
#pragma unroll
      for (int e = 0; e < 4; ++e) {
        kk[e] = kr[e] * inv;
        bb[e] = kk[e] * a[e];
        kd[e] = kq[e] * (1.f + (a[e] - 1.f) * kac[e]);
        bn += rr[e] * kd[e] * rkc[e];
      }
      bn = red16(bn);
      if ((tid & 15) == 0 && prow < NLAT) BON[(size_t)prow * 16 + hh] = bn;
      float* d = buf + bi * 10240 + ((ps * 8 + (col4 >> 3)) * 5) * 8 + (col4 & 7);
      *(float4*)(d) = make_float4(rr[0], rr[1], rr[2], rr[3]);
      *(float4*)(d + 8) = make_float4(w[0], w[1], w[2], w[3]);
      *(float4*)(d + 16) = make_float4(kk[0], kk[1], kk[2], kk[3]);
      *(float4*)(d + 24) = make_float4(bb[0], bb[1], bb[2], bb[3]);
      *(float4*)(d + 32) = make_float4(kd[0], kd[1], kd[2], kd[3]);
      *(float4*)(vbuf + bi * 2048 + ps * 64 + col4) = vv;
    };
    float S[8];
#pragma unroll
    for (int j = 0; j < 8; ++j) S[j] = 0.f;
    gload(0);
    prep(0);
    __syncthreads();
    for (int ch = 0; ch < 136; ++ch) {
      const int cur = ch & 1;
      if (ch + 1 < 136) gload(ch + 1);
      const float* bq = buf + cur * 10240 + c * 40;
      const float* vq = vbuf + cur * 2048 + irow;
      float4 nr0, nr1, nw0, nw1, nk0, nk1, nb0, nb1, nd0, nd1; float nvi;
      {
        const float* q = bq;
        nr0 = *(const float4*)(q); nr1 = *(const float4*)(q + 4); nw0 = *(const float4*)(q + 8); nw1 = *(const float4*)(q + 12);
        nk0 = *(const float4*)(q + 16); nk1 = *(const float4*)(q + 20); nb0 = *(const float4*)(q + 24); nb1 = *(const float4*)(q + 28);
        nd0 = *(const float4*)(q + 32); nd1 = *(const float4*)(q + 36); nvi = vq[0];
      }
#pragma unroll 4
      for (int t = 0; t < 32; ++t) {
        const float4 r0 = nr0, r1 = nr1, w0 = nw0, w1 = nw1, k0 = nk0, k1 = nk1, b0 = nb0, b1 = nb1, d0 = nd0, d1 = nd1;
        const float vi = nvi;
        if (t + 1 < 32) {
          const float* q = bq + (t + 1) * 320;
          nr0 = *(const float4*)(q); nr1 = *(const float4*)(q + 4); nw0 = *(const float4*)(q + 8); nw1 = *(const float4*)(q + 12);
          nk0 = *(const float4*)(q + 16); nk1 = *(const float4*)(q + 20); nb0 = *(const float4*)(q + 24); nb1 = *(const float4*)(q + 28);
          nd0 = *(const float4*)(q + 32); nd1 = *(const float4*)(q + 36); nvi = vq[(t + 1) * 64];
        }
        float sa = (S[0] * k0.x + S[1] * k0.y) + (S[2] * k0.z + S[3] * k0.w) + ((S[4] * k1.x + S[5] * k1.y) + (S[6] * k1.z + S[7] * k1.w));
        sa = red8(sa);
        S[0] = fmaf(S[0], w0.x, fmaf(-sa, b0.x, vi * d0.x));
        S[1] = fmaf(S[1], w0.y, fmaf(-sa, b0.y, vi * d0.y));
        S[2] = fmaf(S[2], w0.z, fmaf(-sa, b0.z, vi * d0.z));
        S[3] = fmaf(S[3], w0.w, fmaf(-sa, b0.w, vi * d0.w));
        S[4] = fmaf(S[4], w1.x, fmaf(-sa, b1.x, vi * d1.x));
        S[5] = fmaf(S[5], w1.y, fmaf(-sa, b1.y, vi * d1.y));
        S[6] = fmaf(S[6], w1.z, fmaf(-sa, b1.z, vi * d1.z));
        S[7] = fmaf(S[7], w1.w, fmaf(-sa, b1.w, vi * d1.w));
        float y = (S[0] * r0.x + S[1] * r0.y) + (S[2] * r0.z + S[3] * r0.w) + ((S[4] * r1.x + S[5] * r1.y) + (S[6] * r1.z + S[7] * r1.w));
        y = red8(y);
        if (c == 0) ybuf[t * 64 + irow] = f2bf(y);
      }
      __syncthreads();
      if (ch >= 8 && !dummy) {
        int row = rowof(ch * 32 + ps);
        uint2 yv = *(const uint2*)(ybuf + ps * 64 + col4);
        *(uint2*)(WA + (size_t)row * 2048 + hh * 128 + col4 * 2) = yv;
      }
      if (ch + 1 < 136) prep(cur ^ 1);
      __syncthreads();
    }
  }
}

__device__ __forceinline__ void phase_readout(const P& p) {
  const u16* Vp = (const u16*)(p.ws + O_V);
  const u16* G = (const u16*)(p.ws + O_G);
  u16* Z = (u16*)(p.ws + O_Z);
  const float* BON = (const float*)(p.ws + O_BONUS);
  const size_t gt = (size_t)blockIdx.x * NT + tid_(), gn = (size_t)gridDim.x * NT;
  for (size_t it = gt; it < (size_t)NLAT * 16 * 8; it += gn) {
    int sub = (int)(it & 7); size_t grp = it >> 3;
    int hh = (int)(grp & 15); int row = (int)(grp >> 4);
    uint4 y0 = *(const uint4*)(p.ws + O_WA0 + (size_t)row * 2048 + hh * 128 + sub * 16);
    uint4 y1 = *(const uint4*)(p.ws + O_WA1 + (size_t)row * 2048 + hh * 128 + sub * 16);
    float y[8] = {bflo(y0.x) + bflo(y1.x), bfhi(y0.x) + bfhi(y1.x), bflo(y0.y) + bflo(y1.y), bfhi(y0.y) + bfhi(y1.y),
                  bflo(y0.z) + bflo(y1.z), bfhi(y0.z) + bfhi(y1.z), bflo(y0.w) + bflo(y1.w), bfhi(y0.w) + bfhi(y1.w)};
    float s = 0.f;
#pragma unroll
    for (int e = 0; e < 8; ++e) s += y[e];
    float mean = red8(s) * (1.f / 64.f);
    float vs = 0.f;
#pragma unroll
    for (int e = 0; e < 8; ++e) { y[e] -= mean; vs += y[e] * y[e]; }
    float var = red8(vs) * (1.f / 64.f);
    float rs = rsqrtf(var + 64e-5f);
    float bonus = BON[(size_t)row * 16 + hh] + BON[(size_t)NLAT * 16 + (size_t)row * 16 + hh];
    int col = hh * 64 + sub * 8;
    uint4 vv = *(const uint4*)(Vp + (size_t)row * DM + col);
    uint4 gg = *(const uint4*)(G + (size_t)row * DM + col);
    float vf[8] = {bflo(vv.x), bfhi(vv.x), bflo(vv.y), bfhi(vv.y), bflo(vv.z), bfhi(vv.z), bflo(vv.w), bfhi(vv.w)};
    float gf[8] = {bflo(gg.x), bfhi(gg.x), bflo(gg.y), bfhi(gg.y), bflo(gg.z), bfhi(gg.z), bflo(gg.w), bfhi(gg.w)};
    float z[8];
#pragma unroll
    for (int e = 0; e < 8; ++e) z[e] = (y[e] * rs * p.in[29][col + e] + p.in[30][col + e] + bonus * vf[e]) * gf[e];
    uint4 ov; ov.x = pack2(z[0], z[1]); ov.y = pack2(z[2], z[3]); ov.z = pack2(z[4], z[5]); ov.w = pack2(z[6], z[7]);
    *(uint4*)(Z + (size_t)row * DM + col) = ov;
  }
}

__global__ void __launch_bounds__(NT) fwd_kernel(P p) {
  extern __shared__ __attribute__((aligned(16))) char lds[];
  cg::grid_group grid = cg::this_grid();
  char* ws = p.ws;
  const float* mod0 = (const float*)(ws + O_MOD);
  const float* mod1 = mod0 + 9 * 6144;
  for (int ph = p.ph_lo; ph < p.ph_hi; ++ph) {
    if (ph > p.ph_lo) grid.sync();
    if (!((PHASE_MASK >> ph) & 1)) continue;
    const int nrep = ((REPEAT_MASK >> ph) & 1) ? 2 : 1;
    for (int rep = 0; rep < nrep; ++rep) {
    const bool dummy = rep + 1 < nrep;
    if (rep) grid.sync();
    switch (ph) {
      case 0: phase_prep(p, lds); break;
      case 1: phase_norm(p, p.in[0], p.in[2], p.in[6], 0, 0, TTOK, (u16*)(ws + O_XN)); break;
      case 2: {
        u16* hgg = (u16*)(ws + O_HGG); u16* Q = (u16*)(ws + O_Q); u16* KBp = (u16*)(ws + O_KB); u16* VT = (u16*)(ws + O_VT);
        for (int t = blockIdx.x; t < 136 * 10; t += gridDim.x) {
          int mt = t / 10, ntw = t % 10;
          if (ntw < 8) {
            const int n0w = ntw * 256;
            u16* dbase; int dld;
            if (n0w < 1536) { dbase = hgg + n0w; dld = 1536; } else { dbase = Q + (n0w - 1536); dld = 512; }
            auto xf = [&](float v, int row, int col) -> float { return v; };
            auto dstf = [&](int row) -> u16* { return dbase + (size_t)row * dld; };
            gemm_tile256<false>((const u16*)(ws + O_XN), 1024, nullptr, (const u16*)(ws + O_WIN) + (size_t)n0w * 1024, 1024, 1024,
                                mt * 256, xf, dstf, (u16*)lds);
            continue;
          }
          int nt = 8 + ntw;
          int n0 = nt * 128;
          auto epi = [&](int row, int col, float v0, float v1, float v2, float v3) {
            int n = n0 + col;
            float v[4] = {v0, v1, v2, v3};
            if (n < 1536) {
#pragma unroll
              for (int j = 0; j < 4; ++j) hgg[(size_t)(row + j) * 1536 + n] = f2bf(v[j]);
            } else if (n < 2048) {
#pragma unroll
              for (int j = 0; j < 4; ++j) Q[(size_t)(row + j) * 512 + n - 1536] = f2bf(v[j]);
            } else if (n < 2176) {
#pragma unroll
              for (int j = 0; j < 4; ++j) KBp[(size_t)(row + j) * 128 + n - 2048] = f2bf(v[j]);
            } else {
              int kvh = (n - 2176) >> 6, d = (n - 2176) & 63;
              int b, pos;
              if (row < NLAT) { b = row >> 12; pos = 256 + (row & 4095); } else { b = (row - NLAT) >> 8; pos = (row - NLAT) & 255; }
              uint2 o; o.x = pack2(v0, v1); o.y = pack2(v2, v3);
              *(uint2*)(VT + ((size_t)((b * 2 + kvh) * 64 + d)) * 4352 + pos) = o;
            }
          };
          if (nt < 17) {
            u16* dbase; int dld;
            if (n0 < 1536) { dbase = hgg + n0; dld = 1536; } else if (n0 < 2048) { dbase = Q + (n0 - 1536); dld = 512; } else { dbase = KBp + (n0 - 2048); dld = 128; }
            auto xf = [&](float v, int row, int col) -> float { return v; };
            auto dstf = [&](int row) -> u16* { return dbase + (size_t)row * dld; };
            gemm_tile<false, 1>((const u16*)(ws + O_XN), 1024, nullptr, (const u16*)(ws + O_WIN) + (size_t)n0 * 1024, 1024, 1024,
                                mt * 256, xf, dstf, (u16*)lds);
          } else {
            gemm_tile<false, 0>((const u16*)(ws + O_XN), 1024, nullptr, (const u16*)(ws + O_WIN) + (size_t)n0 * 1024, 1024, 1024,
                                mt * 256, epi, 0, (u16*)lds);
          }
        }
      } break;
      case 3: phase_conv_qk(p); break;
      case 4: phase_attn(p, lds); break;
      case 5: {
        float* HC = (float*)(ws + O_HC);
        for (int t = blockIdx.x; t < 136 * 8; t += gridDim.x) {
          int mt = t / 8, nt = t % 8;
          int n0 = nt * 128;
          auto epi = [&](int row, int col, float v0, float v1, float v2, float v3) {
            int n = n0 + col;
            float v[4] = {v0, v1, v2, v3};
#pragma unroll
            for (int j = 0; j < 4; ++j) {
              int rw = row + j;
              if (rw < NLAT) {
                float g = mod0[(rw >> 12) * 6144 + 2048 + n];
                p.out[(size_t)rw * DM + n] = p.in[0][(size_t)rw * DM + n] + g * v[j];
              } else {
                float g = mod0[8 * 6144 + 2048 + n];
                HC[(size_t)(rw - NLAT) * DM + n] = p.in[2][(size_t)(rw - NLAT) * DM + n] + g * v[j];
              }
            }
          };
          gemm_tile<false, 0>((const u16*)(ws + O_XN), 1024, nullptr, (const u16*)(ws + O_WOUT) + (size_t)n0 * 1024, 1024, 1024,
                              mt * 256, epi, 0, (u16*)lds);
        }
      } break;
      case 6: phase_norm(p, p.out, (const float*)(ws + O_HC), p.in[7], 0, 3, TTOK, (u16*)(ws + O_XN)); break;
      case 7: case 18: {
        int layer = ph == 7 ? 0 : 1;
        int mtiles = layer == 0 ? 136 : 128;
        u16* PQ = (u16*)(ws + (layer == 0 ? O_PQ0 : O_PQ1));
        const u16* Wq = (const u16*)(ws + O_WQ) + (size_t)layer * 2048 * 1024;
        for (int t = blockIdx.x; t < mtiles * 8; t += gridDim.x) {
          int mt = t / 8, nt = t % 8;
          int n0 = nt * 256;
          auto epi = [&](int row, int col, float v0, float v1, float v2, float v3) {
            int n = n0 + col;
            float v[4] = {v0, v1, v2, v3};
#pragma unroll
            for (int j = 0; j < 4; ++j) PQ[(size_t)(row + j) * 2048 + n] = f2bf(v[j]);
          };
          auto xf = [&](float v, int row, int col) -> float { return v; };
          auto dstf = [&](int row) -> u16* { return PQ + (size_t)row * 2048 + n0; };
          gemm_tile256<false>((const u16*)(ws + O_XN), 1024, nullptr, Wq + (size_t)n0 * 1024, 1024, 1024, mt * 256, xf, dstf, (u16*)lds);
        }
      } break;
      case 8: phase_peer_topk(p, 0, (const u16*)(ws + O_PQ0), TTOK, (int*)(ws + O_IDX0), (float*)(ws + O_GATE0), lds); break;
      case 9: phase_peer_act(p, (const u16*)(ws + O_XN), ws + O_TAB0, (const int*)(ws + O_IDX0), (const float*)(ws + O_GATE0),
                             (float*)(ws + O_COEF0), TTOK, lds); break;
      case 10: phase_peer_sum(p, 0, ws + O_TAB0, (const int*)(ws + O_IDX0), (const float*)(ws + O_COEF0), TTOK, dummy ? (float*)(ws + O_A2R) : nullptr); break;
      case 11: phase_norm(p, p.out, (const float*)(ws + O_HC), p.in[6] + 1024, 1, 0, TTOK, (u16*)(ws + O_XN)); break;
      case 12: {
        u16* LORA = (u16*)(ws + O_LORA);
        for (int t = blockIdx.x; t < 136 * 27; t += gridDim.x) {
          int mt = t / 27, nt = t % 27;
          const u16* Bp; int mixi; u16* dstp = nullptr; int kind;
          if (nt < 8) { Bp = (const u16*)(ws + O_WR) + (size_t)nt * 128 * 1024; mixi = 0; dstp = (u16*)(ws + O_R) + nt * 128; kind = 0; }
          else if (nt < 16) { Bp = (const u16*)(ws + O_WK) + (size_t)(nt - 8) * 128 * 1024; mixi = 2; dstp = (u16*)(ws + O_K) + (nt - 8) * 128; kind = 0; }
          else if (nt < 24) { Bp = (const u16*)(ws + O_WV) + (size_t)(nt - 16) * 128 * 1024; mixi = 3; dstp = (u16*)(ws + O_V) + (nt - 16) * 128; kind = 0; }
          else if (nt == 24) { Bp = (const u16*)(ws + O_W1); mixi = 1; kind = 1; }
          else if (nt == 25) { Bp = (const u16*)(ws + O_A1); mixi = 4; kind = 2; }
          else { Bp = (const u16*)(ws + O_G1); mixi = 5; kind = 3; }
          auto epi = [&](int row, int col, float v0, float v1, float v2, float v3) {
            float v[4] = {v0, v1, v2, v3};
            if (kind == 0) {
#pragma unroll
              for (int j = 0; j < 4; ++j) dstp[(size_t)(row + j) * 1024 + col] = f2bf(v[j]);
            } else if (kind == 1) {
#pragma unroll
              for (int j = 0; j < 4; ++j) LORA[(size_t)(row + j) * 384 + col] = f2bf(tanhf(v[j]));
            } else if (kind == 2) {
#pragma unroll
              for (int j = 0; j < 4; ++j) LORA[(size_t)(row + j) * 384 + 128 + col] = f2bf(v[j]);
            } else {
#pragma unroll
              for (int j = 0; j < 4; ++j) LORA[(size_t)(row + j) * 384 + 256 + col] = f2bf(sigmoidf_(v[j]));
            }
          };
          auto xf = [&](float v, int row, int col) -> float { return kind == 1 ? tanhf(v) : (kind == 3 ? sigmoidf_(v) : v); };
          u16* dbase = kind == 0 ? dstp : (LORA + (kind - 1) * 128);
          const int dld = kind == 0 ? 1024 : 384;
          auto dstf = [&](int row) -> u16* { return dbase + (size_t)row * dld; };
          gemm_tile<true, 1>((const u16*)(ws + O_XN), 1024, p.in[13] + mixi * 1024, Bp, 1024, 1024, mt * 256, xf, dstf, (u16*)lds);
        }
      } break;
      case 13: {
        const u16* LORA = (const u16*)(ws + O_LORA);
        u16* G = (u16*)(ws + O_G);
        for (int t = blockIdx.x; t < 136 * 40; t += gridDim.x) {
          int mt = t / 40, nt = t % 40;
          int grp = nt >> 3, n0 = (nt & 7) * 128;
          const u16* Ap; const u16* Bp; int K, ldb;
          if (grp < 2) { Ap = LORA + grp * 64; Bp = (const u16*)(ws + O_W2) + (size_t)grp * 65536 + (size_t)n0 * 64; K = 64; ldb = 64; }
          else if (grp < 4) { Ap = LORA + 128 + (grp - 2) * 64; Bp = (const u16*)(ws + O_A2) + (size_t)(grp - 2) * 65536 + (size_t)n0 * 64; K = 64; ldb = 64; }
          else { Ap = LORA + 256; Bp = (const u16*)(ws + O_G2) + (size_t)n0 * 128; K = 128; ldb = 128; }
          int d = grp & 1;
          u8* WA = (u8*)(ws + (d ? O_WA1 : O_WA0));
          auto epi = [&](int row, int col, float v0, float v1, float v2, float v3) {
            int n = n0 + col;
            float v[4] = {v0, v1, v2, v3};
            if (grp < 2) {
              float w0 = p.in[23][d * 1024 + n];
#pragma unroll
              for (int j = 0; j < 4; ++j) {
                float x = w0 + v[j];
                float dec = __expf(-0.6065306597126334f * sigmoidf_(x));
                float q = rintf((dec - 0.5f) * 510.f);
                q = fminf(fmaxf(q, 0.f), 255.f);
                WA[(size_t)(row + j) * 2048 + (n >> 6) * 128 + (n & 63)] = (u8)q;
              }
            } else if (grp < 4) {
              float a0 = p.in[26][d * 1024 + n];
#pragma unroll
              for (int j = 0; j < 4; ++j) {
                float a = sigmoidf_(a0 + v[j]);
                float q = fminf(fmaxf(rintf(a * 255.f), 0.f), 255.f);
                WA[(size_t)(row + j) * 2048 + (n >> 6) * 128 + 64 + (n & 63)] = (u8)q;
              }
            } else {
#pragma unroll
              for (int j = 0; j < 4; ++j) G[(size_t)(row + j) * 1024 + n] = f2bf(v[j]);
            }
          };
          if (grp < 4) {
            const float* b0p = (grp < 2 ? p.in[23] : p.in[26]) + d * 1024 + n0;
            auto q8 = [&](float v, int row, int col) -> unsigned {
              float x = b0p[col] + v;
              float qv;
              if (grp < 2) { float dec = __expf(-0.6065306597126334f * sigmoidf_(x)); qv = rintf((dec - 0.5f) * 510.f); }
              else { qv = rintf(sigmoidf_(x) * 255.f); }
              return (unsigned)fminf(fmaxf(qv, 0.f), 255.f);
            };
            auto dst8 = [&](int row, int c16) -> u8* {
              int n = n0 + c16 * 16;
              return WA + (size_t)row * 2048 + (n >> 6) * 128 + (grp < 2 ? 0 : 64) + (n & 63);
            };
            gemm_tile<false, 2>(Ap, 384, nullptr, Bp, ldb, K, mt * 256, q8, dst8, (u16*)lds);
          } else {
            auto xf = [&](float v, int row, int col) -> float { return v; };
            auto dstf = [&](int row) -> u16* { return G + (size_t)row * 1024 + n0; };
            gemm_tile<false, 1>(Ap, 384, nullptr, Bp, ldb, K, mt * 256, xf, dstf, (u16*)lds);
          }
        }
      } break;
      case 14: phase_scan(p, lds, dummy); break;
      case 15:
        phase_readout(p);
        convert_tab_fp8(p.in[33] + (size_t)16384 * 1024, p.in[34] + (size_t)16384 * 1024, ws + O_TAB1);
        break;
      case 16: {
        for (int t = blockIdx.x; t < 128 * 8; t += gridDim.x) {
          int mt = t / 8, nt = t % 8;
          int n0 = nt * 128;
          auto epi = [&](int row, int col, float v0, float v1, float v2, float v3) {
            int n = n0 + col;
            float v[4] = {v0, v1, v2, v3};
#pragma unroll
            for (int j = 0; j < 4; ++j) {
              int rw = row + j;
              float g = mod1[(rw >> 12) * 6144 + 2048 + n];
              p.out[(size_t)rw * DM + n] += g * v[j];
            }
          };
          gemm_tile<false, 0>((const u16*)(ws + O_Z), 1024, nullptr, (const u16*)(ws + O_WO) + (size_t)n0 * 1024, 1024, 1024,
                              mt * 256, epi, 0, (u16*)lds);
        }
      } break;
      case 17: phase_norm(p, p.out, nullptr, p.in[7] + 1024, 1, 3, NLAT, (u16*)(ws + O_XN)); break;
      case 19: phase_peer_topk(p, 1, (const u16*)(ws + O_PQ1), NLAT, (int*)(ws + O_IDX1), (float*)(ws + O_GATE1), lds); break;
      case 20: phase_peer_act(p, (const u16*)(ws + O_XN), ws + O_TAB1, (const int*)(ws + O_IDX1), (const float*)(ws + O_GATE1),
                              (float*)(ws + O_COEF1), NLAT, lds); break;
      case 21: phase_peer_sum(p, 1, ws + O_TAB1, (const int*)(ws + O_IDX1), (const float*)(ws + O_COEF1), NLAT, dummy ? (float*)(ws + O_A5R) : nullptr); break;
      default: break;
    }
    }
  }
}

extern "C" void kernel_launch(void* const* d_in, const int* in_sizes, int n_in, void* d_out, int out_size, void* d_ws,
                              size_t ws_size, hipStream_t stream) {
  static int grid = 0;
  if (grid == 0) {
    if (n_in != 35 || ws_size < WS_END) {
      fprintf(stderr, "kernel_launch: unexpected n_in %d or ws_size %zu (need %zu)\n", n_in, ws_size, (size_t)WS_END);
      grid = -1;
      return;
    }
    int dev = 0, cus = 0, per_cu = 0;
    hipGetDevice(&dev);
    hipDeviceGetAttribute(&cus, hipDeviceAttributeMultiprocessorCount, dev);
    hipFuncSetAttribute((const void*)fwd_kernel, hipFuncAttributeMaxDynamicSharedMemorySize, LDS_BYTES);
    hipOccupancyMaxActiveBlocksPerMultiprocessor(&per_cu, (const void*)fwd_kernel, NT, LDS_BYTES);
    (void)hipGetLastError();
    if (per_cu < 1) per_cu = 1;
    grid = (cus / 8) * 8;
    if (grid > cus * per_cu) grid = cus * per_cu;
  }
  if (grid < 0) return;
  P p{};
  for (int i = 0; i < 35; ++i) p.in[i] = (const float*)d_in[i];
  p.out = (float*)d_out;
  p.ws = (char*)d_ws;
#if N_LAUNCH_MODE == 0
  p.ph_lo = 0; p.ph_hi = NPHASE;
  void* args[] = {&p};
  hipError_t e = hipLaunchCooperativeKernel((const void*)fwd_kernel, dim3(grid), dim3(NT), args, LDS_BYTES, stream);
  if (e != hipSuccess) fprintf(stderr, "cooperative launch failed: %s (grid %d)\n", hipGetErrorString(e), grid);
#else
  for (int ph = 0; ph < NPHASE; ++ph) {
    p.ph_lo = ph; p.ph_hi = ph + 1;
    hipLaunchKernelGGL(fwd_kernel, dim3(grid), dim3(NT), LDS_BYTES, stream, p);
  }
#endif
}
```

```cpp
#include <hip/hip_runtime.h>
#include <hip/hip_cooperative_groups.h>
#include <cstdio>
namespace cg = cooperative_groups;

#ifndef N_LAUNCH_MODE
#define N_LAUNCH_MODE 0
#endif

typedef unsigned short u16;
typedef unsigned char u8;
typedef __attribute__((ext_vector_type(8))) short bf16x8;
typedef __attribute__((ext_vector_type(16))) float f32x16;

#define NT 512
#define TTOK 34816
#define NLAT 32768
#define DM 1024
#define LDSS 72
#define LDS_BYTES 114688
#define NPHASE 22
#ifndef REPEAT_MASK
#define REPEAT_MASK 0
#endif
#ifndef PHASE_MASK
#define PHASE_MASK 0x3FFFFF
#endif

static constexpr size_t MiB = 1048576;
static constexpr size_t O_WIN = 0;
static constexpr size_t O_WOUT = O_WIN + 4718592;
static constexpr size_t O_WR = O_WOUT + 2097152;
static constexpr size_t O_WK = O_WR + 2097152;
static constexpr size_t O_WV = O_WK + 2097152;
static constexpr size_t O_WO = O_WV + 2097152;
static constexpr size_t O_G1 = O_WO + 2097152;
static constexpr size_t O_G2 = O_G1 + 262144;
static constexpr size_t O_W1 = O_G2 + 262144;
static constexpr size_t O_A1 = O_W1 + 262144;
static constexpr size_t O_W2 = O_A1 + 262144;
static constexpr size_t O_A2 = O_W2 + 262144;
static constexpr size_t O_WQ = O_A2 + 262144;
static constexpr size_t O_KEYS = O_WQ + 8388608;
static constexpr size_t O_MOD = O_KEYS + 1048576;
static constexpr size_t O_ROPE = O_MOD + 442368;
static constexpr size_t SZ = 68 * MiB;
static constexpr size_t O_A1R = 26 * MiB;
static constexpr size_t O_A2R = O_A1R + SZ;
static constexpr size_t O_A3R = O_A2R + SZ;
static constexpr size_t O_A4R = O_A3R + SZ;
static constexpr size_t O_A5R = O_A4R + SZ;
static constexpr size_t O_A6R = O_A5R + SZ;
static constexpr size_t O_A7R = O_A6R + SZ;
static constexpr size_t O_LORA = O_A7R;
static constexpr size_t O_BONUS = O_A7R + 26 * MiB;
static constexpr size_t WS_END = O_BONUS + 4 * MiB;
static constexpr size_t O_XN = O_A1R;
static constexpr size_t O_HGG = O_A2R;
static constexpr size_t O_Q = O_A2R + 102 * MiB;
static constexpr size_t O_KB = O_A4R;
static constexpr size_t O_VT = O_A4R + 9 * MiB;
static constexpr size_t O_PQ0 = O_A2R;
static constexpr size_t O_TAB0 = O_A5R;
static constexpr size_t O_IDX0 = O_A6R;
static constexpr size_t O_GATE0 = O_A6R + 17 * MiB;
static constexpr size_t O_HC = O_A6R + 34 * MiB;
static constexpr size_t O_COEF0 = O_A6R + 42 * MiB;
static constexpr size_t O_R = O_A2R, O_K = O_A3R, O_V = O_A4R;
static constexpr size_t O_WA0 = O_A5R, O_WA1 = O_A6R;
static constexpr size_t O_G = O_A1R;
static constexpr size_t O_Z = O_A2R;
static constexpr size_t O_TAB1 = O_A3R;
static constexpr size_t O_PQ1 = O_A5R;
static constexpr size_t O_IDX1 = O_A4R;
static constexpr size_t O_GATE1 = O_A4R + 17 * MiB;
static constexpr size_t O_COEF1 = O_A4R + 34 * MiB;

struct P {
  const float* in[35];
  float* out;
  char* ws;
  int ph_lo, ph_hi;
};

typedef __bf16 bf16x2_t __attribute__((ext_vector_type(2)));
typedef float f32x2_t __attribute__((ext_vector_type(2)));
__device__ __forceinline__ u16 f2bf(float f) {
  __bf16 b = (__bf16)f;
  return __builtin_bit_cast(u16, b);
}
__device__ __forceinline__ float bf2f(u16 h) { return __uint_as_float(((unsigned)h) << 16); }
__device__ __forceinline__ float bflo(unsigned w) { return __uint_as_float(w << 16); }
__device__ __forceinline__ float bfhi(unsigned w) { return __uint_as_float(w & 0xFFFF0000u); }
__device__ __forceinline__ unsigned pack2(float a, float b) { f32x2_t v = {a, b}; bf16x2_t r = __builtin_convertvector(v, bf16x2_t); return __builtin_bit_cast(unsigned, r); }

__device__ __forceinline__ int tid_() { int t = __builtin_amdgcn_workitem_id_x(); asm volatile("" : "+v"(t)); return t; }
template <int CTRL>
__device__ __forceinline__ float dppf(float v) {
  return __builtin_bit_cast(float, __builtin_amdgcn_update_dpp(0, __builtin_bit_cast(int, v), CTRL, 0xF, 0xF, true));
}
__device__ __forceinline__ float red8(float v) {
  v += dppf<0xB1>(v); v += dppf<0x4E>(v); v += dppf<0x141>(v); return v;
}
__device__ __forceinline__ float red16(float v) { v = red8(v); v += dppf<0x140>(v); return v; }
__device__ __forceinline__ float swapsum32(float a, float b) {
  auto r = __builtin_amdgcn_permlane32_swap(__float_as_uint(a), __float_as_uint(b), false, false);
  return __uint_as_float(r[0]) + __uint_as_float(r[1]);
}
__device__ __forceinline__ float swapsum16(float a, float b) {
  auto r = __builtin_amdgcn_permlane16_swap(__float_as_uint(a), __float_as_uint(b), false, false);
  return __uint_as_float(r[0]) + __uint_as_float(r[1]);
}
__device__ __forceinline__ float swapmax32(float a) {
  auto r = __builtin_amdgcn_permlane32_swap(__float_as_uint(a), __float_as_uint(a), false, false);
  return fmaxf(__uint_as_float(r[0]), __uint_as_float(r[1]));
}
__device__ __forceinline__ float swapmax16(float a) {
  auto r = __builtin_amdgcn_permlane16_swap(__float_as_uint(a), __float_as_uint(a), false, false);
  return fmaxf(__uint_as_float(r[0]), __uint_as_float(r[1]));
}
__device__ __forceinline__ float wave_sum(float v) {
  v = red16(v);
  v = swapsum16(v, v); v = swapsum32(v, v);
  return v;
}
__device__ __forceinline__ float sigmoidf_(float x) { return 1.f / (1.f + __expf(-x)); }

template <bool MIX, int OM, class Epi, class Dst>
__device__ __forceinline__ void gemm_tile(const u16* __restrict__ A, int lda, const float* __restrict__ mu,
                                          const u16* __restrict__ B, int ldb, int K, int row0, Epi epi, Dst dstf, u16* lds) {
  u16* sA = lds;
  u16* sB = lds + 256 * LDSS;
  const int tid = tid_(), lane = tid & 63, wave = tid >> 6;
  const int wm = wave & 3, wn = wave >> 2;
  const int r = lane & 31, h = lane >> 5;
  const int kc = tid & 7, lr = tid >> 3;
  f32x16 acc[2][2];
#pragma unroll
  for (int i = 0; i < 2; ++i)
#pragma unroll
    for (int j = 0; j < 2; ++j)
#pragma unroll
      for (int g = 0; g < 16; ++g) acc[i][j][g] = 0.f;
  uint4 pa0, pa1, pa2, pa3, ps0, ps1, ps2, ps3, pb0, pb1;
  ps0 = ps1 = ps2 = ps3 = make_uint4(0, 0, 0, 0);
  float4 m0 = make_float4(0, 0, 0, 0), m1 = m0;
  auto nbr = [&](int row, int kg) -> int {
    if (row < NLAT) {
      int t = row & 4095; int gc = t & 63, gr = t >> 6; int qd = kg >> 8;
      if (qd == 0) return gc > 0 ? row - 1 : -1;
      if (qd == 1) return gc < 63 ? row + 1 : -1;
      if (qd == 2) return gr > 0 ? row - 64 : -1;
      return gr < 63 ? row + 64 : -1;
    } else {
      int t = (row - NLAT) & 255;
      if (kg < 512) return t > 0 ? row - 1 : -1;
      return t < 255 ? row + 1 : -1;
    }
  };
  auto ldA = [&](int i, int k0, uint4& a, uint4& sx) {
    int row = row0 + lr + 64 * i;
    a = *(const uint4*)(A + (size_t)row * lda + k0 + kc * 8);
    if (MIX) {
      int nr = nbr(row, k0 + kc * 8);
      if (nr >= 0) sx = *(const uint4*)(A + (size_t)nr * lda + k0 + kc * 8);
      else sx = make_uint4(0, 0, 0, 0);
    }
  };
  auto gload = [&](int k0) {
    ldA(0, k0, pa0, ps0); ldA(1, k0, pa1, ps1); ldA(2, k0, pa2, ps2); ldA(3, k0, pa3, ps3);
    if (MIX) {
      m0 = *(const float4*)(mu + k0 + kc * 8);
      m1 = *(const float4*)(mu + k0 + kc * 8 + 4);
    }
    pb0 = *(const uint4*)(B + (size_t)lr * ldb + k0 + kc * 8);
    pb1 = *(const uint4*)(B + (size_t)(lr + 64) * ldb + k0 + kc * 8);
  };
  auto mixw = [&](unsigned x, unsigned s, float ma, float mb) -> unsigned {
    float x0 = bflo(x), x1 = bfhi(x), s0 = bflo(s), s1 = bfhi(s);
    return pack2(x0 + (s0 - x0) * ma, x1 + (s1 - x1) * mb);
  };
  auto stA = [&](int i, uint4 a, uint4 sx) {
    uint4 v = a;
    if (MIX) {
      v.x = mixw(a.x, sx.x, m0.x, m0.y);
      v.y = mixw(a.y, sx.y, m0.z, m0.w);
      v.z = mixw(a.z, sx.z, m1.x, m1.y);
      v.w = mixw(a.w, sx.w, m1.z, m1.w);
    }
    *(uint4*)(sA + (lr + 64 * i) * LDSS + kc * 8) = v;
  };
  auto lstore = [&]() {
    stA(0, pa0, ps0); stA(1, pa1, ps1); stA(2, pa2, ps2); stA(3, pa3, ps3);
    *(uint4*)(sB + lr * LDSS + kc * 8) = pb0;
    *(uint4*)(sB + (lr + 64) * LDSS + kc * 8) = pb1;
  };
  gload(0);
  for (int k0 = 0; k0 < K; k0 += 64) {
    lstore();
    __syncthreads();
    if (k0 + 64 < K) gload(k0 + 64);
#pragma unroll
    for (int kk = 0; kk < 4; ++kk) {
      bf16x8 af[2], bfr[2];
#pragma unroll
      for (int i = 0; i < 2; ++i) af[i] = *(const bf16x8*)(sA + (wm * 64 + i * 32 + r) * LDSS + kk * 16 + h * 8);
#pragma unroll
      for (int j = 0; j < 2; ++j) bfr[j] = *(const bf16x8*)(sB + (wn * 64 + j * 32 + r) * LDSS + kk * 16 + h * 8);
#pragma unroll
      for (int i = 0; i < 2; ++i)
#pragma unroll
        for (int j = 0; j < 2; ++j) {
          if (OM == 0) acc[i][j] = __builtin_amdgcn_mfma_f32_32x32x16_bf16(af[i], bfr[j], acc[i][j], 0, 0, 0);
          else acc[i][j] = __builtin_amdgcn_mfma_f32_32x32x16_bf16(bfr[j], af[i], acc[i][j], 0, 0, 0);
        }
    }
    __syncthreads();
  }
  if constexpr (OM == 0) {
#pragma unroll
    for (int i = 0; i < 2; ++i)
#pragma unroll
      for (int j = 0; j < 2; ++j)
#pragma unroll
        for (int g4 = 0; g4 < 4; ++g4) {
          int row = row0 + wm * 64 + i * 32 + 8 * g4 + 4 * h;
          int col = wn * 64 + j * 32 + r;
          epi(row, col, acc[i][j][g4 * 4 + 0], acc[i][j][g4 * 4 + 1], acc[i][j][g4 * 4 + 2], acc[i][j][g4 * 4 + 3]);
        }
  } else if constexpr (OM == 1) {
    u16* st = lds;
#pragma unroll
    for (int i = 0; i < 2; ++i)
#pragma unroll
      for (int j = 0; j < 2; ++j)
#pragma unroll
        for (int g4 = 0; g4 < 4; ++g4) {
          const int rl = wm * 64 + i * 32 + r, c0 = wn * 64 + j * 32 + 8 * g4 + 4 * h;
          uint2 o;
          o.x = pack2(epi(acc[i][j][g4 * 4 + 0], row0 + rl, c0 + 0), epi(acc[i][j][g4 * 4 + 1], row0 + rl, c0 + 1));
          o.y = pack2(epi(acc[i][j][g4 * 4 + 2], row0 + rl, c0 + 2), epi(acc[i][j][g4 * 4 + 3], row0 + rl, c0 + 3));
          *(uint2*)(st + rl * 136 + c0) = o;
        }
    __syncthreads();
#pragma unroll
    for (int q = 0; q < 8; ++q) {
      const int id = tid + NT * q, rl = id >> 4, c8 = id & 15;
      const uint4 v = *(const uint4*)(st + rl * 136 + c8 * 8);
      *(uint4*)(dstf(row0 + rl) + c8 * 8) = v;
    }
    __syncthreads();
  } else {
    u8* st = (u8*)lds;
#pragma unroll
    for (int i = 0; i < 2; ++i)
#pragma unroll
      for (int j = 0; j < 2; ++j)
#pragma unroll
        for (int g4 = 0; g4 < 4; ++g4) {
          const int rl = wm * 64 + i * 32 + r, c0 = wn * 64 + j * 32 + 8 * g4 + 4 * h;
          unsigned o = epi(acc[i][j][g4 * 4 + 0], row0 + rl, c0 + 0) | (epi(acc[i][j][g4 * 4 + 1], row0 + rl, c0 + 1) << 8) |
                       (epi(acc[i][j][g4 * 4 + 2], row0 + rl, c0 + 2) << 16) | (epi(acc[i][j][g4 * 4 + 3], row0 + rl, c0 + 3) << 24);
          *(unsigned*)(st + rl * 144 + c0) = o;
        }
    __syncthreads();
#pragma unroll
    for (int q = 0; q < 4; ++q) {
      const int id = tid + NT * q, rl = id >> 3, c16 = id & 7;
      const uint4 v = *(const uint4*)(st + rl * 144 + c16 * 16);
      *(uint4*)(dstf(row0 + rl, c16)) = v;
    }
    __syncthreads();
  }
}

template <bool MIX, class Epi, class Dst>
__device__ __forceinline__ void gemm_tile256(const u16* __restrict__ A, int lda, const float* __restrict__ mu,
                                             const u16* __restrict__ B, int ldb, int K, int row0, Epi epi, Dst dstf, u16* lds) {
  u16* sA = lds;
  u16* sB = lds + 256 * LDSS;
  const int tid = tid_(), lane = tid & 63, wave = tid >> 6;
  const int wm = wave & 1, wn = wave >> 1;
  const int r = lane & 31, h = lane >> 5;
  const int kc = tid & 7, lr = tid >> 3;
  f32x16 acc[4][2];
#pragma unroll
  for (int i = 0; i < 4; ++i)
#pragma unroll
    for (int j = 0; j < 2; ++j)
#pragma unroll
      for (int g = 0; g < 16; ++g) acc[i][j][g] = 0.f;
  uint4 pa0, pa1, pa2, pa3, ps0, ps1, ps2, ps3, pb0, pb1, pb2, pb3;
  ps0 = ps1 = ps2 = ps3 = make_uint4(0, 0, 0, 0);
  float4 m0 = make_float4(0, 0, 0, 0), m1 = m0;
  auto nbr = [&](int row, int kg) -> int {
    if (row < NLAT) {
      int t = row & 4095; int gc = t & 63, gr = t >> 6; int qd = kg >> 8;
      if (qd == 0) return gc > 0 ? row - 1 : -1;
      if (qd == 1) return gc < 63 ? row + 1 : -1;
      if (qd == 2) return gr > 0 ? row - 64 : -1;
      return gr < 63 ? row + 64 : -1;
    } else {
      int t = (row - NLAT) & 255;
      if (kg < 512) return t > 0 ? row - 1 : -1;
      return t < 255 ? row + 1 : -1;
    }
  };
  auto ldA = [&](int i, int k0, uint4& a, uint4& sx) {
    int row = row0 + lr + 64 * i;
    a = *(const uint4*)(A + (size_t)row * lda + k0 + kc * 8);
    if (MIX) {
      int nr = nbr(row, k0 + kc * 8);
      if (nr >= 0) sx = *(const uint4*)(A + (size_t)nr * lda + k0 + kc * 8);
      else sx = make_uint4(0, 0, 0, 0);
    }
  };
  auto gload = [&](int k0) {
    ldA(0, k0, pa0, ps0); ldA(1, k0, pa1, ps1); ldA(2, k0, pa2, ps2); ldA(3, k0, pa3, ps3);
    if (MIX) {
      m0 = *(const float4*)(mu + k0 + kc * 8);
      m1 = *(const float4*)(mu + k0 + kc * 8 + 4);
    }
    pb0 = *(const uint4*)(B + (size_t)lr * ldb + k0 + kc * 8);
    pb1 = *(const uint4*)(B + (size_t)(lr + 64) * ldb + k0 + kc * 8);
    pb2 = *(const uint4*)(B + (size_t)(lr + 128) * ldb + k0 + kc * 8);
    pb3 = *(const uint4*)(B + (size_t)(lr + 192) * ldb + k0 + kc * 8);
  };
  auto mixw = [&](unsigned x, unsigned s_, float ma, float mb) -> unsigned {
    float x0 = bflo(x), x1 = bfhi(x), s0 = bflo(s_), s1 = bfhi(s_);
    return pack2(x0 + (s0 - x0) * ma, x1 + (s1 - x1) * mb);
  };
  auto stA = [&](int i, uint4 a, uint4 sx) {
    uint4 v = a;
    if (MIX) {
      v.x = mixw(a.x, sx.x, m0.x, m0.y);
      v.y = mixw(a.y, sx.y, m0.z, m0.w);
      v.z = mixw(a.z, sx.z, m1.x, m1.y);
      v.w = mixw(a.w, sx.w, m1.z, m1.w);
    }
    *(uint4*)(sA + (lr + 64 * i) * LDSS + kc * 8) = v;
  };
  auto lstore = [&]() {
    stA(0, pa0, ps0); stA(1, pa1, ps1); stA(2, pa2, ps2); stA(3, pa3, ps3);
    *(uint4*)(sB + lr * LDSS + kc * 8) = pb0;
    *(uint4*)(sB + (lr + 64) * LDSS + kc * 8) = pb1;
    *(uint4*)(sB + (lr + 128) * LDSS + kc * 8) = pb2;
    *(uint4*)(sB + (lr + 192) * LDSS + kc * 8) = pb3;
  };
  gload(0);
  for (int k0 = 0; k0 < K; k0 += 64) {
    lstore();
    __syncthreads();
    if (k0 + 64 < K) gload(k0 + 64);
#pragma unroll
    for (int kk = 0; kk < 4; ++kk) {
      bf16x8 af[4], bfr[2];
#pragma unroll
      for (int i = 0; i < 4; ++i) af[i] = *(const bf16x8*)(sA + (wm * 128 + i * 32 + r) * LDSS + kk * 16 + h * 8);
#pragma unroll
      for (int j = 0; j < 2; ++j) bfr[j] = *(const bf16x8*)(sB + (wn * 64 + j * 32 + r) * LDSS + kk * 16 + h * 8);
#pragma unroll
      for (int i = 0; i < 4; ++i)
#pragma unroll
        for (int j = 0; j < 2; ++j) acc[i][j] = __builtin_amdgcn_mfma_f32_32x32x16_bf16(bfr[j], af[i], acc[i][j], 0, 0, 0);
    }
    __syncthreads();
  }
  u16* st = lds;
#pragma unroll
  for (int half = 0; half < 2; ++half) {
    if ((wn >> 1) == half) {
#pragma unroll
      for (int i = 0; i < 4; ++i)
#pragma unroll
        for (int j = 0; j < 2; ++j)
#pragma unroll
          for (int g4 = 0; g4 < 4; ++g4) {
            const int rl = wm * 128 + i * 32 + r, cl = (wn & 1) * 64 + j * 32 + 8 * g4 + 4 * h, c0 = half * 128 + cl;
            uint2 o;
            o.x = pack2(epi(acc[i][j][g4 * 4 + 0], row0 + rl, c0 + 0), epi(acc[i][j][g4 * 4 + 1], row0 + rl, c0 + 1));
            o.y = pack2(epi(acc[i][j][g4 * 4 + 2], row0 + rl, c0 + 2), epi(acc[i][j][g4 * 4 + 3], row0 + rl, c0 + 3));
            *(uint2*)(st + rl * 136 + cl) = o;
          }
    }
    __syncthreads();
#pragma unroll
    for (int q = 0; q < 8; ++q) {
      const int id = tid + NT * q, rl = id >> 4, c8 = id & 15;
      const uint4 v = *(const uint4*)(st + rl * 136 + c8 * 8);
      *(uint4*)(dstf(row0 + rl) + half * 128 + c8 * 8) = v;
    }
    __syncthreads();
  }
}

__constant__ int TJOBS[18][5] = {
    {8, 0, 1024, 2304, (int)O_WIN},
    {12, 0, 1024, 1024, (int)O_WOUT},
    {14, 0, 1024, 1024, (int)O_WR},
    {15, 0, 1024, 1024, (int)O_WK},
    {16, 0, 1024, 1024, (int)O_WV},
    {17, 0, 1024, 1024, (int)O_WO},
    {18, 0, 1024, 128, (int)O_G1},
    {19, 0, 128, 1024, (int)O_G2},
    {24, 0, 1024, 64, (int)O_W1},
    {24, 65536, 1024, 64, (int)(O_W1 + 131072)},
    {27, 0, 1024, 64, (int)O_A1},
    {27, 65536, 1024, 64, (int)(O_A1 + 131072)},
    {25, 0, 64, 1024, (int)O_W2},
    {25, 65536, 64, 1024, (int)(O_W2 + 131072)},
    {28, 0, 64, 1024, (int)O_A2},
    {28, 65536, 64, 1024, (int)(O_A2 + 131072)},
    {31, 0, 1024, 2048, (int)O_WQ},
    {31, 2097152, 1024, 2048, (int)(O_WQ + 4194304)},
};

__device__ __forceinline__ void convert_bf16(const float* __restrict__ src, u16* __restrict__ dst, size_t n) {
  size_t n4 = n >> 2;
  for (size_t i = (size_t)blockIdx.x * NT + tid_(); i < n4; i += (size_t)gridDim.x * NT) {
    float4 v = ((const float4*)src)[i];
    uint2 o; o.x = pack2(v.x, v.y); o.y = pack2(v.z, v.w);
    ((uint2*)dst)[i] = o;
  }
}

__device__ __forceinline__ void convert_tab_fp8(const float* __restrict__ U, const float* __restrict__ V, char* tab);
__device__ __forceinline__ void phase_prep(const P& p, char* lds) {
  const int tid = tid_();
  float* fl = (float*)lds;
  for (int task = blockIdx.x; task < 192; task += gridDim.x) {
    int l = task / 96, cg_ = task % 96;
    float* sv = fl;
    float* red = fl + 9216;
    for (int i = tid; i < 9216; i += NT) {
      int v = i >> 10, k = i & 1023;
      float x = v < 8 ? p.in[1][v * 1024 + k] : p.in[3][k];
      sv[i] = x / (1.f + __expf(-x));
    }
    __syncthreads();
    int col = cg_ * 64 + (tid & 63), kg = tid >> 6;
    float acc[9];
#pragma unroll
    for (int v = 0; v < 9; ++v) acc[v] = 0.f;
    const float* W = p.in[4] + (size_t)l * 1024 * 6144 + col;
    for (int k = kg * 128; k < kg * 128 + 128; ++k) {
      float w = W[(size_t)k * 6144];
#pragma unroll
      for (int v = 0; v < 9; ++v) acc[v] += sv[v * 1024 + k] * w;
    }
#pragma unroll
    for (int v = 0; v < 9; ++v) red[(kg * 9 + v) * 64 + (tid & 63)] = acc[v];
    __syncthreads();
    if (tid < 576) {
      int v = tid >> 6, c = tid & 63;
      float s = p.in[5][l * 6144 + cg_ * 64 + c];
#pragma unroll
      for (int g = 0; g < 8; ++g) s += red[(g * 9 + v) * 64 + c];
      ((float*)(p.ws + O_MOD))[(l * 9 + v) * 6144 + cg_ * 64 + c] = s;
    }
    __syncthreads();
  }
  {
    int base = 0;
    for (int j = 0; j < 18; ++j) {
      int K = TJOBS[j][2], N = TJOBS[j][3];
      int tk = K >> 6, tn = N >> 6, nt = tk * tn;
      const float* src = p.in[TJOBS[j][0]] + TJOBS[j][1];
      u16* dst = (u16*)(p.ws + (size_t)(unsigned)TJOBS[j][4]);
      int first = (blockIdx.x + gridDim.x - (base % gridDim.x)) % gridDim.x;
      for (int t = first; t < nt; t += gridDim.x) {
        int k0 = (t / tn) * 64, n0 = (t % tn) * 64;
#pragma unroll
        for (int rep = 0; rep < 8; ++rep) {
          int idx = tid + NT * rep; int i = idx >> 6, jj = idx & 63;
          fl[i * 65 + jj] = src[(size_t)(k0 + i) * N + n0 + jj];
        }
        __syncthreads();
        int n = tid >> 3, c8 = tid & 7;
        uint4 o;
        o.x = pack2(fl[(c8 * 8 + 0) * 65 + n], fl[(c8 * 8 + 1) * 65 + n]);
        o.y = pack2(fl[(c8 * 8 + 2) * 65 + n], fl[(c8 * 8 + 3) * 65 + n]);
        o.z = pack2(fl[(c8 * 8 + 4) * 65 + n], fl[(c8 * 8 + 5) * 65 + n]);
        o.w = pack2(fl[(c8 * 8 + 6) * 65 + n], fl[(c8 * 8 + 7) * 65 + n]);
        *(uint4*)(dst + (size_t)(n0 + n) * K + k0 + c8 * 8) = o;
        __syncthreads();
      }
      base += nt;
    }
  }
  convert_bf16(p.in[32], (u16*)(p.ws + O_KEYS), (size_t)2 * 8 * 2 * 128 * 128);
  convert_tab_fp8(p.in[33], p.in[34], p.ws + O_TAB0);
  if (blockIdx.x == 0) {
    float* rope = (float*)(p.ws + O_ROPE);
    for (int i = tid; i < 1024; i += NT) {
      int pos = i >> 4, f = i & 15;
      float inv = exp2f(-(float)f * (13.287712379549449f / 16.f));
      float ang = (float)pos * inv;
      rope[i * 2] = cosf(ang);
      rope[i * 2 + 1] = sinf(ang);
    }
  }
}

__device__ __forceinline__ void phase_norm(const P& p, const float* srcL, const float* srcC, const float* gain, int layer, int shift_idx,
                           int nrows, u16* dst) {
  const int lane = tid_() & 63;
  const int gw = blockIdx.x * 8 + (tid_() >> 6), nw = gridDim.x * 8;
  const float* mod = (const float*)(p.ws + O_MOD) + (size_t)layer * 9 * 6144;
  for (int row = gw; row < nrows; row += nw) {
    const float* src = row < NLAT ? srcL + (size_t)row * DM : srcC + (size_t)(row - NLAT) * DM;
    int mi = row < NLAT ? (row >> 12) : 8;
    const float* sh = mod + mi * 6144 + shift_idx * 1024;
    const float* sc = sh + 1024;
    float4 v[4];
    float ss = 0.f;
#pragma unroll
    for (int i = 0; i < 4; ++i) {
      v[i] = *(const float4*)(src + i * 256 + lane * 4);
      ss += v[i].x * v[i].x + v[i].y * v[i].y + v[i].z * v[i].z + v[i].w * v[i].w;
    }
    ss = wave_sum(ss);
    float rs = rsqrtf(ss * (1.f / 1024.f) + 1e-6f);
#pragma unroll
    for (int i = 0; i < 4; ++i) {
      int c = i * 256 + lane * 4;
      float4 g = *(const float4*)(gain + c);
      float4 s1 = *(const float4*)(sc + c);
      float4 s0 = *(const float4*)(sh + c);
      float a = v[i].x * rs * g.x * (1.f + s1.x) + s0.x;
      float b = v[i].y * rs * g.y * (1.f + s1.y) + s0.y;
      float cc = v[i].z * rs * g.z * (1.f + s1.z) + s0.z;
      float d = v[i].w * rs * g.w * (1.f + s1.w) + s0.w;
      uint2 o; o.x = pack2(a, b); o.y = pack2(cc, d);
      *(uint2*)(dst + (size_t)row * DM + c) = o;
    }
  }
}

__device__ __forceinline__ void phase_conv_qk(const P& p) {
  const u16* hgg = (const u16*)(p.ws + O_HGG);
  u16* mix = (u16*)(p.ws + O_XN);
  const float* cw = p.in[9];
  const size_t gt = (size_t)blockIdx.x * NT + tid_(), gn = (size_t)gridDim.x * NT;
  for (size_t it = gt; it < (size_t)TTOK * 64; it += gn) {
    int row = (int)(it >> 6), c0 = (int)(it & 63) * 8;
    int t, len;
    if (row < NLAT) { t = row & 4095; len = 4096; } else { t = (row - NLAT) & 255; len = 256; }
    float pm[8], pc[8], pp[8];
    {
      const u16* b = hgg + (size_t)row * 1536;
      uint4 hh = *(const uint4*)(b + c0), gc = *(const uint4*)(b + 1024 + c0);
      pc[0] = bflo(hh.x) * bflo(gc.x); pc[1] = bfhi(hh.x) * bfhi(gc.x);
      pc[2] = bflo(hh.y) * bflo(gc.y); pc[3] = bfhi(hh.y) * bfhi(gc.y);
      pc[4] = bflo(hh.z) * bflo(gc.z); pc[5] = bfhi(hh.z) * bfhi(gc.z);
      pc[6] = bflo(hh.w) * bflo(gc.w); pc[7] = bfhi(hh.w) * bfhi(gc.w);
    }
    if (t > 0) {
      const u16* b = hgg + (size_t)(row - 1) * 1536;
      uint4 hh = *(const uint4*)(b + c0), gc = *(const uint4*)(b + 1024 + c0);
      pm[0] = bflo(hh.x) * bflo(gc.x); pm[1] = bfhi(hh.x) * bfhi(gc.x);
      pm[2] = bflo(hh.y) * bflo(gc.y); pm[3] = bfhi(hh.y) * bfhi(gc.y);
      pm[4] = bflo(hh.z) * bflo(gc.z); pm[5] = bfhi(hh.z) * bfhi(gc.z);
      pm[6] = bflo(hh.w) * bflo(gc.w); pm[7] = bfhi(hh.w) * bfhi(gc.w);
    } else {
#pragma unroll
      for (int e = 0; e < 8; ++e) pm[e] = 0.f;
    }
    if (t < len - 1) {
      const u16* b = hgg + (size_t)(row + 1) * 1536;
      uint4 hh = *(const uint4*)(b + c0), gc = *(const uint4*)(b + 1024 + c0);
      pp[0] = bflo(hh.x) * bflo(gc.x); pp[1] = bfhi(hh.x) * bfhi(gc.x);
      pp[2] = bflo(hh.y) * bflo(gc.y); pp[3] = bfhi(hh.y) * bfhi(gc.y);
      pp[4] = bflo(hh.z) * bflo(gc.z); pp[5] = bfhi(hh.z) * bfhi(gc.z);
      pp[6] = bflo(hh.w) * bflo(gc.w); pp[7] = bfhi(hh.w) * bfhi(gc.w);
    } else {
#pragma unroll
      for (int e = 0; e < 8; ++e) pp[e] = 0.f;
    }
    uint4 gbv = *(const uint4*)(hgg + (size_t)row * 1536 + 512 + c0);
    float gb[8] = {bflo(gbv.x), bfhi(gbv.x), bflo(gbv.y), bfhi(gbv.y), bflo(gbv.z), bfhi(gbv.z), bflo(gbv.w), bfhi(gbv.w)};
    float o[8];
#pragma unroll
    for (int e = 0; e < 8; ++e)
      o[e] = gb[e] * (cw[c0 + e] * pm[e] + cw[512 + c0 + e] * pc[e] + cw[1024 + c0 + e] * pp[e]);
    uint4 ov; ov.x = pack2(o[0], o[1]); ov.y = pack2(o[2], o[3]); ov.z = pack2(o[4], o[5]); ov.w = pack2(o[6], o[7]);
    *(uint4*)(mix + (size_t)row * DM + c0) = ov;
  }
  u16* Q = (u16*)(p.ws + O_Q);
  u16* KBp = (u16*)(p.ws + O_KB);
  const float* rope = (const float*)(p.ws + O_ROPE);
  const size_t ngroups = (size_t)TTOK * 10;
  for (size_t it = gt; it < ngroups * 8; it += gn) {
    size_t grp = it >> 3; int sub = (int)(it & 7);
    int row = (int)(grp / 10), hd = (int)(grp % 10);
    u16* ptr; const float* gain;
    if (hd < 8) { ptr = Q + (size_t)row * 512 + hd * 64 + sub * 8; gain = p.in[10]; }
    else { ptr = KBp + (size_t)row * 128 + (hd - 8) * 64 + sub * 8; gain = p.in[11]; }
    uint4 v = *(const uint4*)ptr;
    float x[8] = {bflo(v.x), bfhi(v.x), bflo(v.y), bfhi(v.y), bflo(v.z), bfhi(v.z), bflo(v.w), bfhi(v.w)};
    float ss = 0.f;
#pragma unroll
    for (int e = 0; e < 8; ++e) ss += x[e] * x[e];
    ss = red8(ss);
    float rs = rsqrtf(ss * (1.f / 64.f) + 1e-6f);
#pragma unroll
    for (int e = 0; e < 8; ++e) x[e] = x[e] * rs * gain[sub * 8 + e];
    if (row < NLAT) {
      int t = row & 4095; int gr = t >> 6, gc = t & 63;
#pragma unroll
      for (int e = 0; e < 4; ++e) {
        int pi = sub * 4 + e;
        int pos = pi < 16 ? gr : gc; int f = pi & 15;
        float c = rope[(pos * 16 + f) * 2], s = rope[(pos * 16 + f) * 2 + 1];
        float a = x[2 * e], b = x[2 * e + 1];
        x[2 * e] = a * c - b * s;
        x[2 * e + 1] = a * s + b * c;
      }
    }
    uint4 ov; ov.x = pack2(x[0], x[1]); ov.y = pack2(x[2], x[3]); ov.z = pack2(x[4], x[5]); ov.w = pack2(x[6], x[7]);
    *(uint4*)ptr = ov;
  }
}

__device__ __forceinline__ void phase_attn(const P& p, char* lds) {
  u16* sK = (u16*)lds;
  u16* sV = sK + 64 * LDSS;
  const u16* Q = (const u16*)(p.ws + O_Q);
  const u16* KBp = (const u16*)(p.ws + O_KB);
  const u16* VT = (const u16*)(p.ws + O_VT);
  u16* mix = (u16*)(p.ws + O_XN);
  const int tid = tid_(), lane = tid & 63, wave = tid >> 6;
  const int r = lane & 31, h = lane >> 5;
  const float cs = 0.125f * 1.4426950408889634f;
  for (int item = blockIdx.x; item < 1088; item += gridDim.x) {
    int b, qh, qrow0, nkt;
    if (item < 1024) { b = item >> 7; qh = (item >> 4) & 7; qrow0 = b * 4096 + (item & 15) * 256; nkt = 68; }
    else { int i2 = item - 1024; b = i2 >> 3; qh = i2 & 7; qrow0 = NLAT + b * 256; nkt = 4; }
    const int kvh = qh >> 2;
    const int qrow = qrow0 + wave * 32 + r;
    bf16x8 qf[4];
#pragma unroll
    for (int kk = 0; kk < 4; ++kk) qf[kk] = *(const bf16x8*)(Q + (size_t)qrow * 512 + qh * 64 + kk * 16 + h * 8);
    f32x16 o[2];
#pragma unroll
    for (int g = 0; g < 16; ++g) { o[0][g] = 0.f; o[1][g] = 0.f; }
    float m = -INFINITY, l = 0.f;
    const int lkey = tid >> 3, lch = tid & 7;
    uint4 ka, va;
    auto gl = [&](int kt) {
      int pos = kt * 64 + lkey;
      int krow = pos < 256 ? NLAT + b * 256 + pos : b * 4096 + pos - 256;
      ka = *(const uint4*)(KBp + (size_t)krow * 128 + kvh * 64 + lch * 8);
      va = *(const uint4*)(VT + ((size_t)((b * 2 + kvh) * 64 + lkey)) * 4352 + kt * 64 + lch * 8);
    };
    gl(0);
    for (int kt = 0; kt < nkt; ++kt) {
      *(uint4*)(sK + lkey * LDSS + lch * 8) = ka;
      *(uint4*)(sV + lkey * LDSS + lch * 8) = va;
      __syncthreads();
      if (kt + 1 < nkt) gl(kt + 1);
      f32x16 s[2];
#pragma unroll
      for (int g = 0; g < 16; ++g) { s[0][g] = 0.f; s[1][g] = 0.f; }
#pragma unroll
      for (int kb = 0; kb < 2; ++kb)
#pragma unroll
        for (int kk = 0; kk < 4; ++kk) {
          bf16x8 a = *(const bf16x8*)(sK + (kb * 32 + r) * LDSS + kk * 16 + h * 8);
          s[kb] = __builtin_amdgcn_mfma_f32_32x32x16_bf16(a, qf[kk], s[kb], 0, 0, 0);
        }
      float mx = s[0][0];
#pragma unroll
      for (int g = 0; g < 16; ++g) { mx = fmaxf(mx, s[0][g]); mx = fmaxf(mx, s[1][g]); }
      mx = swapmax32(mx);
      float mn = fmaxf(m, mx);
      float alpha = __builtin_amdgcn_exp2f((m - mn) * cs);
      m = mn;
      float mc = mn * cs, ps = 0.f;
#pragma unroll
      for (int kb = 0; kb < 2; ++kb)
#pragma unroll
        for (int g = 0; g < 16; ++g) { float e = __builtin_amdgcn_exp2f(s[kb][g] * cs - mc); s[kb][g] = e; ps += e; }
      l = l * alpha + ps;
#pragma unroll
      for (int g = 0; g < 16; ++g) { o[0][g] *= alpha; o[1][g] *= alpha; }
      bf16x8 pb[2][2];
#pragma unroll
      for (int kb = 0; kb < 2; ++kb)
#pragma unroll
        for (int c = 0; c < 2; ++c) {
          uint4 pk;
          pk.x = pack2(s[kb][8 * c + 0], s[kb][8 * c + 1]); pk.y = pack2(s[kb][8 * c + 2], s[kb][8 * c + 3]);
          pk.z = pack2(s[kb][8 * c + 4], s[kb][8 * c + 5]); pk.w = pack2(s[kb][8 * c + 6], s[kb][8 * c + 7]);
          pb[kb][c] = __builtin_bit_cast(bf16x8, pk);
        }
#pragma unroll
      for (int db = 0; db < 2; ++db)
#pragma unroll
        for (int kb = 0; kb < 2; ++kb)
#pragma unroll
          for (int c = 0; c < 2; ++c) {
            const u16* vp = sV + (db * 32 + r) * LDSS + kb * 32 + 16 * c + 4 * h;
            uint2 lo = *(const uint2*)vp, hi = *(const uint2*)(vp + 8);
            uint4 av = make_uint4(lo.x, lo.y, hi.x, hi.y);
            o[db] = __builtin_amdgcn_mfma_f32_32x32x16_bf16(__builtin_bit_cast(bf16x8, av), pb[kb][c], o[db], 0, 0, 0);
          }
      __syncthreads();
    }
    l = swapsum32(l, l);
    float inv = 1.f / l;
#pragma unroll
    for (int db = 0; db < 2; ++db)
#pragma unroll
      for (int g4 = 0; g4 < 4; ++g4) {
        int d = db * 32 + 8 * g4 + 4 * h;
        uint2 ov;
        ov.x = pack2(o[db][g4 * 4 + 0] * inv, o[db][g4 * 4 + 1] * inv);
        ov.y = pack2(o[db][g4 * 4 + 2] * inv, o[db][g4 * 4 + 3] * inv);
        *(uint2*)(mix + (size_t)qrow * DM + 512 + qh * 64 + d) = ov;
      }
  }
}

__device__ __forceinline__ int fkey(float f) { int b = __float_as_int(f); return b ^ ((b >> 31) & 0x7FFFFFFF); }
__device__ __forceinline__ float keyf(int k) { return __int_as_float(k ^ ((k >> 31) & 0x7FFFFFFF)); }

#define CE_DESC(a, b) { int hi__ = max(a, b); int lo__ = min(a, b); a = hi__; b = lo__; }
#define BITONIC_SORT16(r)                                                          \
  _Pragma("unroll") for (int k_ = 2; k_ <= 16; k_ <<= 1)                           \
    _Pragma("unroll") for (int j_ = k_ >> 1; j_ > 0; j_ >>= 1)                     \
      _Pragma("unroll") for (int i_ = 0; i_ < 16; ++i_) {                          \
        const int l_ = i_ ^ j_;                                                    \
        if (l_ > i_) { if ((i_ & k_) == 0) CE_DESC(r[i_], r[l_]) else CE_DESC(r[l_], r[i_]) } \
      }
#define BITONIC_MERGE16(r)                                                         \
  _Pragma("unroll") for (int j_ = 8; j_ > 0; j_ >>= 1)                             \
    _Pragma("unroll") for (int i_ = 0; i_ < 16; ++i_) {                            \
      const int l_ = i_ ^ j_;                                                      \
      if (l_ > i_) CE_DESC(r[i_], r[l_])                                           \
    }
#define XLANE_MERGE16(r, CTRL)                                                     \
  {                                                                                \
    int o_[16];                                                                    \
    _Pragma("unroll") for (int i_ = 0; i_ < 16; ++i_) o_[i_] = __builtin_amdgcn_update_dpp(0, r[15 - i_], CTRL, 0xF, 0xF, true); \
    _Pragma("unroll") for (int i_ = 0; i_ < 16; ++i_) r[i_] = max(r[i_], o_[i_]);  \
    BITONIC_MERGE16(r)                                                             \
  }
#define SCS 132
__device__ __forceinline__ void phase_peer_topk(const P& p, int layer, const u16* PQ, int ntok, int* IDX, float* GATE, char* lds) {
  float* sc = (float*)lds;
  int* lists = (int*)(lds + 2 * 64 * SCS * 4);
  const int tid = tid_(), lane = tid & 63, wave = tid >> 6;
  const int r = lane & 31, h = lane >> 5;
  const u16* keys = (const u16*)(p.ws + O_KEYS) + (size_t)layer * 8 * 2 * 128 * 128;
  const int ntile = (ntok >> 6) * 8;
  for (int tile = blockIdx.x; tile < ntile; tile += gridDim.x) {
    int hd = tile & 7, row0 = (tile >> 3) * 64;
    {
      int pp = wave >> 2, kb = wave & 3;
      f32x16 acc[2];
#pragma unroll
      for (int g = 0; g < 16; ++g) { acc[0][g] = 0.f; acc[1][g] = 0.f; }
      const u16* kp = keys + ((size_t)(hd * 2 + pp) * 128 + kb * 32 + r) * 128 + h * 8;
      const u16* qp = PQ + (size_t)(row0 + r) * 2048 + hd * 256 + pp * 128 + h * 8;
#pragma unroll
      for (int kk = 0; kk < 8; ++kk) {
        bf16x8 bfr = *(const bf16x8*)(kp + kk * 16);
        bf16x8 a0 = *(const bf16x8*)(qp + kk * 16);
        bf16x8 a1 = *(const bf16x8*)(qp + (size_t)32 * 2048 + kk * 16);
        acc[0] = __builtin_amdgcn_mfma_f32_32x32x16_bf16(a0, bfr, acc[0], 0, 0, 0);
        acc[1] = __builtin_amdgcn_mfma_f32_32x32x16_bf16(a1, bfr, acc[1], 0, 0, 0);
      }
#pragma unroll
      for (int mb = 0; mb < 2; ++mb)
#pragma unroll
        for (int g = 0; g < 16; ++g) {
          int tok = mb * 32 + (g & 3) + 8 * (g >> 2) + 4 * h;
          sc[(pp * 64 + tok) * SCS + kb * 32 + r] = acc[mb][g];
        }
    }
    __syncthreads();
    {
      const int row = tid >> 2, qd = tid & 3;
      const float* rowp = sc + row * SCS + qd;
      int A[16], B[16];
#pragma unroll
      for (int m = 0; m < 16; ++m) {
        A[m] = (fkey(rowp[4 * m]) & ~0x7F) | (127 - (4 * m + qd));
        B[m] = (fkey(rowp[64 + 4 * m]) & ~0x7F) | (127 - (64 + 4 * m + qd));
      }
      BITONIC_SORT16(A)
      BITONIC_SORT16(B)
#pragma unroll
      for (int i = 0; i < 16; ++i) A[i] = max(A[i], B[15 - i]);
      BITONIC_MERGE16(A)
      XLANE_MERGE16(A, 0xB1)
      XLANE_MERGE16(A, 0x4E)
      if (qd == 0) {
#pragma unroll
        for (int i = 0; i < 16; i += 4) *(int4*)(lists + row * 16 + i) = make_int4(A[i], A[i + 1], A[i + 2], A[i + 3]);
      }
    }
    __syncthreads();
    if (tid < 256) {
      const int tok = tid >> 2, q = tid & 3;
      float bq[16];
#pragma unroll
      for (int j = 0; j < 16; ++j) bq[j] = keyf(lists[(64 + tok) * 16 + j] & ~0x7F);
      int R[16];
#pragma unroll
      for (int i = 0; i < 16; ++i) R[i] = (int)0x80000000;
#pragma unroll
      for (int m = 0; m < 4; ++m) {
        const int i = q + 4 * m;
        const float ai = keyf(lists[tok * 16 + i] & ~0x7F);
        const int jmax = 16 / (i + 1);
        const int nj = m == 0 ? 16 : (m == 1 ? 3 : 1);
#pragma unroll
        for (int j = 0; j < nj; ++j) {
          int x = (fkey(ai + bq[j]) & ~0xFF) | (255 - (i * 16 + j));
          x = j < jmax ? x : (int)0x80000000;
#pragma unroll
          for (int t = 0; t < 16; ++t) { int hi_ = max(R[t], x); x = min(R[t], x); R[t] = hi_; }
        }
      }
      XLANE_MERGE16(R, 0xB1)
      XLANE_MERGE16(R, 0x4E)
      float sv[16];
      float mx = keyf(R[0] & ~0xFF), sum = 0.f;
#pragma unroll
      for (int t = 0; t < 16; ++t) { sv[t] = __expf(keyf(R[t] & ~0xFF) - mx); sum += sv[t]; }
      float inv = 1.f / sum;
      size_t ob = (size_t)(row0 + tok) * 128 + hd * 16;
#pragma unroll
      for (int t = 0; t < 16; ++t) {
        if ((t >> 2) == q) {
          int pos = 255 - (R[t] & 0xFF);
          int i1 = 127 - (lists[tok * 16 + (pos >> 4)] & 0x7F);
          int i2 = 127 - (lists[(64 + tok) * 16 + (pos & 15)] & 0x7F);
          IDX[ob + t] = i1 * 128 + i2;
          GATE[ob + t] = sv[t] * inv;
        }
      }
    }
    __syncthreads();
  }
}

typedef __attribute__((ext_vector_type(2))) float f2;
#define TAB_V8 (16 * MiB)
#define TAB_SU (32 * MiB)
#define TAB_SV (32 * MiB + 65536)
__device__ __forceinline__ float wave_max(float v) {
  v = fmaxf(v, dppf<0xB1>(v)); v = fmaxf(v, dppf<0x4E>(v)); v = fmaxf(v, dppf<0x141>(v)); v = fmaxf(v, dppf<0x140>(v));
  v = swapmax16(v); v = swapmax32(v);
  return v;
}
__device__ __forceinline__ void convert_tab_fp8(const float* __restrict__ U, const float* __restrict__ V, char* tab) {
  const int lane = tid_() & 63;
  const int gw = blockIdx.x * 8 + (tid_() >> 6), nw = gridDim.x * 8;
  for (int rr = gw; rr < 32768; rr += nw) {
    const int isv = rr >> 14, e = rr & 16383;
    const float* src = (isv ? V : U) + (size_t)e * 1024 + lane * 16;
    float4 v0 = *(const float4*)src, v1 = *(const float4*)(src + 4), v2 = *(const float4*)(src + 8), v3 = *(const float4*)(src + 12);
    float am = fmaxf(fmaxf(fmaxf(fabsf(v0.x), fabsf(v0.y)), fmaxf(fabsf(v0.z), fabsf(v0.w))),
                     fmaxf(fmaxf(fabsf(v1.x), fabsf(v1.y)), fmaxf(fabsf(v1.z), fabsf(v1.w))));
    am = fmaxf(am, fmaxf(fmaxf(fmaxf(fabsf(v2.x), fabsf(v2.y)), fmaxf(fabsf(v2.z), fabsf(v2.w))),
                         fmaxf(fmaxf(fabsf(v3.x), fabsf(v3.y)), fmaxf(fabsf(v3.z), fabsf(v3.w)))));
    am = wave_max(am);
    float sc = am > 0.f ? 448.f / am : 1.f;
    uint4 o;
    int t = 0;
    t = __builtin_amdgcn_cvt_pk_fp8_f32(v0.x * sc, v0.y * sc, t, false); t = __builtin_amdgcn_cvt_pk_fp8_f32(v0.z * sc, v0.w * sc, t, true); o.x = t;
    t = __builtin_amdgcn_cvt_pk_fp8_f32(v1.x * sc, v1.y * sc, t, false); t = __builtin_amdgcn_cvt_pk_fp8_f32(v1.z * sc, v1.w * sc, t, true); o.y = t;
    t = __builtin_amdgcn_cvt_pk_fp8_f32(v2.x * sc, v2.y * sc, t, false); t = __builtin_amdgcn_cvt_pk_fp8_f32(v2.z * sc, v2.w * sc, t, true); o.z = t;
    t = __builtin_amdgcn_cvt_pk_fp8_f32(v3.x * sc, v3.y * sc, t, false); t = __builtin_amdgcn_cvt_pk_fp8_f32(v3.z * sc, v3.w * sc, t, true); o.w = t;
    if (!isv) {
      *(uint4*)(tab + (size_t)e * 1024 + lane * 16) = o;
      if (lane == 0) ((float*)(tab + TAB_SU))[e] = am > 0.f ? am / 448.f : 1.f;
    } else {
      *(uint4*)(tab + TAB_V8 + ((size_t)(lane >> 3) * 16384 + e) * 128 + (lane & 7) * 16) = o;
      if (lane == 0) ((float*)(tab + TAB_SV))[e] = am > 0.f ? am / 448.f : 1.f;
    }
  }
}
__device__ __forceinline__ f2 dec8(unsigned w, bool hi) { return hi ? __builtin_amdgcn_cvt_pk_f32_fp8((int)w, true) : __builtin_amdgcn_cvt_pk_f32_fp8((int)w, false); }

__device__ __forceinline__ float dot16(uint4 w, f2 a0, f2 a1, f2 a2, f2 a3, f2 a4, f2 a5, f2 a6, f2 a7) {
  f2 a = f2{0.f, 0.f};
  a = __builtin_elementwise_fma(dec8(w.x, false), a0, a); a = __builtin_elementwise_fma(dec8(w.x, true), a1, a);
  a = __builtin_elementwise_fma(dec8(w.y, false), a2, a); a = __builtin_elementwise_fma(dec8(w.y, true), a3, a);
  a = __builtin_elementwise_fma(dec8(w.z, false), a4, a); a = __builtin_elementwise_fma(dec8(w.z, true), a5, a);
  a = __builtin_elementwise_fma(dec8(w.w, false), a6, a); a = __builtin_elementwise_fma(dec8(w.w, true), a7, a);
  return a.x + a.y;
}
#define DOT16(W) dot16(W, xf0, xf1, xf2, xf3, xf4, xf5, xf6, xf7)
__device__ __forceinline__ void phase_peer_act(const P& p, const u16* XN2, const char* tab, const int* IDX, const float* GATE, float* COEF, int ntok, char* lds) {
  const int tid = tid_(), lane = tid & 63, wave = tid >> 6;
  int* le = (int*)(lds + wave * 1536);
  float* lg = (float*)(le + 128);
  int* ls = le + 256;
  const int part = blockIdx.x & 7;
  const int wv = (blockIdx.x >> 3) * 8 + wave, nwv = (gridDim.x >> 3) * 8;
  const float* SU = (const float*)(tab + TAB_SU);
  const float* SV = (const float*)(tab + TAB_SV);
  const int q = lane >> 4;
  const bool hi = (lane & 32) != 0, b4 = (lane & 16) != 0;
  int i0 = 0, i1 = 0; float g0 = 0.f, g1 = 0.f; uint4 x0 = make_uint4(0, 0, 0, 0), x1 = x0;
  if (wv < ntok) {
    i0 = IDX[(size_t)wv * 128 + lane]; i1 = IDX[(size_t)wv * 128 + 64 + lane];
    g0 = GATE[(size_t)wv * 128 + lane]; g1 = GATE[(size_t)wv * 128 + 64 + lane];
    const u16* xr = XN2 + (size_t)wv * DM + lane * 16;
    x0 = *(const uint4*)xr; x1 = *(const uint4*)(xr + 8);
  }
  for (int tok = wv; tok < ntok; tok += nwv) {
    int ni0 = 0, ni1 = 0; float ng0 = 0.f, ng1 = 0.f; uint4 nx0 = make_uint4(0, 0, 0, 0), nx1 = nx0;
    const int nt = tok + nwv;
    if (nt < ntok) {
      ni0 = IDX[(size_t)nt * 128 + lane]; ni1 = IDX[(size_t)nt * 128 + 64 + lane];
      ng0 = GATE[(size_t)nt * 128 + lane]; ng1 = GATE[(size_t)nt * 128 + 64 + lane];
      const u16* xr = XN2 + (size_t)nt * DM + lane * 16;
      nx0 = *(const uint4*)xr; nx1 = *(const uint4*)(xr + 8);
    }
    const bool s0 = (i0 >> 11) == part, s1 = (i1 >> 11) == part;
    const unsigned long long m0 = __ballot(s0), m1 = __ballot(s1);
    const int c0 = __popcll(m0), cnt = c0 + __popcll(m1);
    const int p0 = __builtin_amdgcn_mbcnt_hi((unsigned)(m0 >> 32), __builtin_amdgcn_mbcnt_lo((unsigned)m0, 0));
    const int p1 = c0 + __builtin_amdgcn_mbcnt_hi((unsigned)(m1 >> 32), __builtin_amdgcn_mbcnt_lo((unsigned)m1, 0));
    if (s0) { le[p0] = i0; lg[p0] = g0; ls[p0] = lane; }
    if (s1) { le[p1] = i1; lg[p1] = g1; ls[p1] = 64 + lane; }
    const int cntp = (cnt + 3) & ~3;
    if (lane < cntp - cnt) { le[cnt + lane] = part << 11; lg[cnt + lane] = 0.f; ls[cnt + lane] = -1; }
    const f2 xf0 = f2{bflo(x0.x), bfhi(x0.x)}, xf1 = f2{bflo(x0.y), bfhi(x0.y)}, xf2 = f2{bflo(x0.z), bfhi(x0.z)}, xf3 = f2{bflo(x0.w), bfhi(x0.w)};
    const f2 xf4 = f2{bflo(x1.x), bfhi(x1.x)}, xf5 = f2{bflo(x1.y), bfhi(x1.y)}, xf6 = f2{bflo(x1.z), bfhi(x1.z)}, xf7 = f2{bflo(x1.w), bfhi(x1.w)};
    for (int base = 0; base < cntp; base += 24) {
      uint4 w[24];
      const int evl = le[base + (lane < 24 ? lane : 0)];
#pragma unroll
      for (int gq = 0; gq < 6; ++gq) {
        if (base + 4 * gq < cntp) {
#pragma unroll
          for (int k = 0; k < 4; ++k) {
            int e = __builtin_amdgcn_readlane(evl, 4 * gq + k);
            w[4 * gq + k] = *(const uint4*)(tab + (size_t)e * 1024 + lane * 16);
          }
        } else {
#pragma unroll
          for (int k = 0; k < 4; ++k) w[4 * gq + k] = make_uint4(0, 0, 0, 0);
        }
      }
#pragma unroll
      for (int gq = 0; gq < 6; ++gq) {
        if (base + 4 * gq < cntp) {
          float d0 = DOT16(w[4 * gq]), d1 = DOT16(w[4 * gq + 1]), d2 = DOT16(w[4 * gq + 2]), d3 = DOT16(w[4 * gq + 3]);
          float kA = swapsum32(d0, d2), kB = swapsum32(d1, d3);
          float kC = swapsum16(kA, kB);
          kC = red16(kC);
          const int j = base + 4 * gq + q;
          const int e = le[j]; const float gt = lg[j]; const int slot = ls[j];
          float act = kC * SU[e];
          float coef = gt * 0.5f * act * (1.f + erff(act * 0.70710678118654752f)) * SV[e];
          if ((lane & 15) == 0 && slot >= 0) COEF[(size_t)tok * 128 + slot] = coef;
        }
      }
    }
    i0 = ni0; i1 = ni1; g0 = ng0; g1 = ng1; x0 = nx0; x1 = nx1;
  }
}

__device__ __forceinline__ void phase_peer_sum(const P& p, int layer, const char* tab, const int* IDX, const float* COEF, int ntok, float* dummy_dst) {
  const int tid = tid_(), lane = tid & 63, wave = tid >> 6;
  const int sl = blockIdx.x & 7;
  const int wv = (blockIdx.x >> 3) * 8 + wave, nwv = (gridDim.x >> 3) * 8;
  const int g = lane >> 3, ch = lane & 7;
  const char* V8 = tab + TAB_V8 + (size_t)sl * 16384 * 128 + ch * 16;
  const float* mod = (const float*)(p.ws + O_MOD) + (size_t)layer * 9 * 6144;
  float* HC = (float*)(p.ws + O_HC);
  const bool b5 = (lane & 32) != 0, b4 = (lane & 16) != 0, b3 = (lane & 8) != 0;
  const int c = sl * 128 + ch * 16 + (b5 ? 8 : 0) + (b4 ? 4 : 0) + (b3 ? 2 : 0);
  uint4 ia, ib, ic, id; float4 ca, cb, cc, cd;
  ia = ib = ic = id = make_uint4(0, 0, 0, 0); ca = cb = cc = cd = make_float4(0, 0, 0, 0);
  if (wv < ntok) {
    const int* ip = IDX + (size_t)wv * 128 + g * 16;
    const float* cp = COEF + (size_t)wv * 128 + g * 16;
    ia = *(const uint4*)ip; ib = *(const uint4*)(ip + 4); ic = *(const uint4*)(ip + 8); id = *(const uint4*)(ip + 12);
    ca = *(const float4*)cp; cb = *(const float4*)(cp + 4); cc = *(const float4*)(cp + 8); cd = *(const float4*)(cp + 12);
  }
  for (int tok = wv; tok < ntok; tok += nwv) {
    const unsigned ev[16] = {ia.x, ia.y, ia.z, ia.w, ib.x, ib.y, ib.z, ib.w, ic.x, ic.y, ic.z, ic.w, id.x, id.y, id.z, id.w};
    const float cv[16] = {ca.x, ca.y, ca.z, ca.w, cb.x, cb.y, cb.z, cb.w, cc.x, cc.y, cc.z, cc.w, cd.x, cd.y, cd.z, cd.w};
    uint4 w[16];
#pragma unroll
    for (int i = 0; i < 16; ++i) w[i] = *(const uint4*)(V8 + (size_t)ev[i] * 128);
    float* dst = (dummy_dst ? dummy_dst + (size_t)tok * DM : (tok < NLAT ? p.out + (size_t)tok * DM : HC + (size_t)(tok - NLAT) * DM)) + c;
    float2 o = *(float2*)dst;
    const int nt = tok + nwv;
    if (nt < ntok) {
      const int* ip = IDX + (size_t)nt * 128 + g * 16;
      const float* cp = COEF + (size_t)nt * 128 + g * 16;
      ia = *(const uint4*)ip; ib = *(const uint4*)(ip + 4); ic = *(const uint4*)(ip + 8); id = *(const uint4*)(ip + 12);
      ca = *(const float4*)cp; cb = *(const float4*)(cp + 4); cc = *(const float4*)(cp + 8); cd = *(const float4*)(cp + 12);
    }
    f2 acc[8];
#pragma unroll
    for (int k = 0; k < 8; ++k) acc[k] = f2{0.f, 0.f};
#pragma unroll
    for (int i = 0; i < 16; ++i) {
      f2 c2 = f2{cv[i], cv[i]};
      acc[0] = __builtin_elementwise_fma(dec8(w[i].x, false), c2, acc[0]); acc[1] = __builtin_elementwise_fma(dec8(w[i].x, true), c2, acc[1]);
      acc[2] = __builtin_elementwise_fma(dec8(w[i].y, false), c2, acc[2]); acc[3] = __builtin_elementwise_fma(dec8(w[i].y, true), c2, acc[3]);
      acc[4] = __builtin_elementwise_fma(dec8(w[i].z, false), c2, acc[4]); acc[5] = __builtin_elementwise_fma(dec8(w[i].z, true), c2, acc[5]);
      acc[6] = __builtin_elementwise_fma(dec8(w[i].w, false), c2, acc[6]); acc[7] = __builtin_elementwise_fma(dec8(w[i].w, true), c2, acc[7]);
    }
    float r8[8];
#pragma unroll
    for (int k = 0; k < 4; ++k) {
      r8[2 * k] = swapsum32(acc[k].x, acc[4 + k].x);
      r8[2 * k + 1] = swapsum32(acc[k].y, acc[4 + k].y);
    }
    float r4[4];
#pragma unroll
    for (int k = 0; k < 4; ++k) r4[k] = swapsum16(r8[k], r8[4 + k]);
    float r2[2];
#pragma unroll
    for (int k = 0; k < 2; ++k) {
      float kx = b3 ? r4[2 + k] : r4[k], sx = b3 ? r4[k] : r4[2 + k];
      r2[k] = kx + dppf<0x128>(sx);
    }
    const int mi = tok < NLAT ? (tok >> 12) : 8;
    const float2 mv = *(const float2*)(mod + mi * 6144 + 5 * 1024 + c);
    o.x += mv.x * r2[0]; o.y += mv.y * r2[1];
    *(float2*)dst = o;
  }
}

__device__ __forceinline__ void phase_scan(const P& p, char* lds, bool dummy) {
  float* buf = (float*)lds;
  float* vbuf = (float*)(lds + 81920);
  u16* ybuf = (u16*)(lds + 81920 + 16384);
  const int tid = tid_(), lane = tid & 63, wave = tid >> 6;
  const int c = lane & 7, irow = wave * 8 + (lane >> 3);
  const u16* R = (const u16*)(p.ws + O_R);
  const u16* Kp = (const u16*)(p.ws + O_K);
  const u16* Vp = (const u16*)(p.ws + O_V);
  const int ps = tid >> 4, col4 = (tid & 15) * 4;
  for (int item = blockIdx.x; item < 256; item += gridDim.x) {
    const int dir = item & 1, hh = (item >> 1) & 15, b = item >> 5;
    char* WA = p.ws + (dir ? O_WA1 : O_WA0);
    float* BON = (float*)(p.ws + O_BONUS) + (size_t)dir * NLAT * 16;
    float kkc[4], kac[4], rkc[4];
#pragma unroll
    for (int e = 0; e < 4; ++e) {
      kkc[e] = p.in[20][hh * 64 + col4 + e];
      kac[e] = p.in[21][hh * 64 + col4 + e];
      rkc[e] = p.in[22][hh * 64 + col4 + e];
    }
    auto rowof = [&](int s) -> int {
      if (s < 256) { int pos = dir ? 255 - s : s; return NLAT + b * 256 + pos; }
      int u = s - 256; int pos = dir ? 4095 - u : u; return b * 4096 + pos;
    };
    uint2 pr, pk, pv; unsigned pw, pa; int prow;
    auto gload = [&](int ch) {
      prow = rowof(ch * 32 + ps);
      size_t o = (size_t)prow * 1024 + hh * 64 + col4;
      pr = *(const uint2*)(R + o); pk = *(const uint2*)(Kp + o); pv = *(const uint2*)(Vp + o);
      const char* wp = WA + (size_t)prow * 2048 + hh * 128;
      pw = *(const unsigned*)(wp + col4); pa = *(const unsigned*)(wp + 64 + col4);
    };
    auto prep = [&](int bi) {
      float rr[4] = {bflo(pr.x), bfhi(pr.x), bflo(pr.y), bfhi(pr.y)};
      float kq[4] = {bflo(pk.x), bfhi(pk.x), bflo(pk.y), bfhi(pk.y)};
      float4 vv = make_float4(bflo(pv.x), bfhi(pv.x), bflo(pv.y), bfhi(pv.y));
      float w[4], a[4], kr[4], kk[4], bb[4], kd[4];
      float ss = 0.f;
#pragma unroll
      for (int e = 0; e < 4; ++e) {
        w[e] = 0.5f + (float)((pw >> (8 * e)) & 255u) * (1.f / 510.f);
        a[e] = (float)((pa >> (8 * e)) & 255u) * (1.f / 255.f);
        kr[e] = kq[e] * kkc[e];
        ss += kr[e] * kr[e];
      }
      ss = red16(ss);
      float inv = rsqrtf(ss + 1e-12f);
      float bn = 0.f;
#pragma unroll
      for (int e = 0; e < 4; ++e) {
        kk[e] = kr[e] * inv;
        bb[e] = kk[e] * a[e];
        kd[e] = kq[e] * (1.f + (a[e] - 1.f) * kac[e]);
        bn += rr[e] * kd[e] * rkc[e];
      }
      bn = red16(bn);
      if ((tid & 15) == 0 && prow < NLAT) BON[(size_t)prow * 16 + hh] = bn;
      float* d = buf + bi * 10240 + ((ps * 8 + (col4 >> 3)) * 5) * 8 + (col4 & 7);
      *(float4*)(d) = make_float4(rr[0], rr[1], rr[2], rr[3]);
      *(float4*)(d + 8) = make_float4(w[0], w[1], w[2], w[3]);
      *(float4*)(d + 16) = make_float4(kk[0], kk[1], kk[2], kk[3]);
      *(float4*)(d + 24) = make_float4(bb[0], bb[1], bb[2], bb[3]);
      *(float4*)(d + 32) = make_float4(kd[0], kd[1], kd[2], kd[3]);
      *(float4*)(vbuf + bi * 2048 + ps * 64 + col4) = vv;
    };
    float S[8];
#pragma unroll
    for (int j = 0; j < 8; ++j) S[j] = 0.f;
    gload(0);
    prep(0);
    __syncthreads();
    for (int ch = 0; ch < 136; ++ch) {
      const int cur = ch & 1;
      if (ch + 1 < 136) gload(ch + 1);
      const float* bq = buf + cur * 10240 + c * 40;
      const float* vq = vbuf + cur * 2048 + irow;
      float4 nr0, nr1, nw0, nw1, nk0, nk1, nb0, nb1, nd0, nd1; float nvi;
      {
        const float* q = bq;
        nr0 = *(const float4*)(q); nr1 = *(const float4*)(q + 4); nw0 = *(const float4*)(q + 8); nw1 = *(const float4*)(q + 12);
        nk0 = *(const float4*)(q + 16); nk1 = *(const float4*)(q + 20); nb0 = *(const float4*)(q + 24); nb1 = *(const float4*)(q + 28);
        nd0 = *(const float4*)(q + 32); nd1 = *(const float4*)(q + 36); nvi = vq[0];
      }
#pragma unroll 4
      for (int t = 0; t < 32; ++t) {
        const float4 r0 = nr0, r1 = nr1, w0 = nw0, w1 = nw1, k0 = nk0, k1 = nk1, b0 = nb0, b1 = nb1, d0 = nd0, d1 = nd1;
        const float vi = nvi;
        if (t + 1 < 32) {
          const float* q = bq + (t + 1) * 320;
          nr0 = *(const float4*)(q); nr1 = *(const float4*)(q + 4); nw0 = *(const float4*)(q + 8); nw1 = *(const float4*)(q + 12);
          nk0 = *(const float4*)(q + 16); nk1 = *(const float4*)(q + 20); nb0 = *(const float4*)(q + 24); nb1 = *(const float4*)(q + 28);
          nd0 = *(const float4*)(q + 32); nd1 = *(const float4*)(q + 36); nvi = vq[(t + 1) * 64];
        }
        float sa = (S[0] * k0.x + S[1] * k0.y) + (S[2] * k0.z + S[3] * k0.w) + ((S[4] * k1.x + S[5] * k1.y) + (S[6] * k1.z + S[7] * k1.w));
        sa = red8(sa);
        S[0] = fmaf(S[0], w0.x, fmaf(-sa, b0.x, vi * d0.x));
        S[1] = fmaf(S[1], w0.y, fmaf(-sa, b0.y, vi * d0.y));
        S[2] = fmaf(S[2], w0.z, fmaf(-sa, b0.z, vi * d0.z));
        S[3] = fmaf(S[3], w0.w, fmaf(-sa, b0.w, vi * d0.w));
        S[4] = fmaf(S[4], w1.x, fmaf(-sa, b1.x, vi * d1.x));
        S[5] = fmaf(S[5], w1.y, fmaf(-sa, b1.y, vi * d1.y));
        S[6] = fmaf(S[6], w1.z, fmaf(-sa, b1.z, vi * d1.z));
        S[7] = fmaf(S[7], w1.w, fmaf(-sa, b1.w, vi * d1.w));
        float y = (S[0] * r0.x + S[1] * r0.y) + (S[2] * r0.z + S[3] * r0.w) + ((S[4] * r1.x + S[5] * r1.y) + (S[6] * r1.z + S[7] * r1.w));
        y = red8(y);
        if (c == 0) ybuf[t * 64 + irow] = f2bf(y);
      }
      __syncthreads();
      if (ch >= 8 && !dummy) {
        int row = rowof(ch * 32 + ps);
        uint2 yv = *(const uint2*)(ybuf + ps * 64 + col4);
        *(uint2*)(WA + (size_t)row * 2048 + hh * 128 + col4 * 2) = yv;
      }
      if (ch + 1 < 136) prep(cur ^ 1);
      __syncthreads();
    }
  }
}

__device__ __forceinline__ void phase_readout(const P& p) {
  const u16* Vp = (const u16*)(p.ws + O_V);
  const u16* G = (const u16*)(p.ws + O_G);
  u16* Z = (u16*)(p.ws + O_Z);
  const float* BON = (const float*)(p.ws + O_BONUS);
  const size_t gt = (size_t)blockIdx.x * NT + tid_(), gn = (size_t)gridDim.x * NT;
  for (size_t it = gt; it < (size_t)NLAT * 16 * 8; it += gn) {
    int sub = (int)(it & 7); size_t grp = it >> 3;
    int hh = (int)(grp & 15); int row = (int)(grp >> 4);
    uint4 y0 = *(const uint4*)(p.ws + O_WA0 + (size_t)row * 2048 + hh * 128 + sub * 16);
    uint4 y1 = *(const uint4*)(p.ws + O_WA1 + (size_t)row * 2048 + hh * 128 + sub * 16);
    float y[8] = {bflo(y0.x) + bflo(y1.x), bfhi(y0.x) + bfhi(y1.x), bflo(y0.y) + bflo(y1.y), bfhi(y0.y) + bfhi(y1.y),
                  bflo(y0.z) + bflo(y1.z), bfhi(y0.z) + bfhi(y1.z), bflo(y0.w) + bflo(y1.w), bfhi(y0.w) + bfhi(y1.w)};
    float s = 0.f;
#pragma unroll
    for (int e = 0; e < 8; ++e) s += y[e];
    float mean = red8(s) * (1.f / 64.f);
    float vs = 0.f;
#pragma unroll
    for (int e = 0; e < 8; ++e) { y[e] -= mean; vs += y[e] * y[e]; }
    float var = red8(vs) * (1.f / 64.f);
    float rs = rsqrtf(var + 64e-5f);
    float bonus = BON[(size_t)row * 16 + hh] + BON[(size_t)NLAT * 16 + (size_t)row * 16 + hh];
    int col = hh * 64 + sub * 8;
    uint4 vv = *(const uint4*)(Vp + (size_t)row * DM + col);
    uint4 gg = *(const uint4*)(G + (size_t)row * DM + col);
    float vf[8] = {bflo(vv.x), bfhi(vv.x), bflo(vv.y), bfhi(vv.y), bflo(vv.z), bfhi(vv.z), bflo(vv.w), bfhi(vv.w)};
    float gf[8] = {bflo(gg.x), bfhi(gg.x), bflo(gg.y), bfhi(gg.y), bflo(gg.z), bfhi(gg.z), bflo(gg.w), bfhi(gg.w)};
    float z[8];
#pragma unroll
    for (int e = 0; e < 8; ++e) z[e] = (y[e] * rs * p.in[29][col + e] + p.in[30][col + e] + bonus * vf[e]) * gf[e];
    uint4 ov; ov.x = pack2(z[0], z[1]); ov.y = pack2(z[2], z[3]); ov.z = pack2(z[4], z[5]); ov.w = pack2(z[6], z[7]);
    *(uint4*)(Z + (size_t)row * DM + col) = ov;
  }
}

__device__ __forceinline__ bool xcd_tile(int k, int Tm, int Tn, int& mt, int& nt) {
  const int x = blockIdx.x & 7, j = blockIdx.x >> 3, J = gridDim.x >> 3;
  const int u = j + J * k;
  if (u >= (Tm >> 3) * Tn) return false;
  mt = (u / Tn) * 8 + x; nt = u % Tn;
  return true;
}

__global__ void __launch_bounds__(NT) fwd_kernel(P p) {
  extern __shared__ __attribute__((aligned(16))) char lds[];
  cg::grid_group grid = cg::this_grid();
  char* ws = p.ws;
  const float* mod0 = (const float*)(ws + O_MOD);
  const float* mod1 = mod0 + 9 * 6144;
  for (int ph = p.ph_lo; ph < p.ph_hi; ++ph) {
    if (ph > p.ph_lo) grid.sync();
    if (!((PHASE_MASK >> ph) & 1)) continue;
    const int nrep = ((REPEAT_MASK >> ph) & 1) ? 2 : 1;
    for (int rep = 0; rep < nrep; ++rep) {
    const bool dummy = rep + 1 < nrep;
    if (rep) grid.sync();
    switch (ph) {
      case 0: phase_prep(p, lds); break;
      case 1: phase_norm(p, p.in[0], p.in[2], p.in[6], 0, 0, TTOK, (u16*)(ws + O_XN)); break;
      case 2: {
        u16* hgg = (u16*)(ws + O_HGG); u16* Q = (u16*)(ws + O_Q); u16* KBp = (u16*)(ws + O_KB); u16* VT = (u16*)(ws + O_VT);
        for (int kq = 0, mt = 0, ntw = 0; xcd_tile(kq, 136, 10, mt, ntw); ++kq) {
          if (ntw < 8) {
            const int n0w = ntw * 256;
            u16* dbase; int dld;
            if (n0w < 1536) { dbase = hgg + n0w; dld = 1536; } else { dbase = Q + (n0w - 1536); dld = 512; }
            auto xf = [&](float v, int row, int col) -> float { return v; };
            auto dstf = [&](int row) -> u16* { return dbase + (size_t)row * dld; };
            gemm_tile256<false>((const u16*)(ws + O_XN), 1024, nullptr, (const u16*)(ws + O_WIN) + (size_t)n0w * 1024, 1024, 1024,
                                mt * 256, xf, dstf, (u16*)lds);
            continue;
          }
          int nt = 8 + ntw;
          int n0 = nt * 128;
          auto epi = [&](int row, int col, float v0, float v1, float v2, float v3) {
            int n = n0 + col;
            float v[4] = {v0, v1, v2, v3};
            if (n < 1536) {
#pragma unroll
              for (int j = 0; j < 4; ++j) hgg[(size_t)(row + j) * 1536 + n] = f2bf(v[j]);
            } else if (n < 2048) {
#pragma unroll
              for (int j = 0; j < 4; ++j) Q[(size_t)(row + j) * 512 + n - 1536] = f2bf(v[j]);
            } else if (n < 2176) {
#pragma unroll
              for (int j = 0; j < 4; ++j) KBp[(size_t)(row + j) * 128 + n - 2048] = f2bf(v[j]);
            } else {
              int kvh = (n - 2176) >> 6, d = (n - 2176) & 63;
              int b, pos;
              if (row < NLAT) { b = row >> 12; pos = 256 + (row & 4095); } else { b = (row - NLAT) >> 8; pos = (row - NLAT) & 255; }
              uint2 o; o.x = pack2(v0, v1); o.y = pack2(v2, v3);
              *(uint2*)(VT + ((size_t)((b * 2 + kvh) * 64 + d)) * 4352 + pos) = o;
            }
          };
          if (nt < 17) {
            u16* dbase; int dld;
            if (n0 < 1536) { dbase = hgg + n0; dld = 1536; } else if (n0 < 2048) { dbase = Q + (n0 - 1536); dld = 512; } else { dbase = KBp + (n0 - 2048); dld = 128; }
            auto xf = [&](float v, int row, int col) -> float { return v; };
            auto dstf = [&](int row) -> u16* { return dbase + (size_t)row * dld; };
            gemm_tile<false, 1>((const u16*)(ws + O_XN), 1024, nullptr, (const u16*)(ws + O_WIN) + (size_t)n0 * 1024, 1024, 1024,
                                mt * 256, xf, dstf, (u16*)lds);
          } else {
            gemm_tile<false, 0>((const u16*)(ws + O_XN), 1024, nullptr, (const u16*)(ws + O_WIN) + (size_t)n0 * 1024, 1024, 1024,
                                mt * 256, epi, 0, (u16*)lds);
          }
        }
      } break;
      case 3: phase_conv_qk(p); break;
      case 4: phase_attn(p, lds); break;
      case 5: {
        float* HC = (float*)(ws + O_HC);
        for (int kq = 0, mt = 0, nt = 0; xcd_tile(kq, 136, 8, mt, nt); ++kq) {
          int n0 = nt * 128;
          auto epi = [&](int row, int col, float v0, float v1, float v2, float v3) {
            int n = n0 + col;
            float v[4] = {v0, v1, v2, v3};
#pragma unroll
            for (int j = 0; j < 4; ++j) {
              int rw = row + j;
              if (rw < NLAT) {
                float g = mod0[(rw >> 12) * 6144 + 2048 + n];
                p.out[(size_t)rw * DM + n] = p.in[0][(size_t)rw * DM + n] + g * v[j];
              } else {
                float g = mod0[8 * 6144 + 2048 + n];
                HC[(size_t)(rw - NLAT) * DM + n] = p.in[2][(size_t)(rw - NLAT) * DM + n] + g * v[j];
              }
            }
          };
          gemm_tile<false, 0>((const u16*)(ws + O_XN), 1024, nullptr, (const u16*)(ws + O_WOUT) + (size_t)n0 * 1024, 1024, 1024,
                              mt * 256, epi, 0, (u16*)lds);
        }
      } break;
      case 6: phase_norm(p, p.out, (const float*)(ws + O_HC), p.in[7], 0, 3, TTOK, (u16*)(ws + O_XN)); break;
      case 7: case 18: {
        int layer = ph == 7 ? 0 : 1;
        int mtiles = layer == 0 ? 136 : 128;
        u16* PQ = (u16*)(ws + (layer == 0 ? O_PQ0 : O_PQ1));
        const u16* Wq = (const u16*)(ws + O_WQ) + (size_t)layer * 2048 * 1024;
        for (int kq = 0, mt = 0, nt = 0; xcd_tile(kq, mtiles, 8, mt, nt); ++kq) {
          int n0 = nt * 256;
          auto epi = [&](int row, int col, float v0, float v1, float v2, float v3) {
            int n = n0 + col;
            float v[4] = {v0, v1, v2, v3};
#pragma unroll
            for (int j = 0; j < 4; ++j) PQ[(size_t)(row + j) * 2048 + n] = f2bf(v[j]);
          };
          auto xf = [&](float v, int row, int col) -> float { return v; };
          auto dstf = [&](int row) -> u16* { return PQ + (size_t)row * 2048 + n0; };
          gemm_tile256<false>((const u16*)(ws + O_XN), 1024, nullptr, Wq + (size_t)n0 * 1024, 1024, 1024, mt * 256, xf, dstf, (u16*)lds);
        }
      } break;
      case 8: phase_peer_topk(p, 0, (const u16*)(ws + O_PQ0), TTOK, (int*)(ws + O_IDX0), (float*)(ws + O_GATE0), lds); break;
      case 9: phase_peer_act(p, (const u16*)(ws + O_XN), ws + O_TAB0, (const int*)(ws + O_IDX0), (const float*)(ws + O_GATE0),
                             (float*)(ws + O_COEF0), TTOK, lds); break;
      case 10: phase_peer_sum(p, 0, ws + O_TAB0, (const int*)(ws + O_IDX0), (const float*)(ws + O_COEF0), TTOK, dummy ? (float*)(ws + O_A2R) : nullptr); break;
      case 11: phase_norm(p, p.out, (const float*)(ws + O_HC), p.in[6] + 1024, 1, 0, TTOK, (u16*)(ws + O_XN)); break;
      case 12: {
        u16* LORA = (u16*)(ws + O_LORA);
        for (int kq = 0;; ++kq) {
          const int u = (blockIdx.x >> 3) + (gridDim.x >> 3) * kq;
          if (u >= 17 * 27) break;
          int mt, nt;
          if (u < 408) { int g = u / 136, rem = u % 136; mt = (rem >> 3) * 8 + (blockIdx.x & 7); nt = g * 8 + (rem & 7); }
          else { int v2 = u - 408; mt = (v2 / 3) * 8 + (blockIdx.x & 7); nt = 24 + v2 % 3; }
          const u16* Bp; int mixi; u16* dstp = nullptr; int kind;
          if (nt < 8) { Bp = (const u16*)(ws + O_WR) + (size_t)nt * 128 * 1024; mixi = 0; dstp = (u16*)(ws + O_R) + nt * 128; kind = 0; }
          else if (nt < 16) { Bp = (const u16*)(ws + O_WK) + (size_t)(nt - 8) * 128 * 1024; mixi = 2; dstp = (u16*)(ws + O_K) + (nt - 8) * 128; kind = 0; }
          else if (nt < 24) { Bp = (const u16*)(ws + O_WV) + (size_t)(nt - 16) * 128 * 1024; mixi = 3; dstp = (u16*)(ws + O_V) + (nt - 16) * 128; kind = 0; }
          else if (nt == 24) { Bp = (const u16*)(ws + O_W1); mixi = 1; kind = 1; }
          else if (nt == 25) { Bp = (const u16*)(ws + O_A1); mixi = 4; kind = 2; }
          else { Bp = (const u16*)(ws + O_G1); mixi = 5; kind = 3; }
          auto epi = [&](int row, int col, float v0, float v1, float v2, float v3) {
            float v[4] = {v0, v1, v2, v3};
            if (kind == 0) {
#pragma unroll
              for (int j = 0; j < 4; ++j) dstp[(size_t)(row + j) * 1024 + col] = f2bf(v[j]);
            } else if (kind == 1) {
#pragma unroll
              for (int j = 0; j < 4; ++j) LORA[(size_t)(row + j) * 384 + col] = f2bf(tanhf(v[j]));
            } else if (kind == 2) {
#pragma unroll
              for (int j = 0; j < 4; ++j) LORA[(size_t)(row + j) * 384 + 128 + col] = f2bf(v[j]);
            } else {
#pragma unroll
              for (int j = 0; j < 4; ++j) LORA[(size_t)(row + j) * 384 + 256 + col] = f2bf(sigmoidf_(v[j]));
            }
          };
          auto xf = [&](float v, int row, int col) -> float { return kind == 1 ? tanhf(v) : (kind == 3 ? sigmoidf_(v) : v); };
          u16* dbase = kind == 0 ? dstp : (LORA + (kind - 1) * 128);
          const int dld = kind == 0 ? 1024 : 384;
          auto dstf = [&](int row) -> u16* { return dbase + (size_t)row * dld; };
          gemm_tile<true, 1>((const u16*)(ws + O_XN), 1024, p.in[13] + mixi * 1024, Bp, 1024, 1024, mt * 256, xf, dstf, (u16*)lds);
        }
      } break;
      case 13: {
        const u16* LORA = (const u16*)(ws + O_LORA);
        u16* G = (u16*)(ws + O_G);
        for (int t = blockIdx.x; t < 136 * 40; t += gridDim.x) {
          int mt = t / 40, nt = t % 40;
          int grp = nt >> 3, n0 = (nt & 7) * 128;
          const u16* Ap; const u16* Bp; int K, ldb;
          if (grp < 2) { Ap = LORA + grp * 64; Bp = (const u16*)(ws + O_W2) + (size_t)grp * 65536 + (size_t)n0 * 64; K = 64; ldb = 64; }
          else if (grp < 4) { Ap = LORA + 128 + (grp - 2) * 64; Bp = (const u16*)(ws + O_A2) + (size_t)(grp - 2) * 65536 + (size_t)n0 * 64; K = 64; ldb = 64; }
          else { Ap = LORA + 256; Bp = (const u16*)(ws + O_G2) + (size_t)n0 * 128; K = 128; ldb = 128; }
          int d = grp & 1;
          u8* WA = (u8*)(ws + (d ? O_WA1 : O_WA0));
          auto epi = [&](int row, int col, float v0, float v1, float v2, float v3) {
            int n = n0 + col;
            float v[4] = {v0, v1, v2, v3};
            if (grp < 2) {
              float w0 = p.in[23][d * 1024 + n];
#pragma unroll
              for (int j = 0; j < 4; ++j) {
                float x = w0 + v[j];
                float dec = __expf(-0.6065306597126334f * sigmoidf_(x));
                float q = rintf((dec - 0.5f) * 510.f);
                q = fminf(fmaxf(q, 0.f), 255.f);
                WA[(size_t)(row + j) * 2048 + (n >> 6) * 128 + (n & 63)] = (u8)q;
              }
            } else if (grp < 4) {
              float a0 = p.in[26][d * 1024 + n];
#pragma unroll
              for (int j = 0; j < 4; ++j) {
                float a = sigmoidf_(a0 + v[j]);
                float q = fminf(fmaxf(rintf(a * 255.f), 0.f), 255.f);
                WA[(size_t)(row + j) * 2048 + (n >> 6) * 128 + 64 + (n & 63)] = (u8)q;
              }
            } else {
#pragma unroll
              for (int j = 0; j < 4; ++j) G[(size_t)(row + j) * 1024 + n] = f2bf(v[j]);
            }
          };
          if (grp < 4) {
            const float* b0p = (grp < 2 ? p.in[23] : p.in[26]) + d * 1024 + n0;
            auto q8 = [&](float v, int row, int col) -> unsigned {
              float x = b0p[col] + v;
              float qv;
              if (grp < 2) { float dec = __expf(-0.6065306597126334f * sigmoidf_(x)); qv = rintf((dec - 0.5f) * 510.f); }
              else { qv = rintf(sigmoidf_(x) * 255.f); }
              return (unsigned)fminf(fmaxf(qv, 0.f), 255.f);
            };
            auto dst8 = [&](int row, int c16) -> u8* {
              int n = n0 + c16 * 16;
              return WA + (size_t)row * 2048 + (n >> 6) * 128 + (grp < 2 ? 0 : 64) + (n & 63);
            };
            gemm_tile<false, 2>(Ap, 384, nullptr, Bp, ldb, K, mt * 256, q8, dst8, (u16*)lds);
          } else {
            auto xf = [&](float v, int row, int col) -> float { return v; };
            auto dstf = [&](int row) -> u16* { return G + (size_t)row * 1024 + n0; };
            gemm_tile<false, 1>(Ap, 384, nullptr, Bp, ldb, K, mt * 256, xf, dstf, (u16*)lds);
          }
        }
      } break;
      case 14: phase_scan(p, lds, dummy); break;
      case 15:
        phase_readout(p);
        convert_tab_fp8(p.in[33] + (size_t)16384 * 1024, p.in[34] + (size_t)16384 * 1024, ws + O_TAB1);
        break;
      case 16: {
        for (int kq = 0, mt = 0, nt = 0; xcd_tile(kq, 128, 8, mt, nt); ++kq) {
          int n0 = nt * 128;
          auto epi = [&](int row, int col, float v0, float v1, float v2, float v3) {
            int n = n0 + col;
            float v[4] = {v0, v1, v2, v3};
#pragma unroll
            for (int j = 0; j < 4; ++j) {
              int rw = row + j;
              float g = mod1[(rw >> 12) * 6144 + 2048 + n];
              p.out[(size_t)rw * DM + n] += g * v[j];
            }
          };
          gemm_tile<false, 0>((const u16*)(ws + O_Z), 1024, nullptr, (const u16*)(ws + O_WO) + (size_t)n0 * 1024, 1024, 1024,
                              mt * 256, epi, 0, (u16*)lds);
        }
      } break;
      case 17: phase_norm(p, p.out, nullptr, p.in[7] + 1024, 1, 3, NLAT, (u16*)(ws + O_XN)); break;
      case 19: phase_peer_topk(p, 1, (const u16*)(ws + O_PQ1), NLAT, (int*)(ws + O_IDX1), (float*)(ws + O_GATE1), lds); break;
      case 20: phase_peer_act(p, (const u16*)(ws + O_XN), ws + O_TAB1, (const int*)(ws + O_IDX1), (const float*)(ws + O_GATE1),
                              (float*)(ws + O_COEF1), NLAT, lds); break;
      case 21: phase_peer_sum(p, 1, ws + O_TAB1, (const int*)(ws + O_IDX1), (const float*)(ws + O_COEF1), NLAT, dummy ? (float*)(ws + O_A5R) : nullptr); break;
      default: break;
    }
    }
  }
}

extern "C" void kernel_launch(void* const* d_in, const int* in_sizes, int n_in, void* d_out, int out_size, void* d_ws,
                              size_t ws_size, hipStream_t stream) {
  static int grid = 0;
  if (grid == 0) {
    if (n_in != 35 || ws_size < WS_END) {
      fprintf(stderr, "kernel_launch: unexpected n_in %d or ws_size %zu (need %zu)\n", n_in, ws_size, (size_t)WS_END);
      grid = -1;
      return;
    }
    int dev = 0, cus = 0, per_cu = 0;
    hipGetDevice(&dev);
    hipDeviceGetAttribute(&cus, hipDeviceAttributeMultiprocessorCount, dev);
    hipFuncSetAttribute((const void*)fwd_kernel, hipFuncAttributeMaxDynamicSharedMemorySize, LDS_BYTES);
    hipOccupancyMaxActiveBlocksPerMultiprocessor(&per_cu, (const void*)fwd_kernel, NT, LDS_BYTES);
    (void)hipGetLastError();
    if (per_cu < 1) per_cu = 1;
    grid = (cus / 8) * 8;
    if (grid > cus * per_cu) grid = cus * per_cu;
  }
  if (grid < 0) return;
  P p{};
  for (int i = 0; i < 35; ++i) p.in[i] = (const float*)d_in[i];
  p.out = (float*)d_out;
  p.ws = (char*)d_ws;
#if N_LAUNCH_MODE == 0
  p.ph_lo = 0; p.ph_hi = NPHASE;
  void* args[] = {&p};
  hipError_t e = hipLaunchCooperativeKernel((const void*)fwd_kernel, dim3(grid), dim3(NT), args, LDS_BYTES, stream);
  if (e != hipSuccess) fprintf(stderr, "cooperative launch failed: %s (grid %d)\n", hipGetErrorString(e), grid);
#else
  for (int ph = 0; ph < NPHASE; ++ph) {
    p.ph_lo = ph; p.ph_hi = ph + 1;
    hipLaunchKernelGGL(fwd_kernel, dim3(grid), dim3(NT), LDS_BYTES, stream, p);
  }
#endif
}
```

```cpp
#include <hip/hip_runtime.h>
#include <hip/hip_cooperative_groups.h>
#include <cstdio>
namespace cg = cooperative_groups;

#ifndef N_LAUNCH_MODE
#define N_LAUNCH_MODE 0
#endif

typedef unsigned short u16;
typedef unsigned char u8;
typedef __attribute__((ext_vector_type(8))) short bf16x8;
typedef __attribute__((ext_vector_type(16))) float f32x16;

#define NT 512
#define TTOK 34816
#define NLAT 32768
#define DM 1024
#define LDSS 72
#define LDS_BYTES 149504
#define NPHASE 22
#ifndef REPEAT_MASK
#define REPEAT_MASK 0
#endif
#ifndef PHASE_MASK
#define PHASE_MASK 0x3FFFFF
#endif

static constexpr size_t MiB = 1048576;
static constexpr size_t O_WIN = 0;
static constexpr size_t O_WOUT = O_WIN + 4718592;
static constexpr size_t O_WR = O_WOUT + 2097152;
static constexpr size_t O_WK = O_WR + 2097152;
static constexpr size_t O_WV = O_WK + 2097152;
static constexpr size_t O_WO = O_WV + 2097152;
static constexpr size_t O_G1 = O_WO + 2097152;
static constexpr size_t O_G2 = O_G1 + 262144;
static constexpr size_t O_W1 = O_G2 + 262144;
static constexpr size_t O_A1 = O_W1 + 262144;
static constexpr size_t O_W2 = O_A1 + 262144;
static constexpr size_t O_A2 = O_W2 + 262144;
static constexpr size_t O_WQ = O_A2 + 262144;
static constexpr size_t O_KEYS = O_WQ + 8388608;
static constexpr size_t O_MOD = O_KEYS + 1048576;
static constexpr size_t O_ROPE = O_MOD + 442368;
static constexpr size_t SZ = 68 * MiB;
static constexpr size_t O_A1R = 26 * MiB;
static constexpr size_t O_A2R = O_A1R + SZ;
static constexpr size_t O_A3R = O_A2R + SZ;
static constexpr size_t O_A4R = O_A3R + SZ;
static constexpr size_t O_A5R = O_A4R + SZ;
static constexpr size_t O_A6R = O_A5R + SZ;
static constexpr size_t O_A7R = O_A6R + SZ;
static constexpr size_t O_LORA = O_A7R;
static constexpr size_t O_BONUS = O_A7R + 26 * MiB;
static constexpr size_t WS_END = O_BONUS + 4 * MiB;
static constexpr size_t O_XN = O_A1R;
static constexpr size_t O_HGG = O_A2R;
static constexpr size_t O_Q = O_A2R + 102 * MiB;
static constexpr size_t O_KB = O_A4R;
static constexpr size_t O_VT = O_A4R + 9 * MiB;
static constexpr size_t O_PQ0 = O_A2R;
static constexpr size_t O_TAB0 = O_A5R;
static constexpr size_t O_IDX0 = O_A6R;
static constexpr size_t O_GATE0 = O_A6R + 17 * MiB;
static constexpr size_t O_HC = O_A6R + 34 * MiB;
static constexpr size_t O_COEF0 = O_A6R + 42 * MiB;
static constexpr size_t O_R = O_A2R, O_K = O_A3R, O_V = O_A4R;
static constexpr size_t O_WA0 = O_A5R, O_WA1 = O_A6R;
static constexpr size_t O_G = O_A1R;
static constexpr size_t O_Z = O_A2R;
static constexpr size_t O_TAB1 = O_A3R;
static constexpr size_t O_PQ1 = O_A5R;
static constexpr size_t O_IDX1 = O_A4R;
static constexpr size_t O_GATE1 = O_A4R + 17 * MiB;
static constexpr size_t O_COEF1 = O_A4R + 34 * MiB;

struct P {
  const float* in[35];
  float* out;
  char* ws;
  int ph_lo, ph_hi;
};

typedef __bf16 bf16x2_t __attribute__((ext_vector_type(2)));
typedef float f32x2_t __attribute__((ext_vector_type(2)));
__device__ __forceinline__ u16 f2bf(float f) {
  __bf16 b = (__bf16)f;
  return __builtin_bit_cast(u16, b);
}
__device__ __forceinline__ float bf2f(u16 h) { return __uint_as_float(((unsigned)h) << 16); }
__device__ __forceinline__ float bflo(unsigned w) { return __uint_as_float(w << 16); }
__device__ __forceinline__ float bfhi(unsigned w) { return __uint_as_float(w & 0xFFFF0000u); }
__device__ __forceinline__ unsigned pack2(float a, float b) { f32x2_t v = {a, b}; bf16x2_t r = __builtin_convertvector(v, bf16x2_t); return __builtin_bit_cast(unsigned, r); }

__device__ __forceinline__ int tid_() { int t = __builtin_amdgcn_workitem_id_x(); asm volatile("" : "+v"(t)); return t; }
template <int CTRL>
__device__ __forceinline__ float dppf(float v) {
  return __builtin_bit_cast(float, __builtin_amdgcn_update_dpp(0, __builtin_bit_cast(int, v), CTRL, 0xF, 0xF, true));
}
__device__ __forceinline__ float red8(float v) {
  v += dppf<0xB1>(v); v += dppf<0x4E>(v); v += dppf<0x141>(v); return v;
}
__device__ __forceinline__ float red16(float v) { v = red8(v); v += dppf<0x140>(v); return v; }
__device__ __forceinline__ float swapsum32(float a, float b) {
  auto r = __builtin_amdgcn_permlane32_swap(__float_as_uint(a), __float_as_uint(b), false, false);
  return __uint_as_float(r[0]) + __uint_as_float(r[1]);
}
__device__ __forceinline__ float swapsum16(float a, float b) {
  auto r = __builtin_amdgcn_permlane16_swap(__float_as_uint(a), __float_as_uint(b), false, false);
  return __uint_as_float(r[0]) + __uint_as_float(r[1]);
}
__device__ __forceinline__ float swapmax32(float a) {
  auto r = __builtin_amdgcn_permlane32_swap(__float_as_uint(a), __float_as_uint(a), false, false);
  return fmaxf(__uint_as_float(r[0]), __uint_as_float(r[1]));
}
__device__ __forceinline__ float swapmax16(float a) {
  auto r = __builtin_amdgcn_permlane16_swap(__float_as_uint(a), __float_as_uint(a), false, false);
  return fmaxf(__uint_as_float(r[0]), __uint_as_float(r[1]));
}
__device__ __forceinline__ float wave_sum(float v) {
  v = red16(v);
  v = swapsum16(v, v); v = swapsum32(v, v);
  return v;
}
__device__ __forceinline__ float sigmoidf_(float x) { return 1.f / (1.f + __expf(-x)); }

template <bool MIX, int OM, class Epi, class Dst>
__device__ __forceinline__ void gemm_tile(const u16* __restrict__ A, int lda, const float* __restrict__ mu,
                                          const u16* __restrict__ B, int ldb, int K, int row0, Epi epi, Dst dstf, u16* lds) {
  u16* sA = lds;
  u16* sB = lds + 256 * LDSS;
  const int tid = tid_(), lane = tid & 63, wave = tid >> 6;
  const int wm = wave & 3, wn = wave >> 2;
  const int r = lane & 31, h = lane >> 5;
  const int kc = tid & 7, lr = tid >> 3;
  f32x16 acc[2][2];
#pragma unroll
  for (int i = 0; i < 2; ++i)
#pragma unroll
    for (int j = 0; j < 2; ++j)
#pragma unroll
      for (int g = 0; g < 16; ++g) acc[i][j][g] = 0.f;
  uint4 pa0, pa1, pa2, pa3, ps0, ps1, ps2, ps3, pb0, pb1;
  ps0 = ps1 = ps2 = ps3 = make_uint4(0, 0, 0, 0);
  float4 m0 = make_float4(0, 0, 0, 0), m1 = m0;
  auto nbr = [&](int row, int kg) -> int {
    if (row < NLAT) {
      int t = row & 4095; int gc = t & 63, gr = t >> 6; int qd = kg >> 8;
      if (qd == 0) return gc > 0 ? row - 1 : -1;
      if (qd == 1) return gc < 63 ? row + 1 : -1;
      if (qd == 2) return gr > 0 ? row - 64 : -1;
      return gr < 63 ? row + 64 : -1;
    } else {
      int t = (row - NLAT) & 255;
      if (kg < 512) return t > 0 ? row - 1 : -1;
      return t < 255 ? row + 1 : -1;
    }
  };
  auto ldA = [&](int i, int k0, uint4& a, uint4& sx) {
    int row = row0 + lr + 64 * i;
    a = *(const uint4*)(A + (size_t)row * lda + k0 + kc * 8);
    if (MIX) {
      int nr = nbr(row, k0 + kc * 8);
      if (nr >= 0) sx = *(const uint4*)(A + (size_t)nr * lda + k0 + kc * 8);
      else sx = make_uint4(0, 0, 0, 0);
    }
  };
  auto gload = [&](int k0) {
    ldA(0, k0, pa0, ps0); ldA(1, k0, pa1, ps1); ldA(2, k0, pa2, ps2); ldA(3, k0, pa3, ps3);
    if (MIX) {
      m0 = *(const float4*)(mu + k0 + kc * 8);
      m1 = *(const float4*)(mu + k0 + kc * 8 + 4);
    }
    pb0 = *(const uint4*)(B + (size_t)lr * ldb + k0 + kc * 8);
    pb1 = *(const uint4*)(B + (size_t)(lr + 64) * ldb + k0 + kc * 8);
  };
  auto mixw = [&](unsigned x, unsigned s, float ma, float mb) -> unsigned {
    float x0 = bflo(x), x1 = bfhi(x), s0 = bflo(s), s1 = bfhi(s);
    return pack2(x0 + (s0 - x0) * ma, x1 + (s1 - x1) * mb);
  };
  int bo = 0;
  auto stA = [&](int i, uint4 a, uint4 sx) {
    uint4 v = a;
    if (MIX) {
      v.x = mixw(a.x, sx.x, m0.x, m0.y);
      v.y = mixw(a.y, sx.y, m0.z, m0.w);
      v.z = mixw(a.z, sx.z, m1.x, m1.y);
      v.w = mixw(a.w, sx.w, m1.z, m1.w);
    }
    *(uint4*)(sA + bo + (lr + 64 * i) * LDSS + kc * 8) = v;
  };
  auto lstore = [&]() {
    stA(0, pa0, ps0); stA(1, pa1, ps1); stA(2, pa2, ps2); stA(3, pa3, ps3);
    *(uint4*)(sB + bo + lr * LDSS + kc * 8) = pb0;
    *(uint4*)(sB + bo + (lr + 64) * LDSS + kc * 8) = pb1;
  };
  constexpr int BUFE = (256 + 128) * LDSS;
  gload(0);
  bo = 0; lstore();
  if (64 < K) gload(64);
  __syncthreads();
  for (int k0 = 0; k0 < K; k0 += 64) {
    const int co = ((k0 >> 6) & 1) * BUFE;
    bf16x8 af[2], bfr[2], naf[2], nbf[2];
#pragma unroll
    for (int i = 0; i < 2; ++i) af[i] = *(const bf16x8*)(sA + co + (wm * 64 + i * 32 + r) * LDSS + h * 8);
#pragma unroll
    for (int j = 0; j < 2; ++j) bfr[j] = *(const bf16x8*)(sB + co + (wn * 64 + j * 32 + r) * LDSS + h * 8);
#pragma unroll
    for (int kk = 0; kk < 4; ++kk) {
      if (kk == 2 && k0 + 64 < K) {
        bo = BUFE - co; lstore();
        if (k0 + 128 < K) gload(k0 + 128);
      }
      if (kk < 3) {
#pragma unroll
        for (int i = 0; i < 2; ++i) naf[i] = *(const bf16x8*)(sA + co + (wm * 64 + i * 32 + r) * LDSS + (kk + 1) * 16 + h * 8);
#pragma unroll
        for (int j = 0; j < 2; ++j) nbf[j] = *(const bf16x8*)(sB + co + (wn * 64 + j * 32 + r) * LDSS + (kk + 1) * 16 + h * 8);
      }
#pragma unroll
      for (int i = 0; i < 2; ++i)
#pragma unroll
        for (int j = 0; j < 2; ++j) {
          if (OM == 0) acc[i][j] = __builtin_amdgcn_mfma_f32_32x32x16_bf16(af[i], bfr[j], acc[i][j], 0, 0, 0);
          else acc[i][j] = __builtin_amdgcn_mfma_f32_32x32x16_bf16(bfr[j], af[i], acc[i][j], 0, 0, 0);
        }
      if (kk < 3) {
#pragma unroll
        for (int i = 0; i < 2; ++i) af[i] = naf[i];
#pragma unroll
        for (int j = 0; j < 2; ++j) bfr[j] = nbf[j];
      }
    }
    __syncthreads();
  }
  if constexpr (OM == 0) {
#pragma unroll
    for (int i = 0; i < 2; ++i)
#pragma unroll
      for (int j = 0; j < 2; ++j)
#pragma unroll
        for (int g4 = 0; g4 < 4; ++g4) {
          int row = row0 + wm * 64 + i * 32 + 8 * g4 + 4 * h;
          int col = wn * 64 + j * 32 + r;
          epi(row, col, acc[i][j][g4 * 4 + 0], acc[i][j][g4 * 4 + 1], acc[i][j][g4 * 4 + 2], acc[i][j][g4 * 4 + 3]);
        }
  } else if constexpr (OM == 1) {
    u16* st = lds;
#pragma unroll
    for (int i = 0; i < 2; ++i)
#pragma unroll
      for (int j = 0; j < 2; ++j)
#pragma unroll
        for (int g4 = 0; g4 < 4; ++g4) {
          const int rl = wm * 64 + i * 32 + r, c0 = wn * 64 + j * 32 + 8 * g4 + 4 * h;
          uint2 o;
          o.x = pack2(epi(acc[i][j][g4 * 4 + 0], row0 + rl, c0 + 0), epi(acc[i][j][g4 * 4 + 1], row0 + rl, c0 + 1));
          o.y = pack2(epi(acc[i][j][g4 * 4 + 2], row0 + rl, c0 + 2), epi(acc[i][j][g4 * 4 + 3], row0 + rl, c0 + 3));
          *(uint2*)(st + rl * 136 + c0) = o;
        }
    __syncthreads();
#pragma unroll
    for (int q = 0; q < 8; ++q) {
      const int id = tid + NT * q, rl = id >> 4, c8 = id & 15;
      const uint4 v = *(const uint4*)(st + rl * 136 + c8 * 8);
      *(uint4*)(dstf(row0 + rl) + c8 * 8) = v;
    }
    __syncthreads();
  } else {
    u8* st = (u8*)lds;
#pragma unroll
    for (int i = 0; i < 2; ++i)
#pragma unroll
      for (int j = 0; j < 2; ++j)
#pragma unroll
        for (int g4 = 0; g4 < 4; ++g4) {
          const int rl = wm * 64 + i * 32 + r, c0 = wn * 64 + j * 32 + 8 * g4 + 4 * h;
          unsigned o = epi(acc[i][j][g4 * 4 + 0], row0 + rl, c0 + 0) | (epi(acc[i][j][g4 * 4 + 1], row0 + rl, c0 + 1) << 8) |
                       (epi(acc[i][j][g4 * 4 + 2], row0 + rl, c0 + 2) << 16) | (epi(acc[i][j][g4 * 4 + 3], row0 + rl, c0 + 3) << 24);
          *(unsigned*)(st + rl * 144 + c0) = o;
        }
    __syncthreads();
#pragma unroll
    for (int q = 0; q < 4; ++q) {
      const int id = tid + NT * q, rl = id >> 3, c16 = id & 7;
      const uint4 v = *(const uint4*)(st + rl * 144 + c16 * 16);
      *(uint4*)(dstf(row0 + rl, c16)) = v;
    }
    __syncthreads();
  }
}

template <bool MIX, class Epi, class Dst>
__device__ __forceinline__ void gemm_tile256(const u16* __restrict__ A, int lda, const float* __restrict__ mu,
                                             const u16* __restrict__ B, int ldb, int K, int row0, Epi epi, Dst dstf, u16* lds) {
  u16* sA = lds;
  u16* sB = lds + 256 * LDSS;
  const int tid = tid_(), lane = tid & 63, wave = tid >> 6;
  const int wm = wave & 1, wn = wave >> 1;
  const int r = lane & 31, h = lane >> 5;
  const int kc = tid & 7, lr = tid >> 3;
  f32x16 acc[4][2];
#pragma unroll
  for (int i = 0; i < 4; ++i)
#pragma unroll
    for (int j = 0; j < 2; ++j)
#pragma unroll
      for (int g = 0; g < 16; ++g) acc[i][j][g] = 0.f;
  uint4 pa0, pa1, pa2, pa3, ps0, ps1, ps2, ps3, pb0, pb1, pb2, pb3;
  ps0 = ps1 = ps2 = ps3 = make_uint4(0, 0, 0, 0);
  float4 m0 = make_float4(0, 0, 0, 0), m1 = m0;
  auto nbr = [&](int row, int kg) -> int {
    if (row < NLAT) {
      int t = row & 4095; int gc = t & 63, gr = t >> 6; int qd = kg >> 8;
      if (qd == 0) return gc > 0 ? row - 1 : -1;
      if (qd == 1) return gc < 63 ? row + 1 : -1;
      if (qd == 2) return gr > 0 ? row - 64 : -1;
      return gr < 63 ? row + 64 : -1;
    } else {
      int t = (row - NLAT) & 255;
      if (kg < 512) return t > 0 ? row - 1 : -1;
      return t < 255 ? row + 1 : -1;
    }
  };
  auto ldA = [&](int i, int k0, uint4& a, uint4& sx) {
    int row = row0 + lr + 64 * i;
    a = *(const uint4*)(A + (size_t)row * lda + k0 + kc * 8);
    if (MIX) {
      int nr = nbr(row, k0 + kc * 8);
      if (nr >= 0) sx = *(const uint4*)(A + (size_t)nr * lda + k0 + kc * 8);
      else sx = make_uint4(0, 0, 0, 0);
    }
  };
  auto gload = [&](int k0) {
    ldA(0, k0, pa0, ps0); ldA(1, k0, pa1, ps1); ldA(2, k0, pa2, ps2); ldA(3, k0, pa3, ps3);
    if (MIX) {
      m0 = *(const float4*)(mu + k0 + kc * 8);
      m1 = *(const float4*)(mu + k0 + kc * 8 + 4);
    }
    pb0 = *(const uint4*)(B + (size_t)lr * ldb + k0 + kc * 8);
    pb1 = *(const uint4*)(B + (size_t)(lr + 64) * ldb + k0 + kc * 8);
    pb2 = *(const uint4*)(B + (size_t)(lr + 128) * ldb + k0 + kc * 8);
    pb3 = *(const uint4*)(B + (size_t)(lr + 192) * ldb + k0 + kc * 8);
  };
  auto mixw = [&](unsigned x, unsigned s_, float ma, float mb) -> unsigned {
    float x0 = bflo(x), x1 = bfhi(x), s0 = bflo(s_), s1 = bfhi(s_);
    return pack2(x0 + (s0 - x0) * ma, x1 + (s1 - x1) * mb);
  };
  int bo = 0;
  auto stA = [&](int i, uint4 a, uint4 sx) {
    uint4 v = a;
    if (MIX) {
      v.x = mixw(a.x, sx.x, m0.x, m0.y);
      v.y = mixw(a.y, sx.y, m0.z, m0.w);
      v.z = mixw(a.z, sx.z, m1.x, m1.y);
      v.w = mixw(a.w, sx.w, m1.z, m1.w);
    }
    *(uint4*)(sA + bo + (lr + 64 * i) * LDSS + kc * 8) = v;
  };
  auto lstore = [&]() {
    stA(0, pa0, ps0); stA(1, pa1, ps1); stA(2, pa2, ps2); stA(3, pa3, ps3);
    *(uint4*)(sB + bo + lr * LDSS + kc * 8) = pb0;
    *(uint4*)(sB + bo + (lr + 64) * LDSS + kc * 8) = pb1;
    *(uint4*)(sB + bo + (lr + 128) * LDSS + kc * 8) = pb2;
    *(uint4*)(sB + bo + (lr + 192) * LDSS + kc * 8) = pb3;
  };
  constexpr int BUFE = 2 * 256 * LDSS;
  gload(0);
  bo = 0; lstore();
  if (64 < K) gload(64);
  __syncthreads();
  for (int k0 = 0; k0 < K; k0 += 64) {
    const int co = ((k0 >> 6) & 1) * BUFE;
    bf16x8 af[4], bfr[2], naf[4], nbf[2];
#pragma unroll
    for (int i = 0; i < 4; ++i) af[i] = *(const bf16x8*)(sA + co + (wm * 128 + i * 32 + r) * LDSS + h * 8);
#pragma unroll
    for (int j = 0; j < 2; ++j) bfr[j] = *(const bf16x8*)(sB + co + (wn * 64 + j * 32 + r) * LDSS + h * 8);
#pragma unroll
    for (int kk = 0; kk < 4; ++kk) {
      if (kk == 2 && k0 + 64 < K) {
        bo = BUFE - co; lstore();
        if (k0 + 128 < K) gload(k0 + 128);
      }
      if (kk < 3) {
#pragma unroll
        for (int i = 0; i < 4; ++i) naf[i] = *(const bf16x8*)(sA + co + (wm * 128 + i * 32 + r) * LDSS + (kk + 1) * 16 + h * 8);
#pragma unroll
        for (int j = 0; j < 2; ++j) nbf[j] = *(const bf16x8*)(sB + co + (wn * 64 + j * 32 + r) * LDSS + (kk + 1) * 16 + h * 8);
      }
#pragma unroll
      for (int i = 0; i < 4; ++i)
#pragma unroll
        for (int j = 0; j < 2; ++j) acc[i][j] = __builtin_amdgcn_mfma_f32_32x32x16_bf16(bfr[j], af[i], acc[i][j], 0, 0, 0);
      if (kk < 3) {
#pragma unroll
        for (int i = 0; i < 4; ++i) af[i] = naf[i];
#pragma unroll
        for (int j = 0; j < 2; ++j) bfr[j] = nbf[j];
      }
    }
    __syncthreads();
  }
  u16* st = lds;
#pragma unroll
  for (int half = 0; half < 2; ++half) {
    if ((wn >> 1) == half) {
#pragma unroll
      for (int i = 0; i < 4; ++i)
#pragma unroll
        for (int j = 0; j < 2; ++j)
#pragma unroll
          for (int g4 = 0; g4 < 4; ++g4) {
            const int rl = wm * 128 + i * 32 + r, cl = (wn & 1) * 64 + j * 32 + 8 * g4 + 4 * h, c0 = half * 128 + cl;
            uint2 o;
            o.x = pack2(epi(acc[i][j][g4 * 4 + 0], row0 + rl, c0 + 0), epi(acc[i][j][g4 * 4 + 1], row0 + rl, c0 + 1));
            o.y = pack2(epi(acc[i][j][g4 * 4 + 2], row0 + rl, c0 + 2), epi(acc[i][j][g4 * 4 + 3], row0 + rl, c0 + 3));
            *(uint2*)(st + rl * 136 + cl) = o;
          }
    }
    __syncthreads();
#pragma unroll
    for (int q = 0; q < 8; ++q) {
      const int id = tid + NT * q, rl = id >> 4, c8 = id & 15;
      const uint4 v = *(const uint4*)(st + rl * 136 + c8 * 8);
      *(uint4*)(dstf(row0 + rl) + half * 128 + c8 * 8) = v;
    }
    __syncthreads();
  }
}

__constant__ int TJOBS[18][5] = {
    {8, 0, 1024, 2304, (int)O_WIN},
    {12, 0, 1024, 1024, (int)O_WOUT},
    {14, 0, 1024, 1024, (int)O_WR},
    {15, 0, 1024, 1024, (int)O_WK},
    {16, 0, 1024, 1024, (int)O_WV},
    {17, 0, 1024, 1024, (int)O_WO},
    {18, 0, 1024, 128, (int)O_G1},
    {19, 0, 128, 1024, (int)O_G2},
    {24, 0, 1024, 64, (int)O_W1},
    {24, 65536, 1024, 64, (int)(O_W1 + 131072)},
    {27, 0, 1024, 64, (int)O_A1},
    {27, 65536, 1024, 64, (int)(O_A1 + 131072)},
    {25, 0, 64, 1024, (int)O_W2},
    {25, 65536, 64, 1024, (int)(O_W2 + 131072)},
    {28, 0, 64, 1024, (int)O_A2},
    {28, 65536, 64, 1024, (int)(O_A2 + 131072)},
    {31, 0, 1024, 2048, (int)O_WQ},
    {31, 2097152, 1024, 2048, (int)(O_WQ + 4194304)},
};

__device__ __forceinline__ void convert_bf16(const float* __restrict__ src, u16* __restrict__ dst, size_t n) {
  size_t n4 = n >> 2;
  for (size_t i = (size_t)blockIdx.x * NT + tid_(); i < n4; i += (size_t)gridDim.x * NT) {
    float4 v = ((const float4*)src)[i];
    uint2 o; o.x = pack2(v.x, v.y); o.y = pack2(v.z, v.w);
    ((uint2*)dst)[i] = o;
  }
}

__device__ __forceinline__ void convert_tab_fp8(const float* __restrict__ U, const float* __restrict__ V, char* tab);
__device__ __forceinline__ void phase_prep(const P& p, char* lds) {
  const int tid = tid_();
  float* fl = (float*)lds;
  for (int task = blockIdx.x; task < 192; task += gridDim.x) {
    int l = task / 96, cg_ = task % 96;
    float* sv = fl;
    float* red = fl + 9216;
    for (int i = tid; i < 9216; i += NT) {
      int v = i >> 10, k = i & 1023;
      float x = v < 8 ? p.in[1][v * 1024 + k] : p.in[3][k];
      sv[i] = x / (1.f + __expf(-x));
    }
    __syncthreads();
    int col = cg_ * 64 + (tid & 63), kg = tid >> 6;
    float acc[9];
#pragma unroll
    for (int v = 0; v < 9; ++v) acc[v] = 0.f;
    const float* W = p.in[4] + (size_t)l * 1024 * 6144 + col;
    for (int k = kg * 128; k < kg * 128 + 128; ++k) {
      float w = W[(size_t)k * 6144];
#pragma unroll
      for (int v = 0; v < 9; ++v) acc[v] += sv[v * 1024 + k] * w;
    }
#pragma unroll
    for (int v = 0; v < 9; ++v) red[(kg * 9 + v) * 64 + (tid & 63)] = acc[v];
    __syncthreads();
    if (tid < 576) {
      int v = tid >> 6, c = tid & 63;
      float s = p.in[5][l * 6144 + cg_ * 64 + c];
#pragma unroll
      for (int g = 0; g < 8; ++g) s += red[(g * 9 + v) * 64 + c];
      ((float*)(p.ws + O_MOD))[(l * 9 + v) * 6144 + cg_ * 64 + c] = s;
    }
    __syncthreads();
  }
  {
    int base = 0;
    for (int j = 0; j < 18; ++j) {
      int K = TJOBS[j][2], N = TJOBS[j][3];
      int tk = K >> 6, tn = N >> 6, nt = tk * tn;
      const float* src = p.in[TJOBS[j][0]] + TJOBS[j][1];
      u16* dst = (u16*)(p.ws + (size_t)(unsigned)TJOBS[j][4]);
      int first = (blockIdx.x + gridDim.x - (base % gridDim.x)) % gridDim.x;
      for (int t = first; t < nt; t += gridDim.x) {
        int k0 = (t / tn) * 64, n0 = (t % tn) * 64;
#pragma unroll
        for (int rep = 0; rep < 8; ++rep) {
          int idx = tid + NT * rep; int i = idx >> 6, jj = idx & 63;
          fl[i * 65 + jj] = src[(size_t)(k0 + i) * N + n0 + jj];
        }
        __syncthreads();
        int n = tid >> 3, c8 = tid & 7;
        uint4 o;
        o.x = pack2(fl[(c8 * 8 + 0) * 65 + n], fl[(c8 * 8 + 1) * 65 + n]);
        o.y = pack2(fl[(c8 * 8 + 2) * 65 + n], fl[(c8 * 8 + 3) * 65 + n]);
        o.z = pack2(fl[(c8 * 8 + 4) * 65 + n], fl[(c8 * 8 + 5) * 65 + n]);
        o.w = pack2(fl[(c8 * 8 + 6) * 65 + n], fl[(c8 * 8 + 7) * 65 + n]);
        *(uint4*)(dst + (size_t)(n0 + n) * K + k0 + c8 * 8) = o;
        __syncthreads();
      }
      base += nt;
    }
  }
  convert_bf16(p.in[32], (u16*)(p.ws + O_KEYS), (size_t)2 * 8 * 2 * 128 * 128);
  convert_tab_fp8(p.in[33], p.in[34], p.ws + O_TAB0);
  if (blockIdx.x == 0) {
    float* rope = (float*)(p.ws + O_ROPE);
    for (int i = tid; i < 1024; i += NT) {
      int pos = i >> 4, f = i & 15;
      float inv = exp2f(-(float)f * (13.287712379549449f / 16.f));
      float ang = (float)pos * inv;
      rope[i * 2] = cosf(ang);
      rope[i * 2 + 1] = sinf(ang);
    }
  }
}

__device__ __forceinline__ void phase_norm(const P& p, const float* srcL, const float* srcC, const float* gain, int layer, int shift_idx,
                           int nrows, u16* dst) {
  const int lane = tid_() & 63;
  const int gw = blockIdx.x * 8 + (tid_() >> 6), nw = gridDim.x * 8;
  const float* mod = (const float*)(p.ws + O_MOD) + (size_t)layer * 9 * 6144;
  for (int row = gw; row < nrows; row += nw) {
    const float* src = row < NLAT ? srcL + (size_t)row * DM : srcC + (size_t)(row - NLAT) * DM;
    int mi = row < NLAT ? (row >> 12) : 8;
    const float* sh = mod + mi * 6144 + shift_idx * 1024;
    const float* sc = sh + 1024;
    float4 v[4];
    float ss = 0.f;
#pragma unroll
    for (int i = 0; i < 4; ++i) {
      v[i] = *(const float4*)(src + i * 256 + lane * 4);
      ss += v[i].x * v[i].x + v[i].y * v[i].y + v[i].z * v[i].z + v[i].w * v[i].w;
    }
    ss = wave_sum(ss);
    float rs = rsqrtf(ss * (1.f / 1024.f) + 1e-6f);
#pragma unroll
    for (int i = 0; i < 4; ++i) {
      int c = i * 256 + lane * 4;
      float4 g = *(const float4*)(gain + c);
      float4 s1 = *(const float4*)(sc + c);
      float4 s0 = *(const float4*)(sh + c);
      float a = v[i].x * rs * g.x * (1.f + s1.x) + s0.x;
      float b = v[i].y * rs * g.y * (1.f + s1.y) + s0.y;
      float cc = v[i].z * rs * g.z * (1.f + s1.z) + s0.z;
      float d = v[i].w * rs * g.w * (1.f + s1.w) + s0.w;
      uint2 o; o.x = pack2(a, b); o.y = pack2(cc, d);
      *(uint2*)(dst + (size_t)row * DM + c) = o;
    }
  }
}

__device__ __forceinline__ void phase_conv_qk(const P& p) {
  const u16* hgg = (const u16*)(p.ws + O_HGG);
  u16* mix = (u16*)(p.ws + O_XN);
  const float* cw = p.in[9];
  const size_t gt = (size_t)blockIdx.x * NT + tid_(), gn = (size_t)gridDim.x * NT;
  for (size_t it = gt; it < (size_t)TTOK * 64; it += gn) {
    int row = (int)(it >> 6), c0 = (int)(it & 63) * 8;
    int t, len;
    if (row < NLAT) { t = row & 4095; len = 4096; } else { t = (row - NLAT) & 255; len = 256; }
    float pm[8], pc[8], pp[8];
    {
      const u16* b = hgg + (size_t)row * 1536;
      uint4 hh = *(const uint4*)(b + c0), gc = *(const uint4*)(b + 1024 + c0);
      pc[0] = bflo(hh.x) * bflo(gc.x); pc[1] = bfhi(hh.x) * bfhi(gc.x);
      pc[2] = bflo(hh.y) * bflo(gc.y); pc[3] = bfhi(hh.y) * bfhi(gc.y);
      pc[4] = bflo(hh.z) * bflo(gc.z); pc[5] = bfhi(hh.z) * bfhi(gc.z);
      pc[6] = bflo(hh.w) * bflo(gc.w); pc[7] = bfhi(hh.w) * bfhi(gc.w);
    }
    if (t > 0) {
      const u16* b = hgg + (size_t)(row - 1) * 1536;
      uint4 hh = *(const uint4*)(b + c0), gc = *(const uint4*)(b + 1024 + c0);
      pm[0] = bflo(hh.x) * bflo(gc.x); pm[1] = bfhi(hh.x) * bfhi(gc.x);
      pm[2] = bflo(hh.y) * bflo(gc.y); pm[3] = bfhi(hh.y) * bfhi(gc.y);
      pm[4] = bflo(hh.z) * bflo(gc.z); pm[5] = bfhi(hh.z) * bfhi(gc.z);
      pm[6] = bflo(hh.w) * bflo(gc.w); pm[7] = bfhi(hh.w) * bfhi(gc.w);
    } else {
#pragma unroll
      for (int e = 0; e < 8; ++e) pm[e] = 0.f;
    }
    if (t < len - 1) {
      const u16* b = hgg + (size_t)(row + 1) * 1536;
      uint4 hh = *(const uint4*)(b + c0), gc = *(const uint4*)(b + 1024 + c0);
      pp[0] = bflo(hh.x) * bflo(gc.x); pp[1] = bfhi(hh.x) * bfhi(gc.x);
      pp[2] = bflo(hh.y) * bflo(gc.y); pp[3] = bfhi(hh.y) * bfhi(gc.y);
      pp[4] = bflo(hh.z) * bflo(gc.z); pp[5] = bfhi(hh.z) * bfhi(gc.z);
      pp[6] = bflo(hh.w) * bflo(gc.w); pp[7] = bfhi(hh.w) * bfhi(gc.w);
    } else {
#pragma unroll
      for (int e = 0; e < 8; ++e) pp[e] = 0.f;
    }
    uint4 gbv = *(const uint4*)(hgg + (size_t)row * 1536 + 512 + c0);
    float gb[8] = {bflo(gbv.x), bfhi(gbv.x), bflo(gbv.y), bfhi(gbv.y), bflo(gbv.z), bfhi(gbv.z), bflo(gbv.w), bfhi(gbv.w)};
    float o[8];
#pragma unroll
    for (int e = 0; e < 8; ++e)
      o[e] = gb[e] * (cw[c0 + e] * pm[e] + cw[512 + c0 + e] * pc[e] + cw[1024 + c0 + e] * pp[e]);
    uint4 ov; ov.x = pack2(o[0], o[1]); ov.y = pack2(o[2], o[3]); ov.z = pack2(o[4], o[5]); ov.w = pack2(o[6], o[7]);
    *(uint4*)(mix + (size_t)row * DM + c0) = ov;
  }
  u16* Q = (u16*)(p.ws + O_Q);
  u16* KBp = (u16*)(p.ws + O_KB);
  const float* rope = (const float*)(p.ws + O_ROPE);
  const size_t ngroups = (size_t)TTOK * 10;
  for (size_t it = gt; it < ngroups * 8; it += gn) {
    size_t grp = it >> 3; int sub = (int)(it & 7);
    int row = (int)(grp / 10), hd = (int)(grp % 10);
    u16* ptr; const float* gain;
    if (hd < 8) { ptr = Q + (size_t)row * 512 + hd * 64 + sub * 8; gain = p.in[10]; }
    else { ptr = KBp + (size_t)row * 128 + (hd - 8) * 64 + sub * 8; gain = p.in[11]; }
    uint4 v = *(const uint4*)ptr;
    float x[8] = {bflo(v.x), bfhi(v.x), bflo(v.y), bfhi(v.y), bflo(v.z), bfhi(v.z), bflo(v.w), bfhi(v.w)};
    float ss = 0.f;
#pragma unroll
    for (int e = 0; e < 8; ++e) ss += x[e] * x[e];
    ss = red8(ss);
    float rs = rsqrtf(ss * (1.f / 64.f) + 1e-6f);
#pragma unroll
    for (int e = 0; e < 8; ++e) x[e] = x[e] * rs * gain[sub * 8 + e];
    if (row < NLAT) {
      int t = row & 4095; int gr = t >> 6, gc = t & 63;
#pragma unroll
      for (int e = 0; e < 4; ++e) {
        int pi = sub * 4 + e;
        int pos = pi < 16 ? gr : gc; int f = pi & 15;
        float c = rope[(pos * 16 + f) * 2], s = rope[(pos * 16 + f) * 2 + 1];
        float a = x[2 * e], b = x[2 * e + 1];
        x[2 * e] = a * c - b * s;
        x[2 * e + 1] = a * s + b * c;
      }
    }
    uint4 ov; ov.x = pack2(x[0], x[1]); ov.y = pack2(x[2], x[3]); ov.z = pack2(x[4], x[5]); ov.w = pack2(x[6], x[7]);
    *(uint4*)ptr = ov;
  }
}

__device__ __forceinline__ void phase_attn(const P& p, char* lds) {
  u16* sK = (u16*)lds;
  u16* sV = sK + 64 * LDSS;
  const u16* Q = (const u16*)(p.ws + O_Q);
  const u16* KBp = (const u16*)(p.ws + O_KB);
  const u16* VT = (const u16*)(p.ws + O_VT);
  u16* mix = (u16*)(p.ws + O_XN);
  const int tid = tid_(), lane = tid & 63, wave = tid >> 6;
  const int r = lane & 31, h = lane >> 5;
  const float cs = 0.125f * 1.4426950408889634f;
  for (int item = blockIdx.x; item < 1088; item += gridDim.x) {
    int b, qh, qrow0, nkt;
    if (item < 1024) { b = item >> 7; qh = (item >> 4) & 7; qrow0 = b * 4096 + (item & 15) * 256; nkt = 68; }
    else { int i2 = item - 1024; b = i2 >> 3; qh = i2 & 7; qrow0 = NLAT + b * 256; nkt = 4; }
    const int kvh = qh >> 2;
    const int qrow = qrow0 + wave * 32 + r;
    bf16x8 qf[4];
#pragma unroll
    for (int kk = 0; kk < 4; ++kk) qf[kk] = *(const bf16x8*)(Q + (size_t)qrow * 512 + qh * 64 + kk * 16 + h * 8);
    f32x16 o[2];
#pragma unroll
    for (int g = 0; g < 16; ++g) { o[0][g] = 0.f; o[1][g] = 0.f; }
    float m = -INFINITY, l = 0.f;
    const int lkey = tid >> 3, lch = tid & 7;
    uint4 ka, va;
    auto gl = [&](int kt) {
      int pos = kt * 64 + lkey;
      int krow = pos < 256 ? NLAT + b * 256 + pos : b * 4096 + pos - 256;
      ka = *(const uint4*)(KBp + (size_t)krow * 128 + kvh * 64 + lch * 8);
      va = *(const uint4*)(VT + ((size_t)((b * 2 + kvh) * 64 + lkey)) * 4352 + kt * 64 + lch * 8);
    };
    gl(0);
    for (int kt = 0; kt < nkt; ++kt) {
      *(uint4*)(sK + lkey * LDSS + lch * 8) = ka;
      *(uint4*)(sV + lkey * LDSS + lch * 8) = va;
      __syncthreads();
      if (kt + 1 < nkt) gl(kt + 1);
      f32x16 s[2];
#pragma unroll
      for (int g = 0; g < 16; ++g) { s[0][g] = 0.f; s[1][g] = 0.f; }
#pragma unroll
      for (int kb = 0; kb < 2; ++kb)
#pragma unroll
        for (int kk = 0; kk < 4; ++kk) {
          bf16x8 a = *(const bf16x8*)(sK + (kb * 32 + r) * LDSS + kk * 16 + h * 8);
          s[kb] = __builtin_amdgcn_mfma_f32_32x32x16_bf16(a, qf[kk], s[kb], 0, 0, 0);
        }
      float mx = s[0][0];
#pragma unroll
      for (int g = 0; g < 16; ++g) { mx = fmaxf(mx, s[0][g]); mx = fmaxf(mx, s[1][g]); }
      mx = swapmax32(mx);
      float mn = fmaxf(m, mx);
      float alpha = __builtin_amdgcn_exp2f((m - mn) * cs);
      m = mn;
      float mc = mn * cs, ps = 0.f;
#pragma unroll
      for (int kb = 0; kb < 2; ++kb)
#pragma unroll
        for (int g = 0; g < 16; ++g) { float e = __builtin_amdgcn_exp2f(s[kb][g] * cs - mc); s[kb][g] = e; ps += e; }
      l = l * alpha + ps;
#pragma unroll
      for (int g = 0; g < 16; ++g) { o[0][g] *= alpha; o[1][g] *= alpha; }
      bf16x8 pb[2][2];
#pragma unroll
      for (int kb = 0; kb < 2; ++kb)
#pragma unroll
        for (int c = 0; c < 2; ++c) {
          uint4 pk;
          pk.x = pack2(s[kb][8 * c + 0], s[kb][8 * c + 1]); pk.y = pack2(s[kb][8 * c + 2], s[kb][8 * c + 3]);
          pk.z = pack2(s[kb][8 * c + 4], s[kb][8 * c + 5]); pk.w = pack2(s[kb][8 * c + 6], s[kb][8 * c + 7]);
          pb[kb][c] = __builtin_bit_cast(bf16x8, pk);
        }
#pragma unroll
      for (int db = 0; db < 2; ++db)
#pragma unroll
        for (int kb = 0; kb < 2; ++kb)
#pragma unroll
          for (int c = 0; c < 2; ++c) {
            const u16* vp = sV + (db * 32 + r) * LDSS + kb * 32 + 16 * c + 4 * h;
            uint2 lo = *(const uint2*)vp, hi = *(const uint2*)(vp + 8);
            uint4 av = make_uint4(lo.x, lo.y, hi.x, hi.y);
            o[db] = __builtin_amdgcn_mfma_f32_32x32x16_bf16(__builtin_bit_cast(bf16x8, av), pb[kb][c], o[db], 0, 0, 0);
          }
      __syncthreads();
    }
    l = swapsum32(l, l);
    float inv = 1.f / l;
#pragma unroll
    for (int db = 0; db < 2; ++db)
#pragma unroll
      for (int g4 = 0; g4 < 4; ++g4) {
        int d = db * 32 + 8 * g4 + 4 * h;
        uint2 ov;
        ov.x = pack2(o[db][g4 * 4 + 0] * inv, o[db][g4 * 4 + 1] * inv);
        ov.y = pack2(o[db][g4 * 4 + 2] * inv, o[db][g4 * 4 + 3] * inv);
        *(uint2*)(mix + (size_t)qrow * DM + 512 + qh * 64 + d) = ov;
      }
  }
}

__device__ __forceinline__ int fkey(float f) { int b = __float_as_int(f); return b ^ ((b >> 31) & 0x7FFFFFFF); }
__device__ __forceinline__ float keyf(int k) { return __int_as_float(k ^ ((k >> 31) & 0x7FFFFFFF)); }

#define CE_DESC(a, b) { int hi__ = max(a, b); int lo__ = min(a, b); a = hi__; b = lo__; }
#define BITONIC_SORT16(r)                                                          \
  _Pragma("unroll") for (int k_ = 2; k_ <= 16; k_ <<= 1)                           \
    _Pragma("unroll") for (int j_ = k_ >> 1; j_ > 0; j_ >>= 1)                     \
      _Pragma("unroll") for (int i_ = 0; i_ < 16; ++i_) {                          \
        const int l_ = i_ ^ j_;                                                    \
        if (l_ > i_) { if ((i_ & k_) == 0) CE_DESC(r[i_], r[l_]) else CE_DESC(r[l_], r[i_]) } \
      }
#define BITONIC_MERGE16(r)                                                         \
  _Pragma("unroll") for (int j_ = 8; j_ > 0; j_ >>= 1)                             \
    _Pragma("unroll") for (int i_ = 0; i_ < 16; ++i_) {                            \
      const int l_ = i_ ^ j_;                                                      \
      if (l_ > i_) CE_DESC(r[i_], r[l_])                                           \
    }
#define XLANE_MERGE16(r, CTRL)                                                     \
  {                                                                                \
    int o_[16];                                                                    \
    _Pragma("unroll") for (int i_ = 0; i_ < 16; ++i_) o_[i_] = __builtin_amdgcn_update_dpp(0, r[15 - i_], CTRL, 0xF, 0xF, true); \
    _Pragma("unroll") for (int i_ = 0; i_ < 16; ++i_) r[i_] = max(r[i_], o_[i_]);  \
    BITONIC_MERGE16(r)                                                             \
  }
#define SCS 132
__device__ __forceinline__ void phase_peer_topk(const P& p, int layer, const u16* PQ, int ntok, int* IDX, float* GATE, char* lds) {
  float* sc = (float*)lds;
  int* lists = (int*)(lds + 2 * 64 * SCS * 4);
  const int tid = tid_(), lane = tid & 63, wave = tid >> 6;
  const int r = lane & 31, h = lane >> 5;
  const u16* keys = (const u16*)(p.ws + O_KEYS) + (size_t)layer * 8 * 2 * 128 * 128;
  const int ntile = (ntok >> 6) * 8;
  for (int tile = blockIdx.x; tile < ntile; tile += gridDim.x) {
    int hd = tile & 7, row0 = (tile >> 3) * 64;
    {
      int pp = wave >> 2, kb = wave & 3;
      f32x16 acc[2];
#pragma unroll
      for (int g = 0; g < 16; ++g) { acc[0][g] = 0.f; acc[1][g] = 0.f; }
      const u16* kp = keys + ((size_t)(hd * 2 + pp) * 128 + kb * 32 + r) * 128 + h * 8;
      const u16* qp = PQ + (size_t)(row0 + r) * 2048 + hd * 256 + pp * 128 + h * 8;
#pragma unroll
      for (int kk = 0; kk < 8; ++kk) {
        bf16x8 bfr = *(const bf16x8*)(kp + kk * 16);
        bf16x8 a0 = *(const bf16x8*)(qp + kk * 16);
        bf16x8 a1 = *(const bf16x8*)(qp + (size_t)32 * 2048 + kk * 16);
        acc[0] = __builtin_amdgcn_mfma_f32_32x32x16_bf16(a0, bfr, acc[0], 0, 0, 0);
        acc[1] = __builtin_amdgcn_mfma_f32_32x32x16_bf16(a1, bfr, acc[1], 0, 0, 0);
      }
#pragma unroll
      for (int mb = 0; mb < 2; ++mb)
#pragma unroll
        for (int g = 0; g < 16; ++g) {
          int tok = mb * 32 + (g & 3) + 8 * (g >> 2) + 4 * h;
          sc[(pp * 64 + tok) * SCS + kb * 32 + r] = acc[mb][g];
        }
    }
    __syncthreads();
    {
      const int row = tid >> 2, qd = tid & 3;
      const float* rowp = sc + row * SCS + qd;
      int A[16], B[16];
#pragma unroll
      for (int m = 0; m < 16; ++m) {
        A[m] = (fkey(rowp[4 * m]) & ~0x7F) | (127 - (4 * m + qd));
        B[m] = (fkey(rowp[64 + 4 * m]) & ~0x7F) | (127 - (64 + 4 * m + qd));
      }
      BITONIC_SORT16(A)
      BITONIC_SORT16(B)
#pragma unroll
      for (int i = 0; i < 16; ++i) A[i] = max(A[i], B[15 - i]);
      BITONIC_MERGE16(A)
      XLANE_MERGE16(A, 0xB1)
      XLANE_MERGE16(A, 0x4E)
      if (qd == 0) {
#pragma unroll
        for (int i = 0; i < 16; i += 4) *(int4*)(lists + row * 16 + i) = make_int4(A[i], A[i + 1], A[i + 2], A[i + 3]);
      }
    }
    __syncthreads();
    if (tid < 256) {
      const int tok = tid >> 2, q = tid & 3;
      float bq[16];
#pragma unroll
      for (int j = 0; j < 16; ++j) bq[j] = keyf(lists[(64 + tok) * 16 + j] & ~0x7F);
      int R[16];
#pragma unroll
      for (int i = 0; i < 16; ++i) R[i] = (int)0x80000000;
#pragma unroll
      for (int m = 0; m < 4; ++m) {
        const int i = q + 4 * m;
        const float ai = keyf(lists[tok * 16 + i] & ~0x7F);
        const int jmax = 16 / (i + 1);
        const int nj = m == 0 ? 16 : (m == 1 ? 3 : 1);
#pragma unroll
        for (int j = 0; j < nj; ++j) {
          int x = (fkey(ai + bq[j]) & ~0xFF) | (255 - (i * 16 + j));
          x = j < jmax ? x : (int)0x80000000;
#pragma unroll
          for (int t = 0; t < 16; ++t) { int hi_ = max(R[t], x); x = min(R[t], x); R[t] = hi_; }
        }
      }
      XLANE_MERGE16(R, 0xB1)
      XLANE_MERGE16(R, 0x4E)
      float sv[16];
      float mx = keyf(R[0] & ~0xFF), sum = 0.f;
#pragma unroll
      for (int t = 0; t < 16; ++t) { sv[t] = __expf(keyf(R[t] & ~0xFF) - mx); sum += sv[t]; }
      float inv = 1.f / sum;
      size_t ob = (size_t)(row0 + tok) * 128 + hd * 16;
#pragma unroll
      for (int t = 0; t < 16; ++t) {
        if ((t >> 2) == q) {
          int pos = 255 - (R[t] & 0xFF);
          int i1 = 127 - (lists[tok * 16 + (pos >> 4)] & 0x7F);
          int i2 = 127 - (lists[(64 + tok) * 16 + (pos & 15)] & 0x7F);
          IDX[ob + t] = i1 * 128 + i2;
          GATE[ob + t] = sv[t] * inv;
        }
      }
    }
    __syncthreads();
  }
}

typedef __attribute__((ext_vector_type(2))) float f2;
#define TAB_V8 (16 * MiB)
#define TAB_SU (32 * MiB)
#define TAB_SV (32 * MiB + 65536)
__device__ __forceinline__ float wave_max(float v) {
  v = fmaxf(v, dppf<0xB1>(v)); v = fmaxf(v, dppf<0x4E>(v)); v = fmaxf(v, dppf<0x141>(v)); v = fmaxf(v, dppf<0x140>(v));
  v = swapmax16(v); v = swapmax32(v);
  return v;
}
__device__ __forceinline__ void convert_tab_fp8(const float* __restrict__ U, const float* __restrict__ V, char* tab) {
  const int lane = tid_() & 63;
  const int gw = blockIdx.x * 8 + (tid_() >> 6), nw = gridDim.x * 8;
  for (int rr = gw; rr < 32768; rr += nw) {
    const int isv = rr >> 14, e = rr & 16383;
    const float* src = (isv ? V : U) + (size_t)e * 1024 + lane * 16;
    float4 v0 = *(const float4*)src, v1 = *(const float4*)(src + 4), v2 = *(const float4*)(src + 8), v3 = *(const float4*)(src + 12);
    float am = fmaxf(fmaxf(fmaxf(fabsf(v0.x), fabsf(v0.y)), fmaxf(fabsf(v0.z), fabsf(v0.w))),
                     fmaxf(fmaxf(fabsf(v1.x), fabsf(v1.y)), fmaxf(fabsf(v1.z), fabsf(v1.w))));
    am = fmaxf(am, fmaxf(fmaxf(fmaxf(fabsf(v2.x), fabsf(v2.y)), fmaxf(fabsf(v2.z), fabsf(v2.w))),
                         fmaxf(fmaxf(fabsf(v3.x), fabsf(v3.y)), fmaxf(fabsf(v3.z), fabsf(v3.w)))));
    am = wave_max(am);
    float sc = am > 0.f ? 448.f / am : 1.f;
    uint4 o;
    int t = 0;
    t = __builtin_amdgcn_cvt_pk_fp8_f32(v0.x * sc, v0.y * sc, t, false); t = __builtin_amdgcn_cvt_pk_fp8_f32(v0.z * sc, v0.w * sc, t, true); o.x = t;
    t = __builtin_amdgcn_cvt_pk_fp8_f32(v1.x * sc, v1.y * sc, t, false); t = __builtin_amdgcn_cvt_pk_fp8_f32(v1.z * sc, v1.w * sc, t, true); o.y = t;
    t = __builtin_amdgcn_cvt_pk_fp8_f32(v2.x * sc, v2.y * sc, t, false); t = __builtin_amdgcn_cvt_pk_fp8_f32(v2.z * sc, v2.w * sc, t, true); o.z = t;
    t = __builtin_amdgcn_cvt_pk_fp8_f32(v3.x * sc, v3.y * sc, t, false); t = __builtin_amdgcn_cvt_pk_fp8_f32(v3.z * sc, v3.w * sc, t, true); o.w = t;
    if (!isv) {
      *(uint4*)(tab + (size_t)e * 1024 + lane * 16) = o;
      if (lane == 0) ((float*)(tab + TAB_SU))[e] = am > 0.f ? am / 448.f : 1.f;
    } else {
      *(uint4*)(tab + TAB_V8 + ((size_t)(lane >> 3) * 16384 + e) * 128 + (lane & 7) * 16) = o;
      if (lane == 0) ((float*)(tab + TAB_SV))[e] = am > 0.f ? am / 448.f : 1.f;
    }
  }
}
__device__ __forceinline__ f2 dec8(unsigned w, bool hi) { return hi ? __builtin_amdgcn_cvt_pk_f32_fp8((int)w, true) : __builtin_amdgcn_cvt_pk_f32_fp8((int)w, false); }

__device__ __forceinline__ float dot16(uint4 w, f2 a0, f2 a1, f2 a2, f2 a3, f2 a4, f2 a5, f2 a6, f2 a7) {
  f2 a = f2{0.f, 0.f};
  a = __builtin_elementwise_fma(dec8(w.x, false), a0, a); a = __builtin_elementwise_fma(dec8(w.x, true), a1, a);
  a = __builtin_elementwise_fma(dec8(w.y, false), a2, a); a = __builtin_elementwise_fma(dec8(w.y, true), a3, a);
  a = __builtin_elementwise_fma(dec8(w.z, false), a4, a); a = __builtin_elementwise_fma(dec8(w.z, true), a5, a);
  a = __builtin_elementwise_fma(dec8(w.w, false), a6, a); a = __builtin_elementwise_fma(dec8(w.w, true), a7, a);
  return a.x + a.y;
}
#define DOT16(W) dot16(W, xf0, xf1, xf2, xf3, xf4, xf5, xf6, xf7)
__device__ __forceinline__ void phase_peer_act(const P& p, const u16* XN2, const char* tab, const int* IDX, const float* GATE, float* COEF, int ntok, char* lds) {
  const int tid = tid_(), lane = tid & 63, wave = tid >> 6;
  int* le = (int*)(lds + wave * 1536);
  float* lg = (float*)(le + 128);
  int* ls = le + 256;
  const int part = blockIdx.x & 7;
  const int wv = (blockIdx.x >> 3) * 8 + wave, nwv = (gridDim.x >> 3) * 8;
  const float* SU = (const float*)(tab + TAB_SU);
  const float* SV = (const float*)(tab + TAB_SV);
  const int q = lane >> 4;
  const bool hi = (lane & 32) != 0, b4 = (lane & 16) != 0;
  int i0 = 0, i1 = 0; float g0 = 0.f, g1 = 0.f; uint4 x0 = make_uint4(0, 0, 0, 0), x1 = x0;
  if (wv < ntok) {
    i0 = IDX[(size_t)wv * 128 + lane]; i1 = IDX[(size_t)wv * 128 + 64 + lane];
    g0 = GATE[(size_t)wv * 128 + lane]; g1 = GATE[(size_t)wv * 128 + 64 + lane];
    const u16* xr = XN2 + (size_t)wv * DM + lane * 16;
    x0 = *(const uint4*)xr; x1 = *(const uint4*)(xr + 8);
  }
  for (int tok = wv; tok < ntok; tok += nwv) {
    int ni0 = 0, ni1 = 0; float ng0 = 0.f, ng1 = 0.f; uint4 nx0 = make_uint4(0, 0, 0, 0), nx1 = nx0;
    const int nt = tok + nwv;
    if (nt < ntok) {
      ni0 = IDX[(size_t)nt * 128 + lane]; ni1 = IDX[(size_t)nt * 128 + 64 + lane];
      ng0 = GATE[(size_t)nt * 128 + lane]; ng1 = GATE[(size_t)nt * 128 + 64 + lane];
      const u16* xr = XN2 + (size_t)nt * DM + lane * 16;
      nx0 = *(const uint4*)xr; nx1 = *(const uint4*)(xr + 8);
    }
    const bool s0 = (i0 >> 11) == part, s1 = (i1 >> 11) == part;
    const unsigned long long m0 = __ballot(s0), m1 = __ballot(s1);
    const int c0 = __popcll(m0), cnt = c0 + __popcll(m1);
    const int p0 = __builtin_amdgcn_mbcnt_hi((unsigned)(m0 >> 32), __builtin_amdgcn_mbcnt_lo((unsigned)m0, 0));
    const int p1 = c0 + __builtin_amdgcn_mbcnt_hi((unsigned)(m1 >> 32), __builtin_amdgcn_mbcnt_lo((unsigned)m1, 0));
    if (s0) { le[p0] = i0; lg[p0] = g0; ls[p0] = lane; }
    if (s1) { le[p1] = i1; lg[p1] = g1; ls[p1] = 64 + lane; }
    const int cntp = (cnt + 3) & ~3;
    if (lane < cntp - cnt) { le[cnt + lane] = part << 11; lg[cnt + lane] = 0.f; ls[cnt + lane] = -1; }
    const f2 xf0 = f2{bflo(x0.x), bfhi(x0.x)}, xf1 = f2{bflo(x0.y), bfhi(x0.y)}, xf2 = f2{bflo(x0.z), bfhi(x0.z)}, xf3 = f2{bflo(x0.w), bfhi(x0.w)};
    const f2 xf4 = f2{bflo(x1.x), bfhi(x1.x)}, xf5 = f2{bflo(x1.y), bfhi(x1.y)}, xf6 = f2{bflo(x1.z), bfhi(x1.z)}, xf7 = f2{bflo(x1.w), bfhi(x1.w)};
    for (int base = 0; base < cntp; base += 24) {
      uint4 w[24];
      const int evl = le[base + (lane < 24 ? lane : 0)];
#pragma unroll
      for (int gq = 0; gq < 6; ++gq) {
        if (base + 4 * gq < cntp) {
#pragma unroll
          for (int k = 0; k < 4; ++k) {
            int e = __builtin_amdgcn_readlane(evl, 4 * gq + k);
            w[4 * gq + k] = *(const uint4*)(tab + (size_t)e * 1024 + lane * 16);
          }
        } else {
#pragma unroll
          for (int k = 0; k < 4; ++k) w[4 * gq + k] = make_uint4(0, 0, 0, 0);
        }
      }
#pragma unroll
      for (int gq = 0; gq < 6; ++gq) {
        if (base + 4 * gq < cntp) {
          float d0 = DOT16(w[4 * gq]), d1 = DOT16(w[4 * gq + 1]), d2 = DOT16(w[4 * gq + 2]), d3 = DOT16(w[4 * gq + 3]);
          float kA = swapsum32(d0, d2), kB = swapsum32(d1, d3);
          float kC = swapsum16(kA, kB);
          kC = red16(kC);
          const int j = base + 4 * gq + q;
          const int e = le[j]; const float gt = lg[j]; const int slot = ls[j];
          float act = kC * SU[e];
          float coef = gt * 0.5f * act * (1.f + erff(act * 0.70710678118654752f)) * SV[e];
          if ((lane & 15) == 0 && slot >= 0) COEF[(size_t)tok * 128 + slot] = coef;
        }
      }
    }
    i0 = ni0; i1 = ni1; g0 = ng0; g1 = ng1; x0 = nx0; x1 = nx1;
  }
}

__device__ __forceinline__ void phase_peer_sum(const P& p, int layer, const char* tab, const int* IDX, const float* COEF, int ntok, float* dummy_dst) {
  const int tid = tid_(), lane = tid & 63, wave = tid >> 6;
  const int sl = blockIdx.x & 7;
  const int wv = (blockIdx.x >> 3) * 8 + wave, nwv = (gridDim.x >> 3) * 8;
  const int g = lane >> 3, ch = lane & 7;
  const char* V8 = tab + TAB_V8 + (size_t)sl * 16384 * 128 + ch * 16;
  const float* mod = (const float*)(p.ws + O_MOD) + (size_t)layer * 9 * 6144;
  float* HC = (float*)(p.ws + O_HC);
  const bool b5 = (lane & 32) != 0, b4 = (lane & 16) != 0, b3 = (lane & 8) != 0;
  const int c = sl * 128 + ch * 16 + (b5 ? 8 : 0) + (b4 ? 4 : 0) + (b3 ? 2 : 0);
  uint4 ia, ib, ic, id; float4 ca, cb, cc, cd;
  ia = ib = ic = id = make_uint4(0, 0, 0, 0); ca = cb = cc = cd = make_float4(0, 0, 0, 0);
  if (wv < ntok) {
    const int* ip = IDX + (size_t)wv * 128 + g * 16;
    const float* cp = COEF + (size_t)wv * 128 + g * 16;
    ia = *(const uint4*)ip; ib = *(const uint4*)(ip + 4); ic = *(const uint4*)(ip + 8); id = *(const uint4*)(ip + 12);
    ca = *(const float4*)cp; cb = *(const float4*)(cp + 4); cc = *(const float4*)(cp + 8); cd = *(const float4*)(cp + 12);
  }
  for (int tok = wv; tok < ntok; tok += nwv) {
    const unsigned ev[16] = {ia.x, ia.y, ia.z, ia.w, ib.x, ib.y, ib.z, ib.w, ic.x, ic.y, ic.z, ic.w, id.x, id.y, id.z, id.w};
    const float cv[16] = {ca.x, ca.y, ca.z, ca.w, cb.x, cb.y, cb.z, cb.w, cc.x, cc.y, cc.z, cc.w, cd.x, cd.y, cd.z, cd.w};
    uint4 w[16];
#pragma unroll
    for (int i = 0; i < 16; ++i) w[i] = *(const uint4*)(V8 + (size_t)ev[i] * 128);
    float* dst = (dummy_dst ? dummy_dst + (size_t)tok * DM : (tok < NLAT ? p.out + (size_t)tok * DM : HC + (size_t)(tok - NLAT) * DM)) + c;
    float2 o = *(float2*)dst;
    const int nt = tok + nwv;
    if (nt < ntok) {
      const int* ip = IDX + (size_t)nt * 128 + g * 16;
      const float* cp = COEF + (size_t)nt * 128 + g * 16;
      ia = *(const uint4*)ip; ib = *(const uint4*)(ip + 4); ic = *(const uint4*)(ip + 8); id = *(const uint4*)(ip + 12);
      ca = *(const float4*)cp; cb = *(const float4*)(cp + 4); cc = *(const float4*)(cp + 8); cd = *(const float4*)(cp + 12);
    }
    f2 acc[8];
#pragma unroll
    for (int k = 0; k < 8; ++k) acc[k] = f2{0.f, 0.f};
#pragma unroll
    for (int i = 0; i < 16; ++i) {
      f2 c2 = f2{cv[i], cv[i]};
      acc[0] = __builtin_elementwise_fma(dec8(w[i].x, false), c2, acc[0]); acc[1] = __builtin_elementwise_fma(dec8(w[i].x, true), c2, acc[1]);
      acc[2] = __builtin_elementwise_fma(dec8(w[i].y, false), c2, acc[2]); acc[3] = __builtin_elementwise_fma(dec8(w[i].y, true), c2, acc[3]);
      acc[4] = __builtin_elementwise_fma(dec8(w[i].z, false), c2, acc[4]); acc[5] = __builtin_elementwise_fma(dec8(w[i].z, true), c2, acc[5]);
      acc[6] = __builtin_elementwise_fma(dec8(w[i].w, false), c2, acc[6]); acc[7] = __builtin_elementwise_fma(dec8(w[i].w, true), c2, acc[7]);
    }
    float r8[8];
#pragma unroll
    for (int k = 0; k < 4; ++k) {
      r8[2 * k] = swapsum32(acc[k].x, acc[4 + k].x);
      r8[2 * k + 1] = swapsum32(acc[k].y, acc[4 + k].y);
    }
    float r4[4];
#pragma unroll
    for (int k = 0; k < 4; ++k) r4[k] = swapsum16(r8[k], r8[4 + k]);
    float r2[2];
#pragma unroll
    for (int k = 0; k < 2; ++k) {
      float kx = b3 ? r4[2 + k] : r4[k], sx = b3 ? r4[k] : r4[2 + k];
      r2[k] = kx + dppf<0x128>(sx);
    }
    const int mi = tok < NLAT ? (tok >> 12) : 8;
    const float2 mv = *(const float2*)(mod + mi * 6144 + 5 * 1024 + c);
    o.x += mv.x * r2[0]; o.y += mv.y * r2[1];
    *(float2*)dst = o;
  }
}

__device__ __forceinline__ void phase_scan(const P& p, char* lds, bool dummy) {
  float* buf = (float*)lds;
  float* vbuf = (float*)(lds + 81920);
  u16* ybuf = (u16*)(lds + 81920 + 16384);
  const int tid = tid_(), lane = tid & 63, wave = tid >> 6;
  const int c = lane & 7, irow = wave * 8 + (lane >> 3);
  const u16* R = (const u16*)(p.ws + O_R);
  const u16* Kp = (const u16*)(p.ws + O_K);
  const u16* Vp = (const u16*)(p.ws + O_V);
  const int ps = tid >> 4, col4 = (tid & 15) * 4;
  for (int item = blockIdx.x; item < 256; item += gridDim.x) {
    const int dir = item & 1, hh = (item >> 1) & 15, b = item >> 5;
    char* WA = p.ws + (dir ? O_WA1 : O_WA0);
    float* BON = (float*)(p.ws + O_BONUS) + (size_t)dir * NLAT * 16;
    float kkc[4], kac[4], rkc[4];
#pragma unroll
    for (int e = 0; e < 4; ++e) {
      kkc[e] = p.in[20][hh * 64 + col4 + e];
      kac[e] = p.in[21][hh * 64 + col4 + e];
      rkc[e] = p.in[22][hh * 64 + col4 + e];
    }
    auto rowof = [&](int s) -> int {
      if (s < 256) { int pos = dir ? 255 - s : s; return NLAT + b * 256 + pos; }
      int u = s - 256; int pos = dir ? 4095 - u : u; return b * 4096 + pos;
    };
    uint2 pr, pk, pv; unsigned pw, pa; int prow;
    auto gload = [&](int ch) {
      prow = rowof(ch * 32 + ps);
      size_t o = (size_t)prow * 1024 + hh * 64 + col4;
      pr = *(const uint2*)(R + o); pk = *(const uint2*)(Kp + o); pv = *(const uint2*)(Vp + o);
      const char* wp = WA + (size_t)prow * 2048 + hh * 128;
      pw = *(const unsigned*)(wp + col4); pa = *(const unsigned*)(wp + 64 + col4);
    };
    auto prep = [&](int bi) {
      float rr[4] = {bflo(pr.x), bfhi(pr.x), bflo(pr.y), bfhi(pr.y)};
      float kq[4] = {bflo(pk.x), bfhi(pk.x), bflo(pk.y), bfhi(pk.y)};
      float4 vv = make_float4(bflo(pv.x), bfhi(pv.x), bflo(pv.y), bfhi(pv.y));
      float w[4], a[4], kr[4], kk[4], bb[4], kd[4];
      float ss = 0.f;
#pragma unroll
      for (int e = 0; e < 4; ++e) {
        w[e] = 0.5f + (float)((pw >> (8 * e)) & 255u) * (1.f / 510.f);
        a[e] = (float)((pa >> (8 * e)) & 255u) * (1.f / 255.f);
        kr[e] = kq[e] * kkc[e];
        ss += kr[e] * kr[e];
      }
      ss = red16(ss);
      float inv = rsqrtf(ss + 1e-12f);
      float bn = 0.f;
#pragma unroll
      for (int e = 0; e < 4; ++e) {
        kk[e] = kr[e] * inv;
        bb[e] = kk[e] * a[e];
        kd[e] = kq[e] * (1.f + (a[e] - 1.f) * kac[e]);
        bn += rr[e] * kd[e] * rkc[e];
      }
      bn = red16(bn);
      if ((tid & 15) == 0 && prow < NLAT) BON[(size_t)prow * 16 + hh] = bn;
      float* d = buf + bi * 10240 + ((ps * 8 + (col4 >> 3)) * 5) * 8 + (col4 & 7);
      *(float4*)(d) = make_float4(rr[0], rr[1], rr[2], rr[3]);
      *(float4*)(d + 8) = make_float4(w[0], w[1], w[2], w[3]);
      *(float4*)(d + 16) = make_float4(kk[0], kk[1], kk[2], kk[3]);
      *(float4*)(d + 24) = make_float4(bb[0], bb[1], bb[2], bb[3]);
      *(float4*)(d + 32) = make_float4(kd[0], kd[1], kd[2], kd[3]);
      *(float4*)(vbuf + bi * 2048 + ps * 64 + col4) = vv;
    };
    float S[8];
#pragma unroll
    for (int j = 0; j < 8; ++j) S[j] = 0.f;
    gload(0);
    prep(0);
    __syncthreads();
    for (int ch = 0; ch < 136; ++ch) {
      const int cur = ch & 1;
      if (ch + 1 < 136) gload(ch + 1);
      const float* bq = buf + cur * 10240 + c * 40;
      const float* vq = vbuf + cur * 2048 + irow;
      float4 nr0, nr1, nw0, nw1, nk0, nk1, nb0, nb1, nd0, nd1; float nvi;
      {
        const float* q = bq;
        nr0 = *(const float4*)(q); nr1 = *(const float4*)(q + 4); nw0 = *(const float4*)(q + 8); nw1 = *(const float4*)(q + 12);
        nk0 = *(const float4*)(q + 16); nk1 = *(const float4*)(q + 20); nb0 = *(const float4*)(q + 24); nb1 = *(const float4*)(q + 28);
        nd0 = *(const float4*)(q + 32); nd1 = *(const float4*)(q + 36); nvi = vq[0];
      }
#pragma unroll 4
      for (int t = 0; t < 32; ++t) {
        const float4 r0 = nr0, r1 = nr1, w0 = nw0, w1 = nw1, k0 = nk0, k1 = nk1, b0 = nb0, b1 = nb1, d0 = nd0, d1 = nd1;
        const float vi = nvi;
        if (t + 1 < 32) {
          const float* q = bq + (t + 1) * 320;
          nr0 = *(const float4*)(q); nr1 = *(const float4*)(q + 4); nw0 = *(const float4*)(q + 8); nw1 = *(const float4*)(q + 12);
          nk0 = *(const float4*)(q + 16); nk1 = *(const float4*)(q + 20); nb0 = *(const float4*)(q + 24); nb1 = *(const float4*)(q + 28);
          nd0 = *(const float4*)(q + 32); nd1 = *(const float4*)(q + 36); nvi = vq[(t + 1) * 64];
        }
        float sa = (S[0] * k0.x + S[1] * k0.y) + (S[2] * k0.z + S[3] * k0.w) + ((S[4] * k1.x + S[5] * k1.y) + (S[6] * k1.z + S[7] * k1.w));
        sa = red8(sa);
        S[0] = fmaf(S[0], w0.x, fmaf(-sa, b0.x, vi * d0.x));
        S[1] = fmaf(S[1], w0.y, fmaf(-sa, b0.y, vi * d0.y));
        S[2] = fmaf(S[2], w0.z, fmaf(-sa, b0.z, vi * d0.z));
        S[3] = fmaf(S[3], w0.w, fmaf(-sa, b0.w, vi * d0.w));
        S[4] = fmaf(S[4], w1.x, fmaf(-sa, b1.x, vi * d1.x));
        S[5] = fmaf(S[5], w1.y, fmaf(-sa, b1.y, vi * d1.y));
        S[6] = fmaf(S[6], w1.z, fmaf(-sa, b1.z, vi * d1.z));
        S[7] = fmaf(S[7], w1.w, fmaf(-sa, b1.w, vi * d1.w));
        float y = (S[0] * r0.x + S[1] * r0.y) + (S[2] * r0.z + S[3] * r0.w) + ((S[4] * r1.x + S[5] * r1.y) + (S[6] * r1.z + S[7] * r1.w));
        y = red8(y);
        if (c == 0) ybuf[t * 64 + irow] = f2bf(y);
      }
      __syncthreads();
      if (ch >= 8 && !dummy) {
        int row = rowof(ch * 32 + ps);
        uint2 yv = *(const uint2*)(ybuf + ps * 64 + col4);
        *(uint2*)(WA + (size_t)row * 2048 + hh * 128 + col4 * 2) = yv;
      }
      if (ch + 1 < 136) prep(cur ^ 1);
      __syncthreads();
    }
  }
}

__device__ __forceinline__ void phase_readout(const P& p) {
  const u16* Vp = (const u16*)(p.ws + O_V);
  const u16* G = (const u16*)(p.ws + O_G);
  u16* Z = (u16*)(p.ws + O_Z);
  const float* BON = (const float*)(p.ws + O_BONUS);
  const size_t gt = (size_t)blockIdx.x * NT + tid_(), gn = (size_t)gridDim.x * NT;
  for (size_t it = gt; it < (size_t)NLAT * 16 * 8; it += gn) {
    int sub = (int)(it & 7); size_t grp = it >> 3;
    int hh = (int)(grp & 15); int row = (int)(grp >> 4);
    uint4 y0 = *(const uint4*)(p.ws + O_WA0 + (size_t)row * 2048 + hh * 128 + sub * 16);
    uint4 y1 = *(const uint4*)(p.ws + O_WA1 + (size_t)row * 2048 + hh * 128 + sub * 16);
    float y[8] = {bflo(y0.x) + bflo(y1.x), bfhi(y0.x) + bfhi(y1.x), bflo(y0.y) + bflo(y1.y), bfhi(y0.y) + bfhi(y1.y),
                  bflo(y0.z) + bflo(y1.z), bfhi(y0.z) + bfhi(y1.z), bflo(y0.w) + bflo(y1.w), bfhi(y0.w) + bfhi(y1.w)};
    float s = 0.f;
#pragma unroll
    for (int e = 0; e < 8; ++e) s += y[e];
    float mean = red8(s) * (1.f / 64.f);
    float vs = 0.f;
#pragma unroll
    for (int e = 0; e < 8; ++e) { y[e] -= mean; vs += y[e] * y[e]; }
    float var = red8(vs) * (1.f / 64.f);
    float rs = rsqrtf(var + 64e-5f);
    float bonus = BON[(size_t)row * 16 + hh] + BON[(size_t)NLAT * 16 + (size_t)row * 16 + hh];
    int col = hh * 64 + sub * 8;
    uint4 vv = *(const uint4*)(Vp + (size_t)row * DM + col);
    uint4 gg = *(const uint4*)(G + (size_t)row * DM + col);
    float vf[8] = {bflo(vv.x), bfhi(vv.x), bflo(vv.y), bfhi(vv.y), bflo(vv.z), bfhi(vv.z), bflo(vv.w), bfhi(vv.w)};
    float gf[8] = {bflo(gg.x), bfhi(gg.x), bflo(gg.y), bfhi(gg.y), bflo(gg.z), bfhi(gg.z), bflo(gg.w), bfhi(gg.w)};
    float z[8];
#pragma unroll
    for (int e = 0; e < 8; ++e) z[e] = (y[e] * rs * p.in[29][col + e] + p.in[30][col + e] + bonus * vf[e]) * gf[e];
    uint4 ov; ov.x = pack2(z[0], z[1]); ov.y = pack2(z[2], z[3]); ov.z = pack2(z[4], z[5]); ov.w = pack2(z[6], z[7]);
    *(uint4*)(Z + (size_t)row * DM + col) = ov;
  }
}

__device__ __forceinline__ bool xcd_tile(int k, int Tm, int Tn, int& mt, int& nt) {
  const int x = blockIdx.x & 7, j = blockIdx.x >> 3, J = gridDim.x >> 3;
  const int u = j + J * k;
  if (u >= (Tm >> 3) * Tn) return false;
  mt = (u / Tn) * 8 + x; nt = u % Tn;
  return true;
}

__global__ void __launch_bounds__(NT) fwd_kernel(P p) {
  extern __shared__ __attribute__((aligned(16))) char lds[];
  cg::grid_group grid = cg::this_grid();
  char* ws = p.ws;
  const float* mod0 = (const float*)(ws + O_MOD);
  const float* mod1 = mod0 + 9 * 6144;
  for (int ph = p.ph_lo; ph < p.ph_hi; ++ph) {
    if (ph > p.ph_lo) grid.sync();
    if (!((PHASE_MASK >> ph) & 1)) continue;
    const int nrep = ((REPEAT_MASK >> ph) & 1) ? 2 : 1;
    for (int rep = 0; rep < nrep; ++rep) {
    const bool dummy = rep + 1 < nrep;
    if (rep) grid.sync();
    switch (ph) {
      case 0: phase_prep(p, lds); break;
      case 1: phase_norm(p, p.in[0], p.in[2], p.in[6], 0, 0, TTOK, (u16*)(ws + O_XN)); break;
      case 2: {
        u16* hgg = (u16*)(ws + O_HGG); u16* Q = (u16*)(ws + O_Q); u16* KBp = (u16*)(ws + O_KB); u16* VT = (u16*)(ws + O_VT);
        for (int kq = 0, mt = 0, ntw = 0; xcd_tile(kq, 136, 10, mt, ntw); ++kq) {
          if (ntw < 8) {
            const int n0w = ntw * 256;
            u16* dbase; int dld;
            if (n0w < 1536) { dbase = hgg + n0w; dld = 1536; } else { dbase = Q + (n0w - 1536); dld = 512; }
            auto xf = [&](float v, int row, int col) -> float { return v; };
            auto dstf = [&](int row) -> u16* { return dbase + (size_t)row * dld; };
            gemm_tile256<false>((const u16*)(ws + O_XN), 1024, nullptr, (const u16*)(ws + O_WIN) + (size_t)n0w * 1024, 1024, 1024,
                                mt * 256, xf, dstf, (u16*)lds);
            continue;
          }
          int nt = 8 + ntw;
          int n0 = nt * 128;
          auto epi = [&](int row, int col, float v0, float v1, float v2, float v3) {
            int n = n0 + col;
            float v[4] = {v0, v1, v2, v3};
            if (n < 1536) {
#pragma unroll
              for (int j = 0; j < 4; ++j) hgg[(size_t)(row + j) * 1536 + n] = f2bf(v[j]);
            } else if (n < 2048) {
#pragma unroll
              for (int j = 0; j < 4; ++j) Q[(size_t)(row + j) * 512 + n - 1536] = f2bf(v[j]);
            } else if (n < 2176) {
#pragma unroll
              for (int j = 0; j < 4; ++j) KBp[(size_t)(row + j) * 128 + n - 2048] = f2bf(v[j]);
            } else {
              int kvh = (n - 2176) >> 6, d = (n - 2176) & 63;
              int b, pos;
              if (row < NLAT) { b = row >> 12; pos = 256 + (row & 4095); } else { b = (row - NLAT) >> 8; pos = (row - NLAT) & 255; }
              uint2 o; o.x = pack2(v0, v1); o.y = pack2(v2, v3);
              *(uint2*)(VT + ((size_t)((b * 2 + kvh) * 64 + d)) * 4352 + pos) = o;
            }
          };
          if (nt < 17) {
            u16* dbase; int dld;
            if (n0 < 1536) { dbase = hgg + n0; dld = 1536; } else if (n0 < 2048) { dbase = Q + (n0 - 1536); dld = 512; } else { dbase = KBp + (n0 - 2048); dld = 128; }
            auto xf = [&](float v, int row, int col) -> float { return v; };
            auto dstf = [&](int row) -> u16* { return dbase + (size_t)row * dld; };
            gemm_tile<false, 1>((const u16*)(ws + O_XN), 1024, nullptr, (const u16*)(ws + O_WIN) + (size_t)n0 * 1024, 1024, 1024,
                                mt * 256, xf, dstf, (u16*)lds);
          } else {
            gemm_tile<false, 0>((const u16*)(ws + O_XN), 1024, nullptr, (const u16*)(ws + O_WIN) + (size_t)n0 * 1024, 1024, 1024,
                                mt * 256, epi, 0, (u16*)lds);
          }
        }
      } break;
      case 3: phase_conv_qk(p); break;
      case 4: phase_attn(p, lds); break;
      case 5: {
        float* HC = (float*)(ws + O_HC);
        for (int kq = 0, mt = 0, nt = 0; xcd_tile(kq, 136, 8, mt, nt); ++kq) {
          int n0 = nt * 128;
          auto epi = [&](int row, int col, float v0, float v1, float v2, float v3) {
            int n = n0 + col;
            float v[4] = {v0, v1, v2, v3};
#pragma unroll
            for (int j = 0; j < 4; ++j) {
              int rw = row + j;
              if (rw < NLAT) {
                float g = mod0[(rw >> 12) * 6144 + 2048 + n];
                p.out[(size_t)rw * DM + n] = p.in[0][(size_t)rw * DM + n] + g * v[j];
              } else {
                float g = mod0[8 * 6144 + 2048 + n];
                HC[(size_t)(rw - NLAT) * DM + n] = p.in[2][(size_t)(rw - NLAT) * DM + n] + g * v[j];
              }
            }
          };
          gemm_tile<false, 0>((const u16*)(ws + O_XN), 1024, nullptr, (const u16*)(ws + O_WOUT) + (size_t)n0 * 1024, 1024, 1024,
                              mt * 256, epi, 0, (u16*)lds);
        }
      } break;
      case 6: phase_norm(p, p.out, (const float*)(ws + O_HC), p.in[7], 0, 3, TTOK, (u16*)(ws + O_XN)); break;
      case 7: case 18: {
        int layer = ph == 7 ? 0 : 1;
        int mtiles = layer == 0 ? 136 : 128;
        u16* PQ = (u16*)(ws + (layer == 0 ? O_PQ0 : O_PQ1));
        const u16* Wq = (const u16*)(ws + O_WQ) + (size_t)layer * 2048 * 1024;
        for (int kq = 0, mt = 0, nt = 0; xcd_tile(kq, mtiles, 8, mt, nt); ++kq) {
          int n0 = nt * 256;
          auto epi = [&](int row, int col, float v0, float v1, float v2, float v3) {
            int n = n0 + col;
            float v[4] = {v0, v1, v2, v3};
#pragma unroll
            for (int j = 0; j < 4; ++j) PQ[(size_t)(row + j) * 2048 + n] = f2bf(v[j]);
          };
          auto xf = [&](float v, int row, int col) -> float { return v; };
          auto dstf = [&](int row) -> u16* { return PQ + (size_t)row * 2048 + n0; };
          gemm_tile256<false>((const u16*)(ws + O_XN), 1024, nullptr, Wq + (size_t)n0 * 1024, 1024, 1024, mt * 256, xf, dstf, (u16*)lds);
        }
      } break;
      case 8: phase_peer_topk(p, 0, (const u16*)(ws + O_PQ0), TTOK, (int*)(ws + O_IDX0), (float*)(ws + O_GATE0), lds); break;
      case 9: phase_peer_act(p, (const u16*)(ws + O_XN), ws + O_TAB0, (const int*)(ws + O_IDX0), (const float*)(ws + O_GATE0),
                             (float*)(ws + O_COEF0), TTOK, lds); break;
      case 10: phase_peer_sum(p, 0, ws + O_TAB0, (const int*)(ws + O_IDX0), (const float*)(ws + O_COEF0), TTOK, dummy ? (float*)(ws + O_A2R) : nullptr); break;
      case 11: phase_norm(p, p.out, (const float*)(ws + O_HC), p.in[6] + 1024, 1, 0, TTOK, (u16*)(ws + O_XN)); break;
      case 12: {
        u16* LORA = (u16*)(ws + O_LORA);
        for (int kq = 0;; ++kq) {
          const int u = (blockIdx.x >> 3) + (gridDim.x >> 3) * kq;
          if (u >= 17 * 27) break;
          int mt, nt;
          if (u < 408) { int g = u / 136, rem = u % 136; mt = (rem >> 3) * 8 + (blockIdx.x & 7); nt = g * 8 + (rem & 7); }
          else { int v2 = u - 408; mt = (v2 / 3) * 8 + (blockIdx.x & 7); nt = 24 + v2 % 3; }
          const u16* Bp; int mixi; u16* dstp = nullptr; int kind;
          if (nt < 8) { Bp = (const u16*)(ws + O_WR) + (size_t)nt * 128 * 1024; mixi = 0; dstp = (u16*)(ws + O_R) + nt * 128; kind = 0; }
          else if (nt < 16) { Bp = (const u16*)(ws + O_WK) + (size_t)(nt - 8) * 128 * 1024; mixi = 2; dstp = (u16*)(ws + O_K) + (nt - 8) * 128; kind = 0; }
          else if (nt < 24) { Bp = (const u16*)(ws + O_WV) + (size_t)(nt - 16) * 128 * 1024; mixi = 3; dstp = (u16*)(ws + O_V) + (nt - 16) * 128; kind = 0; }
          else if (nt == 24) { Bp = (const u16*)(ws + O_W1); mixi = 1; kind = 1; }
          else if (nt == 25) { Bp = (const u16*)(ws + O_A1); mixi = 4; kind = 2; }
          else { Bp = (const u16*)(ws + O_G1); mixi = 5; kind = 3; }
          auto epi = [&](int row, int col, float v0, float v1, float v2, float v3) {
            float v[4] = {v0, v1, v2, v3};
            if (kind == 0) {
#pragma unroll
              for (int j = 0; j < 4; ++j) dstp[(size_t)(row + j) * 1024 + col] = f2bf(v[j]);
            } else if (kind == 1) {
#pragma unroll
              for (int j = 0; j < 4; ++j) LORA[(size_t)(row + j) * 384 + col] = f2bf(tanhf(v[j]));
            } else if (kind == 2) {
#pragma unroll
              for (int j = 0; j < 4; ++j) LORA[(size_t)(row + j) * 384 + 128 + col] = f2bf(v[j]);
            } else {
#pragma unroll
              for (int j = 0; j < 4; ++j) LORA[(size_t)(row + j) * 384 + 256 + col] = f2bf(sigmoidf_(v[j]));
            }
          };
          auto xf = [&](float v, int row, int col) -> float { return kind == 1 ? tanhf(v) : (kind == 3 ? sigmoidf_(v) : v); };
          u16* dbase = kind == 0 ? dstp : (LORA + (kind - 1) * 128);
          const int dld = kind == 0 ? 1024 : 384;
          auto dstf = [&](int row) -> u16* { return dbase + (size_t)row * dld; };
          gemm_tile<true, 1>((const u16*)(ws + O_XN), 1024, p.in[13] + mixi * 1024, Bp, 1024, 1024, mt * 256, xf, dstf, (u16*)lds);
        }
      } break;
      case 13: {
        const u16* LORA = (const u16*)(ws + O_LORA);
        u16* G = (u16*)(ws + O_G);
        for (int t = blockIdx.x; t < 136 * 40; t += gridDim.x) {
          int mt = t / 40, nt = t % 40;
          int grp = nt >> 3, n0 = (nt & 7) * 128;
          const u16* Ap; const u16* Bp; int K, ldb;
          if (grp < 2) { Ap = LORA + grp * 64; Bp = (const u16*)(ws + O_W2) + (size_t)grp * 65536 + (size_t)n0 * 64; K = 64; ldb = 64; }
          else if (grp < 4) { Ap = LORA + 128 + (grp - 2) * 64; Bp = (const u16*)(ws + O_A2) + (size_t)(grp - 2) * 65536 + (size_t)n0 * 64; K = 64; ldb = 64; }
          else { Ap = LORA + 256; Bp = (const u16*)(ws + O_G2) + (size_t)n0 * 128; K = 128; ldb = 128; }
          int d = grp & 1;
          u8* WA = (u8*)(ws + (d ? O_WA1 : O_WA0));
          auto epi = [&](int row, int col, float v0, float v1, float v2, float v3) {
            int n = n0 + col;
            float v[4] = {v0, v1, v2, v3};
            if (grp < 2) {
              float w0 = p.in[23][d * 1024 + n];
#pragma unroll
              for (int j = 0; j < 4; ++j) {
                float x = w0 + v[j];
                float dec = __expf(-0.6065306597126334f * sigmoidf_(x));
                float q = rintf((dec - 0.5f) * 510.f);
                q = fminf(fmaxf(q, 0.f), 255.f);
                WA[(size_t)(row + j) * 2048 + (n >> 6) * 128 + (n & 63)] = (u8)q;
              }
            } else if (grp < 4) {
              float a0 = p.in[26][d * 1024 + n];
#pragma unroll
              for (int j = 0; j < 4; ++j) {
                float a = sigmoidf_(a0 + v[j]);
                float q = fminf(fmaxf(rintf(a * 255.f), 0.f), 255.f);
                WA[(size_t)(row + j) * 2048 + (n >> 6) * 128 + 64 + (n & 63)] = (u8)q;
              }
            } else {
#pragma unroll
              for (int j = 0; j < 4; ++j) G[(size_t)(row + j) * 1024 + n] = f2bf(v[j]);
            }
          };
          if (grp < 4) {
            const float* b0p = (grp < 2 ? p.in[23] : p.in[26]) + d * 1024 + n0;
            auto q8 = [&](float v, int row, int col) -> unsigned {
              float x = b0p[col] + v;
              float qv;
              if (grp < 2) { float dec = __expf(-0.6065306597126334f * sigmoidf_(x)); qv = rintf((dec - 0.5f) * 510.f); }
              else { qv = rintf(sigmoidf_(x) * 255.f); }
              return (unsigned)fminf(fmaxf(qv, 0.f), 255.f);
            };
            auto dst8 = [&](int row, int c16) -> u8* {
              int n = n0 + c16 * 16;
              return WA + (size_t)row * 2048 + (n >> 6) * 128 + (grp < 2 ? 0 : 64) + (n & 63);
            };
            gemm_tile<false, 2>(Ap, 384, nullptr, Bp, ldb, K, mt * 256, q8, dst8, (u16*)lds);
          } else {
            auto xf = [&](float v, int row, int col) -> float { return v; };
            auto dstf = [&](int row) -> u16* { return G + (size_t)row * 1024 + n0; };
            gemm_tile<false, 1>(Ap, 384, nullptr, Bp, ldb, K, mt * 256, xf, dstf, (u16*)lds);
          }
        }
      } break;
      case 14: phase_scan(p, lds, dummy); break;
      case 15:
        phase_readout(p);
        convert_tab_fp8(p.in[33] + (size_t)16384 * 1024, p.in[34] + (size_t)16384 * 1024, ws + O_TAB1);
        break;
      case 16: {
        for (int kq = 0, mt = 0, nt = 0; xcd_tile(kq, 128, 8, mt, nt); ++kq) {
          int n0 = nt * 128;
          auto epi = [&](int row, int col, float v0, float v1, float v2, float v3) {
            int n = n0 + col;
            float v[4] = {v0, v1, v2, v3};
#pragma unroll
            for (int j = 0; j < 4; ++j) {
              int rw = row + j;
              float g = mod1[(rw >> 12) * 6144 + 2048 + n];
              p.out[(size_t)rw * DM + n] += g * v[j];
            }
          };
          gemm_tile<false, 0>((const u16*)(ws + O_Z), 1024, nullptr, (const u16*)(ws + O_WO) + (size_t)n0 * 1024, 1024, 1024,
                              mt * 256, epi, 0, (u16*)lds);
        }
      } break;
      case 17: phase_norm(p, p.out, nullptr, p.in[7] + 1024, 1, 3, NLAT, (u16*)(ws + O_XN)); break;
      case 19: phase_peer_topk(p, 1, (const u16*)(ws + O_PQ1), NLAT, (int*)(ws + O_IDX1), (float*)(ws + O_GATE1), lds); break;
      case 20: phase_peer_act(p, (const u16*)(ws + O_XN), ws + O_TAB1, (const int*)(ws + O_IDX1), (const float*)(ws + O_GATE1),
                              (float*)(ws + O_COEF1), NLAT, lds); break;
      case 21: phase_peer_sum(p, 1, ws + O_TAB1, (const int*)(ws + O_IDX1), (const float*)(ws + O_COEF1), NLAT, dummy ? (float*)(ws + O_A5R) : nullptr); break;
      default: break;
    }
    }
  }
}

extern "C" void kernel_launch(void* const* d_in, const int* in_sizes, int n_in, void* d_out, int out_size, void* d_ws,
                              size_t ws_size, hipStream_t stream) {
  static int grid = 0;
  if (grid == 0) {
    if (n_in != 35 || ws_size < WS_END) {
      fprintf(stderr, "kernel_launch: unexpected n_in %d or ws_size %zu (need %zu)\n", n_in, ws_size, (size_t)WS_END);
      grid = -1;
      return;
    }
    int dev = 0, cus = 0, per_cu = 0;
    hipGetDevice(&dev);
    hipDeviceGetAttribute(&cus, hipDeviceAttributeMultiprocessorCount, dev);
    hipFuncSetAttribute((const void*)fwd_kernel, hipFuncAttributeMaxDynamicSharedMemorySize, LDS_BYTES);
    hipOccupancyMaxActiveBlocksPerMultiprocessor(&per_cu, (const void*)fwd_kernel, NT, LDS_BYTES);
    (void)hipGetLastError();
    if (per_cu < 1) per_cu = 1;
    grid = (cus / 8) * 8;
    if (grid > cus * per_cu) grid = cus * per_cu;
  }
  if (grid < 0) return;
  P p{};
  for (int i = 0; i < 35; ++i) p.in[i] = (const float*)d_in[i];
  p.out = (float*)d_out;
  p.ws = (char*)d_ws;
#if N_LAUNCH_MODE == 0
  p.ph_lo = 0; p.ph_hi = NPHASE;
  void* args[] = {&p};
  hipError_t e = hipLaunchCooperativeKernel((const void*)fwd_kernel, dim3(grid), dim3(NT), args, LDS_BYTES, stream);
  if (e != hipSuccess) fprintf(stderr, "cooperative launch failed: %s (grid %d)\n", hipGetErrorString(e), grid);
#else
  for (int ph = 0; ph < NPHASE; ++ph) {
    p.ph_lo = ph; p.ph_hi = ph + 1;
    hipLaunchKernelGGL(fwd_kernel, dim3(grid), dim3(NT), LDS_BYTES, stream, p);
  }
#endif
}
```

```cpp
#include <hip/hip_runtime.h>
#include <hip/hip_cooperative_groups.h>
#include <cstdio>
namespace cg = cooperative_groups;

#ifndef N_LAUNCH_MODE
#define N_LAUNCH_MODE 0
#endif

typedef unsigned short u16;
typedef unsigned char u8;
typedef __attribute__((ext_vector_type(8))) short bf16x8;
typedef __attribute__((ext_vector_type(16))) float f32x16;

#define NT 512
#define TTOK 34816
#define NLAT 32768
#define DM 1024
#define LDSS 72
#define LDS_BYTES 149504
#define NPHASE 22
#ifndef REPEAT_MASK
#define REPEAT_MASK 0
#endif
#ifndef PHASE_MASK
#define PHASE_MASK 0x3FFFFF
#endif

static constexpr size_t MiB = 1048576;
static constexpr size_t O_WIN = 0;
static constexpr size_t O_WOUT = O_WIN + 4718592;
static constexpr size_t O_WR = O_WOUT + 2097152;
static constexpr size_t O_WK = O_WR + 2097152;
static constexpr size_t O_WV = O_WK + 2097152;
static constexpr size_t O_WO = O_WV + 2097152;
static constexpr size_t O_G1 = O_WO + 2097152;
static constexpr size_t O_G2 = O_G1 + 262144;
static constexpr size_t O_W1 = O_G2 + 262144;
static constexpr size_t O_A1 = O_W1 + 262144;
static constexpr size_t O_W2 = O_A1 + 262144;
static constexpr size_t O_A2 = O_W2 + 262144;
static constexpr size_t O_WQ = O_A2 + 262144;
static constexpr size_t O_KEYS = O_WQ + 8388608;
static constexpr size_t O_MOD = O_KEYS + 1048576;
static constexpr size_t O_ROPE = O_MOD + 442368;
static constexpr size_t SZ = 68 * MiB;
static constexpr size_t O_A1R = 26 * MiB;
static constexpr size_t O_A2R = O_A1R + SZ;
static constexpr size_t O_A3R = O_A2R + SZ;
static constexpr size_t O_A4R = O_A3R + SZ;
static constexpr size_t O_A5R = O_A4R + SZ;
static constexpr size_t O_A6R = O_A5R + SZ;
static constexpr size_t O_A7R = O_A6R + SZ;
static constexpr size_t O_LORA = O_A7R;
static constexpr size_t O_BONUS = O_A7R + 26 * MiB;
static constexpr size_t O_BAR = O_BONUS + 4 * MiB;
static constexpr size_t WS_END = O_BAR + 1 * MiB;
static constexpr size_t O_XN = O_A1R;
static constexpr size_t O_HGG = O_A2R;
static constexpr size_t O_Q = O_A2R + 102 * MiB;
static constexpr size_t O_KB = O_A4R;
static constexpr size_t O_VT = O_A4R + 9 * MiB;
static constexpr size_t O_PQ0 = O_A2R;
static constexpr size_t O_TAB0 = O_A5R;
static constexpr size_t O_IDX0 = O_A6R;
static constexpr size_t O_GATE0 = O_A6R + 17 * MiB;
static constexpr size_t O_HC = O_A6R + 34 * MiB;
static constexpr size_t O_COEF0 = O_A6R + 42 * MiB;
static constexpr size_t O_R = O_A2R, O_K = O_A3R, O_V = O_A4R;
static constexpr size_t O_WA0 = O_A5R, O_WA1 = O_A6R;
static constexpr size_t O_G = O_A1R;
static constexpr size_t O_Z = O_A2R;
static constexpr size_t O_TAB1 = O_A3R;
static constexpr size_t O_PQ1 = O_A5R;
static constexpr size_t O_IDX1 = O_A4R;
static constexpr size_t O_GATE1 = O_A4R + 17 * MiB;
static constexpr size_t O_COEF1 = O_A4R + 34 * MiB;

struct P {
  const float* in[35];
  float* out;
  char* ws;
  int ph_lo, ph_hi;
};

typedef __bf16 bf16x2_t __attribute__((ext_vector_type(2)));
typedef float f32x2_t __attribute__((ext_vector_type(2)));
__device__ __forceinline__ u16 f2bf(float f) {
  __bf16 b = (__bf16)f;
  return __builtin_bit_cast(u16, b);
}
__device__ __forceinline__ float bf2f(u16 h) { return __uint_as_float(((unsigned)h) << 16); }
__device__ __forceinline__ float bflo(unsigned w) { return __uint_as_float(w << 16); }
__device__ __forceinline__ float bfhi(unsigned w) { return __uint_as_float(w & 0xFFFF0000u); }
__device__ __forceinline__ unsigned pack2(float a, float b) { f32x2_t v = {a, b}; bf16x2_t r = __builtin_convertvector(v, bf16x2_t); return __builtin_bit_cast(unsigned, r); }

__device__ __forceinline__ int tid_() { int t = __builtin_amdgcn_workitem_id_x(); asm volatile("" : "+v"(t)); return t; }
template <int CTRL>
__device__ __forceinline__ float dppf(float v) {
  return __builtin_bit_cast(float, __builtin_amdgcn_update_dpp(0, __builtin_bit_cast(int, v), CTRL, 0xF, 0xF, true));
}
__device__ __forceinline__ float red8(float v) {
  v += dppf<0xB1>(v); v += dppf<0x4E>(v); v += dppf<0x141>(v); return v;
}
__device__ __forceinline__ float red16(float v) { v = red8(v); v += dppf<0x140>(v); return v; }
__device__ __forceinline__ float swapsum32(float a, float b) {
  auto r = __builtin_amdgcn_permlane32_swap(__float_as_uint(a), __float_as_uint(b), false, false);
  return __uint_as_float(r[0]) + __uint_as_float(r[1]);
}
__device__ __forceinline__ float swapsum16(float a, float b) {
  auto r = __builtin_amdgcn_permlane16_swap(__float_as_uint(a), __float_as_uint(b), false, false);
  return __uint_as_float(r[0]) + __uint_as_float(r[1]);
}
__device__ __forceinline__ float swapmax32(float a) {
  auto r = __builtin_amdgcn_permlane32_swap(__float_as_uint(a), __float_as_uint(a), false, false);
  return fmaxf(__uint_as_float(r[0]), __uint_as_float(r[1]));
}
__device__ __forceinline__ float swapmax16(float a) {
  auto r = __builtin_amdgcn_permlane16_swap(__float_as_uint(a), __float_as_uint(a), false, false);
  return fmaxf(__uint_as_float(r[0]), __uint_as_float(r[1]));
}
__device__ __forceinline__ float wave_sum(float v) {
  v = red16(v);
  v = swapsum16(v, v); v = swapsum32(v, v);
  return v;
}
__device__ __forceinline__ float sigmoidf_(float x) { return 1.f / (1.f + __expf(-x)); }

template <bool MIX, int OM, class Epi, class Dst>
__device__ __forceinline__ void gemm_tile(const u16* __restrict__ A, int lda, const float* __restrict__ mu,
                                          const u16* __restrict__ B, int ldb, int K, int row0, Epi epi, Dst dstf, u16* lds) {
  u16* sA = lds;
  u16* sB = lds + 256 * LDSS;
  const int tid = tid_(), lane = tid & 63, wave = tid >> 6;
  const int wm = wave & 3, wn = wave >> 2;
  const int r = lane & 31, h = lane >> 5;
  const int kc = tid & 7, lr = tid >> 3;
  f32x16 acc[2][2];
#pragma unroll
  for (int i = 0; i < 2; ++i)
#pragma unroll
    for (int j = 0; j < 2; ++j)
#pragma unroll
      for (int g = 0; g < 16; ++g) acc[i][j][g] = 0.f;
  uint4 pa0, pa1, pa2, pa3, ps0, ps1, ps2, ps3, pb0, pb1;
  ps0 = ps1 = ps2 = ps3 = make_uint4(0, 0, 0, 0);
  float4 m0 = make_float4(0, 0, 0, 0), m1 = m0;
  auto nbr = [&](int row, int kg) -> int {
    if (row < NLAT) {
      int t = row & 4095; int gc = t & 63, gr = t >> 6; int qd = kg >> 8;
      if (qd == 0) return gc > 0 ? row - 1 : -1;
      if (qd == 1) return gc < 63 ? row + 1 : -1;
      if (qd == 2) return gr > 0 ? row - 64 : -1;
      return gr < 63 ? row + 64 : -1;
    } else {
      int t = (row - NLAT) & 255;
      if (kg < 512) return t > 0 ? row - 1 : -1;
      return t < 255 ? row + 1 : -1;
    }
  };
  auto ldA = [&](int i, int k0, uint4& a, uint4& sx) {
    int row = row0 + lr + 64 * i;
    a = *(const uint4*)(A + (size_t)row * lda + k0 + kc * 8);
    if (MIX) {
      int nr = nbr(row, k0 + kc * 8);
      if (nr >= 0) sx = *(const uint4*)(A + (size_t)nr * lda + k0 + kc * 8);
      else sx = make_uint4(0, 0, 0, 0);
    }
  };
  auto gload = [&](int k0) {
    ldA(0, k0, pa0, ps0); ldA(1, k0, pa1, ps1); ldA(2, k0, pa2, ps2); ldA(3, k0, pa3, ps3);
    if (MIX) {
      m0 = *(const float4*)(mu + k0 + kc * 8);
      m1 = *(const float4*)(mu + k0 + kc * 8 + 4);
    }
    pb0 = *(const uint4*)(B + (size_t)lr * ldb + k0 + kc * 8);
    pb1 = *(const uint4*)(B + (size_t)(lr + 64) * ldb + k0 + kc * 8);
  };
  auto mixw = [&](unsigned x, unsigned s, float ma, float mb) -> unsigned {
    float x0 = bflo(x), x1 = bfhi(x), s0 = bflo(s), s1 = bfhi(s);
    return pack2(x0 + (s0 - x0) * ma, x1 + (s1 - x1) * mb);
  };
  int bo = 0;
  auto stA = [&](int i, uint4 a, uint4 sx) {
    uint4 v = a;
    if (MIX) {
      v.x = mixw(a.x, sx.x, m0.x, m0.y);
      v.y = mixw(a.y, sx.y, m0.z, m0.w);
      v.z = mixw(a.z, sx.z, m1.x, m1.y);
      v.w = mixw(a.w, sx.w, m1.z, m1.w);
    }
    *(uint4*)(sA + bo + (lr + 64 * i) * LDSS + kc * 8) = v;
  };
  auto lstore = [&]() {
    stA(0, pa0, ps0); stA(1, pa1, ps1); stA(2, pa2, ps2); stA(3, pa3, ps3);
    *(uint4*)(sB + bo + lr * LDSS + kc * 8) = pb0;
    *(uint4*)(sB + bo + (lr + 64) * LDSS + kc * 8) = pb1;
  };
  constexpr int BUFE = (256 + 128) * LDSS;
  gload(0);
  bo = 0; lstore();
  if (64 < K) gload(64);
  __syncthreads();
  for (int k0 = 0; k0 < K; k0 += 64) {
    const int co = ((k0 >> 6) & 1) * BUFE;
    bf16x8 af[2], bfr[2], naf[2], nbf[2];
#pragma unroll
    for (int i = 0; i < 2; ++i) af[i] = *(const bf16x8*)(sA + co + (wm * 64 + i * 32 + r) * LDSS + h * 8);
#pragma unroll
    for (int j = 0; j < 2; ++j) bfr[j] = *(const bf16x8*)(sB + co + (wn * 64 + j * 32 + r) * LDSS + h * 8);
#pragma unroll
    for (int kk = 0; kk < 4; ++kk) {
      if (kk == 2 && k0 + 64 < K) {
        bo = BUFE - co; lstore();
        if (k0 + 128 < K) gload(k0 + 128);
      }
      if (kk < 3) {
#pragma unroll
        for (int i = 0; i < 2; ++i) naf[i] = *(const bf16x8*)(sA + co + (wm * 64 + i * 32 + r) * LDSS + (kk + 1) * 16 + h * 8);
#pragma unroll
        for (int j = 0; j < 2; ++j) nbf[j] = *(const bf16x8*)(sB + co + (wn * 64 + j * 32 + r) * LDSS + (kk + 1) * 16 + h * 8);
      }
#pragma unroll
      for (int i = 0; i < 2; ++i)
#pragma unroll
        for (int j = 0; j < 2; ++j) {
          if (OM == 0) acc[i][j] = __builtin_amdgcn_mfma_f32_32x32x16_bf16(af[i], bfr[j], acc[i][j], 0, 0, 0);
          else acc[i][j] = __builtin_amdgcn_mfma_f32_32x32x16_bf16(bfr[j], af[i], acc[i][j], 0, 0, 0);
        }
      if (kk < 3) {
#pragma unroll
        for (int i = 0; i < 2; ++i) af[i] = naf[i];
#pragma unroll
        for (int j = 0; j < 2; ++j) bfr[j] = nbf[j];
      }
    }
    __syncthreads();
  }
  if constexpr (OM == 0) {
#pragma unroll
    for (int i = 0; i < 2; ++i)
#pragma unroll
      for (int j = 0; j < 2; ++j)
#pragma unroll
        for (int g4 = 0; g4 < 4; ++g4) {
          int row = row0 + wm * 64 + i * 32 + 8 * g4 + 4 * h;
          int col = wn * 64 + j * 32 + r;
          epi(row, col, acc[i][j][g4 * 4 + 0], acc[i][j][g4 * 4 + 1], acc[i][j][g4 * 4 + 2], acc[i][j][g4 * 4 + 3]);
        }
  } else if constexpr (OM == 1) {
    u16* st = lds;
#pragma unroll
    for (int i = 0; i < 2; ++i)
#pragma unroll
      for (int j = 0; j < 2; ++j)
#pragma unroll
        for (int g4 = 0; g4 < 4; ++g4) {
          const int rl = wm * 64 + i * 32 + r, c0 = wn * 64 + j * 32 + 8 * g4 + 4 * h;
          uint2 o;
          o.x = pack2(epi(acc[i][j][g4 * 4 + 0], row0 + rl, c0 + 0), epi(acc[i][j][g4 * 4 + 1], row0 + rl, c0 + 1));
          o.y = pack2(epi(acc[i][j][g4 * 4 + 2], row0 + rl, c0 + 2), epi(acc[i][j][g4 * 4 + 3], row0 + rl, c0 + 3));
          *(uint2*)(st + rl * 136 + c0) = o;
        }
    __syncthreads();
#pragma unroll
    for (int q = 0; q < 8; ++q) {
      const int id = tid + NT * q, rl = id >> 4, c8 = id & 15;
      const uint4 v = *(const uint4*)(st + rl * 136 + c8 * 8);
      *(uint4*)(dstf(row0 + rl) + c8 * 8) = v;
    }
    __syncthreads();
  } else {
    u8* st = (u8*)lds;
#pragma unroll
    for (int i = 0; i < 2; ++i)
#pragma unroll
      for (int j = 0; j < 2; ++j)
#pragma unroll
        for (int g4 = 0; g4 < 4; ++g4) {
          const int rl = wm * 64 + i * 32 + r, c0 = wn * 64 + j * 32 + 8 * g4 + 4 * h;
          unsigned o = epi(acc[i][j][g4 * 4 + 0], row0 + rl, c0 + 0) | (epi(acc[i][j][g4 * 4 + 1], row0 + rl, c0 + 1) << 8) |
                       (epi(acc[i][j][g4 * 4 + 2], row0 + rl, c0 + 2) << 16) | (epi(acc[i][j][g4 * 4 + 3], row0 + rl, c0 + 3) << 24);
          *(unsigned*)(st + rl * 144 + c0) = o;
        }
    __syncthreads();
#pragma unroll
    for (int q = 0; q < 4; ++q) {
      const int id = tid + NT * q, rl = id >> 3, c16 = id & 7;
      const uint4 v = *(const uint4*)(st + rl * 144 + c16 * 16);
      *(uint4*)(dstf(row0 + rl, c16)) = v;
    }
    __syncthreads();
  }
}

template <bool MIX, class Epi, class Dst>
__device__ __forceinline__ void gemm_tile256(const u16* __restrict__ A, int lda, const float* __restrict__ mu,
                                             const u16* __restrict__ B, int ldb, int K, int row0, Epi epi, Dst dstf, u16* lds) {
  u16* sA = lds;
  u16* sB = lds + 256 * LDSS;
  const int tid = tid_(), lane = tid & 63, wave = tid >> 6;
  const int wm = wave & 1, wn = wave >> 1;
  const int r = lane & 31, h = lane >> 5;
  const int kc = tid & 7, lr = tid >> 3;
  f32x16 acc[4][2];
#pragma unroll
  for (int i = 0; i < 4; ++i)
#pragma unroll
    for (int j = 0; j < 2; ++j)
#pragma unroll
      for (int g = 0; g < 16; ++g) acc[i][j][g] = 0.f;
  uint4 pa0, pa1, pa2, pa3, ps0, ps1, ps2, ps3, pb0, pb1, pb2, pb3;
  ps0 = ps1 = ps2 = ps3 = make_uint4(0, 0, 0, 0);
  float4 m0 = make_float4(0, 0, 0, 0), m1 = m0;
  auto nbr = [&](int row, int kg) -> int {
    if (row < NLAT) {
      int t = row & 4095; int gc = t & 63, gr = t >> 6; int qd = kg >> 8;
      if (qd == 0) return gc > 0 ? row - 1 : -1;
      if (qd == 1) return gc < 63 ? row + 1 : -1;
      if (qd == 2) return gr > 0 ? row - 64 : -1;
      return gr < 63 ? row + 64 : -1;
    } else {
      int t = (row - NLAT) & 255;
      if (kg < 512) return t > 0 ? row - 1 : -1;
      return t < 255 ? row + 1 : -1;
    }
  };
  auto ldA = [&](int i, int k0, uint4& a, uint4& sx) {
    int row = row0 + lr + 64 * i;
    a = *(const uint4*)(A + (size_t)row * lda + k0 + kc * 8);
    if (MIX) {
      int nr = nbr(row, k0 + kc * 8);
      if (nr >= 0) sx = *(const uint4*)(A + (size_t)nr * lda + k0 + kc * 8);
      else sx = make_uint4(0, 0, 0, 0);
    }
  };
  auto gload = [&](int k0) {
    ldA(0, k0, pa0, ps0); ldA(1, k0, pa1, ps1); ldA(2, k0, pa2, ps2); ldA(3, k0, pa3, ps3);
    if (MIX) {
      m0 = *(const float4*)(mu + k0 + kc * 8);
      m1 = *(const float4*)(mu + k0 + kc * 8 + 4);
    }
    pb0 = *(const uint4*)(B + (size_t)lr * ldb + k0 + kc * 8);
    pb1 = *(const uint4*)(B + (size_t)(lr + 64) * ldb + k0 + kc * 8);
    pb2 = *(const uint4*)(B + (size_t)(lr + 128) * ldb + k0 + kc * 8);
    pb3 = *(const uint4*)(B + (size_t)(lr + 192) * ldb + k0 + kc * 8);
  };
  auto mixw = [&](unsigned x, unsigned s_, float ma, float mb) -> unsigned {
    float x0 = bflo(x), x1 = bfhi(x), s0 = bflo(s_), s1 = bfhi(s_);
    return pack2(x0 + (s0 - x0) * ma, x1 + (s1 - x1) * mb);
  };
  int bo = 0;
  auto stA = [&](int i, uint4 a, uint4 sx) {
    uint4 v = a;
    if (MIX) {
      v.x = mixw(a.x, sx.x, m0.x, m0.y);
      v.y = mixw(a.y, sx.y, m0.z, m0.w);
      v.z = mixw(a.z, sx.z, m1.x, m1.y);
      v.w = mixw(a.w, sx.w, m1.z, m1.w);
    }
    *(uint4*)(sA + bo + (lr + 64 * i) * LDSS + kc * 8) = v;
  };
  auto lstore = [&]() {
    stA(0, pa0, ps0); stA(1, pa1, ps1); stA(2, pa2, ps2); stA(3, pa3, ps3);
    *(uint4*)(sB + bo + lr * LDSS + kc * 8) = pb0;
    *(uint4*)(sB + bo + (lr + 64) * LDSS + kc * 8) = pb1;
    *(uint4*)(sB + bo + (lr + 128) * LDSS + kc * 8) = pb2;
    *(uint4*)(sB + bo + (lr + 192) * LDSS + kc * 8) = pb3;
  };
  constexpr int BUFE = 2 * 256 * LDSS;
  gload(0);
  bo = 0; lstore();
  if (64 < K) gload(64);
  __syncthreads();
  for (int k0 = 0; k0 < K; k0 += 64) {
    const int co = ((k0 >> 6) & 1) * BUFE;
    bf16x8 af[4], bfr[2], naf[4], nbf[2];
#pragma unroll
    for (int i = 0; i < 4; ++i) af[i] = *(const bf16x8*)(sA + co + (wm * 128 + i * 32 + r) * LDSS + h * 8);
#pragma unroll
    for (int j = 0; j < 2; ++j) bfr[j] = *(const bf16x8*)(sB + co + (wn * 64 + j * 32 + r) * LDSS + h * 8);
#pragma unroll
    for (int kk = 0; kk < 4; ++kk) {
      if (kk == 2 && k0 + 64 < K) {
        bo = BUFE - co; lstore();
        if (k0 + 128 < K) gload(k0 + 128);
      }
      if (kk < 3) {
#pragma unroll
        for (int i = 0; i < 4; ++i) naf[i] = *(const bf16x8*)(sA + co + (wm * 128 + i * 32 + r) * LDSS + (kk + 1) * 16 + h * 8);
#pragma unroll
        for (int j = 0; j < 2; ++j) nbf[j] = *(const bf16x8*)(sB + co + (wn * 64 + j * 32 + r) * LDSS + (kk + 1) * 16 + h * 8);
      }
#pragma unroll
      for (int i = 0; i < 4; ++i)
#pragma unroll
        for (int j = 0; j < 2; ++j) acc[i][j] = __builtin_amdgcn_mfma_f32_32x32x16_bf16(bfr[j], af[i], acc[i][j], 0, 0, 0);
      if (kk < 3) {
#pragma unroll
        for (int i = 0; i < 4; ++i) af[i] = naf[i];
#pragma unroll
        for (int j = 0; j < 2; ++j) bfr[j] = nbf[j];
      }
    }
    __syncthreads();
  }
  u16* st = lds;
#pragma unroll
  for (int half = 0; half < 2; ++half) {
    if ((wn >> 1) == half) {
#pragma unroll
      for (int i = 0; i < 4; ++i)
#pragma unroll
        for (int j = 0; j < 2; ++j)
#pragma unroll
          for (int g4 = 0; g4 < 4; ++g4) {
            const int rl = wm * 128 + i * 32 + r, cl = (wn & 1) * 64 + j * 32 + 8 * g4 + 4 * h, c0 = half * 128 + cl;
            uint2 o;
            o.x = pack2(epi(acc[i][j][g4 * 4 + 0], row0 + rl, c0 + 0), epi(acc[i][j][g4 * 4 + 1], row0 + rl, c0 + 1));
            o.y = pack2(epi(acc[i][j][g4 * 4 + 2], row0 + rl, c0 + 2), epi(acc[i][j][g4 * 4 + 3], row0 + rl, c0 + 3));
            *(uint2*)(st + rl * 136 + cl) = o;
          }
    }
    __syncthreads();
#pragma unroll
    for (int q = 0; q < 8; ++q) {
      const int id = tid + NT * q, rl = id >> 4, c8 = id & 15;
      const uint4 v = *(const uint4*)(st + rl * 136 + c8 * 8);
      *(uint4*)(dstf(row0 + rl) + half * 128 + c8 * 8) = v;
    }
    __syncthreads();
  }
}

__constant__ int TJOBS[18][5] = {
    {8, 0, 1024, 2304, (int)O_WIN},
    {12, 0, 1024, 1024, (int)O_WOUT},
    {14, 0, 1024, 1024, (int)O_WR},
    {15, 0, 1024, 1024, (int)O_WK},
    {16, 0, 1024, 1024, (int)O_WV},
    {17, 0, 1024, 1024, (int)O_WO},
    {18, 0, 1024, 128, (int)O_G1},
    {19, 0, 128, 1024, (int)O_G2},
    {24, 0, 1024, 64, (int)O_W1},
    {24, 65536, 1024, 64, (int)(O_W1 + 131072)},
    {27, 0, 1024, 64, (int)O_A1},
    {27, 65536, 1024, 64, (int)(O_A1 + 131072)},
    {25, 0, 64, 1024, (int)O_W2},
    {25, 65536, 64, 1024, (int)(O_W2 + 131072)},
    {28, 0, 64, 1024, (int)O_A2},
    {28, 65536, 64, 1024, (int)(O_A2 + 131072)},
    {31, 0, 1024, 2048, (int)O_WQ},
    {31, 2097152, 1024, 2048, (int)(O_WQ + 4194304)},
};

__device__ __forceinline__ void convert_bf16(const float* __restrict__ src, u16* __restrict__ dst, size_t n) {
  size_t n4 = n >> 2;
  for (size_t i = (size_t)blockIdx.x * NT + tid_(); i < n4; i += (size_t)gridDim.x * NT) {
    float4 v = ((const float4*)src)[i];
    uint2 o; o.x = pack2(v.x, v.y); o.y = pack2(v.z, v.w);
    ((uint2*)dst)[i] = o;
  }
}

__device__ __forceinline__ void convert_tab_fp8(const float* __restrict__ U, const float* __restrict__ V, char* tab);
__device__ __forceinline__ void phase_prep(const P& p, char* lds) {
  const int tid = tid_();
  float* fl = (float*)lds;
  for (int task = blockIdx.x; task < 192; task += gridDim.x) {
    int l = task / 96, cg_ = task % 96;
    float* sv = fl;
    float* red = fl + 9216;
    for (int i = tid; i < 9216; i += NT) {
      int v = i >> 10, k = i & 1023;
      float x = v < 8 ? p.in[1][v * 1024 + k] : p.in[3][k];
      sv[i] = x / (1.f + __expf(-x));
    }
    __syncthreads();
    int col = cg_ * 64 + (tid & 63), kg = tid >> 6;
    float acc[9];
#pragma unroll
    for (int v = 0; v < 9; ++v) acc[v] = 0.f;
    const float* W = p.in[4] + (size_t)l * 1024 * 6144 + col;
    for (int k = kg * 128; k < kg * 128 + 128; ++k) {
      float w = W[(size_t)k * 6144];
#pragma unroll
      for (int v = 0; v < 9; ++v) acc[v] += sv[v * 1024 + k] * w;
    }
#pragma unroll
    for (int v = 0; v < 9; ++v) red[(kg * 9 + v) * 64 + (tid & 63)] = acc[v];
    __syncthreads();
    if (tid < 576) {
      int v = tid >> 6, c = tid & 63;
      float s = p.in[5][l * 6144 + cg_ * 64 + c];
#pragma unroll
      for (int g = 0; g < 8; ++g) s += red[(g * 9 + v) * 64 + c];
      ((float*)(p.ws + O_MOD))[(l * 9 + v) * 6144 + cg_ * 64 + c] = s;
    }
    __syncthreads();
  }
  {
    int base = 0;
    for (int j = 0; j < 18; ++j) {
      int K = TJOBS[j][2], N = TJOBS[j][3];
      int tk = K >> 6, tn = N >> 6, nt = tk * tn;
      const float* src = p.in[TJOBS[j][0]] + TJOBS[j][1];
      u16* dst = (u16*)(p.ws + (size_t)(unsigned)TJOBS[j][4]);
      int first = (blockIdx.x + gridDim.x - (base % gridDim.x)) % gridDim.x;
      for (int t = first; t < nt; t += gridDim.x) {
        int k0 = (t / tn) * 64, n0 = (t % tn) * 64;
#pragma unroll
        for (int rep = 0; rep < 8; ++rep) {
          int idx = tid + NT * rep; int i = idx >> 6, jj = idx & 63;
          fl[i * 65 + jj] = src[(size_t)(k0 + i) * N + n0 + jj];
        }
        __syncthreads();
        int n = tid >> 3, c8 = tid & 7;
        uint4 o;
        o.x = pack2(fl[(c8 * 8 + 0) * 65 + n], fl[(c8 * 8 + 1) * 65 + n]);
        o.y = pack2(fl[(c8 * 8 + 2) * 65 + n], fl[(c8 * 8 + 3) * 65 + n]);
        o.z = pack2(fl[(c8 * 8 + 4) * 65 + n], fl[(c8 * 8 + 5) * 65 + n]);
        o.w = pack2(fl[(c8 * 8 + 6) * 65 + n], fl[(c8 * 8 + 7) * 65 + n]);
        *(uint4*)(dst + (size_t)(n0 + n) * K + k0 + c8 * 8) = o;
        __syncthreads();
      }
      base += nt;
    }
  }
  convert_bf16(p.in[32], (u16*)(p.ws + O_KEYS), (size_t)2 * 8 * 2 * 128 * 128);
  convert_tab_fp8(p.in[33], p.in[34], p.ws + O_TAB0);
  if (blockIdx.x == 0) {
    float* rope = (float*)(p.ws + O_ROPE);
    for (int i = tid; i < 1024; i += NT) {
      int pos = i >> 4, f = i & 15;
      float inv = exp2f(-(float)f * (13.287712379549449f / 16.f));
      float ang = (float)pos * inv;
      rope[i * 2] = cosf(ang);
      rope[i * 2 + 1] = sinf(ang);
    }
  }
}

__device__ __forceinline__ void phase_norm(const P& p, const float* srcL, const float* srcC, const float* gain, int layer, int shift_idx,
                           int nrows, u16* dst) {
  const int lane = tid_() & 63;
  const int gw = blockIdx.x * 8 + (tid_() >> 6), nw = gridDim.x * 8;
  const float* mod = (const float*)(p.ws + O_MOD) + (size_t)layer * 9 * 6144;
  for (int row = gw; row < nrows; row += nw) {
    const float* src = row < NLAT ? srcL + (size_t)row * DM : srcC + (size_t)(row - NLAT) * DM;
    int mi = row < NLAT ? (row >> 12) : 8;
    const float* sh = mod + mi * 6144 + shift_idx * 1024;
    const float* sc = sh + 1024;
    float4 v[4];
    float ss = 0.f;
#pragma unroll
    for (int i = 0; i < 4; ++i) {
      v[i] = *(const float4*)(src + i * 256 + lane * 4);
      ss += v[i].x * v[i].x + v[i].y * v[i].y + v[i].z * v[i].z + v[i].w * v[i].w;
    }
    ss = wave_sum(ss);
    float rs = rsqrtf(ss * (1.f / 1024.f) + 1e-6f);
#pragma unroll
    for (int i = 0; i < 4; ++i) {
      int c = i * 256 + lane * 4;
      float4 g = *(const float4*)(gain + c);
      float4 s1 = *(const float4*)(sc + c);
      float4 s0 = *(const float4*)(sh + c);
      float a = v[i].x * rs * g.x * (1.f + s1.x) + s0.x;
      float b = v[i].y * rs * g.y * (1.f + s1.y) + s0.y;
      float cc = v[i].z * rs * g.z * (1.f + s1.z) + s0.z;
      float d = v[i].w * rs * g.w * (1.f + s1.w) + s0.w;
      uint2 o; o.x = pack2(a, b); o.y = pack2(cc, d);
      *(uint2*)(dst + (size_t)row * DM + c) = o;
    }
  }
}

__device__ __forceinline__ void phase_conv_qk(const P& p) {
  const u16* hgg = (const u16*)(p.ws + O_HGG);
  u16* mix = (u16*)(p.ws + O_XN);
  const float* cw = p.in[9];
  const size_t gt = (size_t)blockIdx.x * NT + tid_(), gn = (size_t)gridDim.x * NT;
  for (size_t it = gt; it < (size_t)TTOK * 64; it += gn) {
    int row = (int)(it >> 6), c0 = (int)(it & 63) * 8;
    int t, len;
    if (row < NLAT) { t = row & 4095; len = 4096; } else { t = (row - NLAT) & 255; len = 256; }
    float pm[8], pc[8], pp[8];
    {
      const u16* b = hgg + (size_t)row * 1536;
      uint4 hh = *(const uint4*)(b + c0), gc = *(const uint4*)(b + 1024 + c0);
      pc[0] = bflo(hh.x) * bflo(gc.x); pc[1] = bfhi(hh.x) * bfhi(gc.x);
      pc[2] = bflo(hh.y) * bflo(gc.y); pc[3] = bfhi(hh.y) * bfhi(gc.y);
      pc[4] = bflo(hh.z) * bflo(gc.z); pc[5] = bfhi(hh.z) * bfhi(gc.z);
      pc[6] = bflo(hh.w) * bflo(gc.w); pc[7] = bfhi(hh.w) * bfhi(gc.w);
    }
    if (t > 0) {
      const u16* b = hgg + (size_t)(row - 1) * 1536;
      uint4 hh = *(const uint4*)(b + c0), gc = *(const uint4*)(b + 1024 + c0);
      pm[0] = bflo(hh.x) * bflo(gc.x); pm[1] = bfhi(hh.x) * bfhi(gc.x);
      pm[2] = bflo(hh.y) * bflo(gc.y); pm[3] = bfhi(hh.y) * bfhi(gc.y);
      pm[4] = bflo(hh.z) * bflo(gc.z); pm[5] = bfhi(hh.z) * bfhi(gc.z);
      pm[6] = bflo(hh.w) * bflo(gc.w); pm[7] = bfhi(hh.w) * bfhi(gc.w);
    } else {
#pragma unroll
      for (int e = 0; e < 8; ++e) pm[e] = 0.f;
    }
    if (t < len - 1) {
      const u16* b = hgg + (size_t)(row + 1) * 1536;
      uint4 hh = *(const uint4*)(b + c0), gc = *(const uint4*)(b + 1024 + c0);
      pp[0] = bflo(hh.x) * bflo(gc.x); pp[1] = bfhi(hh.x) * bfhi(gc.x);
      pp[2] = bflo(hh.y) * bflo(gc.y); pp[3] = bfhi(hh.y) * bfhi(gc.y);
      pp[4] = bflo(hh.z) * bflo(gc.z); pp[5] = bfhi(hh.z) * bfhi(gc.z);
      pp[6] = bflo(hh.w) * bflo(gc.w); pp[7] = bfhi(hh.w) * bfhi(gc.w);
    } else {
#pragma unroll
      for (int e = 0; e < 8; ++e) pp[e] = 0.f;
    }
    uint4 gbv = *(const uint4*)(hgg + (size_t)row * 1536 + 512 + c0);
    float gb[8] = {bflo(gbv.x), bfhi(gbv.x), bflo(gbv.y), bfhi(gbv.y), bflo(gbv.z), bfhi(gbv.z), bflo(gbv.w), bfhi(gbv.w)};
    float o[8];
#pragma unroll
    for (int e = 0; e < 8; ++e)
      o[e] = gb[e] * (cw[c0 + e] * pm[e] + cw[512 + c0 + e] * pc[e] + cw[1024 + c0 + e] * pp[e]);
    uint4 ov; ov.x = pack2(o[0], o[1]); ov.y = pack2(o[2], o[3]); ov.z = pack2(o[4], o[5]); ov.w = pack2(o[6], o[7]);
    *(uint4*)(mix + (size_t)row * DM + c0) = ov;
  }
  u16* Q = (u16*)(p.ws + O_Q);
  u16* KBp = (u16*)(p.ws + O_KB);
  const float* rope = (const float*)(p.ws + O_ROPE);
  const size_t ngroups = (size_t)TTOK * 10;
  for (size_t it = gt; it < ngroups * 8; it += gn) {
    size_t grp = it >> 3; int sub = (int)(it & 7);
    int row = (int)(grp / 10), hd = (int)(grp % 10);
    u16* ptr; const float* gain;
    if (hd < 8) { ptr = Q + (size_t)row * 512 + hd * 64 + sub * 8; gain = p.in[10]; }
    else { ptr = KBp + (size_t)row * 128 + (hd - 8) * 64 + sub * 8; gain = p.in[11]; }
    uint4 v = *(const uint4*)ptr;
    float x[8] = {bflo(v.x), bfhi(v.x), bflo(v.y), bfhi(v.y), bflo(v.z), bfhi(v.z), bflo(v.w), bfhi(v.w)};
    float ss = 0.f;
#pragma unroll
    for (int e = 0; e < 8; ++e) ss += x[e] * x[e];
    ss = red8(ss);
    float rs = rsqrtf(ss * (1.f / 64.f) + 1e-6f);
#pragma unroll
    for (int e = 0; e < 8; ++e) x[e] = x[e] * rs * gain[sub * 8 + e];
    if (row < NLAT) {
      int t = row & 4095; int gr = t >> 6, gc = t & 63;
#pragma unroll
      for (int e = 0; e < 4; ++e) {
        int pi = sub * 4 + e;
        int pos = pi < 16 ? gr : gc; int f = pi & 15;
        float c = rope[(pos * 16 + f) * 2], s = rope[(pos * 16 + f) * 2 + 1];
        float a = x[2 * e], b = x[2 * e + 1];
        x[2 * e] = a * c - b * s;
        x[2 * e + 1] = a * s + b * c;
      }
    }
    uint4 ov; ov.x = pack2(x[0], x[1]); ov.y = pack2(x[2], x[3]); ov.z = pack2(x[4], x[5]); ov.w = pack2(x[6], x[7]);
    *(uint4*)ptr = ov;
  }
}

__device__ __forceinline__ void phase_attn(const P& p, char* lds) {
  u16* sK = (u16*)lds;
  u16* sV = sK + 64 * LDSS;
  const u16* Q = (const u16*)(p.ws + O_Q);
  const u16* KBp = (const u16*)(p.ws + O_KB);
  const u16* VT = (const u16*)(p.ws + O_VT);
  u16* mix = (u16*)(p.ws + O_XN);
  const int tid = tid_(), lane = tid & 63, wave = tid >> 6;
  const int r = lane & 31, h = lane >> 5;
  const float cs = 0.125f * 1.4426950408889634f;
  for (int item = blockIdx.x; item < 1088; item += gridDim.x) {
    int b, qh, qrow0, nkt;
    if (item < 1024) { b = item >> 7; qh = (item >> 4) & 7; qrow0 = b * 4096 + (item & 15) * 256; nkt = 68; }
    else { int i2 = item - 1024; b = i2 >> 3; qh = i2 & 7; qrow0 = NLAT + b * 256; nkt = 4; }
    const int kvh = qh >> 2;
    const int qrow = qrow0 + wave * 32 + r;
    bf16x8 qf[4];
#pragma unroll
    for (int kk = 0; kk < 4; ++kk) qf[kk] = *(const bf16x8*)(Q + (size_t)qrow * 512 + qh * 64 + kk * 16 + h * 8);
    f32x16 o[2];
#pragma unroll
    for (int g = 0; g < 16; ++g) { o[0][g] = 0.f; o[1][g] = 0.f; }
    float m = -INFINITY, l = 0.f;
    const int lkey = tid >> 3, lch = tid & 7;
    uint4 ka, va;
    auto gl = [&](int kt) {
      int pos = kt * 64 + lkey;
      int krow = pos < 256 ? NLAT + b * 256 + pos : b * 4096 + pos - 256;
      ka = *(const uint4*)(KBp + (size_t)krow * 128 + kvh * 64 + lch * 8);
      va = *(const uint4*)(VT + ((size_t)((b * 2 + kvh) * 64 + lkey)) * 4352 + kt * 64 + lch * 8);
    };
    gl(0);
    for (int kt = 0; kt < nkt; ++kt) {
      *(uint4*)(sK + lkey * LDSS + lch * 8) = ka;
      *(uint4*)(sV + lkey * LDSS + lch * 8) = va;
      __syncthreads();
      if (kt + 1 < nkt) gl(kt + 1);
      f32x16 s[2];
#pragma unroll
      for (int g = 0; g < 16; ++g) { s[0][g] = 0.f; s[1][g] = 0.f; }
#pragma unroll
      for (int kb = 0; kb < 2; ++kb)
#pragma unroll
        for (int kk = 0; kk < 4; ++kk) {
          bf16x8 a = *(const bf16x8*)(sK + (kb * 32 + r) * LDSS + kk * 16 + h * 8);
          s[kb] = __builtin_amdgcn_mfma_f32_32x32x16_bf16(a, qf[kk], s[kb], 0, 0, 0);
        }
      float mx = s[0][0];
#pragma unroll
      for (int g = 0; g < 16; ++g) { mx = fmaxf(mx, s[0][g]); mx = fmaxf(mx, s[1][g]); }
      mx = swapmax32(mx);
      float mn = fmaxf(m, mx);
      float alpha = __builtin_amdgcn_exp2f((m - mn) * cs);
      m = mn;
      float mc = mn * cs, ps = 0.f;
#pragma unroll
      for (int kb = 0; kb < 2; ++kb)
#pragma unroll
        for (int g = 0; g < 16; ++g) { float e = __builtin_amdgcn_exp2f(s[kb][g] * cs - mc); s[kb][g] = e; ps += e; }
      l = l * alpha + ps;
#pragma unroll
      for (int g = 0; g < 16; ++g) { o[0][g] *= alpha; o[1][g] *= alpha; }
      bf16x8 pb[2][2];
#pragma unroll
      for (int kb = 0; kb < 2; ++kb)
#pragma unroll
        for (int c = 0; c < 2; ++c) {
          uint4 pk;
          pk.x = pack2(s[kb][8 * c + 0], s[kb][8 * c + 1]); pk.y = pack2(s[kb][8 * c + 2], s[kb][8 * c + 3]);
          pk.z = pack2(s[kb][8 * c + 4], s[kb][8 * c + 5]); pk.w = pack2(s[kb][8 * c + 6], s[kb][8 * c + 7]);
          pb[kb][c] = __builtin_bit_cast(bf16x8, pk);
        }
#pragma unroll
      for (int db = 0; db < 2; ++db)
#pragma unroll
        for (int kb = 0; kb < 2; ++kb)
#pragma unroll
          for (int c = 0; c < 2; ++c) {
            const u16* vp = sV + (db * 32 + r) * LDSS + kb * 32 + 16 * c + 4 * h;
            uint2 lo = *(const uint2*)vp, hi = *(const uint2*)(vp + 8);
            uint4 av = make_uint4(lo.x, lo.y, hi.x, hi.y);
            o[db] = __builtin_amdgcn_mfma_f32_32x32x16_bf16(__builtin_bit_cast(bf16x8, av), pb[kb][c], o[db], 0, 0, 0);
          }
      __syncthreads();
    }
    l = swapsum32(l, l);
    float inv = 1.f / l;
#pragma unroll
    for (int db = 0; db < 2; ++db)
#pragma unroll
      for (int g4 = 0; g4 < 4; ++g4) {
        int d = db * 32 + 8 * g4 + 4 * h;
        uint2 ov;
        ov.x = pack2(o[db][g4 * 4 + 0] * inv, o[db][g4 * 4 + 1] * inv);
        ov.y = pack2(o[db][g4 * 4 + 2] * inv, o[db][g4 * 4 + 3] * inv);
        *(uint2*)(mix + (size_t)qrow * DM + 512 + qh * 64 + d) = ov;
      }
  }
}

__device__ __forceinline__ int fkey(float f) { int b = __float_as_int(f); return b ^ ((b >> 31) & 0x7FFFFFFF); }
__device__ __forceinline__ float keyf(int k) { return __int_as_float(k ^ ((k >> 31) & 0x7FFFFFFF)); }

#define CE_DESC(a, b) { int hi__ = max(a, b); int lo__ = min(a, b); a = hi__; b = lo__; }
#define BITONIC_SORT16(r)                                                          \
  _Pragma("unroll") for (int k_ = 2; k_ <= 16; k_ <<= 1)                           \
    _Pragma("unroll") for (int j_ = k_ >> 1; j_ > 0; j_ >>= 1)                     \
      _Pragma("unroll") for (int i_ = 0; i_ < 16; ++i_) {                          \
        const int l_ = i_ ^ j_;                                                    \
        if (l_ > i_) { if ((i_ & k_) == 0) CE_DESC(r[i_], r[l_]) else CE_DESC(r[l_], r[i_]) } \
      }
#define BITONIC_MERGE16(r)                                                         \
  _Pragma("unroll") for (int j_ = 8; j_ > 0; j_ >>= 1)                             \
    _Pragma("unroll") for (int i_ = 0; i_ < 16; ++i_) {                            \
      const int l_ = i_ ^ j_;                                                      \
      if (l_ > i_) CE_DESC(r[i_], r[l_])                                           \
    }
#define XLANE_MERGE16(r, CTRL)                                                     \
  {                                                                                \
    int o_[16];                                                                    \
    _Pragma("unroll") for (int i_ = 0; i_ < 16; ++i_) o_[i_] = __builtin_amdgcn_update_dpp(0, r[15 - i_], CTRL, 0xF, 0xF, true); \
    _Pragma("unroll") for (int i_ = 0; i_ < 16; ++i_) r[i_] = max(r[i_], o_[i_]);  \
    BITONIC_MERGE16(r)                                                             \
  }
#define SCS 132
__device__ __forceinline__ void phase_peer_topk(const P& p, int layer, const u16* PQ, int ntok, int* IDX, float* GATE, char* lds) {
  float* sc = (float*)lds;
  int* lists = (int*)(lds + 2 * 64 * SCS * 4);
  const int tid = tid_(), lane = tid & 63, wave = tid >> 6;
  const int r = lane & 31, h = lane >> 5;
  const u16* keys = (const u16*)(p.ws + O_KEYS) + (size_t)layer * 8 * 2 * 128 * 128;
  const int ntile = (ntok >> 6) * 8;
  for (int tile = blockIdx.x; tile < ntile; tile += gridDim.x) {
    int hd = tile & 7, row0 = (tile >> 3) * 64;
    {
      int pp = wave >> 2, kb = wave & 3;
      f32x16 acc[2];
#pragma unroll
      for (int g = 0; g < 16; ++g) { acc[0][g] = 0.f; acc[1][g] = 0.f; }
      const u16* kp = keys + ((size_t)(hd * 2 + pp) * 128 + kb * 32 + r) * 128 + h * 8;
      const u16* qp = PQ + (size_t)(row0 + r) * 2048 + hd * 256 + pp * 128 + h * 8;
#pragma unroll
      for (int kk = 0; kk < 8; ++kk) {
        bf16x8 bfr = *(const bf16x8*)(kp + kk * 16);
        bf16x8 a0 = *(const bf16x8*)(qp + kk * 16);
        bf16x8 a1 = *(const bf16x8*)(qp + (size_t)32 * 2048 + kk * 16);
        acc[0] = __builtin_amdgcn_mfma_f32_32x32x16_bf16(a0, bfr, acc[0], 0, 0, 0);
        acc[1] = __builtin_amdgcn_mfma_f32_32x32x16_bf16(a1, bfr, acc[1], 0, 0, 0);
      }
#pragma unroll
      for (int mb = 0; mb < 2; ++mb)
#pragma unroll
        for (int g = 0; g < 16; ++g) {
          int tok = mb * 32 + (g & 3) + 8 * (g >> 2) + 4 * h;
          sc[(pp * 64 + tok) * SCS + kb * 32 + r] = acc[mb][g];
        }
    }
    __syncthreads();
    {
      const int row = tid >> 2, qd = tid & 3;
      const float* rowp = sc + row * SCS + qd;
      int A[16], B[16];
#pragma unroll
      for (int m = 0; m < 16; ++m) {
        A[m] = (fkey(rowp[4 * m]) & ~0x7F) | (127 - (4 * m + qd));
        B[m] = (fkey(rowp[64 + 4 * m]) & ~0x7F) | (127 - (64 + 4 * m + qd));
      }
      BITONIC_SORT16(A)
      BITONIC_SORT16(B)
#pragma unroll
      for (int i = 0; i < 16; ++i) A[i] = max(A[i], B[15 - i]);
      BITONIC_MERGE16(A)
      XLANE_MERGE16(A, 0xB1)
      XLANE_MERGE16(A, 0x4E)
      if (qd == 0) {
#pragma unroll
        for (int i = 0; i < 16; i += 4) *(int4*)(lists + row * 16 + i) = make_int4(A[i], A[i + 1], A[i + 2], A[i + 3]);
      }
    }
    __syncthreads();
    if (tid < 256) {
      const int tok = tid >> 2, q = tid & 3;
      float bq[16];
#pragma unroll
      for (int j = 0; j < 16; ++j) bq[j] = keyf(lists[(64 + tok) * 16 + j] & ~0x7F);
      int R[16];
#pragma unroll
      for (int i = 0; i < 16; ++i) R[i] = (int)0x80000000;
#pragma unroll
      for (int m = 0; m < 4; ++m) {
        const int i = q + 4 * m;
        const float ai = keyf(lists[tok * 16 + i] & ~0x7F);
        const int jmax = 16 / (i + 1);
        const int nj = m == 0 ? 16 : (m == 1 ? 3 : 1);
#pragma unroll
        for (int j = 0; j < nj; ++j) {
          int x = (fkey(ai + bq[j]) & ~0xFF) | (255 - (i * 16 + j));
          x = j < jmax ? x : (int)0x80000000;
#pragma unroll
          for (int t = 0; t < 16; ++t) { int hi_ = max(R[t], x); x = min(R[t], x); R[t] = hi_; }
        }
      }
      XLANE_MERGE16(R, 0xB1)
      XLANE_MERGE16(R, 0x4E)
      float sv[16];
      float mx = keyf(R[0] & ~0xFF), sum = 0.f;
#pragma unroll
      for (int t = 0; t < 16; ++t) { sv[t] = __expf(keyf(R[t] & ~0xFF) - mx); sum += sv[t]; }
      float inv = 1.f / sum;
      size_t ob = (size_t)(row0 + tok) * 128 + hd * 16;
#pragma unroll
      for (int t = 0; t < 16; ++t) {
        if ((t >> 2) == q) {
          int pos = 255 - (R[t] & 0xFF);
          int i1 = 127 - (lists[tok * 16 + (pos >> 4)] & 0x7F);
          int i2 = 127 - (lists[(64 + tok) * 16 + (pos & 15)] & 0x7F);
          IDX[ob + t] = i1 * 128 + i2;
          GATE[ob + t] = sv[t] * inv;
        }
      }
    }
    __syncthreads();
  }
}

typedef __attribute__((ext_vector_type(2))) float f2;
#define TAB_V8 (16 * MiB)
#define TAB_SU (32 * MiB)
#define TAB_SV (32 * MiB + 65536)
__device__ __forceinline__ float wave_max(float v) {
  v = fmaxf(v, dppf<0xB1>(v)); v = fmaxf(v, dppf<0x4E>(v)); v = fmaxf(v, dppf<0x141>(v)); v = fmaxf(v, dppf<0x140>(v));
  v = swapmax16(v); v = swapmax32(v);
  return v;
}
__device__ __forceinline__ void convert_tab_fp8(const float* __restrict__ U, const float* __restrict__ V, char* tab) {
  const int lane = tid_() & 63;
  const int gw = blockIdx.x * 8 + (tid_() >> 6), nw = gridDim.x * 8;
  for (int rr = gw; rr < 32768; rr += nw) {
    const int isv = rr >> 14, e = rr & 16383;
    const float* src = (isv ? V : U) + (size_t)e * 1024 + lane * 16;
    float4 v0 = *(const float4*)src, v1 = *(const float4*)(src + 4), v2 = *(const float4*)(src + 8), v3 = *(const float4*)(src + 12);
    float am = fmaxf(fmaxf(fmaxf(fabsf(v0.x), fabsf(v0.y)), fmaxf(fabsf(v0.z), fabsf(v0.w))),
                     fmaxf(fmaxf(fabsf(v1.x), fabsf(v1.y)), fmaxf(fabsf(v1.z), fabsf(v1.w))));
    am = fmaxf(am, fmaxf(fmaxf(fmaxf(fabsf(v2.x), fabsf(v2.y)), fmaxf(fabsf(v2.z), fabsf(v2.w))),
                         fmaxf(fmaxf(fabsf(v3.x), fabsf(v3.y)), fmaxf(fabsf(v3.z), fabsf(v3.w)))));
    am = wave_max(am);
    float sc = am > 0.f ? 448.f / am : 1.f;
    uint4 o;
    int t = 0;
    t = __builtin_amdgcn_cvt_pk_fp8_f32(v0.x * sc, v0.y * sc, t, false); t = __builtin_amdgcn_cvt_pk_fp8_f32(v0.z * sc, v0.w * sc, t, true); o.x = t;
    t = __builtin_amdgcn_cvt_pk_fp8_f32(v1.x * sc, v1.y * sc, t, false); t = __builtin_amdgcn_cvt_pk_fp8_f32(v1.z * sc, v1.w * sc, t, true); o.y = t;
    t = __builtin_amdgcn_cvt_pk_fp8_f32(v2.x * sc, v2.y * sc, t, false); t = __builtin_amdgcn_cvt_pk_fp8_f32(v2.z * sc, v2.w * sc, t, true); o.z = t;
    t = __builtin_amdgcn_cvt_pk_fp8_f32(v3.x * sc, v3.y * sc, t, false); t = __builtin_amdgcn_cvt_pk_fp8_f32(v3.z * sc, v3.w * sc, t, true); o.w = t;
    if (!isv) {
      *(uint4*)(tab + (size_t)e * 1024 + lane * 16) = o;
      if (lane == 0) ((float*)(tab + TAB_SU))[e] = am > 0.f ? am / 448.f : 1.f;
    } else {
      *(uint4*)(tab + TAB_V8 + ((size_t)(lane >> 3) * 16384 + e) * 128 + (lane & 7) * 16) = o;
      if (lane == 0) ((float*)(tab + TAB_SV))[e] = am > 0.f ? am / 448.f : 1.f;
    }
  }
}
__device__ __forceinline__ f2 dec8(unsigned w, bool hi) { return hi ? __builtin_amdgcn_cvt_pk_f32_fp8((int)w, true) : __builtin_amdgcn_cvt_pk_f32_fp8((int)w, false); }

__device__ __forceinline__ float dot16(uint4 w, f2 a0, f2 a1, f2 a2, f2 a3, f2 a4, f2 a5, f2 a6, f2 a7) {
  f2 a = f2{0.f, 0.f};
  a = __builtin_elementwise_fma(dec8(w.x, false), a0, a); a = __builtin_elementwise_fma(dec8(w.x, true), a1, a);
  a = __builtin_elementwise_fma(dec8(w.y, false), a2, a); a = __builtin_elementwise_fma(dec8(w.y, true), a3, a);
  a = __builtin_elementwise_fma(dec8(w.z, false), a4, a); a = __builtin_elementwise_fma(dec8(w.z, true), a5, a);
  a = __builtin_elementwise_fma(dec8(w.w, false), a6, a); a = __builtin_elementwise_fma(dec8(w.w, true), a7, a);
  return a.x + a.y;
}
#define DOT16(W) dot16(W, xf0, xf1, xf2, xf3, xf4, xf5, xf6, xf7)
__device__ __forceinline__ void phase_peer_act(const P& p, const u16* XN2, const char* tab, const int* IDX, const float* GATE, float* COEF, int ntok, char* lds) {
  const int tid = tid_(), lane = tid & 63, wave = tid >> 6;
  int* le = (int*)(lds + wave * 1536);
  float* lg = (float*)(le + 128);
  int* ls = le + 256;
  const int part = blockIdx.x & 7;
  const int wv = (blockIdx.x >> 3) * 8 + wave, nwv = (gridDim.x >> 3) * 8;
  const float* SU = (const float*)(tab + TAB_SU);
  const float* SV = (const float*)(tab + TAB_SV);
  const int q = lane >> 4;
  const bool hi = (lane & 32) != 0, b4 = (lane & 16) != 0;
  int i0 = 0, i1 = 0; float g0 = 0.f, g1 = 0.f; uint4 x0 = make_uint4(0, 0, 0, 0), x1 = x0;
  if (wv < ntok) {
    i0 = IDX[(size_t)wv * 128 + lane]; i1 = IDX[(size_t)wv * 128 + 64 + lane];
    g0 = GATE[(size_t)wv * 128 + lane]; g1 = GATE[(size_t)wv * 128 + 64 + lane];
    const u16* xr = XN2 + (size_t)wv * DM + lane * 16;
    x0 = *(const uint4*)xr; x1 = *(const uint4*)(xr + 8);
  }
  for (int tok = wv; tok < ntok; tok += nwv) {
    int ni0 = 0, ni1 = 0; float ng0 = 0.f, ng1 = 0.f; uint4 nx0 = make_uint4(0, 0, 0, 0), nx1 = nx0;
    const int nt = tok + nwv;
    if (nt < ntok) {
      ni0 = IDX[(size_t)nt * 128 + lane]; ni1 = IDX[(size_t)nt * 128 + 64 + lane];
      ng0 = GATE[(size_t)nt * 128 + lane]; ng1 = GATE[(size_t)nt * 128 + 64 + lane];
      const u16* xr = XN2 + (size_t)nt * DM + lane * 16;
      nx0 = *(const uint4*)xr; nx1 = *(const uint4*)(xr + 8);
    }
    const bool s0 = (i0 >> 11) == part, s1 = (i1 >> 11) == part;
    const unsigned long long m0 = __ballot(s0), m1 = __ballot(s1);
    const int c0 = __popcll(m0), cnt = c0 + __popcll(m1);
    const int p0 = __builtin_amdgcn_mbcnt_hi((unsigned)(m0 >> 32), __builtin_amdgcn_mbcnt_lo((unsigned)m0, 0));
    const int p1 = c0 + __builtin_amdgcn_mbcnt_hi((unsigned)(m1 >> 32), __builtin_amdgcn_mbcnt_lo((unsigned)m1, 0));
    if (s0) { le[p0] = i0; lg[p0] = g0; ls[p0] = lane; }
    if (s1) { le[p1] = i1; lg[p1] = g1; ls[p1] = 64 + lane; }
    const int cntp = (cnt + 3) & ~3;
    if (lane < cntp - cnt) { le[cnt + lane] = part << 11; lg[cnt + lane] = 0.f; ls[cnt + lane] = -1; }
    const f2 xf0 = f2{bflo(x0.x), bfhi(x0.x)}, xf1 = f2{bflo(x0.y), bfhi(x0.y)}, xf2 = f2{bflo(x0.z), bfhi(x0.z)}, xf3 = f2{bflo(x0.w), bfhi(x0.w)};
    const f2 xf4 = f2{bflo(x1.x), bfhi(x1.x)}, xf5 = f2{bflo(x1.y), bfhi(x1.y)}, xf6 = f2{bflo(x1.z), bfhi(x1.z)}, xf7 = f2{bflo(x1.w), bfhi(x1.w)};
    for (int base = 0; base < cntp; base += 24) {
      uint4 w[24];
      const int evl = le[base + (lane < 24 ? lane : 0)];
#pragma unroll
      for (int gq = 0; gq < 6; ++gq) {
        if (base + 4 * gq < cntp) {
#pragma unroll
          for (int k = 0; k < 4; ++k) {
            int e = __builtin_amdgcn_readlane(evl, 4 * gq + k);
            w[4 * gq + k] = *(const uint4*)(tab + (size_t)e * 1024 + lane * 16);
          }
        } else {
#pragma unroll
          for (int k = 0; k < 4; ++k) w[4 * gq + k] = make_uint4(0, 0, 0, 0);
        }
      }
#pragma unroll
      for (int gq = 0; gq < 6; ++gq) {
        if (base + 4 * gq < cntp) {
          float d0 = DOT16(w[4 * gq]), d1 = DOT16(w[4 * gq + 1]), d2 = DOT16(w[4 * gq + 2]), d3 = DOT16(w[4 * gq + 3]);
          float kA = swapsum32(d0, d2), kB = swapsum32(d1, d3);
          float kC = swapsum16(kA, kB);
          kC = red16(kC);
          const int j = base + 4 * gq + q;
          const int e = le[j]; const float gt = lg[j]; const int slot = ls[j];
          float act = kC * SU[e];
          float coef = gt * 0.5f * act * (1.f + erff(act * 0.70710678118654752f)) * SV[e];
          if ((lane & 15) == 0 && slot >= 0) COEF[(size_t)tok * 128 + slot] = coef;
        }
      }
    }
    i0 = ni0; i1 = ni1; g0 = ng0; g1 = ng1; x0 = nx0; x1 = nx1;
  }
}

__device__ __forceinline__ void phase_peer_sum(const P& p, int layer, const char* tab, const int* IDX, const float* COEF, int ntok, float* dummy_dst) {
  const int tid = tid_(), lane = tid & 63, wave = tid >> 6;
  const int sl = blockIdx.x & 7;
  const int wv = (blockIdx.x >> 3) * 8 + wave, nwv = (gridDim.x >> 3) * 8;
  const int g = lane >> 3, ch = lane & 7;
  const char* V8 = tab + TAB_V8 + (size_t)sl * 16384 * 128 + ch * 16;
  const float* mod = (const float*)(p.ws + O_MOD) + (size_t)layer * 9 * 6144;
  float* HC = (float*)(p.ws + O_HC);
  const bool b5 = (lane & 32) != 0, b4 = (lane & 16) != 0, b3 = (lane & 8) != 0;
  const int c = sl * 128 + ch * 16 + (b5 ? 8 : 0) + (b4 ? 4 : 0) + (b3 ? 2 : 0);
  uint4 ia, ib, ic, id; float4 ca, cb, cc, cd;
  ia = ib = ic = id = make_uint4(0, 0, 0, 0); ca = cb = cc = cd = make_float4(0, 0, 0, 0);
  if (wv < ntok) {
    const int* ip = IDX + (size_t)wv * 128 + g * 16;
    const float* cp = COEF + (size_t)wv * 128 + g * 16;
    ia = *(const uint4*)ip; ib = *(const uint4*)(ip + 4); ic = *(const uint4*)(ip + 8); id = *(const uint4*)(ip + 12);
    ca = *(const float4*)cp; cb = *(const float4*)(cp + 4); cc = *(const float4*)(cp + 8); cd = *(const float4*)(cp + 12);
  }
  for (int tok = wv; tok < ntok; tok += nwv) {
    const unsigned ev[16] = {ia.x, ia.y, ia.z, ia.w, ib.x, ib.y, ib.z, ib.w, ic.x, ic.y, ic.z, ic.w, id.x, id.y, id.z, id.w};
    const float cv[16] = {ca.x, ca.y, ca.z, ca.w, cb.x, cb.y, cb.z, cb.w, cc.x, cc.y, cc.z, cc.w, cd.x, cd.y, cd.z, cd.w};
    uint4 w[16];
#pragma unroll
    for (int i = 0; i < 16; ++i) w[i] = *(const uint4*)(V8 + (size_t)ev[i] * 128);
    float* dst = (dummy_dst ? dummy_dst + (size_t)tok * DM : (tok < NLAT ? p.out + (size_t)tok * DM : HC + (size_t)(tok - NLAT) * DM)) + c;
    float2 o = *(float2*)dst;
    const int nt = tok + nwv;
    if (nt < ntok) {
      const int* ip = IDX + (size_t)nt * 128 + g * 16;
      const float* cp = COEF + (size_t)nt * 128 + g * 16;
      ia = *(const uint4*)ip; ib = *(const uint4*)(ip + 4); ic = *(const uint4*)(ip + 8); id = *(const uint4*)(ip + 12);
      ca = *(const float4*)cp; cb = *(const float4*)(cp + 4); cc = *(const float4*)(cp + 8); cd = *(const float4*)(cp + 12);
    }
    f2 acc[8];
#pragma unroll
    for (int k = 0; k < 8; ++k) acc[k] = f2{0.f, 0.f};
#pragma unroll
    for (int i = 0; i < 16; ++i) {
      f2 c2 = f2{cv[i], cv[i]};
      acc[0] = __builtin_elementwise_fma(dec8(w[i].x, false), c2, acc[0]); acc[1] = __builtin_elementwise_fma(dec8(w[i].x, true), c2, acc[1]);
      acc[2] = __builtin_elementwise_fma(dec8(w[i].y, false), c2, acc[2]); acc[3] = __builtin_elementwise_fma(dec8(w[i].y, true), c2, acc[3]);
      acc[4] = __builtin_elementwise_fma(dec8(w[i].z, false), c2, acc[4]); acc[5] = __builtin_elementwise_fma(dec8(w[i].z, true), c2, acc[5]);
      acc[6] = __builtin_elementwise_fma(dec8(w[i].w, false), c2, acc[6]); acc[7] = __builtin_elementwise_fma(dec8(w[i].w, true), c2, acc[7]);
    }
    float r8[8];
#pragma unroll
    for (int k = 0; k < 4; ++k) {
      r8[2 * k] = swapsum32(acc[k].x, acc[4 + k].x);
      r8[2 * k + 1] = swapsum32(acc[k].y, acc[4 + k].y);
    }
    float r4[4];
#pragma unroll
    for (int k = 0; k < 4; ++k) r4[k] = swapsum16(r8[k], r8[4 + k]);
    float r2[2];
#pragma unroll
    for (int k = 0; k < 2; ++k) {
      float kx = b3 ? r4[2 + k] : r4[k], sx = b3 ? r4[k] : r4[2 + k];
      r2[k] = kx + dppf<0x128>(sx);
    }
    const int mi = tok < NLAT ? (tok >> 12) : 8;
    const float2 mv = *(const float2*)(mod + mi * 6144 + 5 * 1024 + c);
    o.x += mv.x * r2[0]; o.y += mv.y * r2[1];
    *(float2*)dst = o;
  }
}

__device__ __forceinline__ void phase_scan(const P& p, char* lds, bool dummy) {
  float* buf = (float*)lds;
  float* vbuf = (float*)(lds + 81920);
  u16* ybuf = (u16*)(lds + 81920 + 16384);
  const int tid = tid_(), lane = tid & 63, wave = tid >> 6;
  const int c = lane & 7, irow = wave * 8 + (lane >> 3);
  const u16* R = (const u16*)(p.ws + O_R);
  const u16* Kp = (const u16*)(p.ws + O_K);
  const u16* Vp = (const u16*)(p.ws + O_V);
  const int ps = tid >> 4, col4 = (tid & 15) * 4;
  for (int item = blockIdx.x; item < 256; item += gridDim.x) {
    const int dir = item & 1, hh = (item >> 1) & 15, b = item >> 5;
    char* WA = p.ws + (dir ? O_WA1 : O_WA0);
    float* BON = (float*)(p.ws + O_BONUS) + (size_t)dir * NLAT * 16;
    float kkc[4], kac[4], rkc[4];
#pragma unroll
    for (int e = 0; e < 4; ++e) {
      kkc[e] = p.in[20][hh * 64 + col4 + e];
      kac[e] = p.in[21][hh * 64 + col4 + e];
      rkc[e] = p.in[22][hh * 64 + col4 + e];
    }
    auto rowof = [&](int s) -> int {
      if (s < 256) { int pos = dir ? 255 - s : s; return NLAT + b * 256 + pos; }
      int u = s - 256; int pos = dir ? 4095 - u : u; return b * 4096 + pos;
    };
    uint2 pr, pk, pv; unsigned pw, pa; int prow;
    auto gload = [&](int ch) {
      prow = rowof(ch * 32 + ps);
      size_t o = (size_t)prow * 1024 + hh * 64 + col4;
      pr = *(const uint2*)(R + o); pk = *(const uint2*)(Kp + o); pv = *(const uint2*)(Vp + o);
      const char* wp = WA + (size_t)prow * 2048 + hh * 128;
      pw = *(const unsigned*)(wp + col4); pa = *(const unsigned*)(wp + 64 + col4);
    };
    auto prep = [&](int bi) {
      float rr[4] = {bflo(pr.x), bfhi(pr.x), bflo(pr.y), bfhi(pr.y)};
      float kq[4] = {bflo(pk.x), bfhi(pk.x), bflo(pk.y), bfhi(pk.y)};
      float4 vv = make_float4(bflo(pv.x), bfhi(pv.x), bflo(pv.y), bfhi(pv.y));
      float w[4], a[4], kr[4], kk[4], bb[4], kd[4];
      float ss = 0.f;
#pragma unroll
      for (int e = 0; e < 4; ++e) {
        w[e] = 0.5f + (float)((pw >> (8 * e)) & 255u) * (1.f / 510.f);
        a[e] = (float)((pa >> (8 * e)) & 255u) * (1.f / 255.f);
        kr[e] = kq[e] * kkc[e];
        ss += kr[e] * kr[e];
      }
      ss = red16(ss);
      float inv = rsqrtf(ss + 1e-12f);
      float bn = 0.f;
#pragma unroll
      for (int e = 0; e < 4; ++e) {
        kk[e] = kr[e] * inv;
        bb[e] = kk[e] * a[e];
        kd[e] = kq[e] * (1.f + (a[e] - 1.f) * kac[e]);
        bn += rr[e] * kd[e] * rkc[e];
      }
      bn = red16(bn);
      if ((tid & 15) == 0 && prow < NLAT) BON[(size_t)prow * 16 + hh] = bn;
      float* d = buf + bi * 10240 + ((ps * 8 + (col4 >> 3)) * 5) * 8 + (col4 & 7);
      *(float4*)(d) = make_float4(rr[0], rr[1], rr[2], rr[3]);
      *(float4*)(d + 8) = make_float4(w[0], w[1], w[2], w[3]);
      *(float4*)(d + 16) = make_float4(kk[0], kk[1], kk[2], kk[3]);
      *(float4*)(d + 24) = make_float4(bb[0], bb[1], bb[2], bb[3]);
      *(float4*)(d + 32) = make_float4(kd[0], kd[1], kd[2], kd[3]);
      *(float4*)(vbuf + bi * 2048 + ps * 64 + col4) = vv;
    };
    float S[8];
#pragma unroll
    for (int j = 0; j < 8; ++j) S[j] = 0.f;
    gload(0);
    prep(0);
    __syncthreads();
    for (int ch = 0; ch < 136; ++ch) {
      const int cur = ch & 1;
      if (ch + 1 < 136) gload(ch + 1);
      const float* bq = buf + cur * 10240 + c * 40;
      const float* vq = vbuf + cur * 2048 + irow;
      float4 nr0, nr1, nw0, nw1, nk0, nk1, nb0, nb1, nd0, nd1; float nvi;
      {
        const float* q = bq;
        nr0 = *(const float4*)(q); nr1 = *(const float4*)(q + 4); nw0 = *(const float4*)(q + 8); nw1 = *(const float4*)(q + 12);
        nk0 = *(const float4*)(q + 16); nk1 = *(const float4*)(q + 20); nb0 = *(const float4*)(q + 24); nb1 = *(const float4*)(q + 28);
        nd0 = *(const float4*)(q + 32); nd1 = *(const float4*)(q + 36); nvi = vq[0];
      }
#pragma unroll 4
      for (int t = 0; t < 32; ++t) {
        const float4 r0 = nr0, r1 = nr1, w0 = nw0, w1 = nw1, k0 = nk0, k1 = nk1, b0 = nb0, b1 = nb1, d0 = nd0, d1 = nd1;
        const float vi = nvi;
        if (t + 1 < 32) {
          const float* q = bq + (t + 1) * 320;
          nr0 = *(const float4*)(q); nr1 = *(const float4*)(q + 4); nw0 = *(const float4*)(q + 8); nw1 = *(const float4*)(q + 12);
          nk0 = *(const float4*)(q + 16); nk1 = *(const float4*)(q + 20); nb0 = *(const float4*)(q + 24); nb1 = *(const float4*)(q + 28);
          nd0 = *(const float4*)(q + 32); nd1 = *(const float4*)(q + 36); nvi = vq[(t + 1) * 64];
        }
        float sa = (S[0] * k0.x + S[1] * k0.y) + (S[2] * k0.z + S[3] * k0.w) + ((S[4] * k1.x + S[5] * k1.y) + (S[6] * k1.z + S[7] * k1.w));
        sa = red8(sa);
        S[0] = fmaf(S[0], w0.x, fmaf(-sa, b0.x, vi * d0.x));
        S[1] = fmaf(S[1], w0.y, fmaf(-sa, b0.y, vi * d0.y));
        S[2] = fmaf(S[2], w0.z, fmaf(-sa, b0.z, vi * d0.z));
        S[3] = fmaf(S[3], w0.w, fmaf(-sa, b0.w, vi * d0.w));
        S[4] = fmaf(S[4], w1.x, fmaf(-sa, b1.x, vi * d1.x));
        S[5] = fmaf(S[5], w1.y, fmaf(-sa, b1.y, vi * d1.y));
        S[6] = fmaf(S[6], w1.z, fmaf(-sa, b1.z, vi * d1.z));
        S[7] = fmaf(S[7], w1.w, fmaf(-sa, b1.w, vi * d1.w));
        float y = (S[0] * r0.x + S[1] * r0.y) + (S[2] * r0.z + S[3] * r0.w) + ((S[4] * r1.x + S[5] * r1.y) + (S[6] * r1.z + S[7] * r1.w));
        y = red8(y);
        if (c == 0) ybuf[t * 64 + irow] = f2bf(y);
      }
      __syncthreads();
      if (ch >= 8 && !dummy) {
        int row = rowof(ch * 32 + ps);
        uint2 yv = *(const uint2*)(ybuf + ps * 64 + col4);
        *(uint2*)(WA + (size_t)row * 2048 + hh * 128 + col4 * 2) = yv;
      }
      if (ch + 1 < 136) prep(cur ^ 1);
      __syncthreads();
    }
  }
}

__device__ __forceinline__ void phase_readout(const P& p) {
  const u16* Vp = (const u16*)(p.ws + O_V);
  const u16* G = (const u16*)(p.ws + O_G);
  u16* Z = (u16*)(p.ws + O_Z);
  const float* BON = (const float*)(p.ws + O_BONUS);
  const size_t gt = (size_t)blockIdx.x * NT + tid_(), gn = (size_t)gridDim.x * NT;
  for (size_t it = gt; it < (size_t)NLAT * 16 * 8; it += gn) {
    int sub = (int)(it & 7); size_t grp = it >> 3;
    int hh = (int)(grp & 15); int row = (int)(grp >> 4);
    uint4 y0 = *(const uint4*)(p.ws + O_WA0 + (size_t)row * 2048 + hh * 128 + sub * 16);
    uint4 y1 = *(const uint4*)(p.ws + O_WA1 + (size_t)row * 2048 + hh * 128 + sub * 16);
    float y[8] = {bflo(y0.x) + bflo(y1.x), bfhi(y0.x) + bfhi(y1.x), bflo(y0.y) + bflo(y1.y), bfhi(y0.y) + bfhi(y1.y),
                  bflo(y0.z) + bflo(y1.z), bfhi(y0.z) + bfhi(y1.z), bflo(y0.w) + bflo(y1.w), bfhi(y0.w) + bfhi(y1.w)};
    float s = 0.f;
#pragma unroll
    for (int e = 0; e < 8; ++e) s += y[e];
    float mean = red8(s) * (1.f / 64.f);
    float vs = 0.f;
#pragma unroll
    for (int e = 0; e < 8; ++e) { y[e] -= mean; vs += y[e] * y[e]; }
    float var = red8(vs) * (1.f / 64.f);
    float rs = rsqrtf(var + 64e-5f);
    float bonus = BON[(size_t)row * 16 + hh] + BON[(size_t)NLAT * 16 + (size_t)row * 16 + hh];
    int col = hh * 64 + sub * 8;
    uint4 vv = *(const uint4*)(Vp + (size_t)row * DM + col);
    uint4 gg = *(const uint4*)(G + (size_t)row * DM + col);
    float vf[8] = {bflo(vv.x), bfhi(vv.x), bflo(vv.y), bfhi(vv.y), bflo(vv.z), bfhi(vv.z), bflo(vv.w), bfhi(vv.w)};
    float gf[8] = {bflo(gg.x), bfhi(gg.x), bflo(gg.y), bfhi(gg.y), bflo(gg.z), bfhi(gg.z), bflo(gg.w), bfhi(gg.w)};
    float z[8];
#pragma unroll
    for (int e = 0; e < 8; ++e) z[e] = (y[e] * rs * p.in[29][col + e] + p.in[30][col + e] + bonus * vf[e]) * gf[e];
    uint4 ov; ov.x = pack2(z[0], z[1]); ov.y = pack2(z[2], z[3]); ov.z = pack2(z[4], z[5]); ov.w = pack2(z[6], z[7]);
    *(uint4*)(Z + (size_t)row * DM + col) = ov;
  }
}

__device__ __forceinline__ bool xcd_tile(int k, int Tm, int Tn, int& mt, int& nt) {
  const int x = blockIdx.x & 7, j = blockIdx.x >> 3, J = gridDim.x >> 3;
  const int u = j + J * k;
  if (u >= (Tm >> 3) * Tn) return false;
  mt = (u / Tn) * 8 + x; nt = u % Tn;
  return true;
}

__device__ __forceinline__ void grid_barrier(unsigned* bar, unsigned target) {
#if defined(__HIP_DEVICE_COMPILE__)
  asm volatile("s_waitcnt vmcnt(0)" ::: "memory");
  __syncthreads();
  if (tid_() == 0) {
    __builtin_amdgcn_fence(__ATOMIC_RELEASE, "agent");
    __hip_atomic_fetch_add(bar, 1u, __ATOMIC_RELAXED, __HIP_MEMORY_SCOPE_AGENT);
    while (__hip_atomic_load(bar, __ATOMIC_RELAXED, __HIP_MEMORY_SCOPE_AGENT) < target) __builtin_amdgcn_s_sleep(1);
    __builtin_amdgcn_fence(__ATOMIC_ACQUIRE, "agent");
  }
  __syncthreads();
#endif
}

__global__ void __launch_bounds__(NT) fwd_kernel(P p) {
  extern __shared__ __attribute__((aligned(16))) char lds[];
  cg::grid_group grid = cg::this_grid();
  char* ws = p.ws;
  const float* mod0 = (const float*)(ws + O_MOD);
  const float* mod1 = mod0 + 9 * 6144;
  unsigned epoch = 0;
  for (int ph = p.ph_lo; ph < p.ph_hi; ++ph) {
    if (ph > p.ph_lo) {
      if (ph == p.ph_lo + 1) grid.sync();
      else { ++epoch; grid_barrier((unsigned*)(p.ws + O_BAR), epoch * gridDim.x); }
    }
    if (!((PHASE_MASK >> ph) & 1)) continue;
    const int nrep = ((REPEAT_MASK >> ph) & 1) ? 2 : 1;
    for (int rep = 0; rep < nrep; ++rep) {
    const bool dummy = rep + 1 < nrep;
    if (rep) grid.sync();
    switch (ph) {
      case 0: phase_prep(p, lds); break;
      case 1: phase_norm(p, p.in[0], p.in[2], p.in[6], 0, 0, TTOK, (u16*)(ws + O_XN)); break;
      case 2: {
        u16* hgg = (u16*)(ws + O_HGG); u16* Q = (u16*)(ws + O_Q); u16* KBp = (u16*)(ws + O_KB); u16* VT = (u16*)(ws + O_VT);
        for (int kq = 0, mt = 0, ntw = 0; xcd_tile(kq, 136, 10, mt, ntw); ++kq) {
          if (ntw < 8) {
            const int n0w = ntw * 256;
            u16* dbase; int dld;
            if (n0w < 1536) { dbase = hgg + n0w; dld = 1536; } else { dbase = Q + (n0w - 1536); dld = 512; }
            auto xf = [&](float v, int row, int col) -> float { return v; };
            auto dstf = [&](int row) -> u16* { return dbase + (size_t)row * dld; };
            gemm_tile256<false>((const u16*)(ws + O_XN), 1024, nullptr, (const u16*)(ws + O_WIN) + (size_t)n0w * 1024, 1024, 1024,
                                mt * 256, xf, dstf, (u16*)lds);
            continue;
          }
          int nt = 8 + ntw;
          int n0 = nt * 128;
          auto epi = [&](int row, int col, float v0, float v1, float v2, float v3) {
            int n = n0 + col;
            float v[4] = {v0, v1, v2, v3};
            if (n < 1536) {
#pragma unroll
              for (int j = 0; j < 4; ++j) hgg[(size_t)(row + j) * 1536 + n] = f2bf(v[j]);
            } else if (n < 2048) {
#pragma unroll
              for (int j = 0; j < 4; ++j) Q[(size_t)(row + j) * 512 + n - 1536] = f2bf(v[j]);
            } else if (n < 2176) {
#pragma unroll
              for (int j = 0; j < 4; ++j) KBp[(size_t)(row + j) * 128 + n - 2048] = f2bf(v[j]);
            } else {
              int kvh = (n - 2176) >> 6, d = (n - 2176) & 63;
              int b, pos;
              if (row < NLAT) { b = row >> 12; pos = 256 + (row & 4095); } else { b = (row - NLAT) >> 8; pos = (row - NLAT) & 255; }
              uint2 o; o.x = pack2(v0, v1); o.y = pack2(v2, v3);
              *(uint2*)(VT + ((size_t)((b * 2 + kvh) * 64 + d)) * 4352 + pos) = o;
            }
          };
          if (nt < 17) {
            u16* dbase; int dld;
            if (n0 < 1536) { dbase = hgg + n0; dld = 1536; } else if (n0 < 2048) { dbase = Q + (n0 - 1536); dld = 512; } else { dbase = KBp + (n0 - 2048); dld = 128; }
            auto xf = [&](float v, int row, int col) -> float { return v; };
            auto dstf = [&](int row) -> u16* { return dbase + (size_t)row * dld; };
            gemm_tile<false, 1>((const u16*)(ws + O_XN), 1024, nullptr, (const u16*)(ws + O_WIN) + (size_t)n0 * 1024, 1024, 1024,
                                mt * 256, xf, dstf, (u16*)lds);
          } else {
            gemm_tile<false, 0>((const u16*)(ws + O_XN), 1024, nullptr, (const u16*)(ws + O_WIN) + (size_t)n0 * 1024, 1024, 1024,
                                mt * 256, epi, 0, (u16*)lds);
          }
        }
      } break;
      case 3: phase_conv_qk(p); break;
      case 4: phase_attn(p, lds); break;
      case 5: {
        float* HC = (float*)(ws + O_HC);
        for (int kq = 0, mt = 0, nt = 0; xcd_tile(kq, 136, 8, mt, nt); ++kq) {
          int n0 = nt * 128;
          auto epi = [&](int row, int col, float v0, float v1, float v2, float v3) {
            int n = n0 + col;
            float v[4] = {v0, v1, v2, v3};
#pragma unroll
            for (int j = 0; j < 4; ++j) {
              int rw = row + j;
              if (rw < NLAT) {
                float g = mod0[(rw >> 12) * 6144 + 2048 + n];
                p.out[(size_t)rw * DM + n] = p.in[0][(size_t)rw * DM + n] + g * v[j];
              } else {
                float g = mod0[8 * 6144 + 2048 + n];
                HC[(size_t)(rw - NLAT) * DM + n] = p.in[2][(size_t)(rw - NLAT) * DM + n] + g * v[j];
              }
            }
          };
          gemm_tile<false, 0>((const u16*)(ws + O_XN), 1024, nullptr, (const u16*)(ws + O_WOUT) + (size_t)n0 * 1024, 1024, 1024,
                              mt * 256, epi, 0, (u16*)lds);
        }
      } break;
      case 6: phase_norm(p, p.out, (const float*)(ws + O_HC), p.in[7], 0, 3, TTOK, (u16*)(ws + O_XN)); break;
      case 7: case 18: {
        int layer = ph == 7 ? 0 : 1;
        int mtiles = layer == 0 ? 136 : 128;
        u16* PQ = (u16*)(ws + (layer == 0 ? O_PQ0 : O_PQ1));
        const u16* Wq = (const u16*)(ws + O_WQ) + (size_t)layer * 2048 * 1024;
        for (int kq = 0, mt = 0, nt = 0; xcd_tile(kq, mtiles, 8, mt, nt); ++kq) {
          int n0 = nt * 256;
          auto epi = [&](int row, int col, float v0, float v1, float v2, float v3) {
            int n = n0 + col;
            float v[4] = {v0, v1, v2, v3};
#pragma unroll
            for (int j = 0; j < 4; ++j) PQ[(size_t)(row + j) * 2048 + n] = f2bf(v[j]);
          };
          auto xf = [&](float v, int row, int col) -> float { return v; };
          auto dstf = [&](int row) -> u16* { return PQ + (size_t)row * 2048 + n0; };
          gemm_tile256<false>((const u16*)(ws + O_XN), 1024, nullptr, Wq + (size_t)n0 * 1024, 1024, 1024, mt * 256, xf, dstf, (u16*)lds);
        }
      } break;
      case 8: phase_peer_topk(p, 0, (const u16*)(ws + O_PQ0), TTOK, (int*)(ws + O_IDX0), (float*)(ws + O_GATE0), lds); break;
      case 9: phase_peer_act(p, (const u16*)(ws + O_XN), ws + O_TAB0, (const int*)(ws + O_IDX0), (const float*)(ws + O_GATE0),
                             (float*)(ws + O_COEF0), TTOK, lds); break;
      case 10: phase_peer_sum(p, 0, ws + O_TAB0, (const int*)(ws + O_IDX0), (const float*)(ws + O_COEF0), TTOK, dummy ? (float*)(ws + O_A2R) : nullptr); break;
      case 11: phase_norm(p, p.out, (const float*)(ws + O_HC), p.in[6] + 1024, 1, 0, TTOK, (u16*)(ws + O_XN)); break;
      case 12: {
        u16* LORA = (u16*)(ws + O_LORA);
        for (int kq = 0;; ++kq) {
          const int u = (blockIdx.x >> 3) + (gridDim.x >> 3) * kq;
          if (u >= 17 * 27) break;
          int mt, nt;
          if (u < 408) { int g = u / 136, rem = u % 136; mt = (rem >> 3) * 8 + (blockIdx.x & 7); nt = g * 8 + (rem & 7); }
          else { int v2 = u - 408; mt = (v2 / 3) * 8 + (blockIdx.x & 7); nt = 24 + v2 % 3; }
          const u16* Bp; int mixi; u16* dstp = nullptr; int kind;
          if (nt < 8) { Bp = (const u16*)(ws + O_WR) + (size_t)nt * 128 * 1024; mixi = 0; dstp = (u16*)(ws + O_R) + nt * 128; kind = 0; }
          else if (nt < 16) { Bp = (const u16*)(ws + O_WK) + (size_t)(nt - 8) * 128 * 1024; mixi = 2; dstp = (u16*)(ws + O_K) + (nt - 8) * 128; kind = 0; }
          else if (nt < 24) { Bp = (const u16*)(ws + O_WV) + (size_t)(nt - 16) * 128 * 1024; mixi = 3; dstp = (u16*)(ws + O_V) + (nt - 16) * 128; kind = 0; }
          else if (nt == 24) { Bp = (const u16*)(ws + O_W1); mixi = 1; kind = 1; }
          else if (nt == 25) { Bp = (const u16*)(ws + O_A1); mixi = 4; kind = 2; }
          else { Bp = (const u16*)(ws + O_G1); mixi = 5; kind = 3; }
          auto epi = [&](int row, int col, float v0, float v1, float v2, float v3) {
            float v[4] = {v0, v1, v2, v3};
            if (kind == 0) {
#pragma unroll
              for (int j = 0; j < 4; ++j) dstp[(size_t)(row + j) * 1024 + col] = f2bf(v[j]);
            } else if (kind == 1) {
#pragma unroll
              for (int j = 0; j < 4; ++j) LORA[(size_t)(row + j) * 384 + col] = f2bf(tanhf(v[j]));
            } else if (kind == 2) {
#pragma unroll
              for (int j = 0; j < 4; ++j) LORA[(size_t)(row + j) * 384 + 128 + col] = f2bf(v[j]);
            } else {
#pragma unroll
              for (int j = 0; j < 4; ++j) LORA[(size_t)(row + j) * 384 + 256 + col] = f2bf(sigmoidf_(v[j]));
            }
          };
          auto xf = [&](float v, int row, int col) -> float { return kind == 1 ? tanhf(v) : (kind == 3 ? sigmoidf_(v) : v); };
          u16* dbase = kind == 0 ? dstp : (LORA + (kind - 1) * 128);
          const int dld = kind == 0 ? 1024 : 384;
          auto dstf = [&](int row) -> u16* { return dbase + (size_t)row * dld; };
          gemm_tile<true, 1>((const u16*)(ws + O_XN), 1024, p.in[13] + mixi * 1024, Bp, 1024, 1024, mt * 256, xf, dstf, (u16*)lds);
        }
      } break;
      case 13: {
        const u16* LORA = (const u16*)(ws + O_LORA);
        u16* G = (u16*)(ws + O_G);
        for (int t = blockIdx.x; t < 136 * 40; t += gridDim.x) {
          int mt = t / 40, nt = t % 40;
          int grp = nt >> 3, n0 = (nt & 7) * 128;
          const u16* Ap; const u16* Bp; int K, ldb;
          if (grp < 2) { Ap = LORA + grp * 64; Bp = (const u16*)(ws + O_W2) + (size_t)grp * 65536 + (size_t)n0 * 64; K = 64; ldb = 64; }
          else if (grp < 4) { Ap = LORA + 128 + (grp - 2) * 64; Bp = (const u16*)(ws + O_A2) + (size_t)(grp - 2) * 65536 + (size_t)n0 * 64; K = 64; ldb = 64; }
          else { Ap = LORA + 256; Bp = (const u16*)(ws + O_G2) + (size_t)n0 * 128; K = 128; ldb = 128; }
          int d = grp & 1;
          u8* WA = (u8*)(ws + (d ? O_WA1 : O_WA0));
          auto epi = [&](int row, int col, float v0, float v1, float v2, float v3) {
            int n = n0 + col;
            float v[4] = {v0, v1, v2, v3};
            if (grp < 2) {
              float w0 = p.in[23][d * 1024 + n];
#pragma unroll
              for (int j = 0; j < 4; ++j) {
                float x = w0 + v[j];
                float dec = __expf(-0.6065306597126334f * sigmoidf_(x));
                float q = rintf((dec - 0.5f) * 510.f);
                q = fminf(fmaxf(q, 0.f), 255.f);
                WA[(size_t)(row + j) * 2048 + (n >> 6) * 128 + (n & 63)] = (u8)q;
              }
            } else if (grp < 4) {
              float a0 = p.in[26][d * 1024 + n];
#pragma unroll
              for (int j = 0; j < 4; ++j) {
                float a = sigmoidf_(a0 + v[j]);
                float q = fminf(fmaxf(rintf(a * 255.f), 0.f), 255.f);
                WA[(size_t)(row + j) * 2048 + (n >> 6) * 128 + 64 + (n & 63)] = (u8)q;
              }
            } else {
#pragma unroll
              for (int j = 0; j < 4; ++j) G[(size_t)(row + j) * 1024 + n] = f2bf(v[j]);
            }
          };
          if (grp < 4) {
            const float* b0p = (grp < 2 ? p.in[23] : p.in[26]) + d * 1024 + n0;
            auto q8 = [&](float v, int row, int col) -> unsigned {
              float x = b0p[col] + v;
              float qv;
              if (grp < 2) { float dec = __expf(-0.6065306597126334f * sigmoidf_(x)); qv = rintf((dec - 0.5f) * 510.f); }
              else { qv = rintf(sigmoidf_(x) * 255.f); }
              return (unsigned)fminf(fmaxf(qv, 0.f), 255.f);
            };
            auto dst8 = [&](int row, int c16) -> u8* {
              int n = n0 + c16 * 16;
              return WA + (size_t)row * 2048 + (n >> 6) * 128 + (grp < 2 ? 0 : 64) + (n & 63);
            };
            gemm_tile<false, 2>(Ap, 384, nullptr, Bp, ldb, K, mt * 256, q8, dst8, (u16*)lds);
          } else {
            auto xf = [&](float v, int row, int col) -> float { return v; };
            auto dstf = [&](int row) -> u16* { return G + (size_t)row * 1024 + n0; };
            gemm_tile<false, 1>(Ap, 384, nullptr, Bp, ldb, K, mt * 256, xf, dstf, (u16*)lds);
          }
        }
      } break;
      case 14: phase_scan(p, lds, dummy); break;
      case 15:
        phase_readout(p);
        convert_tab_fp8(p.in[33] + (size_t)16384 * 1024, p.in[34] + (size_t)16384 * 1024, ws + O_TAB1);
        break;
      case 16: {
        for (int kq = 0, mt = 0, nt = 0; xcd_tile(kq, 128, 8, mt, nt); ++kq) {
          int n0 = nt * 128;
          auto epi = [&](int row, int col, float v0, float v1, float v2, float v3) {
            int n = n0 + col;
            float v[4] = {v0, v1, v2, v3};
#pragma unroll
            for (int j = 0; j < 4; ++j) {
              int rw = row + j;
              float g = mod1[(rw >> 12) * 6144 + 2048 + n];
              p.out[(size_t)rw * DM + n] += g * v[j];
            }
          };
          gemm_tile<false, 0>((const u16*)(ws + O_Z), 1024, nullptr, (const u16*)(ws + O_WO) + (size_t)n0 * 1024, 1024, 1024,
                              mt * 256, epi, 0, (u16*)lds);
        }
      } break;
      case 17: phase_norm(p, p.out, nullptr, p.in[7] + 1024, 1, 3, NLAT, (u16*)(ws + O_XN)); break;
      case 19: phase_peer_topk(p, 1, (const u16*)(ws + O_PQ1), NLAT, (int*)(ws + O_IDX1), (float*)(ws + O_GATE1), lds); break;
      case 20: phase_peer_act(p, (const u16*)(ws + O_XN), ws + O_TAB1, (const int*)(ws + O_IDX1), (const float*)(ws + O_GATE1),
                              (float*)(ws + O_COEF1), NLAT, lds); break;
      case 21: phase_peer_sum(p, 1, ws + O_TAB1, (const int*)(ws + O_IDX1), (const float*)(ws + O_COEF1), NLAT, dummy ? (float*)(ws + O_A5R) : nullptr); break;
      default: break;
    }
    }
  }
}

extern "C" void kernel_launch(void* const* d_in, const int* in_sizes, int n_in, void* d_out, int out_size, void* d_ws,
                              size_t ws_size, hipStream_t stream) {
  static int grid = 0;
  if (grid == 0) {
    if (n_in != 35 || ws_size < WS_END) {
      fprintf(stderr, "kernel_launch: unexpected n_in %d or ws_size %zu (need %zu)\n", n_in, ws_size, (size_t)WS_END);
      grid = -1;
      return;
    }
    int dev = 0, cus = 0, per_cu = 0;
    hipGetDevice(&dev);
    hipDeviceGetAttribute(&cus, hipDeviceAttributeMultiprocessorCount, dev);
    hipFuncSetAttribute((const void*)fwd_kernel, hipFuncAttributeMaxDynamicSharedMemorySize, LDS_BYTES);
    hipOccupancyMaxActiveBlocksPerMultiprocessor(&per_cu, (const void*)fwd_kernel, NT, LDS_BYTES);
    (void)hipGetLastError();
    if (per_cu < 1) per_cu = 1;
    grid = (cus / 8) * 8;
    if (grid > cus * per_cu) grid = cus * per_cu;
  }
  if (grid < 0) return;
  P p{};
  for (int i = 0; i < 35; ++i) p.in[i] = (const float*)d_in[i];
  p.out = (float*)d_out;
  p.ws = (char*)d_ws;
#if N_LAUNCH_MODE == 0
  (void)hipMemsetAsync((char*)d_ws + O_BAR, 0, 256, stream);
  p.ph_lo = 0; p.ph_hi = NPHASE;
  void* args[] = {&p};
  hipError_t e = hipLaunchCooperativeKernel((const void*)fwd_kernel, dim3(grid), dim3(NT), args, LDS_BYTES, stream);
  if (e != hipSuccess) fprintf(stderr, "cooperative launch failed: %s (grid %d)\n", hipGetErrorString(e), grid);
#else
  for (int ph = 0; ph < NPHASE; ++ph) {
    p.ph_lo = ph; p.ph_hi = ph + 1;
    hipLaunchKernelGGL(fwd_kernel, dim3(grid), dim3(NT), LDS_BYTES, stream, p);
  }
#endif
}
```

```cpp
#include <hip/hip_runtime.h>
#include <hip/hip_cooperative_groups.h>
#include <cstdio>
namespace cg = cooperative_groups;

#ifndef N_LAUNCH_MODE
#define N_LAUNCH_MODE 0
#endif

typedef unsigned short u16;
typedef unsigned char u8;
typedef __attribute__((ext_vector_type(8))) short bf16x8;
typedef __attribute__((ext_vector_type(16))) float f32x16;

#define NT 512
#define TTOK 34816
#define NLAT 32768
#define DM 1024
#define LDSS 72
#define LDS_BYTES 149504
#define NPHASE 22
#ifndef REPEAT_MASK
#define REPEAT_MASK 0
#endif
#ifndef PHASE_MASK
#define PHASE_MASK 0x3FFFFF
#endif

static constexpr size_t MiB = 1048576;
static constexpr size_t O_WIN = 0;
static constexpr size_t O_WOUT = O_WIN + 4718592;
static constexpr size_t O_WR = O_WOUT + 2097152;
static constexpr size_t O_WK = O_WR + 2097152;
static constexpr size_t O_WV = O_WK + 2097152;
static constexpr size_t O_WO = O_WV + 2097152;
static constexpr size_t O_G1 = O_WO + 2097152;
static constexpr size_t O_G2 = O_G1 + 262144;
static constexpr size_t O_W1 = O_G2 + 262144;
static constexpr size_t O_A1 = O_W1 + 262144;
static constexpr size_t O_W2 = O_A1 + 262144;
static constexpr size_t O_A2 = O_W2 + 262144;
static constexpr size_t O_WQ = O_A2 + 262144;
static constexpr size_t O_KEYS = O_WQ + 8388608;
static constexpr size_t O_MOD = O_KEYS + 1048576;
static constexpr size_t O_ROPE = O_MOD + 442368;
static constexpr size_t SZ = 68 * MiB;
static constexpr size_t O_A1R = 26 * MiB;
static constexpr size_t O_A2R = O_A1R + SZ;
static constexpr size_t O_A3R = O_A2R + SZ;
static constexpr size_t O_A4R = O_A3R + SZ;
static constexpr size_t O_A5R = O_A4R + SZ;
static constexpr size_t O_A6R = O_A5R + SZ;
static constexpr size_t O_A7R = O_A6R + SZ;
static constexpr size_t O_LORA = O_A7R;
static constexpr size_t O_BONUS = O_A7R + 26 * MiB;
static constexpr size_t O_BAR = O_BONUS + 4 * MiB;
static constexpr size_t WS_END = O_BAR + 1 * MiB;
static constexpr size_t O_XN = O_A1R;
static constexpr size_t O_HGG = O_A2R;
static constexpr size_t O_Q = O_A2R + 102 * MiB;
static constexpr size_t O_KB = O_A4R;
static constexpr size_t O_VT = O_A4R + 9 * MiB;
static constexpr size_t O_PQ0 = O_A2R;
static constexpr size_t O_TAB0 = O_A5R;
static constexpr size_t O_IDX0 = O_A6R;
static constexpr size_t O_GATE0 = O_A6R + 17 * MiB;
static constexpr size_t O_HC = O_A6R + 34 * MiB;
static constexpr size_t O_COEF0 = O_A6R + 42 * MiB;
static constexpr size_t O_R = O_A2R, O_K = O_A3R, O_V = O_A4R;
static constexpr size_t O_WA0 = O_A5R, O_WA1 = O_A6R;
static constexpr size_t O_G = O_A1R;
static constexpr size_t O_Z = O_A2R;
static constexpr size_t O_TAB1 = O_A3R;
static constexpr size_t O_PQ1 = O_A5R;
static constexpr size_t O_IDX1 = O_A4R;
static constexpr size_t O_GATE1 = O_A4R + 17 * MiB;
static constexpr size_t O_COEF1 = O_A4R + 34 * MiB;

struct P {
  const float* in[35];
  float* out;
  char* ws;
  int ph_lo, ph_hi;
};

typedef __bf16 bf16x2_t __attribute__((ext_vector_type(2)));
typedef float f32x2_t __attribute__((ext_vector_type(2)));
__device__ __forceinline__ u16 f2bf(float f) {
  __bf16 b = (__bf16)f;
  return __builtin_bit_cast(u16, b);
}
__device__ __forceinline__ float bf2f(u16 h) { return __uint_as_float(((unsigned)h) << 16); }
__device__ __forceinline__ float bflo(unsigned w) { return __uint_as_float(w << 16); }
__device__ __forceinline__ float bfhi(unsigned w) { return __uint_as_float(w & 0xFFFF0000u); }
__device__ __forceinline__ unsigned pack2(float a, float b) { f32x2_t v = {a, b}; bf16x2_t r = __builtin_convertvector(v, bf16x2_t); return __builtin_bit_cast(unsigned, r); }

__device__ __forceinline__ int tid_() { int t = __builtin_amdgcn_workitem_id_x(); asm volatile("" : "+v"(t)); return t; }
template <int CTRL>
__device__ __forceinline__ float dppf(float v) {
  return __builtin_bit_cast(float, __builtin_amdgcn_update_dpp(0, __builtin_bit_cast(int, v), CTRL, 0xF, 0xF, true));
}
__device__ __forceinline__ float red8(float v) {
  v += dppf<0xB1>(v); v += dppf<0x4E>(v); v += dppf<0x141>(v); return v;
}
__device__ __forceinline__ float red16(float v) { v = red8(v); v += dppf<0x140>(v); return v; }
__device__ __forceinline__ float swapsum32(float a, float b) {
  auto r = __builtin_amdgcn_permlane32_swap(__float_as_uint(a), __float_as_uint(b), false, false);
  return __uint_as_float(r[0]) + __uint_as_float(r[1]);
}
__device__ __forceinline__ float swapsum16(float a, float b) {
  auto r = __builtin_amdgcn_permlane16_swap(__float_as_uint(a), __float_as_uint(b), false, false);
  return __uint_as_float(r[0]) + __uint_as_float(r[1]);
}
__device__ __forceinline__ float swapmax32(float a) {
  auto r = __builtin_amdgcn_permlane32_swap(__float_as_uint(a), __float_as_uint(a), false, false);
  return fmaxf(__uint_as_float(r[0]), __uint_as_float(r[1]));
}
__device__ __forceinline__ float swapmax16(float a) {
  auto r = __builtin_amdgcn_permlane16_swap(__float_as_uint(a), __float_as_uint(a), false, false);
  return fmaxf(__uint_as_float(r[0]), __uint_as_float(r[1]));
}
__device__ __forceinline__ float wave_sum(float v) {
  v = red16(v);
  v = swapsum16(v, v); v = swapsum32(v, v);
  return v;
}
__device__ __forceinline__ float sigmoidf_(float x) { return 1.f / (1.f + __expf(-x)); }

template <bool MIX, int OM, class Epi, class Dst>
__device__ __forceinline__ void gemm_tile(const u16* __restrict__ A, int lda, const float* __restrict__ mu,
                                          const u16* __restrict__ B, int ldb, int K, int row0, Epi epi, Dst dstf, u16* lds) {
  u16* sA = lds;
  u16* sB = lds + 256 * LDSS;
  const int tid = tid_(), lane = tid & 63, wave = tid >> 6;
  const int wm = wave & 3, wn = wave >> 2;
  const int r = lane & 31, h = lane >> 5;
  const int kc = tid & 7, lr = tid >> 3;
  f32x16 acc[2][2];
#pragma unroll
  for (int i = 0; i < 2; ++i)
#pragma unroll
    for (int j = 0; j < 2; ++j)
#pragma unroll
      for (int g = 0; g < 16; ++g) acc[i][j][g] = 0.f;
  uint4 pa0, pa1, pa2, pa3, ps0, ps1, ps2, ps3, pb0, pb1;
  ps0 = ps1 = ps2 = ps3 = make_uint4(0, 0, 0, 0);
  float4 m0 = make_float4(0, 0, 0, 0), m1 = m0;
  auto nbr = [&](int row, int kg) -> int {
    if (row < NLAT) {
      int t = row & 4095; int gc = t & 63, gr = t >> 6; int qd = kg >> 8;
      if (qd == 0) return gc > 0 ? row - 1 : -1;
      if (qd == 1) return gc < 63 ? row + 1 : -1;
      if (qd == 2) return gr > 0 ? row - 64 : -1;
      return gr < 63 ? row + 64 : -1;
    } else {
      int t = (row - NLAT) & 255;
      if (kg < 512) return t > 0 ? row - 1 : -1;
      return t < 255 ? row + 1 : -1;
    }
  };
  auto ldA = [&](int i, int k0, uint4& a, uint4& sx) {
    int row = row0 + lr + 64 * i;
    a = *(const uint4*)(A + (size_t)row * lda + k0 + kc * 8);
    if (MIX) {
      int nr = nbr(row, k0 + kc * 8);
      if (nr >= 0) sx = *(const uint4*)(A + (size_t)nr * lda + k0 + kc * 8);
      else sx = make_uint4(0, 0, 0, 0);
    }
  };
  auto gload = [&](int k0) {
    ldA(0, k0, pa0, ps0); ldA(1, k0, pa1, ps1); ldA(2, k0, pa2, ps2); ldA(3, k0, pa3, ps3);
    if (MIX) {
      m0 = *(const float4*)(mu + k0 + kc * 8);
      m1 = *(const float4*)(mu + k0 + kc * 8 + 4);
    }
    pb0 = *(const uint4*)(B + (size_t)lr * ldb + k0 + kc * 8);
    pb1 = *(const uint4*)(B + (size_t)(lr + 64) * ldb + k0 + kc * 8);
  };
  auto mixw = [&](unsigned x, unsigned s, float ma, float mb) -> unsigned {
    float x0 = bflo(x), x1 = bfhi(x), s0 = bflo(s), s1 = bfhi(s);
    return pack2(x0 + (s0 - x0) * ma, x1 + (s1 - x1) * mb);
  };
  int bo = 0;
  auto stA = [&](int i, uint4 a, uint4 sx) {
    uint4 v = a;
    if (MIX) {
      v.x = mixw(a.x, sx.x, m0.x, m0.y);
      v.y = mixw(a.y, sx.y, m0.z, m0.w);
      v.z = mixw(a.z, sx.z, m1.x, m1.y);
      v.w = mixw(a.w, sx.w, m1.z, m1.w);
    }
    *(uint4*)(sA + bo + (lr + 64 * i) * LDSS + kc * 8) = v;
  };
  auto lstore = [&]() {
    stA(0, pa0, ps0); stA(1, pa1, ps1); stA(2, pa2, ps2); stA(3, pa3, ps3);
    *(uint4*)(sB + bo + lr * LDSS + kc * 8) = pb0;
    *(uint4*)(sB + bo + (lr + 64) * LDSS + kc * 8) = pb1;
  };
  constexpr int BUFE = (256 + 128) * LDSS;
  gload(0);
  bo = 0; lstore();
  if (64 < K) gload(64);
  __syncthreads();
  for (int k0 = 0; k0 < K; k0 += 64) {
    const int co = ((k0 >> 6) & 1) * BUFE;
    bf16x8 af[2], bfr[2], naf[2], nbf[2];
#pragma unroll
    for (int i = 0; i < 2; ++i) af[i] = *(const bf16x8*)(sA + co + (wm * 64 + i * 32 + r) * LDSS + h * 8);
#pragma unroll
    for (int j = 0; j < 2; ++j) bfr[j] = *(const bf16x8*)(sB + co + (wn * 64 + j * 32 + r) * LDSS + h * 8);
#pragma unroll
    for (int kk = 0; kk < 4; ++kk) {
      if (kk == 2 && k0 + 64 < K) {
        bo = BUFE - co; lstore();
        if (k0 + 128 < K) gload(k0 + 128);
      }
      if (kk < 3) {
#pragma unroll
        for (int i = 0; i < 2; ++i) naf[i] = *(const bf16x8*)(sA + co + (wm * 64 + i * 32 + r) * LDSS + (kk + 1) * 16 + h * 8);
#pragma unroll
        for (int j = 0; j < 2; ++j) nbf[j] = *(const bf16x8*)(sB + co + (wn * 64 + j * 32 + r) * LDSS + (kk + 1) * 16 + h * 8);
      }
#pragma unroll
      for (int i = 0; i < 2; ++i)
#pragma unroll
        for (int j = 0; j < 2; ++j) {
          if (OM == 0) acc[i][j] = __builtin_amdgcn_mfma_f32_32x32x16_bf16(af[i], bfr[j], acc[i][j], 0, 0, 0);
          else acc[i][j] = __builtin_amdgcn_mfma_f32_32x32x16_bf16(bfr[j], af[i], acc[i][j], 0, 0, 0);
        }
      if (kk < 3) {
#pragma unroll
        for (int i = 0; i < 2; ++i) af[i] = naf[i];
#pragma unroll
        for (int j = 0; j < 2; ++j) bfr[j] = nbf[j];
      }
    }
    __syncthreads();
  }
  if constexpr (OM == 0) {
#pragma unroll
    for (int i = 0; i < 2; ++i)
#pragma unroll
      for (int j = 0; j < 2; ++j)
#pragma unroll
        for (int g4 = 0; g4 < 4; ++g4) {
          int row = row0 + wm * 64 + i * 32 + 8 * g4 + 4 * h;
          int col = wn * 64 + j * 32 + r;
          epi(row, col, acc[i][j][g4 * 4 + 0], acc[i][j][g4 * 4 + 1], acc[i][j][g4 * 4 + 2], acc[i][j][g4 * 4 + 3]);
        }
  } else if constexpr (OM == 1) {
    u16* st = lds;
#pragma unroll
    for (int i = 0; i < 2; ++i)
#pragma unroll
      for (int j = 0; j < 2; ++j)
#pragma unroll
        for (int g4 = 0; g4 < 4; ++g4) {
          const int rl = wm * 64 + i * 32 + r, c0 = wn * 64 + j * 32 + 8 * g4 + 4 * h;
          uint2 o;
          o.x = pack2(epi(acc[i][j][g4 * 4 + 0], row0 + rl, c0 + 0), epi(acc[i][j][g4 * 4 + 1], row0 + rl, c0 + 1));
          o.y = pack2(epi(acc[i][j][g4 * 4 + 2], row0 + rl, c0 + 2), epi(acc[i][j][g4 * 4 + 3], row0 + rl, c0 + 3));
          *(uint2*)(st + rl * 136 + c0) = o;
        }
    __syncthreads();
#pragma unroll
    for (int q = 0; q < 8; ++q) {
      const int id = tid + NT * q, rl = id >> 4, c8 = id & 15;
      const uint4 v = *(const uint4*)(st + rl * 136 + c8 * 8);
      *(uint4*)(dstf(row0 + rl) + c8 * 8) = v;
    }
    __syncthreads();
  } else {
    u8* st = (u8*)lds;
#pragma unroll
    for (int i = 0; i < 2; ++i)
#pragma unroll
      for (int j = 0; j < 2; ++j)
#pragma unroll
        for (int g4 = 0; g4 < 4; ++g4) {
          const int rl = wm * 64 + i * 32 + r, c0 = wn * 64 + j * 32 + 8 * g4 + 4 * h;
          unsigned o = epi(acc[i][j][g4 * 4 + 0], row0 + rl, c0 + 0) | (epi(acc[i][j][g4 * 4 + 1], row0 + rl, c0 + 1) << 8) |
                       (epi(acc[i][j][g4 * 4 + 2], row0 + rl, c0 + 2) << 16) | (epi(acc[i][j][g4 * 4 + 3], row0 + rl, c0 + 3) << 24);
          *(unsigned*)(st + rl * 144 + c0) = o;
        }
    __syncthreads();
#pragma unroll
    for (int q = 0; q < 4; ++q) {
      const int id = tid + NT * q, rl = id >> 3, c16 = id & 7;
      const uint4 v = *(const uint4*)(st + rl * 144 + c16 * 16);
      *(uint4*)(dstf(row0 + rl, c16)) = v;
    }
    __syncthreads();
  }
}

template <bool MIX, class Epi, class Dst>
__device__ __forceinline__ void gemm_tile256(const u16* __restrict__ A, int lda, const float* __restrict__ mu,
                                             const u16* __restrict__ B, int ldb, int K, int row0, Epi epi, Dst dstf, u16* lds) {
  u16* sA = lds;
  u16* sB = lds + 256 * LDSS;
  const int tid = tid_(), lane = tid & 63, wave = tid >> 6;
  const int wm = wave & 1, wn = wave >> 1;
  const int r = lane & 31, h = lane >> 5;
  const int kc = tid & 7, lr = tid >> 3;
  f32x16 acc[4][2];
#pragma unroll
  for (int i = 0; i < 4; ++i)
#pragma unroll
    for (int j = 0; j < 2; ++j)
#pragma unroll
      for (int g = 0; g < 16; ++g) acc[i][j][g] = 0.f;
  uint4 pa0, pa1, pa2, pa3, ps0, ps1, ps2, ps3, pb0, pb1, pb2, pb3;
  ps0 = ps1 = ps2 = ps3 = make_uint4(0, 0, 0, 0);
  float4 m0 = make_float4(0, 0, 0, 0), m1 = m0;
  auto nbr = [&](int row, int kg) -> int {
    if (row < NLAT) {
      int t = row & 4095; int gc = t & 63, gr = t >> 6; int qd = kg >> 8;
      if (qd == 0) return gc > 0 ? row - 1 : -1;
      if (qd == 1) return gc < 63 ? row + 1 : -1;
      if (qd == 2) return gr > 0 ? row - 64 : -1;
      return gr < 63 ? row + 64 : -1;
    } else {
      int t = (row - NLAT) & 255;
      if (kg < 512) return t > 0 ? row - 1 : -1;
      return t < 255 ? row + 1 : -1;
    }
  };
  auto ldA = [&](int i, int k0, uint4& a, uint4& sx) {
    int row = row0 + lr + 64 * i;
    a = *(const uint4*)(A + (size_t)row * lda + k0 + kc * 8);
    if (MIX) {
      int nr = nbr(row, k0 + kc * 8);
      if (nr >= 0) sx = *(const uint4*)(A + (size_t)nr * lda + k0 + kc * 8);
      else sx = make_uint4(0, 0, 0, 0);
    }
  };
  auto gload = [&](int k0) {
    ldA(0, k0, pa0, ps0); ldA(1, k0, pa1, ps1); ldA(2, k0, pa2, ps2); ldA(3, k0, pa3, ps3);
    if (MIX) {
      m0 = *(const float4*)(mu + k0 + kc * 8);
      m1 = *(const float4*)(mu + k0 + kc * 8 + 4);
    }
    pb0 = *(const uint4*)(B + (size_t)lr * ldb + k0 + kc * 8);
    pb1 = *(const uint4*)(B + (size_t)(lr + 64) * ldb + k0 + kc * 8);
    pb2 = *(const uint4*)(B + (size_t)(lr + 128) * ldb + k0 + kc * 8);
    pb3 = *(const uint4*)(B + (size_t)(lr + 192) * ldb + k0 + kc * 8);
  };
  auto mixw = [&](unsigned x, unsigned s_, float ma, float mb) -> unsigned {
    float x0 = bflo(x), x1 = bfhi(x), s0 = bflo(s_), s1 = bfhi(s_);
    return pack2(x0 + (s0 - x0) * ma, x1 + (s1 - x1) * mb);
  };
  int bo = 0;
  auto stA = [&](int i, uint4 a, uint4 sx) {
    uint4 v = a;
    if (MIX) {
      v.x = mixw(a.x, sx.x, m0.x, m0.y);
      v.y = mixw(a.y, sx.y, m0.z, m0.w);
      v.z = mixw(a.z, sx.z, m1.x, m1.y);
      v.w = mixw(a.w, sx.w, m1.z, m1.w);
    }
    *(uint4*)(sA + bo + (lr + 64 * i) * LDSS + kc * 8) = v;
  };
  auto lstore = [&]() {
    stA(0, pa0, ps0); stA(1, pa1, ps1); stA(2, pa2, ps2); stA(3, pa3, ps3);
    *(uint4*)(sB + bo + lr * LDSS + kc * 8) = pb0;
    *(uint4*)(sB + bo + (lr + 64) * LDSS + kc * 8) = pb1;
    *(uint4*)(sB + bo + (lr + 128) * LDSS + kc * 8) = pb2;
    *(uint4*)(sB + bo + (lr + 192) * LDSS + kc * 8) = pb3;
  };
  constexpr int BUFE = 2 * 256 * LDSS;
  gload(0);
  bo = 0; lstore();
  if (64 < K) gload(64);
  __syncthreads();
  for (int k0 = 0; k0 < K; k0 += 64) {
    const int co = ((k0 >> 6) & 1) * BUFE;
    bf16x8 af[4], bfr[2], naf[4], nbf[2];
#pragma unroll
    for (int i = 0; i < 4; ++i) af[i] = *(const bf16x8*)(sA + co + (wm * 128 + i * 32 + r) * LDSS + h * 8);
#pragma unroll
    for (int j = 0; j < 2; ++j) bfr[j] = *(const bf16x8*)(sB + co + (wn * 64 + j * 32 + r) * LDSS + h * 8);
#pragma unroll
    for (int kk = 0; kk < 4; ++kk) {
      if (kk == 2 && k0 + 64 < K) {
        bo = BUFE - co; lstore();
        if (k0 + 128 < K) gload(k0 + 128);
      }
      if (kk < 3) {
#pragma unroll
        for (int i = 0; i < 4; ++i) naf[i] = *(const bf16x8*)(sA + co + (wm * 128 + i * 32 + r) * LDSS + (kk + 1) * 16 + h * 8);
#pragma unroll
        for (int j = 0; j < 2; ++j) nbf[j] = *(const bf16x8*)(sB + co + (wn * 64 + j * 32 + r) * LDSS + (kk + 1) * 16 + h * 8);
      }
#pragma unroll
      for (int i = 0; i < 4; ++i)
#pragma unroll
        for (int j = 0; j < 2; ++j) acc[i][j] = __builtin_amdgcn_mfma_f32_32x32x16_bf16(bfr[j], af[i], acc[i][j], 0, 0, 0);
      if (kk < 3) {
#pragma unroll
        for (int i = 0; i < 4; ++i) af[i] = naf[i];
#pragma unroll
        for (int j = 0; j < 2; ++j) bfr[j] = nbf[j];
      }
    }
    __syncthreads();
  }
  u16* st = lds;
#pragma unroll
  for (int half = 0; half < 2; ++half) {
    if ((wn >> 1) == half) {
#pragma unroll
      for (int i = 0; i < 4; ++i)
#pragma unroll
        for (int j = 0; j < 2; ++j)
#pragma unroll
          for (int g4 = 0; g4 < 4; ++g4) {
            const int rl = wm * 128 + i * 32 + r, cl = (wn & 1) * 64 + j * 32 + 8 * g4 + 4 * h, c0 = half * 128 + cl;
            uint2 o;
            o.x = pack2(epi(acc[i][j][g4 * 4 + 0], row0 + rl, c0 + 0), epi(acc[i][j][g4 * 4 + 1], row0 + rl, c0 + 1));
            o.y = pack2(epi(acc[i][j][g4 * 4 + 2], row0 + rl, c0 + 2), epi(acc[i][j][g4 * 4 + 3], row0 + rl, c0 + 3));
            *(uint2*)(st + rl * 136 + cl) = o;
          }
    }
    __syncthreads();
#pragma unroll
    for (int q = 0; q < 8; ++q) {
      const int id = tid + NT * q, rl = id >> 4, c8 = id & 15;
      const uint4 v = *(const uint4*)(st + rl * 136 + c8 * 8);
      *(uint4*)(dstf(row0 + rl) + half * 128 + c8 * 8) = v;
    }
    __syncthreads();
  }
}

__constant__ int TJOBS[18][5] = {
    {8, 0, 1024, 2304, (int)O_WIN},
    {12, 0, 1024, 1024, (int)O_WOUT},
    {14, 0, 1024, 1024, (int)O_WR},
    {15, 0, 1024, 1024, (int)O_WK},
    {16, 0, 1024, 1024, (int)O_WV},
    {17, 0, 1024, 1024, (int)O_WO},
    {18, 0, 1024, 128, (int)O_G1},
    {19, 0, 128, 1024, (int)O_G2},
    {24, 0, 1024, 64, (int)O_W1},
    {24, 65536, 1024, 64, (int)(O_W1 + 131072)},
    {27, 0, 1024, 64, (int)O_A1},
    {27, 65536, 1024, 64, (int)(O_A1 + 131072)},
    {25, 0, 64, 1024, (int)O_W2},
    {25, 65536, 64, 1024, (int)(O_W2 + 131072)},
    {28, 0, 64, 1024, (int)O_A2},
    {28, 65536, 64, 1024, (int)(O_A2 + 131072)},
    {31, 0, 1024, 2048, (int)O_WQ},
    {31, 2097152, 1024, 2048, (int)(O_WQ + 4194304)},
};

__device__ __forceinline__ void convert_bf16(const float* __restrict__ src, u16* __restrict__ dst, size_t n) {
  size_t n4 = n >> 2;
  for (size_t i = (size_t)blockIdx.x * NT + tid_(); i < n4; i += (size_t)gridDim.x * NT) {
    float4 v = ((const float4*)src)[i];
    uint2 o; o.x = pack2(v.x, v.y); o.y = pack2(v.z, v.w);
    ((uint2*)dst)[i] = o;
  }
}

__device__ __forceinline__ void convert_tab_fp8(const float* __restrict__ U, const float* __restrict__ V, char* tab);
__device__ __forceinline__ void phase_prep(const P& p, char* lds) {
  const int tid = tid_();
  float* fl = (float*)lds;
  for (int task = blockIdx.x; task < 192; task += gridDim.x) {
    int l = task / 96, cg_ = task % 96;
    float* sv = fl;
    float* red = fl + 9216;
    for (int i = tid; i < 9216; i += NT) {
      int v = i >> 10, k = i & 1023;
      float x = v < 8 ? p.in[1][v * 1024 + k] : p.in[3][k];
      sv[i] = x / (1.f + __expf(-x));
    }
    __syncthreads();
    int col = cg_ * 64 + (tid & 63), kg = tid >> 6;
    float acc[9];
#pragma unroll
    for (int v = 0; v < 9; ++v) acc[v] = 0.f;
    const float* W = p.in[4] + (size_t)l * 1024 * 6144 + col;
    for (int k = kg * 128; k < kg * 128 + 128; ++k) {
      float w = W[(size_t)k * 6144];
#pragma unroll
      for (int v = 0; v < 9; ++v) acc[v] += sv[v * 1024 + k] * w;
    }
#pragma unroll
    for (int v = 0; v < 9; ++v) red[(kg * 9 + v) * 64 + (tid & 63)] = acc[v];
    __syncthreads();
    if (tid < 576) {
      int v = tid >> 6, c = tid & 63;
      float s = p.in[5][l * 6144 + cg_ * 64 + c];
#pragma unroll
      for (int g = 0; g < 8; ++g) s += red[(g * 9 + v) * 64 + c];
      ((float*)(p.ws + O_MOD))[(l * 9 + v) * 6144 + cg_ * 64 + c] = s;
    }
    __syncthreads();
  }
  {
    int base = 0;
    for (int j = 0; j < 18; ++j) {
      int K = TJOBS[j][2], N = TJOBS[j][3];
      int tk = K >> 6, tn = N >> 6, nt = tk * tn;
      const float* src = p.in[TJOBS[j][0]] + TJOBS[j][1];
      u16* dst = (u16*)(p.ws + (size_t)(unsigned)TJOBS[j][4]);
      int first = (blockIdx.x + gridDim.x - (base % gridDim.x)) % gridDim.x;
      for (int t = first; t < nt; t += gridDim.x) {
        int k0 = (t / tn) * 64, n0 = (t % tn) * 64;
#pragma unroll
        for (int rep = 0; rep < 8; ++rep) {
          int idx = tid + NT * rep; int i = idx >> 6, jj = idx & 63;
          fl[i * 65 + jj] = src[(size_t)(k0 + i) * N + n0 + jj];
        }
        __syncthreads();
        int n = tid >> 3, c8 = tid & 7;
        uint4 o;
        o.x = pack2(fl[(c8 * 8 + 0) * 65 + n], fl[(c8 * 8 + 1) * 65 + n]);
        o.y = pack2(fl[(c8 * 8 + 2) * 65 + n], fl[(c8 * 8 + 3) * 65 + n]);
        o.z = pack2(fl[(c8 * 8 + 4) * 65 + n], fl[(c8 * 8 + 5) * 65 + n]);
        o.w = pack2(fl[(c8 * 8 + 6) * 65 + n], fl[(c8 * 8 + 7) * 65 + n]);
        *(uint4*)(dst + (size_t)(n0 + n) * K + k0 + c8 * 8) = o;
        __syncthreads();
      }
      base += nt;
    }
  }
  convert_bf16(p.in[32], (u16*)(p.ws + O_KEYS), (size_t)2 * 8 * 2 * 128 * 128);
  convert_tab_fp8(p.in[33], p.in[34], p.ws + O_TAB0);
  if (blockIdx.x == 0) {
    float* rope = (float*)(p.ws + O_ROPE);
    for (int i = tid; i < 1024; i += NT) {
      int pos = i >> 4, f = i & 15;
      float inv = exp2f(-(float)f * (13.287712379549449f / 16.f));
      float ang = (float)pos * inv;
      rope[i * 2] = cosf(ang);
      rope[i * 2 + 1] = sinf(ang);
    }
  }
}

__device__ __forceinline__ void phase_norm(const P& p, const float* srcL, const float* srcC, const float* gain, int layer, int shift_idx,
                           int nrows, u16* dst) {
  const int lane = tid_() & 63;
  const int gw = blockIdx.x * 8 + (tid_() >> 6), nw = gridDim.x * 8;
  const float* mod = (const float*)(p.ws + O_MOD) + (size_t)layer * 9 * 6144;
  for (int row = gw; row < nrows; row += nw) {
    const float* src = row < NLAT ? srcL + (size_t)row * DM : srcC + (size_t)(row - NLAT) * DM;
    int mi = row < NLAT ? (row >> 12) : 8;
    const float* sh = mod + mi * 6144 + shift_idx * 1024;
    const float* sc = sh + 1024;
    float4 v[4];
    float ss = 0.f;
#pragma unroll
    for (int i = 0; i < 4; ++i) {
      v[i] = *(const float4*)(src + i * 256 + lane * 4);
      ss += v[i].x * v[i].x + v[i].y * v[i].y + v[i].z * v[i].z + v[i].w * v[i].w;
    }
    ss = wave_sum(ss);
    float rs = rsqrtf(ss * (1.f / 1024.f) + 1e-6f);
#pragma unroll
    for (int i = 0; i < 4; ++i) {
      int c = i * 256 + lane * 4;
      float4 g = *(const float4*)(gain + c);
      float4 s1 = *(const float4*)(sc + c);
      float4 s0 = *(const float4*)(sh + c);
      float a = v[i].x * rs * g.x * (1.f + s1.x) + s0.x;
      float b = v[i].y * rs * g.y * (1.f + s1.y) + s0.y;
      float cc = v[i].z * rs * g.z * (1.f + s1.z) + s0.z;
      float d = v[i].w * rs * g.w * (1.f + s1.w) + s0.w;
      uint2 o; o.x = pack2(a, b); o.y = pack2(cc, d);
      *(uint2*)(dst + (size_t)row * DM + c) = o;
    }
  }
}

__device__ __forceinline__ void phase_conv_qk(const P& p) {
  const u16* hgg = (const u16*)(p.ws + O_HGG);
  u16* mix = (u16*)(p.ws + O_XN);
  const float* cw = p.in[9];
  const size_t gt = (size_t)blockIdx.x * NT + tid_(), gn = (size_t)gridDim.x * NT;
  for (size_t it = gt; it < (size_t)TTOK * 64; it += gn) {
    int row = (int)(it >> 6), c0 = (int)(it & 63) * 8;
    int t, len;
    if (row < NLAT) { t = row & 4095; len = 4096; } else { t = (row - NLAT) & 255; len = 256; }
    float pm[8], pc[8], pp[8];
    {
      const u16* b = hgg + (size_t)row * 1536;
      uint4 hh = *(const uint4*)(b + c0), gc = *(const uint4*)(b + 1024 + c0);
      pc[0] = bflo(hh.x) * bflo(gc.x); pc[1] = bfhi(hh.x) * bfhi(gc.x);
      pc[2] = bflo(hh.y) * bflo(gc.y); pc[3] = bfhi(hh.y) * bfhi(gc.y);
      pc[4] = bflo(hh.z) * bflo(gc.z); pc[5] = bfhi(hh.z) * bfhi(gc.z);
      pc[6] = bflo(hh.w) * bflo(gc.w); pc[7] = bfhi(hh.w) * bfhi(gc.w);
    }
    if (t > 0) {
      const u16* b = hgg + (size_t)(row - 1) * 1536;
      uint4 hh = *(const uint4*)(b + c0), gc = *(const uint4*)(b + 1024 + c0);
      pm[0] = bflo(hh.x) * bflo(gc.x); pm[1] = bfhi(hh.x) * bfhi(gc.x);
      pm[2] = bflo(hh.y) * bflo(gc.y); pm[3] = bfhi(hh.y) * bfhi(gc.y);
      pm[4] = bflo(hh.z) * bflo(gc.z); pm[5] = bfhi(hh.z) * bfhi(gc.z);
      pm[6] = bflo(hh.w) * bflo(gc.w); pm[7] = bfhi(hh.w) * bfhi(gc.w);
    } else {
#pragma unroll
      for (int e = 0; e < 8; ++e) pm[e] = 0.f;
    }
    if (t < len - 1) {
      const u16* b = hgg + (size_t)(row + 1) * 1536;
      uint4 hh = *(const uint4*)(b + c0), gc = *(const uint4*)(b + 1024 + c0);
      pp[0] = bflo(hh.x) * bflo(gc.x); pp[1] = bfhi(hh.x) * bfhi(gc.x);
      pp[2] = bflo(hh.y) * bflo(gc.y); pp[3] = bfhi(hh.y) * bfhi(gc.y);
      pp[4] = bflo(hh.z) * bflo(gc.z); pp[5] = bfhi(hh.z) * bfhi(gc.z);
      pp[6] = bflo(hh.w) * bflo(gc.w); pp[7] = bfhi(hh.w) * bfhi(gc.w);
    } else {
#pragma unroll
      for (int e = 0; e < 8; ++e) pp[e] = 0.f;
    }
    uint4 gbv = *(const uint4*)(hgg + (size_t)row * 1536 + 512 + c0);
    float gb[8] = {bflo(gbv.x), bfhi(gbv.x), bflo(gbv.y), bfhi(gbv.y), bflo(gbv.z), bfhi(gbv.z), bflo(gbv.w), bfhi(gbv.w)};
    float o[8];
#pragma unroll
    for (int e = 0; e < 8; ++e)
      o[e] = gb[e] * (cw[c0 + e] * pm[e] + cw[512 + c0 + e] * pc[e] + cw[1024 + c0 + e] * pp[e]);
    uint4 ov; ov.x = pack2(o[0], o[1]); ov.y = pack2(o[2], o[3]); ov.z = pack2(o[4], o[5]); ov.w = pack2(o[6], o[7]);
    *(uint4*)(mix + (size_t)row * DM + c0) = ov;
  }
  u16* Q = (u16*)(p.ws + O_Q);
  u16* KBp = (u16*)(p.ws + O_KB);
  const float* rope = (const float*)(p.ws + O_ROPE);
  const size_t ngroups = (size_t)TTOK * 10;
  for (size_t it = gt; it < ngroups * 8; it += gn) {
    size_t grp = it >> 3; int sub = (int)(it & 7);
    int row = (int)(grp / 10), hd = (int)(grp % 10);
    u16* ptr; const float* gain;
    if (hd < 8) { ptr = Q + (size_t)row * 512 + hd * 64 + sub * 8; gain = p.in[10]; }
    else { ptr = KBp + (size_t)row * 128 + (hd - 8) * 64 + sub * 8; gain = p.in[11]; }
    uint4 v = *(const uint4*)ptr;
    float x[8] = {bflo(v.x), bfhi(v.x), bflo(v.y), bfhi(v.y), bflo(v.z), bfhi(v.z), bflo(v.w), bfhi(v.w)};
    float ss = 0.f;
#pragma unroll
    for (int e = 0; e < 8; ++e) ss += x[e] * x[e];
    ss = red8(ss);
    float rs = rsqrtf(ss * (1.f / 64.f) + 1e-6f);
#pragma unroll
    for (int e = 0; e < 8; ++e) x[e] = x[e] * rs * gain[sub * 8 + e];
    if (row < NLAT) {
      int t = row & 4095; int gr = t >> 6, gc = t & 63;
#pragma unroll
      for (int e = 0; e < 4; ++e) {
        int pi = sub * 4 + e;
        int pos = pi < 16 ? gr : gc; int f = pi & 15;
        float c = rope[(pos * 16 + f) * 2], s = rope[(pos * 16 + f) * 2 + 1];
        float a = x[2 * e], b = x[2 * e + 1];
        x[2 * e] = a * c - b * s;
        x[2 * e + 1] = a * s + b * c;
      }
    }
    uint4 ov; ov.x = pack2(x[0], x[1]); ov.y = pack2(x[2], x[3]); ov.z = pack2(x[4], x[5]); ov.w = pack2(x[6], x[7]);
    *(uint4*)ptr = ov;
  }
}

__device__ __forceinline__ void phase_attn(const P& p, char* lds) {
  u16* sK = (u16*)lds;
  u16* sV = sK + 64 * LDSS;
  const u16* Q = (const u16*)(p.ws + O_Q);
  const u16* KBp = (const u16*)(p.ws + O_KB);
  const u16* VT = (const u16*)(p.ws + O_VT);
  u16* mix = (u16*)(p.ws + O_XN);
  const int tid = tid_(), lane = tid & 63, wave = tid >> 6;
  const int r = lane & 31, h = lane >> 5;
  const float cs = 0.125f * 1.4426950408889634f;
  for (int item = blockIdx.x; item < 1088; item += gridDim.x) {
    int b, qh, qrow0, nkt;
    if (item < 1024) { b = item >> 7; qh = (item >> 4) & 7; qrow0 = b * 4096 + (item & 15) * 256; nkt = 68; }
    else { int i2 = item - 1024; b = i2 >> 3; qh = i2 & 7; qrow0 = NLAT + b * 256; nkt = 4; }
    const int kvh = qh >> 2;
    const int qrow = qrow0 + wave * 32 + r;
    bf16x8 qf[4];
#pragma unroll
    for (int kk = 0; kk < 4; ++kk) qf[kk] = *(const bf16x8*)(Q + (size_t)qrow * 512 + qh * 64 + kk * 16 + h * 8);
    f32x16 o[2];
#pragma unroll
    for (int g = 0; g < 16; ++g) { o[0][g] = 0.f; o[1][g] = 0.f; }
    float m = -INFINITY, l = 0.f;
    const int lkey = tid >> 3, lch = tid & 7;
    uint4 ka, va;
    auto gl = [&](int kt) {
      int pos = kt * 64 + lkey;
      int krow = pos < 256 ? NLAT + b * 256 + pos : b * 4096 + pos - 256;
      ka = *(const uint4*)(KBp + (size_t)krow * 128 + kvh * 64 + lch * 8);
      va = *(const uint4*)(VT + ((size_t)((b * 2 + kvh) * 64 + lkey)) * 4352 + kt * 64 + lch * 8);
    };
    gl(0);
    for (int kt = 0; kt < nkt; ++kt) {
      *(uint4*)(sK + lkey * LDSS + lch * 8) = ka;
      *(uint4*)(sV + lkey * LDSS + lch * 8) = va;
      __syncthreads();
      if (kt + 1 < nkt) gl(kt + 1);
      f32x16 s[2];
#pragma unroll
      for (int g = 0; g < 16; ++g) { s[0][g] = 0.f; s[1][g] = 0.f; }
#pragma unroll
      for (int kb = 0; kb < 2; ++kb)
#pragma unroll
        for (int kk = 0; kk < 4; ++kk) {
          bf16x8 a = *(const bf16x8*)(sK + (kb * 32 + r) * LDSS + kk * 16 + h * 8);
          s[kb] = __builtin_amdgcn_mfma_f32_32x32x16_bf16(a, qf[kk], s[kb], 0, 0, 0);
        }
      float mx = s[0][0];
#pragma unroll
      for (int g = 0; g < 16; ++g) { mx = fmaxf(mx, s[0][g]); mx = fmaxf(mx, s[1][g]); }
      mx = swapmax32(mx);
      float mn = fmaxf(m, mx);
      float alpha = __builtin_amdgcn_exp2f((m - mn) * cs);
      m = mn;
      float mc = mn * cs, ps = 0.f;
#pragma unroll
      for (int kb = 0; kb < 2; ++kb)
#pragma unroll
        for (int g = 0; g < 16; ++g) { float e = __builtin_amdgcn_exp2f(s[kb][g] * cs - mc); s[kb][g] = e; ps += e; }
      l = l * alpha + ps;
#pragma unroll
      for (int g = 0; g < 16; ++g) { o[0][g] *= alpha; o[1][g] *= alpha; }
      bf16x8 pb[2][2];
#pragma unroll
      for (int kb = 0; kb < 2; ++kb)
#pragma unroll
        for (int c = 0; c < 2; ++c) {
          uint4 pk;
          pk.x = pack2(s[kb][8 * c + 0], s[kb][8 * c + 1]); pk.y = pack2(s[kb][8 * c + 2], s[kb][8 * c + 3]);
          pk.z = pack2(s[kb][8 * c + 4], s[kb][8 * c + 5]); pk.w = pack2(s[kb][8 * c + 6], s[kb][8 * c + 7]);
          pb[kb][c] = __builtin_bit_cast(bf16x8, pk);
        }
#pragma unroll
      for (int db = 0; db < 2; ++db)
#pragma unroll
        for (int kb = 0; kb < 2; ++kb)
#pragma unroll
          for (int c = 0; c < 2; ++c) {
            const u16* vp = sV + (db * 32 + r) * LDSS + kb * 32 + 16 * c + 4 * h;
            uint2 lo = *(const uint2*)vp, hi = *(const uint2*)(vp + 8);
            uint4 av = make_uint4(lo.x, lo.y, hi.x, hi.y);
            o[db] = __builtin_amdgcn_mfma_f32_32x32x16_bf16(__builtin_bit_cast(bf16x8, av), pb[kb][c], o[db], 0, 0, 0);
          }
      __syncthreads();
    }
    l = swapsum32(l, l);
    float inv = 1.f / l;
#pragma unroll
    for (int db = 0; db < 2; ++db)
#pragma unroll
      for (int g4 = 0; g4 < 4; ++g4) {
        int d = db * 32 + 8 * g4 + 4 * h;
        uint2 ov;
        ov.x = pack2(o[db][g4 * 4 + 0] * inv, o[db][g4 * 4 + 1] * inv);
        ov.y = pack2(o[db][g4 * 4 + 2] * inv, o[db][g4 * 4 + 3] * inv);
        *(uint2*)(mix + (size_t)qrow * DM + 512 + qh * 64 + d) = ov;
      }
  }
}

__device__ __forceinline__ int fkey(float f) { int b = __float_as_int(f); return b ^ ((b >> 31) & 0x7FFFFFFF); }
__device__ __forceinline__ float keyf(int k) { return __int_as_float(k ^ ((k >> 31) & 0x7FFFFFFF)); }

#define CE_DESC(a, b) { int hi__ = max(a, b); int lo__ = min(a, b); a = hi__; b = lo__; }
#define BITONIC_SORT16(r)                                                          \
  _Pragma("unroll") for (int k_ = 2; k_ <= 16; k_ <<= 1)                           \
    _Pragma("unroll") for (int j_ = k_ >> 1; j_ > 0; j_ >>= 1)                     \
      _Pragma("unroll") for (int i_ = 0; i_ < 16; ++i_) {                          \
        const int l_ = i_ ^ j_;                                                    \
        if (l_ > i_) { if ((i_ & k_) == 0) CE_DESC(r[i_], r[l_]) else CE_DESC(r[l_], r[i_]) } \
      }
#define BITONIC_MERGE16(r)                                                         \
  _Pragma("unroll") for (int j_ = 8; j_ > 0; j_ >>= 1)                             \
    _Pragma("unroll") for (int i_ = 0; i_ < 16; ++i_) {                            \
      const int l_ = i_ ^ j_;                                                      \
      if (l_ > i_) CE_DESC(r[i_], r[l_])                                           \
    }
#define XLANE_MERGE16(r, CTRL)                                                     \
  {                                                                                \
    int o_[16];                                                                    \
    _Pragma("unroll") for (int i_ = 0; i_ < 16; ++i_) o_[i_] = __builtin_amdgcn_update_dpp(0, r[15 - i_], CTRL, 0xF, 0xF, true); \
    _Pragma("unroll") for (int i_ = 0; i_ < 16; ++i_) r[i_] = max(r[i_], o_[i_]);  \
    BITONIC_MERGE16(r)                                                             \
  }
#define SCS 132
__device__ __forceinline__ void phase_peer_topk(const P& p, int layer, const u16* PQ, int ntok, int* IDX, float* GATE, char* lds) {
  float* sc = (float*)lds;
  int* lists = (int*)(lds + 2 * 64 * SCS * 4);
  const int tid = tid_(), lane = tid & 63, wave = tid >> 6;
  const int r = lane & 31, h = lane >> 5;
  const u16* keys = (const u16*)(p.ws + O_KEYS) + (size_t)layer * 8 * 2 * 128 * 128;
  const int ntile = (ntok >> 6) * 8;
  for (int tile = blockIdx.x; tile < ntile; tile += gridDim.x) {
    int hd = tile & 7, row0 = (tile >> 3) * 64;
    {
      int pp = wave >> 2, kb = wave & 3;
      f32x16 acc[2];
#pragma unroll
      for (int g = 0; g < 16; ++g) { acc[0][g] = 0.f; acc[1][g] = 0.f; }
      const u16* kp = keys + ((size_t)(hd * 2 + pp) * 128 + kb * 32 + r) * 128 + h * 8;
      const u16* qp = PQ + (size_t)(row0 + r) * 2048 + hd * 256 + pp * 128 + h * 8;
#pragma unroll
      for (int kk = 0; kk < 8; ++kk) {
        bf16x8 bfr = *(const bf16x8*)(kp + kk * 16);
        bf16x8 a0 = *(const bf16x8*)(qp + kk * 16);
        bf16x8 a1 = *(const bf16x8*)(qp + (size_t)32 * 2048 + kk * 16);
        acc[0] = __builtin_amdgcn_mfma_f32_32x32x16_bf16(a0, bfr, acc[0], 0, 0, 0);
        acc[1] = __builtin_amdgcn_mfma_f32_32x32x16_bf16(a1, bfr, acc[1], 0, 0, 0);
      }
#pragma unroll
      for (int mb = 0; mb < 2; ++mb)
#pragma unroll
        for (int g = 0; g < 16; ++g) {
          int tok = mb * 32 + (g & 3) + 8 * (g >> 2) + 4 * h;
          sc[(pp * 64 + tok) * SCS + kb * 32 + r] = acc[mb][g];
        }
    }
    __syncthreads();
    {
      const int row = tid >> 2, qd = tid & 3;
      const float* rowp = sc + row * SCS + qd;
      int A[16], B[16];
#pragma unroll
      for (int m = 0; m < 16; ++m) {
        A[m] = (fkey(rowp[4 * m]) & ~0x7F) | (127 - (4 * m + qd));
        B[m] = (fkey(rowp[64 + 4 * m]) & ~0x7F) | (127 - (64 + 4 * m + qd));
      }
      BITONIC_SORT16(A)
      BITONIC_SORT16(B)
#pragma unroll
      for (int i = 0; i < 16; ++i) A[i] = max(A[i], B[15 - i]);
      BITONIC_MERGE16(A)
      XLANE_MERGE16(A, 0xB1)
      XLANE_MERGE16(A, 0x4E)
      if (qd == 0) {
#pragma unroll
        for (int i = 0; i < 16; i += 4) *(int4*)(lists + row * 16 + i) = make_int4(A[i], A[i + 1], A[i + 2], A[i + 3]);
      }
    }
    __syncthreads();
    if (tid < 256) {
      const int tok = tid >> 2, q = tid & 3;
      float bq[16];
#pragma unroll
      for (int j = 0; j < 16; ++j) bq[j] = keyf(lists[(64 + tok) * 16 + j] & ~0x7F);
      int R[16];
#pragma unroll
      for (int i = 0; i < 16; ++i) R[i] = (int)0x80000000;
#pragma unroll
      for (int m = 0; m < 4; ++m) {
        const int i = q + 4 * m;
        const float ai = keyf(lists[tok * 16 + i] & ~0x7F);
        const int jmax = 16 / (i + 1);
        const int nj = m == 0 ? 16 : (m == 1 ? 3 : 1);
#pragma unroll
        for (int j = 0; j < nj; ++j) {
          int x = (fkey(ai + bq[j]) & ~0xFF) | (255 - (i * 16 + j));
          x = j < jmax ? x : (int)0x80000000;
#pragma unroll
          for (int t = 0; t < 16; ++t) { int hi_ = max(R[t], x); x = min(R[t], x); R[t] = hi_; }
        }
      }
      XLANE_MERGE16(R, 0xB1)
      XLANE_MERGE16(R, 0x4E)
      float sv[16];
      float mx = keyf(R[0] & ~0xFF), sum = 0.f;
#pragma unroll
      for (int t = 0; t < 16; ++t) { sv[t] = __expf(keyf(R[t] & ~0xFF) - mx); sum += sv[t]; }
      float inv = 1.f / sum;
      size_t ob = (size_t)(row0 + tok) * 128 + hd * 16;
#pragma unroll
      for (int t = 0; t < 16; ++t) {
        if ((t >> 2) == q) {
          int pos = 255 - (R[t] & 0xFF);
          int i1 = 127 - (lists[tok * 16 + (pos >> 4)] & 0x7F);
          int i2 = 127 - (lists[(64 + tok) * 16 + (pos & 15)] & 0x7F);
          IDX[ob + t] = i1 * 128 + i2;
          GATE[ob + t] = sv[t] * inv;
        }
      }
    }
    __syncthreads();
  }
}

typedef __attribute__((ext_vector_type(2))) float f2;
#define TAB_V8 (16 * MiB)
#define TAB_SU (32 * MiB)
#define TAB_SV (32 * MiB + 65536)
__device__ __forceinline__ float wave_max(float v) {
  v = fmaxf(v, dppf<0xB1>(v)); v = fmaxf(v, dppf<0x4E>(v)); v = fmaxf(v, dppf<0x141>(v)); v = fmaxf(v, dppf<0x140>(v));
  v = swapmax16(v); v = swapmax32(v);
  return v;
}
__device__ __forceinline__ void convert_tab_fp8(const float* __restrict__ U, const float* __restrict__ V, char* tab) {
  const int lane = tid_() & 63;
  const int gw = blockIdx.x * 8 + (tid_() >> 6), nw = gridDim.x * 8;
  for (int rr = gw; rr < 32768; rr += nw) {
    const int isv = rr >> 14, e = rr & 16383;
    const float* src = (isv ? V : U) + (size_t)e * 1024 + lane * 16;
    float4 v0 = *(const float4*)src, v1 = *(const float4*)(src + 4), v2 = *(const float4*)(src + 8), v3 = *(const float4*)(src + 12);
    float am = fmaxf(fmaxf(fmaxf(fabsf(v0.x), fabsf(v0.y)), fmaxf(fabsf(v0.z), fabsf(v0.w))),
                     fmaxf(fmaxf(fabsf(v1.x), fabsf(v1.y)), fmaxf(fabsf(v1.z), fabsf(v1.w))));
    am = fmaxf(am, fmaxf(fmaxf(fmaxf(fabsf(v2.x), fabsf(v2.y)), fmaxf(fabsf(v2.z), fabsf(v2.w))),
                         fmaxf(fmaxf(fabsf(v3.x), fabsf(v3.y)), fmaxf(fabsf(v3.z), fabsf(v3.w)))));
    am = wave_max(am);
    float sc = am > 0.f ? 448.f / am : 1.f;
    uint4 o;
    int t = 0;
    t = __builtin_amdgcn_cvt_pk_fp8_f32(v0.x * sc, v0.y * sc, t, false); t = __builtin_amdgcn_cvt_pk_fp8_f32(v0.z * sc, v0.w * sc, t, true); o.x = t;
    t = __builtin_amdgcn_cvt_pk_fp8_f32(v1.x * sc, v1.y * sc, t, false); t = __builtin_amdgcn_cvt_pk_fp8_f32(v1.z * sc, v1.w * sc, t, true); o.y = t;
    t = __builtin_amdgcn_cvt_pk_fp8_f32(v2.x * sc, v2.y * sc, t, false); t = __builtin_amdgcn_cvt_pk_fp8_f32(v2.z * sc, v2.w * sc, t, true); o.z = t;
    t = __builtin_amdgcn_cvt_pk_fp8_f32(v3.x * sc, v3.y * sc, t, false); t = __builtin_amdgcn_cvt_pk_fp8_f32(v3.z * sc, v3.w * sc, t, true); o.w = t;
    if (!isv) {
      *(uint4*)(tab + (size_t)e * 1024 + lane * 16) = o;
      if (lane == 0) ((float*)(tab + TAB_SU))[e] = am > 0.f ? am / 448.f : 1.f;
    } else {
      *(uint4*)(tab + TAB_V8 + ((size_t)(lane >> 3) * 16384 + e) * 128 + (lane & 7) * 16) = o;
      if (lane == 0) ((float*)(tab + TAB_SV))[e] = am > 0.f ? am / 448.f : 1.f;
    }
  }
}
__device__ __forceinline__ f2 dec8(unsigned w, bool hi) { return hi ? __builtin_amdgcn_cvt_pk_f32_fp8((int)w, true) : __builtin_amdgcn_cvt_pk_f32_fp8((int)w, false); }

__device__ __forceinline__ float dot16(uint4 w, f2 a0, f2 a1, f2 a2, f2 a3, f2 a4, f2 a5, f2 a6, f2 a7) {
  f2 a = f2{0.f, 0.f};
  a = __builtin_elementwise_fma(dec8(w.x, false), a0, a); a = __builtin_elementwise_fma(dec8(w.x, true), a1, a);
  a = __builtin_elementwise_fma(dec8(w.y, false), a2, a); a = __builtin_elementwise_fma(dec8(w.y, true), a3, a);
  a = __builtin_elementwise_fma(dec8(w.z, false), a4, a); a = __builtin_elementwise_fma(dec8(w.z, true), a5, a);
  a = __builtin_elementwise_fma(dec8(w.w, false), a6, a); a = __builtin_elementwise_fma(dec8(w.w, true), a7, a);
  return a.x + a.y;
}
#define DOT16(W) dot16(W, xf0, xf1, xf2, xf3, xf4, xf5, xf6, xf7)
__device__ __forceinline__ void phase_peer_act(const P& p, const u16* XN2, const char* tab, const int* IDX, const float* GATE, float* COEF, int ntok, char* lds) {
  const int tid = tid_(), lane = tid & 63, wave = tid >> 6;
  int* le = (int*)(lds + wave * 1536);
  float* lg = (float*)(le + 128);
  int* ls = le + 256;
  const int part = blockIdx.x & 7;
  const int wv = (blockIdx.x >> 3) * 8 + wave, nwv = (gridDim.x >> 3) * 8;
  const float* SU = (const float*)(tab + TAB_SU);
  const float* SV = (const float*)(tab + TAB_SV);
  const int q = lane >> 4;
  const bool hi = (lane & 32) != 0, b4 = (lane & 16) != 0;
  int i0 = 0, i1 = 0; float g0 = 0.f, g1 = 0.f; uint4 x0 = make_uint4(0, 0, 0, 0), x1 = x0;
  if (wv < ntok) {
    i0 = IDX[(size_t)wv * 128 + lane]; i1 = IDX[(size_t)wv * 128 + 64 + lane];
    g0 = GATE[(size_t)wv * 128 + lane]; g1 = GATE[(size_t)wv * 128 + 64 + lane];
    const u16* xr = XN2 + (size_t)wv * DM + lane * 16;
    x0 = *(const uint4*)xr; x1 = *(const uint4*)(xr + 8);
  }
  for (int tok = wv; tok < ntok; tok += nwv) {
    int ni0 = 0, ni1 = 0; float ng0 = 0.f, ng1 = 0.f; uint4 nx0 = make_uint4(0, 0, 0, 0), nx1 = nx0;
    const int nt = tok + nwv;
    if (nt < ntok) {
      ni0 = IDX[(size_t)nt * 128 + lane]; ni1 = IDX[(size_t)nt * 128 + 64 + lane];
      ng0 = GATE[(size_t)nt * 128 + lane]; ng1 = GATE[(size_t)nt * 128 + 64 + lane];
      const u16* xr = XN2 + (size_t)nt * DM + lane * 16;
      nx0 = *(const uint4*)xr; nx1 = *(const uint4*)(xr + 8);
    }
    const bool s0 = (i0 >> 11) == part, s1 = (i1 >> 11) == part;
    const unsigned long long m0 = __ballot(s0), m1 = __ballot(s1);
    const int c0 = __popcll(m0), cnt = c0 + __popcll(m1);
    const int p0 = __builtin_amdgcn_mbcnt_hi((unsigned)(m0 >> 32), __builtin_amdgcn_mbcnt_lo((unsigned)m0, 0));
    const int p1 = c0 + __builtin_amdgcn_mbcnt_hi((unsigned)(m1 >> 32), __builtin_amdgcn_mbcnt_lo((unsigned)m1, 0));
    if (s0) { le[p0] = i0; lg[p0] = g0; ls[p0] = lane; }
    if (s1) { le[p1] = i1; lg[p1] = g1; ls[p1] = 64 + lane; }
    const int cntp = (cnt + 3) & ~3;
    if (lane < cntp - cnt) { le[cnt + lane] = part << 11; lg[cnt + lane] = 0.f; ls[cnt + lane] = -1; }
    const f2 xf0 = f2{bflo(x0.x), bfhi(x0.x)}, xf1 = f2{bflo(x0.y), bfhi(x0.y)}, xf2 = f2{bflo(x0.z), bfhi(x0.z)}, xf3 = f2{bflo(x0.w), bfhi(x0.w)};
    const f2 xf4 = f2{bflo(x1.x), bfhi(x1.x)}, xf5 = f2{bflo(x1.y), bfhi(x1.y)}, xf6 = f2{bflo(x1.z), bfhi(x1.z)}, xf7 = f2{bflo(x1.w), bfhi(x1.w)};
    for (int base = 0; base < cntp; base += 24) {
      uint4 w[24];
      const int evl = le[base + (lane < 24 ? lane : 0)];
#pragma unroll
      for (int gq = 0; gq < 6; ++gq) {
        if (base + 4 * gq < cntp) {
#pragma unroll
          for (int k = 0; k < 4; ++k) {
            int e = __builtin_amdgcn_readlane(evl, 4 * gq + k);
            w[4 * gq + k] = *(const uint4*)(tab + (size_t)e * 1024 + lane * 16);
          }
        } else {
#pragma unroll
          for (int k = 0; k < 4; ++k) w[4 * gq + k] = make_uint4(0, 0, 0, 0);
        }
      }
#pragma unroll
      for (int gq = 0; gq < 6; ++gq) {
        if (base + 4 * gq < cntp) {
          float d0 = DOT16(w[4 * gq]), d1 = DOT16(w[4 * gq + 1]), d2 = DOT16(w[4 * gq + 2]), d3 = DOT16(w[4 * gq + 3]);
          float kA = swapsum32(d0, d2), kB = swapsum32(d1, d3);
          float kC = swapsum16(kA, kB);
          kC = red16(kC);
          const int j = base + 4 * gq + q;
          const int e = le[j]; const float gt = lg[j]; const int slot = ls[j];
          float act = kC * SU[e];
          float coef = gt * 0.5f * act * (1.f + erff(act * 0.70710678118654752f)) * SV[e];
          if ((lane & 15) == 0 && slot >= 0) COEF[(size_t)tok * 128 + slot] = coef;
        }
      }
    }
    i0 = ni0; i1 = ni1; g0 = ng0; g1 = ng1; x0 = nx0; x1 = nx1;
  }
}

__device__ __forceinline__ void phase_peer_sum(const P& p, int layer, const char* tab, const int* IDX, const float* COEF, int ntok, float* dummy_dst) {
  const int tid = tid_(), lane = tid & 63, wave = tid >> 6;
  const int sl = blockIdx.x & 7;
  const int wv = (blockIdx.x >> 3) * 8 + wave, nwv = (gridDim.x >> 3) * 8;
  const int g = lane >> 3, ch = lane & 7;
  const char* V8 = tab + TAB_V8 + (size_t)sl * 16384 * 128 + ch * 16;
  const float* mod = (const float*)(p.ws + O_MOD) + (size_t)layer * 9 * 6144;
  float* HC = (float*)(p.ws + O_HC);
  const bool b5 = (lane & 32) != 0, b4 = (lane & 16) != 0, b3 = (lane & 8) != 0;
  const int c = sl * 128 + ch * 16 + (b5 ? 8 : 0) + (b4 ? 4 : 0) + (b3 ? 2 : 0);
  uint4 ia, ib, ic, id; float4 ca, cb, cc, cd;
  ia = ib = ic = id = make_uint4(0, 0, 0, 0); ca = cb = cc = cd = make_float4(0, 0, 0, 0);
  if (wv < ntok) {
    const int* ip = IDX + (size_t)wv * 128 + g * 16;
    const float* cp = COEF + (size_t)wv * 128 + g * 16;
    ia = *(const uint4*)ip; ib = *(const uint4*)(ip + 4); ic = *(const uint4*)(ip + 8); id = *(const uint4*)(ip + 12);
    ca = *(const float4*)cp; cb = *(const float4*)(cp + 4); cc = *(const float4*)(cp + 8); cd = *(const float4*)(cp + 12);
  }
  for (int tok = wv; tok < ntok; tok += nwv) {
    const unsigned ev[16] = {ia.x, ia.y, ia.z, ia.w, ib.x, ib.y, ib.z, ib.w, ic.x, ic.y, ic.z, ic.w, id.x, id.y, id.z, id.w};
    const float cv[16] = {ca.x, ca.y, ca.z, ca.w, cb.x, cb.y, cb.z, cb.w, cc.x, cc.y, cc.z, cc.w, cd.x, cd.y, cd.z, cd.w};
    uint4 w[16];
#pragma unroll
    for (int i = 0; i < 16; ++i) w[i] = *(const uint4*)(V8 + (size_t)ev[i] * 128);
    float* dst = (dummy_dst ? dummy_dst + (size_t)tok * DM : (tok < NLAT ? p.out + (size_t)tok * DM : HC + (size_t)(tok - NLAT) * DM)) + c;
    float2 o = *(float2*)dst;
    const int nt = tok + nwv;
    if (nt < ntok) {
      const int* ip = IDX + (size_t)nt * 128 + g * 16;
      const float* cp = COEF + (size_t)nt * 128 + g * 16;
      ia = *(const uint4*)ip; ib = *(const uint4*)(ip + 4); ic = *(const uint4*)(ip + 8); id = *(const uint4*)(ip + 12);
      ca = *(const float4*)cp; cb = *(const float4*)(cp + 4); cc = *(const float4*)(cp + 8); cd = *(const float4*)(cp + 12);
    }
    f2 acc[8];
#pragma unroll
    for (int k = 0; k < 8; ++k) acc[k] = f2{0.f, 0.f};
#pragma unroll
    for (int i = 0; i < 16; ++i) {
      f2 c2 = f2{cv[i], cv[i]};
      acc[0] = __builtin_elementwise_fma(dec8(w[i].x, false), c2, acc[0]); acc[1] = __builtin_elementwise_fma(dec8(w[i].x, true), c2, acc[1]);
      acc[2] = __builtin_elementwise_fma(dec8(w[i].y, false), c2, acc[2]); acc[3] = __builtin_elementwise_fma(dec8(w[i].y, true), c2, acc[3]);
      acc[4] = __builtin_elementwise_fma(dec8(w[i].z, false), c2, acc[4]); acc[5] = __builtin_elementwise_fma(dec8(w[i].z, true), c2, acc[5]);
      acc[6] = __builtin_elementwise_fma(dec8(w[i].w, false), c2, acc[6]); acc[7] = __builtin_elementwise_fma(dec8(w[i].w, true), c2, acc[7]);
    }
    float r8[8];
#pragma unroll
    for (int k = 0; k < 4; ++k) {
      r8[2 * k] = swapsum32(acc[k].x, acc[4 + k].x);
      r8[2 * k + 1] = swapsum32(acc[k].y, acc[4 + k].y);
    }
    float r4[4];
#pragma unroll
    for (int k = 0; k < 4; ++k) r4[k] = swapsum16(r8[k], r8[4 + k]);
    float r2[2];
#pragma unroll
    for (int k = 0; k < 2; ++k) {
      float kx = b3 ? r4[2 + k] : r4[k], sx = b3 ? r4[k] : r4[2 + k];
      r2[k] = kx + dppf<0x128>(sx);
    }
    const int mi = tok < NLAT ? (tok >> 12) : 8;
    const float2 mv = *(const float2*)(mod + mi * 6144 + 5 * 1024 + c);
    o.x += mv.x * r2[0]; o.y += mv.y * r2[1];
    *(float2*)dst = o;
  }
}

__device__ __forceinline__ void phase_scan(const P& p, char* lds, bool dummy) {
  float* buf = (float*)lds;
  float* vbuf = (float*)(lds + 81920);
  u16* ybuf = (u16*)(lds + 81920 + 16384);
  const int tid = tid_(), lane = tid & 63, wave = tid >> 6;
  const int c = lane & 7, irow = wave * 8 + (lane >> 3);
  const u16* R = (const u16*)(p.ws + O_R);
  const u16* Kp = (const u16*)(p.ws + O_K);
  const u16* Vp = (const u16*)(p.ws + O_V);
  const int ps = tid >> 4, col4 = (tid & 15) * 4;
  for (int item = blockIdx.x; item < 256; item += gridDim.x) {
    const int dir = item & 1, hh = (item >> 1) & 15, b = item >> 5;
    char* WA = p.ws + (dir ? O_WA1 : O_WA0);
    float* BON = (float*)(p.ws + O_BONUS) + (size_t)dir * NLAT * 16;
    float kkc[4], kac[4], rkc[4];
#pragma unroll
    for (int e = 0; e < 4; ++e) {
      kkc[e] = p.in[20][hh * 64 + col4 + e];
      kac[e] = p.in[21][hh * 64 + col4 + e];
      rkc[e] = p.in[22][hh * 64 + col4 + e];
    }
    auto rowof = [&](int s) -> int {
      if (s < 256) { int pos = dir ? 255 - s : s; return NLAT + b * 256 + pos; }
      int u = s - 256; int pos = dir ? 4095 - u : u; return b * 4096 + pos;
    };
    uint2 pr, pk, pv; unsigned pw, pa; int prow;
    auto gload = [&](int ch) {
      prow = rowof(ch * 32 + ps);
      size_t o = (size_t)prow * 1024 + hh * 64 + col4;
      pr = *(const uint2*)(R + o); pk = *(const uint2*)(Kp + o); pv = *(const uint2*)(Vp + o);
      const char* wp = WA + (size_t)prow * 2048 + hh * 128;
      pw = *(const unsigned*)(wp + col4); pa = *(const unsigned*)(wp + 64 + col4);
    };
    auto prep = [&](int bi) {
      float rr[4] = {bflo(pr.x), bfhi(pr.x), bflo(pr.y), bfhi(pr.y)};
      float kq[4] = {bflo(pk.x), bfhi(pk.x), bflo(pk.y), bfhi(pk.y)};
      float4 vv = make_float4(bflo(pv.x), bfhi(pv.x), bflo(pv.y), bfhi(pv.y));
      float w[4], a[4], kr[4], kk[4], bb[4], kd[4];
      float ss = 0.f;
#pragma unroll
      for (int e = 0; e < 4; ++e) {
        w[e] = 0.5f + (float)((pw >> (8 * e)) & 255u) * (1.f / 510.f);
        a[e] = (float)((pa >> (8 * e)) & 255u) * (1.f / 255.f);
        kr[e] = kq[e] * kkc[e];
        ss += kr[e] * kr[e];
      }
      ss = red16(ss);
      float inv = rsqrtf(ss + 1e-12f);
      float bn = 0.f;
#pragma unroll
      for (int e = 0; e < 4; ++e) {
        kk[e] = kr[e] * inv;
        bb[e] = kk[e] * a[e];
        kd[e] = kq[e] * (1.f + (a[e] - 1.f) * kac[e]);
        bn += rr[e] * kd[e] * rkc[e];
      }
      bn = red16(bn);
      if ((tid & 15) == 0 && prow < NLAT) BON[(size_t)prow * 16 + hh] = bn;
      float* d = buf + bi * 10240 + ((ps * 8 + (col4 >> 3)) * 5) * 8 + (col4 & 7);
      *(float4*)(d) = make_float4(rr[0], rr[1], rr[2], rr[3]);
      *(float4*)(d + 8) = make_float4(w[0], w[1], w[2], w[3]);
      *(float4*)(d + 16) = make_float4(kk[0], kk[1], kk[2], kk[3]);
      *(float4*)(d + 24) = make_float4(bb[0], bb[1], bb[2], bb[3]);
      *(float4*)(d + 32) = make_float4(kd[0], kd[1], kd[2], kd[3]);
      *(float4*)(vbuf + bi * 2048 + ps * 64 + col4) = vv;
    };
    float S[8];
#pragma unroll
    for (int j = 0; j < 8; ++j) S[j] = 0.f;
    gload(0);
    prep(0);
    __syncthreads();
    for (int ch = 0; ch < 136; ++ch) {
      const int cur = ch & 1;
      if (ch + 1 < 136) gload(ch + 1);
      const float* bq = buf + cur * 10240 + c * 40;
      const float* vq = vbuf + cur * 2048 + irow;
      float4 nr0, nr1, nw0, nw1, nk0, nk1, nb0, nb1, nd0, nd1; float nvi;
      {
        const float* q = bq;
        nr0 = *(const float4*)(q); nr1 = *(const float4*)(q + 4); nw0 = *(const float4*)(q + 8); nw1 = *(const float4*)(q + 12);
        nk0 = *(const float4*)(q + 16); nk1 = *(const float4*)(q + 20); nb0 = *(const float4*)(q + 24); nb1 = *(const float4*)(q + 28);
        nd0 = *(const float4*)(q + 32); nd1 = *(const float4*)(q + 36); nvi = vq[0];
      }
#pragma unroll 4
      for (int t = 0; t < 32; ++t) {
        const float4 r0 = nr0, r1 = nr1, w0 = nw0, w1 = nw1, k0 = nk0, k1 = nk1, b0 = nb0, b1 = nb1, d0 = nd0, d1 = nd1;
        const float vi = nvi;
        if (t + 1 < 32) {
          const float* q = bq + (t + 1) * 320;
          nr0 = *(const float4*)(q); nr1 = *(const float4*)(q + 4); nw0 = *(const float4*)(q + 8); nw1 = *(const float4*)(q + 12);
          nk0 = *(const float4*)(q + 16); nk1 = *(const float4*)(q + 20); nb0 = *(const float4*)(q + 24); nb1 = *(const float4*)(q + 28);
          nd0 = *(const float4*)(q + 32); nd1 = *(const float4*)(q + 36); nvi = vq[(t + 1) * 64];
        }
        float sa = (S[0] * k0.x + S[1] * k0.y) + (S[2] * k0.z + S[3] * k0.w) + ((S[4] * k1.x + S[5] * k1.y) + (S[6] * k1.z + S[7] * k1.w));
        sa = red8(sa);
        S[0] = fmaf(S[0], w0.x, fmaf(-sa, b0.x, vi * d0.x));
        S[1] = fmaf(S[1], w0.y, fmaf(-sa, b0.y, vi * d0.y));
        S[2] = fmaf(S[2], w0.z, fmaf(-sa, b0.z, vi * d0.z));
        S[3] = fmaf(S[3], w0.w, fmaf(-sa, b0.w, vi * d0.w));
        S[4] = fmaf(S[4], w1.x, fmaf(-sa, b1.x, vi * d1.x));
        S[5] = fmaf(S[5], w1.y, fmaf(-sa, b1.y, vi * d1.y));
        S[6] = fmaf(S[6], w1.z, fmaf(-sa, b1.z, vi * d1.z));
        S[7] = fmaf(S[7], w1.w, fmaf(-sa, b1.w, vi * d1.w));
        float y = (S[0] * r0.x + S[1] * r0.y) + (S[2] * r0.z + S[3] * r0.w) + ((S[4] * r1.x + S[5] * r1.y) + (S[6] * r1.z + S[7] * r1.w));
        y = red8(y);
        if (c == 0) ybuf[t * 64 + irow] = f2bf(y);
      }
      __syncthreads();
      if (ch >= 8 && !dummy) {
        int row = rowof(ch * 32 + ps);
        uint2 yv = *(const uint2*)(ybuf + ps * 64 + col4);
        *(uint2*)(WA + (size_t)row * 2048 + hh * 128 + col4 * 2) = yv;
      }
      if (ch + 1 < 136) prep(cur ^ 1);
      __syncthreads();
    }
  }
}

__device__ __forceinline__ void phase_readout(const P& p) {
  const u16* Vp = (const u16*)(p.ws + O_V);
  const u16* G = (const u16*)(p.ws + O_G);
  u16* Z = (u16*)(p.ws + O_Z);
  const float* BON = (const float*)(p.ws + O_BONUS);
  const size_t gt = (size_t)blockIdx.x * NT + tid_(), gn = (size_t)gridDim.x * NT;
  for (size_t it = gt; it < (size_t)NLAT * 16 * 8; it += gn) {
    int sub = (int)(it & 7); size_t grp = it >> 3;
    int hh = (int)(grp & 15); int row = (int)(grp >> 4);
    uint4 y0 = *(const uint4*)(p.ws + O_WA0 + (size_t)row * 2048 + hh * 128 + sub * 16);
    uint4 y1 = *(const uint4*)(p.ws + O_WA1 + (size_t)row * 2048 + hh * 128 + sub * 16);
    float y[8] = {bflo(y0.x) + bflo(y1.x), bfhi(y0.x) + bfhi(y1.x), bflo(y0.y) + bflo(y1.y), bfhi(y0.y) + bfhi(y1.y),
                  bflo(y0.z) + bflo(y1.z), bfhi(y0.z) + bfhi(y1.z), bflo(y0.w) + bflo(y1.w), bfhi(y0.w) + bfhi(y1.w)};
    float s = 0.f;
#pragma unroll
    for (int e = 0; e < 8; ++e) s += y[e];
    float mean = red8(s) * (1.f / 64.f);
    float vs = 0.f;
#pragma unroll
    for (int e = 0; e < 8; ++e) { y[e] -= mean; vs += y[e] * y[e]; }
    float var = red8(vs) * (1.f / 64.f);
    float rs = rsqrtf(var + 64e-5f);
    float bonus = BON[(size_t)row * 16 + hh] + BON[(size_t)NLAT * 16 + (size_t)row * 16 + hh];
    int col = hh * 64 + sub * 8;
    uint4 vv = *(const uint4*)(Vp + (size_t)row * DM + col);
    uint4 gg = *(const uint4*)(G + (size_t)row * DM + col);
    float vf[8] = {bflo(vv.x), bfhi(vv.x), bflo(vv.y), bfhi(vv.y), bflo(vv.z), bfhi(vv.z), bflo(vv.w), bfhi(vv.w)};
    float gf[8] = {bflo(gg.x), bfhi(gg.x), bflo(gg.y), bfhi(gg.y), bflo(gg.z), bfhi(gg.z), bflo(gg.w), bfhi(gg.w)};
    float z[8];
#pragma unroll
    for (int e = 0; e < 8; ++e) z[e] = (y[e] * rs * p.in[29][col + e] + p.in[30][col + e] + bonus * vf[e]) * gf[e];
    uint4 ov; ov.x = pack2(z[0], z[1]); ov.y = pack2(z[2], z[3]); ov.z = pack2(z[4], z[5]); ov.w = pack2(z[6], z[7]);
    *(uint4*)(Z + (size_t)row * DM + col) = ov;
  }
}

__device__ __forceinline__ bool xcd_tile(int k, int Tm, int Tn, int& mt, int& nt) {
  const int x = blockIdx.x & 7, j = blockIdx.x >> 3, J = gridDim.x >> 3;
  const int u = j + J * k;
  if (u >= (Tm >> 3) * Tn) return false;
  mt = (u / Tn) * 8 + x; nt = u % Tn;
  return true;
}

#define XB_TMO      128
#define XB_XCNT(j)  (256  + 64 * (j))
#define XB_XSUB(j)  (1280 + 64 * (j))
#define XB_XGEN(j)  (2304 + 64 * (j))
#define XB_TOP      3328
#define XB_TOPGEN   3392
#define XCD_BAR_WORDS 3456
#define XB_SPIN_CAP (1u << 18)
#define LAS __attribute__((address_space(3)))
__device__ __forceinline__ unsigned xb_ld(unsigned* p)              { return __hip_atomic_load(p, __ATOMIC_RELAXED, __HIP_MEMORY_SCOPE_AGENT); }
__device__ __forceinline__ unsigned xb_add(unsigned* p, unsigned v) { return __hip_atomic_fetch_add(p, v, __ATOMIC_RELAXED, __HIP_MEMORY_SCOPE_AGENT); }
__device__ __forceinline__ unsigned xb_xcc_id() { return (unsigned)__builtin_amdgcn_s_getreg((3 << 11) | 20) & 0xFu; }
#define XB_SPIN(cond, bar) do { unsigned _sp = 0; while (cond) { __builtin_amdgcn_s_sleep(1); \
    if ((++_sp & 255u) == 0u) { if (xb_ld(&(bar)[XB_TMO])) break; if (_sp > XB_SPIN_CAP) { atomicAdd(&(bar)[XB_TMO], 1u); break; } } } } while (0)
struct XcdBarrier { unsigned* bar; unsigned x; volatile LAS unsigned* st; };
__device__ __forceinline__ XcdBarrier xcd_barrier_post(unsigned* bar, volatile LAS unsigned* st) {
  XcdBarrier b; b.bar = bar; b.x = xb_xcc_id(); b.st = st;
  if (tid_() == 0) (void)xb_add(&bar[XB_XCNT(b.x)], 1u);
  return b;
}
__device__ __forceinline__ void xcd_barrier_complete(unsigned* bar, unsigned x, unsigned& nloc, unsigned& nx) {
  const unsigned G = gridDim.x * gridDim.y * gridDim.z;
  unsigned sum, cnt, mine, sp = 0u;
  for (;;) {
    sum = 0u; cnt = 0u; mine = 0u;
#pragma unroll
    for (unsigned j = 0; j < 16; ++j) { const unsigned c = xb_ld(&bar[XB_XCNT(j)]); sum += c; cnt += (c > 0u) ? 1u : 0u; mine = (j == x) ? c : mine; }
    if (sum == G) break;
    __builtin_amdgcn_s_sleep(1);
    if ((++sp & 255u) == 0u) { if (xb_ld(&bar[XB_TMO])) break; if (sp > XB_SPIN_CAP) { atomicAdd(&bar[XB_TMO], 1u); break; } }
  }
  nloc = mine > 0u ? mine : 1u; nx = cnt > 0u ? cnt : 1u;
}
__device__ __forceinline__ void xcd_barrier(char* wsb, char* ldsb) {
#if defined(__HIP_DEVICE_COMPILE__)
  XcdBarrier b; b.bar = (unsigned*)(wsb + O_BAR); b.x = xb_xcc_id(); b.st = (volatile LAS unsigned*)(ldsb + LDS_BYTES - 16);
  asm volatile("s_waitcnt vmcnt(0)" ::: "memory");
  __syncthreads();
  if (tid_() == 0) {
    unsigned* bar = b.bar;
    __builtin_amdgcn_s_waitcnt(0);
    unsigned nloc = b.st[0], nx = b.st[1];
    if (nloc == 0u) { xcd_barrier_complete(bar, b.x, nloc, nx); b.st[0] = nloc; b.st[1] = nx; }
    const unsigned old = xb_add(&bar[XB_XSUB(b.x)], 1u);
    const unsigned gen = old / nloc;
    if (old + 1u == (gen + 1u) * nloc) {
      __builtin_amdgcn_fence(__ATOMIC_RELEASE, "agent");
      asm volatile("s_waitcnt vmcnt(0)" ::: "memory");
      const unsigned og = xb_add(&bar[XB_TOP], 1u);
      const unsigned tg = og / nx;
      if (og + 1u == (tg + 1u) * nx) xb_add(&bar[XB_TOPGEN], 1u);
      else XB_SPIN(xb_ld(&bar[XB_TOPGEN]) == tg, bar);
      __builtin_amdgcn_fence(__ATOMIC_ACQUIRE, "agent");
      xb_add(&bar[XB_XGEN(b.x)], 1u);
      asm volatile("s_waitcnt vmcnt(0)" ::: "memory");
    } else {
      XB_SPIN(xb_ld(&bar[XB_XGEN(b.x)]) == gen, bar);
      __builtin_amdgcn_fence(__ATOMIC_ACQUIRE, "agent");
      asm volatile("s_waitcnt vmcnt(0)" ::: "memory");
    }
  }
  __syncthreads();
#endif
}

__global__ void __launch_bounds__(NT) fwd_kernel(P p) {
  extern __shared__ __attribute__((aligned(16))) char lds[];
  cg::grid_group grid = cg::this_grid();
  char* ws = p.ws;
  const float* mod0 = (const float*)(ws + O_MOD);
  const float* mod1 = mod0 + 9 * 6144;
  volatile LAS unsigned* xst = (volatile LAS unsigned*)(lds + LDS_BYTES - 16);
  if (tid_() == 0) { xst[0] = 0u; xst[1] = 0u; }
  __syncthreads();
  (void)xcd_barrier_post((unsigned*)(p.ws + O_BAR), xst);
  for (int ph = p.ph_lo; ph < p.ph_hi; ++ph) {
    if (ph > p.ph_lo) {
      if (ph == p.ph_lo + 1) grid.sync();
      else xcd_barrier(p.ws, lds);
    }
    if (!((PHASE_MASK >> ph) & 1)) continue;
    const int nrep = ((REPEAT_MASK >> ph) & 1) ? 2 : 1;
    for (int rep = 0; rep < nrep; ++rep) {
    const bool dummy = rep + 1 < nrep;
    if (rep) grid.sync();
    switch (ph) {
      case 0: phase_prep(p, lds); break;
      case 1: phase_norm(p, p.in[0], p.in[2], p.in[6], 0, 0, TTOK, (u16*)(ws + O_XN)); break;
      case 2: {
        u16* hgg = (u16*)(ws + O_HGG); u16* Q = (u16*)(ws + O_Q); u16* KBp = (u16*)(ws + O_KB); u16* VT = (u16*)(ws + O_VT);
        for (int kq = 0, mt = 0, ntw = 0; xcd_tile(kq, 136, 10, mt, ntw); ++kq) {
          if (ntw < 8) {
            const int n0w = ntw * 256;
            u16* dbase; int dld;
            if (n0w < 1536) { dbase = hgg + n0w; dld = 1536; } else { dbase = Q + (n0w - 1536); dld = 512; }
            auto xf = [&](float v, int row, int col) -> float { return v; };
            auto dstf = [&](int row) -> u16* { return dbase + (size_t)row * dld; };
            gemm_tile256<false>((const u16*)(ws + O_XN), 1024, nullptr, (const u16*)(ws + O_WIN) + (size_t)n0w * 1024, 1024, 1024,
                                mt * 256, xf, dstf, (u16*)lds);
            continue;
          }
          int nt = 8 + ntw;
          int n0 = nt * 128;
          auto epi = [&](int row, int col, float v0, float v1, float v2, float v3) {
            int n = n0 + col;
            float v[4] = {v0, v1, v2, v3};
            if (n < 1536) {
#pragma unroll
              for (int j = 0; j < 4; ++j) hgg[(size_t)(row + j) * 1536 + n] = f2bf(v[j]);
            } else if (n < 2048) {
#pragma unroll
              for (int j = 0; j < 4; ++j) Q[(size_t)(row + j) * 512 + n - 1536] = f2bf(v[j]);
            } else if (n < 2176) {
#pragma unroll
              for (int j = 0; j < 4; ++j) KBp[(size_t)(row + j) * 128 + n - 2048] = f2bf(v[j]);
            } else {
              int kvh = (n - 2176) >> 6, d = (n - 2176) & 63;
              int b, pos;
              if (row < NLAT) { b = row >> 12; pos = 256 + (row & 4095); } else { b = (row - NLAT) >> 8; pos = (row - NLAT) & 255; }
              uint2 o; o.x = pack2(v0, v1); o.y = pack2(v2, v3);
              *(uint2*)(VT + ((size_t)((b * 2 + kvh) * 64 + d)) * 4352 + pos) = o;
            }
          };
          if (nt < 17) {
            u16* dbase; int dld;
            if (n0 < 1536) { dbase = hgg + n0; dld = 1536; } else if (n0 < 2048) { dbase = Q + (n0 - 1536); dld = 512; } else { dbase = KBp + (n0 - 2048); dld = 128; }
            auto xf = [&](float v, int row, int col) -> float { return v; };
            auto dstf = [&](int row) -> u16* { return dbase + (size_t)row * dld; };
            gemm_tile<false, 1>((const u16*)(ws + O_XN), 1024, nullptr, (const u16*)(ws + O_WIN) + (size_t)n0 * 1024, 1024, 1024,
                                mt * 256, xf, dstf, (u16*)lds);
          } else {
            gemm_tile<false, 0>((const u16*)(ws + O_XN), 1024, nullptr, (const u16*)(ws + O_WIN) + (size_t)n0 * 1024, 1024, 1024,
                                mt * 256, epi, 0, (u16*)lds);
          }
        }
      } break;
      case 3: phase_conv_qk(p); break;
      case 4: phase_attn(p, lds); break;
      case 5: {
        float* HC = (float*)(ws + O_HC);
        for (int kq = 0, mt = 0, nt = 0; xcd_tile(kq, 136, 8, mt, nt); ++kq) {
          int n0 = nt * 128;
          auto epi = [&](int row, int col, float v0, float v1, float v2, float v3) {
            int n = n0 + col;
            float v[4] = {v0, v1, v2, v3};
#pragma unroll
            for (int j = 0; j < 4; ++j) {
              int rw = row + j;
              if (rw < NLAT) {
                float g = mod0[(rw >> 12) * 6144 + 2048 + n];
                p.out[(size_t)rw * DM + n] = p.in[0][(size_t)rw * DM + n] + g * v[j];
              } else {
                float g = mod0[8 * 6144 + 2048 + n];
                HC[(size_t)(rw - NLAT) * DM + n] = p.in[2][(size_t)(rw - NLAT) * DM + n] + g * v[j];
              }
            }
          };
          gemm_tile<false, 0>((const u16*)(ws + O_XN), 1024, nullptr, (const u16*)(ws + O_WOUT) + (size_t)n0 * 1024, 1024, 1024,
                              mt * 256, epi, 0, (u16*)lds);
        }
      } break;
      case 6: phase_norm(p, p.out, (const float*)(ws + O_HC), p.in[7], 0, 3, TTOK, (u16*)(ws + O_XN)); break;
      case 7: case 18: {
        int layer = ph == 7 ? 0 : 1;
        int mtiles = layer == 0 ? 136 : 128;
        u16* PQ = (u16*)(ws + (layer == 0 ? O_PQ0 : O_PQ1));
        const u16* Wq = (const u16*)(ws + O_WQ) + (size_t)layer * 2048 * 1024;
        for (int kq = 0, mt = 0, nt = 0; xcd_tile(kq, mtiles, 8, mt, nt); ++kq) {
          int n0 = nt * 256;
          auto epi = [&](int row, int col, float v0, float v1, float v2, float v3) {
            int n = n0 + col;
            float v[4] = {v0, v1, v2, v3};
#pragma unroll
            for (int j = 0; j < 4; ++j) PQ[(size_t)(row + j) * 2048 + n] = f2bf(v[j]);
          };
          auto xf = [&](float v, int row, int col) -> float { return v; };
          auto dstf = [&](int row) -> u16* { return PQ + (size_t)row * 2048 + n0; };
          gemm_tile256<false>((const u16*)(ws + O_XN), 1024, nullptr, Wq + (size_t)n0 * 1024, 1024, 1024, mt * 256, xf, dstf, (u16*)lds);
        }
      } break;
      case 8: phase_peer_topk(p, 0, (const u16*)(ws + O_PQ0), TTOK, (int*)(ws + O_IDX0), (float*)(ws + O_GATE0), lds); break;
      case 9: phase_peer_act(p, (const u16*)(ws + O_XN), ws + O_TAB0, (const int*)(ws + O_IDX0), (const float*)(ws + O_GATE0),
                             (float*)(ws + O_COEF0), TTOK, lds); break;
      case 10: phase_peer_sum(p, 0, ws + O_TAB0, (const int*)(ws + O_IDX0), (const float*)(ws + O_COEF0), TTOK, dummy ? (float*)(ws + O_A2R) : nullptr); break;
      case 11: phase_norm(p, p.out, (const float*)(ws + O_HC), p.in[6] + 1024, 1, 0, TTOK, (u16*)(ws + O_XN)); break;
      case 12: {
        u16* LORA = (u16*)(ws + O_LORA);
        for (int kq = 0;; ++kq) {
          const int u = (blockIdx.x >> 3) + (gridDim.x >> 3) * kq;
          if (u >= 17 * 27) break;
          int mt, nt;
          if (u < 408) { int g = u / 136, rem = u % 136; mt = (rem >> 3) * 8 + (blockIdx.x & 7); nt = g * 8 + (rem & 7); }
          else { int v2 = u - 408; mt = (v2 / 3) * 8 + (blockIdx.x & 7); nt = 24 + v2 % 3; }
          const u16* Bp; int mixi; u16* dstp = nullptr; int kind;
          if (nt < 8) { Bp = (const u16*)(ws + O_WR) + (size_t)nt * 128 * 1024; mixi = 0; dstp = (u16*)(ws + O_R) + nt * 128; kind = 0; }
          else if (nt < 16) { Bp = (const u16*)(ws + O_WK) + (size_t)(nt - 8) * 128 * 1024; mixi = 2; dstp = (u16*)(ws + O_K) + (nt - 8) * 128; kind = 0; }
          else if (nt < 24) { Bp = (const u16*)(ws + O_WV) + (size_t)(nt - 16) * 128 * 1024; mixi = 3; dstp = (u16*)(ws + O_V) + (nt - 16) * 128; kind = 0; }
          else if (nt == 24) { Bp = (const u16*)(ws + O_W1); mixi = 1; kind = 1; }
          else if (nt == 25) { Bp = (const u16*)(ws + O_A1); mixi = 4; kind = 2; }
          else { Bp = (const u16*)(ws + O_G1); mixi = 5; kind = 3; }
          auto epi = [&](int row, int col, float v0, float v1, float v2, float v3) {
            float v[4] = {v0, v1, v2, v3};
            if (kind == 0) {
#pragma unroll
              for (int j = 0; j < 4; ++j) dstp[(size_t)(row + j) * 1024 + col] = f2bf(v[j]);
            } else if (kind == 1) {
#pragma unroll
              for (int j = 0; j < 4; ++j) LORA[(size_t)(row + j) * 384 + col] = f2bf(tanhf(v[j]));
            } else if (kind == 2) {
#pragma unroll
              for (int j = 0; j < 4; ++j) LORA[(size_t)(row + j) * 384 + 128 + col] = f2bf(v[j]);
            } else {
#pragma unroll
              for (int j = 0; j < 4; ++j) LORA[(size_t)(row + j) * 384 + 256 + col] = f2bf(sigmoidf_(v[j]));
            }
          };
          auto xf = [&](float v, int row, int col) -> float { return kind == 1 ? tanhf(v) : (kind == 3 ? sigmoidf_(v) : v); };
          u16* dbase = kind == 0 ? dstp : (LORA + (kind - 1) * 128);
          const int dld = kind == 0 ? 1024 : 384;
          auto dstf = [&](int row) -> u16* { return dbase + (size_t)row * dld; };
          gemm_tile<true, 1>((const u16*)(ws + O_XN), 1024, p.in[13] + mixi * 1024, Bp, 1024, 1024, mt * 256, xf, dstf, (u16*)lds);
        }
      } break;
      case 13: {
        const u16* LORA = (const u16*)(ws + O_LORA);
        u16* G = (u16*)(ws + O_G);
        for (int t = blockIdx.x; t < 136 * 40; t += gridDim.x) {
          int mt = t / 40, nt = t % 40;
          int grp = nt >> 3, n0 = (nt & 7) * 128;
          const u16* Ap; const u16* Bp; int K, ldb;
          if (grp < 2) { Ap = LORA + grp * 64; Bp = (const u16*)(ws + O_W2) + (size_t)grp * 65536 + (size_t)n0 * 64; K = 64; ldb = 64; }
          else if (grp < 4) { Ap = LORA + 128 + (grp - 2) * 64; Bp = (const u16*)(ws + O_A2) + (size_t)(grp - 2) * 65536 + (size_t)n0 * 64; K = 64; ldb = 64; }
          else { Ap = LORA + 256; Bp = (const u16*)(ws + O_G2) + (size_t)n0 * 128; K = 128; ldb = 128; }
          int d = grp & 1;
          u8* WA = (u8*)(ws + (d ? O_WA1 : O_WA0));
          auto epi = [&](int row, int col, float v0, float v1, float v2, float v3) {
            int n = n0 + col;
            float v[4] = {v0, v1, v2, v3};
            if (grp < 2) {
              float w0 = p.in[23][d * 1024 + n];
#pragma unroll
              for (int j = 0; j < 4; ++j) {
                float x = w0 + v[j];
                float dec = __expf(-0.6065306597126334f * sigmoidf_(x));
                float q = rintf((dec - 0.5f) * 510.f);
                q = fminf(fmaxf(q, 0.f), 255.f);
                WA[(size_t)(row + j) * 2048 + (n >> 6) * 128 + (n & 63)] = (u8)q;
              }
            } else if (grp < 4) {
              float a0 = p.in[26][d * 1024 + n];
#pragma unroll
              for (int j = 0; j < 4; ++j) {
                float a = sigmoidf_(a0 + v[j]);
                float q = fminf(fmaxf(rintf(a * 255.f), 0.f), 255.f);
                WA[(size_t)(row + j) * 2048 + (n >> 6) * 128 + 64 + (n & 63)] = (u8)q;
              }
            } else {
#pragma unroll
              for (int j = 0; j < 4; ++j) G[(size_t)(row + j) * 1024 + n] = f2bf(v[j]);
            }
          };
          if (grp < 4) {
            const float* b0p = (grp < 2 ? p.in[23] : p.in[26]) + d * 1024 + n0;
            auto q8 = [&](float v, int row, int col) -> unsigned {
              float x = b0p[col] + v;
              float qv;
              if (grp < 2) { float dec = __expf(-0.6065306597126334f * sigmoidf_(x)); qv = rintf((dec - 0.5f) * 510.f); }
              else { qv = rintf(sigmoidf_(x) * 255.f); }
              return (unsigned)fminf(fmaxf(qv, 0.f), 255.f);
            };
            auto dst8 = [&](int row, int c16) -> u8* {
              int n = n0 + c16 * 16;
              return WA + (size_t)row * 2048 + (n >> 6) * 128 + (grp < 2 ? 0 : 64) + (n & 63);
            };
            gemm_tile<false, 2>(Ap, 384, nullptr, Bp, ldb, K, mt * 256, q8, dst8, (u16*)lds);
          } else {
            auto xf = [&](float v, int row, int col) -> float { return v; };
            auto dstf = [&](int row) -> u16* { return G + (size_t)row * 1024 + n0; };
            gemm_tile<false, 1>(Ap, 384, nullptr, Bp, ldb, K, mt * 256, xf, dstf, (u16*)lds);
          }
        }
      } break;
      case 14: phase_scan(p, lds, dummy); break;
      case 15:
        phase_readout(p);
        convert_tab_fp8(p.in[33] + (size_t)16384 * 1024, p.in[34] + (size_t)16384 * 1024, ws + O_TAB1);
        break;
      case 16: {
        for (int kq = 0, mt = 0, nt = 0; xcd_tile(kq, 128, 8, mt, nt); ++kq) {
          int n0 = nt * 128;
          auto epi = [&](int row, int col, float v0, float v1, float v2, float v3) {
            int n = n0 + col;
            float v[4] = {v0, v1, v2, v3};
#pragma unroll
            for (int j = 0; j < 4; ++j) {
              int rw = row + j;
              float g = mod1[(rw >> 12) * 6144 + 2048 + n];
              p.out[(size_t)rw * DM + n] += g * v[j];
            }
          };
          gemm_tile<false, 0>((const u16*)(ws + O_Z), 1024, nullptr, (const u16*)(ws + O_WO) + (size_t)n0 * 1024, 1024, 1024,
                              mt * 256, epi, 0, (u16*)lds);
        }
      } break;
      case 17: phase_norm(p, p.out, nullptr, p.in[7] + 1024, 1, 3, NLAT, (u16*)(ws + O_XN)); break;
      case 19: phase_peer_topk(p, 1, (const u16*)(ws + O_PQ1), NLAT, (int*)(ws + O_IDX1), (float*)(ws + O_GATE1), lds); break;
      case 20: phase_peer_act(p, (const u16*)(ws + O_XN), ws + O_TAB1, (const int*)(ws + O_IDX1), (const float*)(ws + O_GATE1),
                              (float*)(ws + O_COEF1), NLAT, lds); break;
      case 21: phase_peer_sum(p, 1, ws + O_TAB1, (const int*)(ws + O_IDX1), (const float*)(ws + O_COEF1), NLAT, dummy ? (float*)(ws + O_A5R) : nullptr); break;
      default: break;
    }
    }
  }
}

extern "C" void kernel_launch(void* const* d_in, const int* in_sizes, int n_in, void* d_out, int out_size, void* d_ws,
                              size_t ws_size, hipStream_t stream) {
  static int grid = 0;
  if (grid == 0) {
    if (n_in != 35 || ws_size < WS_END) {
      fprintf(stderr, "kernel_launch: unexpected n_in %d or ws_size %zu (need %zu)\n", n_in, ws_size, (size_t)WS_END);
      grid = -1;
      return;
    }
    int dev = 0, cus = 0, per_cu = 0;
    hipGetDevice(&dev);
    hipDeviceGetAttribute(&cus, hipDeviceAttributeMultiprocessorCount, dev);
    hipFuncSetAttribute((const void*)fwd_kernel, hipFuncAttributeMaxDynamicSharedMemorySize, LDS_BYTES);
    hipOccupancyMaxActiveBlocksPerMultiprocessor(&per_cu, (const void*)fwd_kernel, NT, LDS_BYTES);
    (void)hipGetLastError();
    if (per_cu < 1) per_cu = 1;
    grid = (cus / 8) * 8;
    if (grid > cus * per_cu) grid = cus * per_cu;
  }
  if (grid < 0) return;
  P p{};
  for (int i = 0; i < 35; ++i) p.in[i] = (const float*)d_in[i];
  p.out = (float*)d_out;
  p.ws = (char*)d_ws;
#if N_LAUNCH_MODE == 0
  (void)hipMemsetAsync((char*)d_ws + O_BAR, 0, 16384, stream);
  p.ph_lo = 0; p.ph_hi = NPHASE;
  void* args[] = {&p};
  hipError_t e = hipLaunchCooperativeKernel((const void*)fwd_kernel, dim3(grid), dim3(NT), args, LDS_BYTES, stream);
  if (e != hipSuccess) fprintf(stderr, "cooperative launch failed: %s (grid %d)\n", hipGetErrorString(e), grid);
#else
  for (int ph = 0; ph < NPHASE; ++ph) {
    p.ph_lo = ph; p.ph_hi = ph + 1;
    hipLaunchKernelGGL(fwd_kernel, dim3(grid), dim3(NT), LDS_BYTES, stream, p);
  }
#endif
}
```

```cpp
#include <hip/hip_runtime.h>
#include <hip/hip_cooperative_groups.h>
#include <cstdio>
namespace cg = cooperative_groups;

#ifndef N_LAUNCH_MODE
#define N_LAUNCH_MODE 0
#endif

typedef unsigned short u16;
typedef unsigned char u8;
typedef __attribute__((ext_vector_type(8))) short bf16x8;
typedef __attribute__((ext_vector_type(16))) float f32x16;

#define NT 512
#define TTOK 34816
#define NLAT 32768
#define DM 1024
#define LDSS 72
#define LDS_BYTES 149504
#define NPHASE 22
#ifndef REPEAT_MASK
#define REPEAT_MASK 0
#endif
#ifndef PHASE_MASK
#define PHASE_MASK 0x3FFFFF
#endif

static constexpr size_t MiB = 1048576;
static constexpr size_t O_WIN = 0;
static constexpr size_t O_WOUT = O_WIN + 4718592;
static constexpr size_t O_WR = O_WOUT + 2097152;
static constexpr size_t O_WK = O_WR + 2097152;
static constexpr size_t O_WV = O_WK + 2097152;
static constexpr size_t O_WO = O_WV + 2097152;
static constexpr size_t O_G1 = O_WO + 2097152;
static constexpr size_t O_G2 = O_G1 + 262144;
static constexpr size_t O_W1 = O_G2 + 262144;
static constexpr size_t O_A1 = O_W1 + 262144;
static constexpr size_t O_W2 = O_A1 + 262144;
static constexpr size_t O_A2 = O_W2 + 262144;
static constexpr size_t O_WQ = O_A2 + 262144;
static constexpr size_t O_KEYS = O_WQ + 8388608;
static constexpr size_t O_MOD = O_KEYS + 1048576;
static constexpr size_t O_ROPE = O_MOD + 442368;
static constexpr size_t SZ = 68 * MiB;
static constexpr size_t O_A1R = 26 * MiB;
static constexpr size_t O_A2R = O_A1R + SZ;
static constexpr size_t O_A3R = O_A2R + SZ;
static constexpr size_t O_A4R = O_A3R + SZ;
static constexpr size_t O_A5R = O_A4R + SZ;
static constexpr size_t O_A6R = O_A5R + SZ;
static constexpr size_t O_A7R = O_A6R + SZ;
static constexpr size_t O_LORA = O_A7R;
static constexpr size_t O_BONUS = O_A7R + 26 * MiB;
static constexpr size_t O_BAR = O_BONUS + 4 * MiB;
static constexpr size_t WS_END = O_BAR + 1 * MiB;
static constexpr size_t O_XN = O_A1R;
static constexpr size_t O_HGG = O_A2R;
static constexpr size_t O_Q = O_A2R + 102 * MiB;
static constexpr size_t O_KB = O_A4R;
static constexpr size_t O_VT = O_A4R + 9 * MiB;
static constexpr size_t O_PQ0 = O_A2R;
static constexpr size_t O_TAB0 = O_A5R;
static constexpr size_t O_IDX0 = O_A6R;
static constexpr size_t O_GATE0 = O_A6R + 17 * MiB;
static constexpr size_t O_HC = O_A6R + 34 * MiB;
static constexpr size_t O_COEF0 = O_A6R + 42 * MiB;
static constexpr size_t O_R = O_A2R, O_K = O_A3R, O_V = O_A4R;
static constexpr size_t O_WA0 = O_A5R, O_WA1 = O_A6R;
static constexpr size_t O_G = O_A1R;
static constexpr size_t O_Z = O_A2R;
static constexpr size_t O_TAB1 = O_A3R;
static constexpr size_t O_PQ1 = O_A5R;
static constexpr size_t O_IDX1 = O_A4R;
static constexpr size_t O_GATE1 = O_A4R + 17 * MiB;
static constexpr size_t O_COEF1 = O_A4R + 34 * MiB;

struct P {
  const float* in[35];
  float* out;
  char* ws;
  int ph_lo, ph_hi;
};

typedef __bf16 bf16x2_t __attribute__((ext_vector_type(2)));
typedef float f32x2_t __attribute__((ext_vector_type(2)));
__device__ __forceinline__ u16 f2bf(float f) {
  __bf16 b = (__bf16)f;
  return __builtin_bit_cast(u16, b);
}
__device__ __forceinline__ float bf2f(u16 h) { return __uint_as_float(((unsigned)h) << 16); }
__device__ __forceinline__ float bflo(unsigned w) { return __uint_as_float(w << 16); }
__device__ __forceinline__ float bfhi(unsigned w) { return __uint_as_float(w & 0xFFFF0000u); }
__device__ __forceinline__ unsigned pack2(float a, float b) { f32x2_t v = {a, b}; bf16x2_t r = __builtin_convertvector(v, bf16x2_t); return __builtin_bit_cast(unsigned, r); }

__device__ __forceinline__ int tid_() { int t = __builtin_amdgcn_workitem_id_x(); asm volatile("" : "+v"(t)); return t; }
template <int CTRL>
__device__ __forceinline__ float dppf(float v) {
  return __builtin_bit_cast(float, __builtin_amdgcn_update_dpp(0, __builtin_bit_cast(int, v), CTRL, 0xF, 0xF, true));
}
__device__ __forceinline__ float red8(float v) {
  v += dppf<0xB1>(v); v += dppf<0x4E>(v); v += dppf<0x141>(v); return v;
}
__device__ __forceinline__ float red16(float v) { v = red8(v); v += dppf<0x140>(v); return v; }
__device__ __forceinline__ float swapsum32(float a, float b) {
  auto r = __builtin_amdgcn_permlane32_swap(__float_as_uint(a), __float_as_uint(b), false, false);
  return __uint_as_float(r[0]) + __uint_as_float(r[1]);
}
__device__ __forceinline__ float swapsum16(float a, float b) {
  auto r = __builtin_amdgcn_permlane16_swap(__float_as_uint(a), __float_as_uint(b), false, false);
  return __uint_as_float(r[0]) + __uint_as_float(r[1]);
}
__device__ __forceinline__ float swapmax32(float a) {
  auto r = __builtin_amdgcn_permlane32_swap(__float_as_uint(a), __float_as_uint(a), false, false);
  return fmaxf(__uint_as_float(r[0]), __uint_as_float(r[1]));
}
__device__ __forceinline__ float swapmax16(float a) {
  auto r = __builtin_amdgcn_permlane16_swap(__float_as_uint(a), __float_as_uint(a), false, false);
  return fmaxf(__uint_as_float(r[0]), __uint_as_float(r[1]));
}
__device__ __forceinline__ float wave_sum(float v) {
  v = red16(v);
  v = swapsum16(v, v); v = swapsum32(v, v);
  return v;
}
__device__ __forceinline__ float sigmoidf_(float x) { return 1.f / (1.f + __expf(-x)); }

template <bool MIX, int OM, class Epi, class Dst>
__device__ __forceinline__ void gemm_tile(const u16* __restrict__ A, int lda, const float* __restrict__ mu,
                                          const u16* __restrict__ B, int ldb, int K, int row0, Epi epi, Dst dstf, u16* lds) {
  u16* sA = lds;
  u16* sB = lds + 256 * LDSS;
  const int tid = tid_(), lane = tid & 63, wave = tid >> 6;
  const int wm = wave & 3, wn = wave >> 2;
  const int r = lane & 31, h = lane >> 5;
  const int kc = tid & 7, lr = tid >> 3;
  f32x16 acc[2][2];
#pragma unroll
  for (int i = 0; i < 2; ++i)
#pragma unroll
    for (int j = 0; j < 2; ++j)
#pragma unroll
      for (int g = 0; g < 16; ++g) acc[i][j][g] = 0.f;
  uint4 pa0, pa1, pa2, pa3, ps0, ps1, ps2, ps3, pb0, pb1;
  ps0 = ps1 = ps2 = ps3 = make_uint4(0, 0, 0, 0);
  float4 m0 = make_float4(0, 0, 0, 0), m1 = m0;
  auto nbr = [&](int row, int kg) -> int {
    if (row < NLAT) {
      int t = row & 4095; int gc = t & 63, gr = t >> 6; int qd = kg >> 8;
      if (qd == 0) return gc > 0 ? row - 1 : -1;
      if (qd == 1) return gc < 63 ? row + 1 : -1;
      if (qd == 2) return gr > 0 ? row - 64 : -1;
      return gr < 63 ? row + 64 : -1;
    } else {
      int t = (row - NLAT) & 255;
      if (kg < 512) return t > 0 ? row - 1 : -1;
      return t < 255 ? row + 1 : -1;
    }
  };
  auto ldA = [&](int i, int k0, uint4& a, uint4& sx) {
    int row = row0 + lr + 64 * i;
    a = *(const uint4*)(A + (size_t)row * lda + k0 + kc * 8);
    if (MIX) {
      int nr = nbr(row, k0 + kc * 8);
      if (nr >= 0) sx = *(const uint4*)(A + (size_t)nr * lda + k0 + kc * 8);
      else sx = make_uint4(0, 0, 0, 0);
    }
  };
  auto gload = [&](int k0) {
    ldA(0, k0, pa0, ps0); ldA(1, k0, pa1, ps1); ldA(2, k0, pa2, ps2); ldA(3, k0, pa3, ps3);
    if (MIX) {
      m0 = *(const float4*)(mu + k0 + kc * 8);
      m1 = *(const float4*)(mu + k0 + kc * 8 + 4);
    }
    pb0 = *(const uint4*)(B + (size_t)lr * ldb + k0 + kc * 8);
    pb1 = *(const uint4*)(B + (size_t)(lr + 64) * ldb + k0 + kc * 8);
  };
  auto mixw = [&](unsigned x, unsigned s, float ma, float mb) -> unsigned {
    float x0 = bflo(x), x1 = bfhi(x), s0 = bflo(s), s1 = bfhi(s);
    return pack2(x0 + (s0 - x0) * ma, x1 + (s1 - x1) * mb);
  };
  int bo = 0;
  auto stA = [&](int i, uint4 a, uint4 sx) {
    uint4 v = a;
    if (MIX) {
      v.x = mixw(a.x, sx.x, m0.x, m0.y);
      v.y = mixw(a.y, sx.y, m0.z, m0.w);
      v.z = mixw(a.z, sx.z, m1.x, m1.y);
      v.w = mixw(a.w, sx.w, m1.z, m1.w);
    }
    *(uint4*)(sA + bo + (lr + 64 * i) * LDSS + kc * 8) = v;
  };
  auto lstore = [&]() {
    stA(0, pa0, ps0); stA(1, pa1, ps1); stA(2, pa2, ps2); stA(3, pa3, ps3);
    *(uint4*)(sB + bo + lr * LDSS + kc * 8) = pb0;
    *(uint4*)(sB + bo + (lr + 64) * LDSS + kc * 8) = pb1;
  };
  constexpr int BUFE = (256 + 128) * LDSS;
  gload(0);
  bo = 0; lstore();
  if (64 < K) gload(64);
  __syncthreads();
  for (int k0 = 0; k0 < K; k0 += 64) {
    const int co = ((k0 >> 6) & 1) * BUFE;
    bf16x8 af[2], bfr[2], naf[2], nbf[2];
#pragma unroll
    for (int i = 0; i < 2; ++i) af[i] = *(const bf16x8*)(sA + co + (wm * 64 + i * 32 + r) * LDSS + h * 8);
#pragma unroll
    for (int j = 0; j < 2; ++j) bfr[j] = *(const bf16x8*)(sB + co + (wn * 64 + j * 32 + r) * LDSS + h * 8);
#pragma unroll
    for (int kk = 0; kk < 4; ++kk) {
      if (kk == 2 && k0 + 64 < K) {
        bo = BUFE - co; lstore();
        if (k0 + 128 < K) gload(k0 + 128);
      }
      if (kk < 3) {
#pragma unroll
        for (int i = 0; i < 2; ++i) naf[i] = *(const bf16x8*)(sA + co + (wm * 64 + i * 32 + r) * LDSS + (kk + 1) * 16 + h * 8);
#pragma unroll
        for (int j = 0; j < 2; ++j) nbf[j] = *(const bf16x8*)(sB + co + (wn * 64 + j * 32 + r) * LDSS + (kk + 1) * 16 + h * 8);
      }
#pragma unroll
      for (int i = 0; i < 2; ++i)
#pragma unroll
        for (int j = 0; j < 2; ++j) {
          if (OM == 0) acc[i][j] = __builtin_amdgcn_mfma_f32_32x32x16_bf16(af[i], bfr[j], acc[i][j], 0, 0, 0);
          else acc[i][j] = __builtin_amdgcn_mfma_f32_32x32x16_bf16(bfr[j], af[i], acc[i][j], 0, 0, 0);
        }
      if (kk < 3) {
#pragma unroll
        for (int i = 0; i < 2; ++i) af[i] = naf[i];
#pragma unroll
        for (int j = 0; j < 2; ++j) bfr[j] = nbf[j];
      }
    }
    __syncthreads();
  }
  if constexpr (OM == 0) {
#pragma unroll
    for (int i = 0; i < 2; ++i)
#pragma unroll
      for (int j = 0; j < 2; ++j)
#pragma unroll
        for (int g4 = 0; g4 < 4; ++g4) {
          int row = row0 + wm * 64 + i * 32 + 8 * g4 + 4 * h;
          int col = wn * 64 + j * 32 + r;
          epi(row, col, acc[i][j][g4 * 4 + 0], acc[i][j][g4 * 4 + 1], acc[i][j][g4 * 4 + 2], acc[i][j][g4 * 4 + 3]);
        }
  } else if constexpr (OM == 1) {
    u16* st = lds;
#pragma unroll
    for (int i = 0; i < 2; ++i)
#pragma unroll
      for (int j = 0; j < 2; ++j)
#pragma unroll
        for (int g4 = 0; g4 < 4; ++g4) {
          const int rl = wm * 64 + i * 32 + r, c0 = wn * 64 + j * 32 + 8 * g4 + 4 * h;
          uint2 o;
          o.x = pack2(epi(acc[i][j][g4 * 4 + 0], row0 + rl, c0 + 0), epi(acc[i][j][g4 * 4 + 1], row0 + rl, c0 + 1));
          o.y = pack2(epi(acc[i][j][g4 * 4 + 2], row0 + rl, c0 + 2), epi(acc[i][j][g4 * 4 + 3], row0 + rl, c0 + 3));
          *(uint2*)(st + rl * 136 + c0) = o;
        }
    __syncthreads();
#pragma unroll
    for (int q = 0; q < 8; ++q) {
      const int id = tid + NT * q, rl = id >> 4, c8 = id & 15;
      const uint4 v = *(const uint4*)(st + rl * 136 + c8 * 8);
      *(uint4*)(dstf(row0 + rl) + c8 * 8) = v;
    }
    __syncthreads();
  } else {
    u8* st = (u8*)lds;
#pragma unroll
    for (int i = 0; i < 2; ++i)
#pragma unroll
      for (int j = 0; j < 2; ++j)
#pragma unroll
        for (int g4 = 0; g4 < 4; ++g4) {
          const int rl = wm * 64 + i * 32 + r, c0 = wn * 64 + j * 32 + 8 * g4 + 4 * h;
          unsigned o = epi(acc[i][j][g4 * 4 + 0], row0 + rl, c0 + 0) | (epi(acc[i][j][g4 * 4 + 1], row0 + rl, c0 + 1) << 8) |
                       (epi(acc[i][j][g4 * 4 + 2], row0 + rl, c0 + 2) << 16) | (epi(acc[i][j][g4 * 4 + 3], row0 + rl, c0 + 3) << 24);
          *(unsigned*)(st + rl * 144 + c0) = o;
        }
    __syncthreads();
#pragma unroll
    for (int q = 0; q < 4; ++q) {
      const int id = tid + NT * q, rl = id >> 3, c16 = id & 7;
      const uint4 v = *(const uint4*)(st + rl * 144 + c16 * 16);
      *(uint4*)(dstf(row0 + rl, c16)) = v;
    }
    __syncthreads();
  }
}

template <bool MIX, class Epi, class Dst>
__device__ __forceinline__ void gemm_tile256(const u16* __restrict__ A, int lda, const float* __restrict__ mu,
                                             const u16* __restrict__ B, int ldb, int K, int row0, Epi epi, Dst dstf, u16* lds) {
  u16* sA = lds;
  u16* sB = lds + 256 * LDSS;
  const int tid = tid_(), lane = tid & 63, wave = tid >> 6;
  const int wm = wave & 1, wn = wave >> 1;
  const int r = lane & 31, h = lane >> 5;
  const int kc = tid & 7, lr = tid >> 3;
  f32x16 acc[4][2];
#pragma unroll
  for (int i = 0; i < 4; ++i)
#pragma unroll
    for (int j = 0; j < 2; ++j)
#pragma unroll
      for (int g = 0; g < 16; ++g) acc[i][j][g] = 0.f;
  uint4 pa0, pa1, pa2, pa3, ps0, ps1, ps2, ps3, pb0, pb1, pb2, pb3;
  ps0 = ps1 = ps2 = ps3 = make_uint4(0, 0, 0, 0);
  float4 m0 = make_float4(0, 0, 0, 0), m1 = m0;
  auto nbr = [&](int row, int kg) -> int {
    if (row < NLAT) {
      int t = row & 4095; int gc = t & 63, gr = t >> 6; int qd = kg >> 8;
      if (qd == 0) return gc > 0 ? row - 1 : -1;
      if (qd == 1) return gc < 63 ? row + 1 : -1;
      if (qd == 2) return gr > 0 ? row - 64 : -1;
      return gr < 63 ? row + 64 : -1;
    } else {
      int t = (row - NLAT) & 255;
      if (kg < 512) return t > 0 ? row - 1 : -1;
      return t < 255 ? row + 1 : -1;
    }
  };
  auto ldA = [&](int i, int k0, uint4& a, uint4& sx) {
    int row = row0 + lr + 64 * i;
    a = *(const uint4*)(A + (size_t)row * lda + k0 + kc * 8);
    if (MIX) {
      int nr = nbr(row, k0 + kc * 8);
      if (nr >= 0) sx = *(const uint4*)(A + (size_t)nr * lda + k0 + kc * 8);
      else sx = make_uint4(0, 0, 0, 0);
    }
  };
  auto gload = [&](int k0) {
    ldA(0, k0, pa0, ps0); ldA(1, k0, pa1, ps1); ldA(2, k0, pa2, ps2); ldA(3, k0, pa3, ps3);
    if (MIX) {
      m0 = *(const float4*)(mu + k0 + kc * 8);
      m1 = *(const float4*)(mu + k0 + kc * 8 + 4);
    }
    pb0 = *(const uint4*)(B + (size_t)lr * ldb + k0 + kc * 8);
    pb1 = *(const uint4*)(B + (size_t)(lr + 64) * ldb + k0 + kc * 8);
    pb2 = *(const uint4*)(B + (size_t)(lr + 128) * ldb + k0 + kc * 8);
    pb3 = *(const uint4*)(B + (size_t)(lr + 192) * ldb + k0 + kc * 8);
  };
  auto mixw = [&](unsigned x, unsigned s_, float ma, float mb) -> unsigned {
    float x0 = bflo(x), x1 = bfhi(x), s0 = bflo(s_), s1 = bfhi(s_);
    return pack2(x0 + (s0 - x0) * ma, x1 + (s1 - x1) * mb);
  };
  int bo = 0;
  auto stA = [&](int i, uint4 a, uint4 sx) {
    uint4 v = a;
    if (MIX) {
      v.x = mixw(a.x, sx.x, m0.x, m0.y);
      v.y = mixw(a.y, sx.y, m0.z, m0.w);
      v.z = mixw(a.z, sx.z, m1.x, m1.y);
      v.w = mixw(a.w, sx.w, m1.z, m1.w);
    }
    *(uint4*)(sA + bo + (lr + 64 * i) * LDSS + kc * 8) = v;
  };
  auto lstore = [&]() {
    stA(0, pa0, ps0); stA(1, pa1, ps1); stA(2, pa2, ps2); stA(3, pa3, ps3);
    *(uint4*)(sB + bo + lr * LDSS + kc * 8) = pb0;
    *(uint4*)(sB + bo + (lr + 64) * LDSS + kc * 8) = pb1;
    *(uint4*)(sB + bo + (lr + 128) * LDSS + kc * 8) = pb2;
    *(uint4*)(sB + bo + (lr + 192) * LDSS + kc * 8) = pb3;
  };
  constexpr int BUFE = 2 * 256 * LDSS;
  gload(0);
  bo = 0; lstore();
  if (64 < K) gload(64);
  __syncthreads();
  for (int k0 = 0; k0 < K; k0 += 64) {
    const int co = ((k0 >> 6) & 1) * BUFE;
    bf16x8 af[4], bfr[2], naf[4], nbf[2];
#pragma unroll
    for (int i = 0; i < 4; ++i) af[i] = *(const bf16x8*)(sA + co + (wm * 128 + i * 32 + r) * LDSS + h * 8);
#pragma unroll
    for (int j = 0; j < 2; ++j) bfr[j] = *(const bf16x8*)(sB + co + (wn * 64 + j * 32 + r) * LDSS + h * 8);
#pragma unroll
    for (int kk = 0; kk < 4; ++kk) {
      if (kk == 2 && k0 + 64 < K) {
        bo = BUFE - co; lstore();
        if (k0 + 128 < K) gload(k0 + 128);
      }
      if (kk < 3) {
#pragma unroll
        for (int i = 0; i < 4; ++i) naf[i] = *(const bf16x8*)(sA + co + (wm * 128 + i * 32 + r) * LDSS + (kk + 1) * 16 + h * 8);
#pragma unroll
        for (int j = 0; j < 2; ++j) nbf[j] = *(const bf16x8*)(sB + co + (wn * 64 + j * 32 + r) * LDSS + (kk + 1) * 16 + h * 8);
      }
#pragma unroll
      for (int i = 0; i < 4; ++i)
#pragma unroll
        for (int j = 0; j < 2; ++j) acc[i][j] = __builtin_amdgcn_mfma_f32_32x32x16_bf16(bfr[j], af[i], acc[i][j], 0, 0, 0);
      if (kk < 3) {
#pragma unroll
        for (int i = 0; i < 4; ++i) af[i] = naf[i];
#pragma unroll
        for (int j = 0; j < 2; ++j) bfr[j] = nbf[j];
      }
    }
    __syncthreads();
  }
  u16* st = lds;
#pragma unroll
  for (int half = 0; half < 2; ++half) {
    if ((wn >> 1) == half) {
#pragma unroll
      for (int i = 0; i < 4; ++i)
#pragma unroll
        for (int j = 0; j < 2; ++j)
#pragma unroll
          for (int g4 = 0; g4 < 4; ++g4) {
            const int rl = wm * 128 + i * 32 + r, cl = (wn & 1) * 64 + j * 32 + 8 * g4 + 4 * h, c0 = half * 128 + cl;
            uint2 o;
            o.x = pack2(epi(acc[i][j][g4 * 4 + 0], row0 + rl, c0 + 0), epi(acc[i][j][g4 * 4 + 1], row0 + rl, c0 + 1));
            o.y = pack2(epi(acc[i][j][g4 * 4 + 2], row0 + rl, c0 + 2), epi(acc[i][j][g4 * 4 + 3], row0 + rl, c0 + 3));
            *(uint2*)(st + rl * 136 + cl) = o;
          }
    }
    __syncthreads();
#pragma unroll
    for (int q = 0; q < 8; ++q) {
      const int id = tid + NT * q, rl = id >> 4, c8 = id & 15;
      const uint4 v = *(const uint4*)(st + rl * 136 + c8 * 8);
      *(uint4*)(dstf(row0 + rl) + half * 128 + c8 * 8) = v;
    }
    __syncthreads();
  }
}

__constant__ int TJOBS[18][5] = {
    {8, 0, 1024, 2304, (int)O_WIN},
    {12, 0, 1024, 1024, (int)O_WOUT},
    {14, 0, 1024, 1024, (int)O_WR},
    {15, 0, 1024, 1024, (int)O_WK},
    {16, 0, 1024, 1024, (int)O_WV},
    {17, 0, 1024, 1024, (int)O_WO},
    {18, 0, 1024, 128, (int)O_G1},
    {19, 0, 128, 1024, (int)O_G2},
    {24, 0, 1024, 64, (int)O_W1},
    {24, 65536, 1024, 64, (int)(O_W1 + 131072)},
    {27, 0, 1024, 64, (int)O_A1},
    {27, 65536, 1024, 64, (int)(O_A1 + 131072)},
    {25, 0, 64, 1024, (int)O_W2},
    {25, 65536, 64, 1024, (int)(O_W2 + 131072)},
    {28, 0, 64, 1024, (int)O_A2},
    {28, 65536, 64, 1024, (int)(O_A2 + 131072)},
    {31, 0, 1024, 2048, (int)O_WQ},
    {31, 2097152, 1024, 2048, (int)(O_WQ + 4194304)},
};

__device__ __forceinline__ void convert_bf16(const float* __restrict__ src, u16* __restrict__ dst, size_t n) {
  size_t n4 = n >> 2;
  for (size_t i = (size_t)blockIdx.x * NT + tid_(); i < n4; i += (size_t)gridDim.x * NT) {
    float4 v = ((const float4*)src)[i];
    uint2 o; o.x = pack2(v.x, v.y); o.y = pack2(v.z, v.w);
    ((uint2*)dst)[i] = o;
  }
}

__device__ __forceinline__ void convert_tab_fp8(const float* __restrict__ U, const float* __restrict__ V, char* tab);
__device__ __forceinline__ void phase_prep(const P& p, char* lds) {
  const int tid = tid_();
  float* fl = (float*)lds;
  for (int task = blockIdx.x; task < 192; task += gridDim.x) {
    int l = task / 96, cg_ = task % 96;
    float* sv = fl;
    float* red = fl + 9216;
    for (int i = tid; i < 9216; i += NT) {
      int v = i >> 10, k = i & 1023;
      float x = v < 8 ? p.in[1][v * 1024 + k] : p.in[3][k];
      sv[i] = x / (1.f + __expf(-x));
    }
    __syncthreads();
    int col = cg_ * 64 + (tid & 63), kg = tid >> 6;
    float acc[9];
#pragma unroll
    for (int v = 0; v < 9; ++v) acc[v] = 0.f;
    const float* W = p.in[4] + (size_t)l * 1024 * 6144 + col;
    for (int k = kg * 128; k < kg * 128 + 128; ++k) {
      float w = W[(size_t)k * 6144];
#pragma unroll
      for (int v = 0; v < 9; ++v) acc[v] += sv[v * 1024 + k] * w;
    }
#pragma unroll
    for (int v = 0; v < 9; ++v) red[(kg * 9 + v) * 64 + (tid & 63)] = acc[v];
    __syncthreads();
    if (tid < 576) {
      int v = tid >> 6, c = tid & 63;
      float s = p.in[5][l * 6144 + cg_ * 64 + c];
#pragma unroll
      for (int g = 0; g < 8; ++g) s += red[(g * 9 + v) * 64 + c];
      ((float*)(p.ws + O_MOD))[(l * 9 + v) * 6144 + cg_ * 64 + c] = s;
    }
    __syncthreads();
  }
  {
    int base = 0;
    for (int j = 0; j < 18; ++j) {
      int K = TJOBS[j][2], N = TJOBS[j][3];
      int tk = K >> 6, tn = N >> 6, nt = tk * tn;
      const float* src = p.in[TJOBS[j][0]] + TJOBS[j][1];
      u16* dst = (u16*)(p.ws + (size_t)(unsigned)TJOBS[j][4]);
      int first = (blockIdx.x + gridDim.x - (base % gridDim.x)) % gridDim.x;
      for (int t = first; t < nt; t += gridDim.x) {
        int k0 = (t / tn) * 64, n0 = (t % tn) * 64;
#pragma unroll
        for (int rep = 0; rep < 8; ++rep) {
          int idx = tid + NT * rep; int i = idx >> 6, jj = idx & 63;
          fl[i * 65 + jj] = src[(size_t)(k0 + i) * N + n0 + jj];
        }
        __syncthreads();
        int n = tid >> 3, c8 = tid & 7;
        uint4 o;
        o.x = pack2(fl[(c8 * 8 + 0) * 65 + n], fl[(c8 * 8 + 1) * 65 + n]);
        o.y = pack2(fl[(c8 * 8 + 2) * 65 + n], fl[(c8 * 8 + 3) * 65 + n]);
        o.z = pack2(fl[(c8 * 8 + 4) * 65 + n], fl[(c8 * 8 + 5) * 65 + n]);
        o.w = pack2(fl[(c8 * 8 + 6) * 65 + n], fl[(c8 * 8 + 7) * 65 + n]);
        *(uint4*)(dst + (size_t)(n0 + n) * K + k0 + c8 * 8) = o;
        __syncthreads();
      }
      base += nt;
    }
  }
  convert_bf16(p.in[32], (u16*)(p.ws + O_KEYS), (size_t)2 * 8 * 2 * 128 * 128);
  convert_tab_fp8(p.in[33], p.in[34], p.ws + O_TAB0);
  if (blockIdx.x == 0) {
    float* rope = (float*)(p.ws + O_ROPE);
    for (int i = tid; i < 1024; i += NT) {
      int pos = i >> 4, f = i & 15;
      float inv = exp2f(-(float)f * (13.287712379549449f / 16.f));
      float ang = (float)pos * inv;
      rope[i * 2] = cosf(ang);
      rope[i * 2 + 1] = sinf(ang);
    }
  }
}

__device__ __forceinline__ void phase_norm(const P& p, const float* srcL, const float* srcC, const float* gain, int layer, int shift_idx,
                           int nrows, u16* dst) {
  const int lane = tid_() & 63;
  const int gw = blockIdx.x * 8 + (tid_() >> 6), nw = gridDim.x * 8;
  const float* mod = (const float*)(p.ws + O_MOD) + (size_t)layer * 9 * 6144;
  for (int row = gw; row < nrows; row += nw) {
    const float* src = row < NLAT ? srcL + (size_t)row * DM : srcC + (size_t)(row - NLAT) * DM;
    int mi = row < NLAT ? (row >> 12) : 8;
    const float* sh = mod + mi * 6144 + shift_idx * 1024;
    const float* sc = sh + 1024;
    float4 v[4];
    float ss = 0.f;
#pragma unroll
    for (int i = 0; i < 4; ++i) {
      v[i] = *(const float4*)(src + i * 256 + lane * 4);
      ss += v[i].x * v[i].x + v[i].y * v[i].y + v[i].z * v[i].z + v[i].w * v[i].w;
    }
    ss = wave_sum(ss);
    float rs = rsqrtf(ss * (1.f / 1024.f) + 1e-6f);
#pragma unroll
    for (int i = 0; i < 4; ++i) {
      int c = i * 256 + lane * 4;
      float4 g = *(const float4*)(gain + c);
      float4 s1 = *(const float4*)(sc + c);
      float4 s0 = *(const float4*)(sh + c);
      float a = v[i].x * rs * g.x * (1.f + s1.x) + s0.x;
      float b = v[i].y * rs * g.y * (1.f + s1.y) + s0.y;
      float cc = v[i].z * rs * g.z * (1.f + s1.z) + s0.z;
      float d = v[i].w * rs * g.w * (1.f + s1.w) + s0.w;
      uint2 o; o.x = pack2(a, b); o.y = pack2(cc, d);
      *(uint2*)(dst + (size_t)row * DM + c) = o;
    }
  }
}

__device__ __forceinline__ void phase_conv_qk(const P& p) {
  const u16* hgg = (const u16*)(p.ws + O_HGG);
  u16* mix = (u16*)(p.ws + O_XN);
  const float* cw = p.in[9];
  const size_t gt = (size_t)blockIdx.x * NT + tid_(), gn = (size_t)gridDim.x * NT;
  for (size_t it = gt; it < (size_t)TTOK * 64; it += gn) {
    int row = (int)(it >> 6), c0 = (int)(it & 63) * 8;
    int t, len;
    if (row < NLAT) { t = row & 4095; len = 4096; } else { t = (row - NLAT) & 255; len = 256; }
    float pm[8], pc[8], pp[8];
    {
      const u16* b = hgg + (size_t)row * 1536;
      uint4 hh = *(const uint4*)(b + c0), gc = *(const uint4*)(b + 1024 + c0);
      pc[0] = bflo(hh.x) * bflo(gc.x); pc[1] = bfhi(hh.x) * bfhi(gc.x);
      pc[2] = bflo(hh.y) * bflo(gc.y); pc[3] = bfhi(hh.y) * bfhi(gc.y);
      pc[4] = bflo(hh.z) * bflo(gc.z); pc[5] = bfhi(hh.z) * bfhi(gc.z);
      pc[6] = bflo(hh.w) * bflo(gc.w); pc[7] = bfhi(hh.w) * bfhi(gc.w);
    }
    if (t > 0) {
      const u16* b = hgg + (size_t)(row - 1) * 1536;
      uint4 hh = *(const uint4*)(b + c0), gc = *(const uint4*)(b + 1024 + c0);
      pm[0] = bflo(hh.x) * bflo(gc.x); pm[1] = bfhi(hh.x) * bfhi(gc.x);
      pm[2] = bflo(hh.y) * bflo(gc.y); pm[3] = bfhi(hh.y) * bfhi(gc.y);
      pm[4] = bflo(hh.z) * bflo(gc.z); pm[5] = bfhi(hh.z) * bfhi(gc.z);
      pm[6] = bflo(hh.w) * bflo(gc.w); pm[7] = bfhi(hh.w) * bfhi(gc.w);
    } else {
#pragma unroll
      for (int e = 0; e < 8; ++e) pm[e] = 0.f;
    }
    if (t < len - 1) {
      const u16* b = hgg + (size_t)(row + 1) * 1536;
      uint4 hh = *(const uint4*)(b + c0), gc = *(const uint4*)(b + 1024 + c0);
      pp[0] = bflo(hh.x) * bflo(gc.x); pp[1] = bfhi(hh.x) * bfhi(gc.x);
      pp[2] = bflo(hh.y) * bflo(gc.y); pp[3] = bfhi(hh.y) * bfhi(gc.y);
      pp[4] = bflo(hh.z) * bflo(gc.z); pp[5] = bfhi(hh.z) * bfhi(gc.z);
      pp[6] = bflo(hh.w) * bflo(gc.w); pp[7] = bfhi(hh.w) * bfhi(gc.w);
    } else {
#pragma unroll
      for (int e = 0; e < 8; ++e) pp[e] = 0.f;
    }
    uint4 gbv = *(const uint4*)(hgg + (size_t)row * 1536 + 512 + c0);
    float gb[8] = {bflo(gbv.x), bfhi(gbv.x), bflo(gbv.y), bfhi(gbv.y), bflo(gbv.z), bfhi(gbv.z), bflo(gbv.w), bfhi(gbv.w)};
    float o[8];
#pragma unroll
    for (int e = 0; e < 8; ++e)
      o[e] = gb[e] * (cw[c0 + e] * pm[e] + cw[512 + c0 + e] * pc[e] + cw[1024 + c0 + e] * pp[e]);
    uint4 ov; ov.x = pack2(o[0], o[1]); ov.y = pack2(o[2], o[3]); ov.z = pack2(o[4], o[5]); ov.w = pack2(o[6], o[7]);
    *(uint4*)(mix + (size_t)row * DM + c0) = ov;
  }
  u16* Q = (u16*)(p.ws + O_Q);
  u16* KBp = (u16*)(p.ws + O_KB);
  const float* rope = (const float*)(p.ws + O_ROPE);
  const size_t ngroups = (size_t)TTOK * 10;
  for (size_t it = gt; it < ngroups * 8; it += gn) {
    size_t grp = it >> 3; int sub = (int)(it & 7);
    int row = (int)(grp / 10), hd = (int)(grp % 10);
    u16* ptr; const float* gain;
    if (hd < 8) { ptr = Q + (size_t)row * 512 + hd * 64 + sub * 8; gain = p.in[10]; }
    else { ptr = KBp + (size_t)row * 128 + (hd - 8) * 64 + sub * 8; gain = p.in[11]; }
    uint4 v = *(const uint4*)ptr;
    float x[8] = {bflo(v.x), bfhi(v.x), bflo(v.y), bfhi(v.y), bflo(v.z), bfhi(v.z), bflo(v.w), bfhi(v.w)};
    float ss = 0.f;
#pragma unroll
    for (int e = 0; e < 8; ++e) ss += x[e] * x[e];
    ss = red8(ss);
    float rs = rsqrtf(ss * (1.f / 64.f) + 1e-6f);
#pragma unroll
    for (int e = 0; e < 8; ++e) x[e] = x[e] * rs * gain[sub * 8 + e];
    if (row < NLAT) {
      int t = row & 4095; int gr = t >> 6, gc = t & 63;
#pragma unroll
      for (int e = 0; e < 4; ++e) {
        int pi = sub * 4 + e;
        int pos = pi < 16 ? gr : gc; int f = pi & 15;
        float c = rope[(pos * 16 + f) * 2], s = rope[(pos * 16 + f) * 2 + 1];
        float a = x[2 * e], b = x[2 * e + 1];
        x[2 * e] = a * c - b * s;
        x[2 * e + 1] = a * s + b * c;
      }
    }
    uint4 ov; ov.x = pack2(x[0], x[1]); ov.y = pack2(x[2], x[3]); ov.z = pack2(x[4], x[5]); ov.w = pack2(x[6], x[7]);
    *(uint4*)ptr = ov;
  }
}

__device__ __forceinline__ void phase_attn(const P& p, char* lds) {
  u16* sK = (u16*)lds;
  u16* sV = sK + 64 * LDSS;
  const u16* Q = (const u16*)(p.ws + O_Q);
  const u16* KBp = (const u16*)(p.ws + O_KB);
  const u16* VT = (const u16*)(p.ws + O_VT);
  u16* mix = (u16*)(p.ws + O_XN);
  const int tid = tid_(), lane = tid & 63, wave = tid >> 6;
  const int r = lane & 31, h = lane >> 5;
  const float cs = 0.125f * 1.4426950408889634f;
  for (int item = blockIdx.x; item < 1088; item += gridDim.x) {
    int b, qh, qrow0, nkt;
    if (item < 1024) { b = item >> 7; qh = (item >> 4) & 7; qrow0 = b * 4096 + (item & 15) * 256; nkt = 68; }
    else { int i2 = item - 1024; b = i2 >> 3; qh = i2 & 7; qrow0 = NLAT + b * 256; nkt = 4; }
    const int kvh = qh >> 2;
    const int qrow = qrow0 + wave * 32 + r;
    bf16x8 qf[4];
#pragma unroll
    for (int kk = 0; kk < 4; ++kk) qf[kk] = *(const bf16x8*)(Q + (size_t)qrow * 512 + qh * 64 + kk * 16 + h * 8);
    f32x16 o[2];
#pragma unroll
    for (int g = 0; g < 16; ++g) { o[0][g] = 0.f; o[1][g] = 0.f; }
    float m = -INFINITY, l = 0.f;
    const int lkey = tid >> 3, lch = tid & 7;
    uint4 ka, va;
    auto gl = [&](int kt) {
      int pos = kt * 64 + lkey;
      int krow = pos < 256 ? NLAT + b * 256 + pos : b * 4096 + pos - 256;
      ka = *(const uint4*)(KBp + (size_t)krow * 128 + kvh * 64 + lch * 8);
      va = *(const uint4*)(VT + ((size_t)((b * 2 + kvh) * 64 + lkey)) * 4352 + kt * 64 + lch * 8);
    };
    gl(0);
    for (int kt = 0; kt < nkt; ++kt) {
      *(uint4*)(sK + lkey * LDSS + lch * 8) = ka;
      *(uint4*)(sV + lkey * LDSS + lch * 8) = va;
      __syncthreads();
      if (kt + 1 < nkt) gl(kt + 1);
      f32x16 s[2];
#pragma unroll
      for (int g = 0; g < 16; ++g) { s[0][g] = 0.f; s[1][g] = 0.f; }
#pragma unroll
      for (int kb = 0; kb < 2; ++kb)
#pragma unroll
        for (int kk = 0; kk < 4; ++kk) {
          bf16x8 a = *(const bf16x8*)(sK + (kb * 32 + r) * LDSS + kk * 16 + h * 8);
          s[kb] = __builtin_amdgcn_mfma_f32_32x32x16_bf16(a, qf[kk], s[kb], 0, 0, 0);
        }
      float mx = s[0][0];
#pragma unroll
      for (int g = 0; g < 16; ++g) { mx = fmaxf(mx, s[0][g]); mx = fmaxf(mx, s[1][g]); }
      mx = swapmax32(mx);
      float mn = fmaxf(m, mx);
      float alpha = __builtin_amdgcn_exp2f((m - mn) * cs);
      m = mn;
      float mc = mn * cs, ps = 0.f;
#pragma unroll
      for (int kb = 0; kb < 2; ++kb)
#pragma unroll
        for (int g = 0; g < 16; ++g) { float e = __builtin_amdgcn_exp2f(s[kb][g] * cs - mc); s[kb][g] = e; ps += e; }
      l = l * alpha + ps;
#pragma unroll
      for (int g = 0; g < 16; ++g) { o[0][g] *= alpha; o[1][g] *= alpha; }
      bf16x8 pb[2][2];
#pragma unroll
      for (int kb = 0; kb < 2; ++kb)
#pragma unroll
        for (int c = 0; c < 2; ++c) {
          uint4 pk;
          pk.x = pack2(s[kb][8 * c + 0], s[kb][8 * c + 1]); pk.y = pack2(s[kb][8 * c + 2], s[kb][8 * c + 3]);
          pk.z = pack2(s[kb][8 * c + 4], s[kb][8 * c + 5]); pk.w = pack2(s[kb][8 * c + 6], s[kb][8 * c + 7]);
          pb[kb][c] = __builtin_bit_cast(bf16x8, pk);
        }
#pragma unroll
      for (int db = 0; db < 2; ++db)
#pragma unroll
        for (int kb = 0; kb < 2; ++kb)
#pragma unroll
          for (int c = 0; c < 2; ++c) {
            const u16* vp = sV + (db * 32 + r) * LDSS + kb * 32 + 16 * c + 4 * h;
            uint2 lo = *(const uint2*)vp, hi = *(const uint2*)(vp + 8);
            uint4 av = make_uint4(lo.x, lo.y, hi.x, hi.y);
            o[db] = __builtin_amdgcn_mfma_f32_32x32x16_bf16(__builtin_bit_cast(bf16x8, av), pb[kb][c], o[db], 0, 0, 0);
          }
      __syncthreads();
    }
    l = swapsum32(l, l);
    float inv = 1.f / l;
#pragma unroll
    for (int db = 0; db < 2; ++db)
#pragma unroll
      for (int g4 = 0; g4 < 4; ++g4) {
        int d = db * 32 + 8 * g4 + 4 * h;
        uint2 ov;
        ov.x = pack2(o[db][g4 * 4 + 0] * inv, o[db][g4 * 4 + 1] * inv);
        ov.y = pack2(o[db][g4 * 4 + 2] * inv, o[db][g4 * 4 + 3] * inv);
        *(uint2*)(mix + (size_t)qrow * DM + 512 + qh * 64 + d) = ov;
      }
  }
}

__device__ __forceinline__ int fkey(float f) { int b = __float_as_int(f); return b ^ ((b >> 31) & 0x7FFFFFFF); }
__device__ __forceinline__ float keyf(int k) { return __int_as_float(k ^ ((k >> 31) & 0x7FFFFFFF)); }

#define CE_DESC(a, b) { int hi__ = max(a, b); int lo__ = min(a, b); a = hi__; b = lo__; }
#define BITONIC_SORT16(r)                                                          \
  _Pragma("unroll") for (int k_ = 2; k_ <= 16; k_ <<= 1)                           \
    _Pragma("unroll") for (int j_ = k_ >> 1; j_ > 0; j_ >>= 1)                     \
      _Pragma("unroll") for (int i_ = 0; i_ < 16; ++i_) {                          \
        const int l_ = i_ ^ j_;                                                    \
        if (l_ > i_) { if ((i_ & k_) == 0) CE_DESC(r[i_], r[l_]) else CE_DESC(r[l_], r[i_]) } \
      }
#define BITONIC_MERGE16(r)                                                         \
  _Pragma("unroll") for (int j_ = 8; j_ > 0; j_ >>= 1)                             \
    _Pragma("unroll") for (int i_ = 0; i_ < 16; ++i_) {                            \
      const int l_ = i_ ^ j_;                                                      \
      if (l_ > i_) CE_DESC(r[i_], r[l_])                                           \
    }
#define XLANE_MERGE16(r, CTRL)                                                     \
  {                                                                                \
    int o_[16];                                                                    \
    _Pragma("unroll") for (int i_ = 0; i_ < 16; ++i_) o_[i_] = __builtin_amdgcn_update_dpp(0, r[15 - i_], CTRL, 0xF, 0xF, true); \
    _Pragma("unroll") for (int i_ = 0; i_ < 16; ++i_) r[i_] = max(r[i_], o_[i_]);  \
    BITONIC_MERGE16(r)                                                             \
  }
#define SCS 132
__device__ __forceinline__ void phase_peer_topk(const P& p, int layer, const u16* PQ, int ntok, int* IDX, float* GATE, char* lds) {
  float* sc = (float*)lds;
  int* lists = (int*)(lds + 2 * 64 * SCS * 4);
  u16* sq = (u16*)(lds + 2 * 64 * SCS * 4 + 8192);
  const int tid = tid_(), lane = tid & 63, wave = tid >> 6;
  const int r = lane & 31, h = lane >> 5;
  const u16* keys = (const u16*)(p.ws + O_KEYS) + (size_t)layer * 8 * 2 * 128 * 128;
  const int ntile = (ntok >> 6) * 8;
  for (int tile = blockIdx.x; tile < ntile; tile += gridDim.x) {
    int hd = tile & 7, row0 = (tile >> 3) * 64;
    {
#pragma unroll
      for (int q = 0; q < 4; ++q) {
        const int id = tid + NT * q, rw = id >> 5, c = id & 31;
        const uint4 v = *(const uint4*)(PQ + (size_t)(row0 + rw) * 2048 + hd * 256 + c * 8);
        *(uint4*)(sq + ((c >> 4) * 64 + rw) * 136 + (c & 15) * 8) = v;
      }
    }
    __syncthreads();
    {
      int pp = wave >> 2, kb = wave & 3;
      f32x16 acc[2];
#pragma unroll
      for (int g = 0; g < 16; ++g) { acc[0][g] = 0.f; acc[1][g] = 0.f; }
      const u16* kp = keys + ((size_t)(hd * 2 + pp) * 128 + kb * 32 + r) * 128 + h * 8;
      const u16* qp = sq + (pp * 64 + r) * 136 + h * 8;
#pragma unroll
      for (int kk = 0; kk < 8; ++kk) {
        bf16x8 bfr = *(const bf16x8*)(kp + kk * 16);
        bf16x8 a0 = *(const bf16x8*)(qp + kk * 16);
        bf16x8 a1 = *(const bf16x8*)(qp + 32 * 136 + kk * 16);
        acc[0] = __builtin_amdgcn_mfma_f32_32x32x16_bf16(a0, bfr, acc[0], 0, 0, 0);
        acc[1] = __builtin_amdgcn_mfma_f32_32x32x16_bf16(a1, bfr, acc[1], 0, 0, 0);
      }
#pragma unroll
      for (int mb = 0; mb < 2; ++mb)
#pragma unroll
        for (int g = 0; g < 16; ++g) {
          int tok = mb * 32 + (g & 3) + 8 * (g >> 2) + 4 * h;
          sc[(pp * 64 + tok) * SCS + kb * 32 + r] = acc[mb][g];
        }
    }
    __syncthreads();
    {
      const int row = tid >> 2, qd = tid & 3;
      const float* rowp = sc + row * SCS + qd;
      int A[16], B[16];
#pragma unroll
      for (int m = 0; m < 16; ++m) {
        A[m] = (fkey(rowp[4 * m]) & ~0x7F) | (127 - (4 * m + qd));
        B[m] = (fkey(rowp[64 + 4 * m]) & ~0x7F) | (127 - (64 + 4 * m + qd));
      }
      BITONIC_SORT16(A)
      BITONIC_SORT16(B)
#pragma unroll
      for (int i = 0; i < 16; ++i) A[i] = max(A[i], B[15 - i]);
      BITONIC_MERGE16(A)
      XLANE_MERGE16(A, 0xB1)
      XLANE_MERGE16(A, 0x4E)
      if (qd == 0) {
#pragma unroll
        for (int i = 0; i < 16; i += 4) *(int4*)(lists + row * 16 + i) = make_int4(A[i], A[i + 1], A[i + 2], A[i + 3]);
      }
    }
    __syncthreads();
    if (tid < 256) {
      const int tok = tid >> 2, q = tid & 3;
      float bq[16];
#pragma unroll
      for (int j = 0; j < 16; ++j) bq[j] = keyf(lists[(64 + tok) * 16 + j] & ~0x7F);
      int R[16];
#pragma unroll
      for (int i = 0; i < 16; ++i) R[i] = (int)0x80000000;
#pragma unroll
      for (int m = 0; m < 4; ++m) {
        const int i = q + 4 * m;
        const float ai = keyf(lists[tok * 16 + i] & ~0x7F);
        const int jmax = 16 / (i + 1);
        const int nj = m == 0 ? 16 : (m == 1 ? 3 : 1);
#pragma unroll
        for (int j = 0; j < nj; ++j) {
          int x = (fkey(ai + bq[j]) & ~0xFF) | (255 - (i * 16 + j));
          x = j < jmax ? x : (int)0x80000000;
#pragma unroll
          for (int t = 0; t < 16; ++t) { int hi_ = max(R[t], x); x = min(R[t], x); R[t] = hi_; }
        }
      }
      XLANE_MERGE16(R, 0xB1)
      XLANE_MERGE16(R, 0x4E)
      float sv[16];
      float mx = keyf(R[0] & ~0xFF), sum = 0.f;
#pragma unroll
      for (int t = 0; t < 16; ++t) { sv[t] = __expf(keyf(R[t] & ~0xFF) - mx); sum += sv[t]; }
      float inv = 1.f / sum;
      size_t ob = (size_t)(row0 + tok) * 128 + hd * 16;
#pragma unroll
      for (int t = 0; t < 16; ++t) {
        if ((t >> 2) == q) {
          int pos = 255 - (R[t] & 0xFF);
          int i1 = 127 - (lists[tok * 16 + (pos >> 4)] & 0x7F);
          int i2 = 127 - (lists[(64 + tok) * 16 + (pos & 15)] & 0x7F);
          IDX[ob + t] = i1 * 128 + i2;
          GATE[ob + t] = sv[t] * inv;
        }
      }
    }
    __syncthreads();
  }
}

typedef __attribute__((ext_vector_type(2))) float f2;
#define TAB_V8 (16 * MiB)
#define TAB_SU (32 * MiB)
#define TAB_SV (32 * MiB + 65536)
__device__ __forceinline__ float wave_max(float v) {
  v = fmaxf(v, dppf<0xB1>(v)); v = fmaxf(v, dppf<0x4E>(v)); v = fmaxf(v, dppf<0x141>(v)); v = fmaxf(v, dppf<0x140>(v));
  v = swapmax16(v); v = swapmax32(v);
  return v;
}
__device__ __forceinline__ void convert_tab_fp8(const float* __restrict__ U, const float* __restrict__ V, char* tab) {
  const int lane = tid_() & 63;
  const int gw = blockIdx.x * 8 + (tid_() >> 6), nw = gridDim.x * 8;
  for (int rr = gw; rr < 32768; rr += nw) {
    const int isv = rr >> 14, e = rr & 16383;
    const float* src = (isv ? V : U) + (size_t)e * 1024 + lane * 16;
    float4 v0 = *(const float4*)src, v1 = *(const float4*)(src + 4), v2 = *(const float4*)(src + 8), v3 = *(const float4*)(src + 12);
    float am = fmaxf(fmaxf(fmaxf(fabsf(v0.x), fabsf(v0.y)), fmaxf(fabsf(v0.z), fabsf(v0.w))),
                     fmaxf(fmaxf(fabsf(v1.x), fabsf(v1.y)), fmaxf(fabsf(v1.z), fabsf(v1.w))));
    am = fmaxf(am, fmaxf(fmaxf(fmaxf(fabsf(v2.x), fabsf(v2.y)), fmaxf(fabsf(v2.z), fabsf(v2.w))),
                         fmaxf(fmaxf(fabsf(v3.x), fabsf(v3.y)), fmaxf(fabsf(v3.z), fabsf(v3.w)))));
    am = wave_max(am);
    float sc = am > 0.f ? 448.f / am : 1.f;
    uint4 o;
    int t = 0;
    t = __builtin_amdgcn_cvt_pk_fp8_f32(v0.x * sc, v0.y * sc, t, false); t = __builtin_amdgcn_cvt_pk_fp8_f32(v0.z * sc, v0.w * sc, t, true); o.x = t;
    t = __builtin_amdgcn_cvt_pk_fp8_f32(v1.x * sc, v1.y * sc, t, false); t = __builtin_amdgcn_cvt_pk_fp8_f32(v1.z * sc, v1.w * sc, t, true); o.y = t;
    t = __builtin_amdgcn_cvt_pk_fp8_f32(v2.x * sc, v2.y * sc, t, false); t = __builtin_amdgcn_cvt_pk_fp8_f32(v2.z * sc, v2.w * sc, t, true); o.z = t;
    t = __builtin_amdgcn_cvt_pk_fp8_f32(v3.x * sc, v3.y * sc, t, false); t = __builtin_amdgcn_cvt_pk_fp8_f32(v3.z * sc, v3.w * sc, t, true); o.w = t;
    if (!isv) {
      *(uint4*)(tab + (size_t)e * 1024 + lane * 16) = o;
      if (lane == 0) ((float*)(tab + TAB_SU))[e] = am > 0.f ? am / 448.f : 1.f;
    } else {
      *(uint4*)(tab + TAB_V8 + ((size_t)(lane >> 3) * 16384 + e) * 128 + (lane & 7) * 16) = o;
      if (lane == 0) ((float*)(tab + TAB_SV))[e] = am > 0.f ? am / 448.f : 1.f;
    }
  }
}
__device__ __forceinline__ f2 dec8(unsigned w, bool hi) { return hi ? __builtin_amdgcn_cvt_pk_f32_fp8((int)w, true) : __builtin_amdgcn_cvt_pk_f32_fp8((int)w, false); }

__device__ __forceinline__ float dot16(uint4 w, f2 a0, f2 a1, f2 a2, f2 a3, f2 a4, f2 a5, f2 a6, f2 a7) {
  f2 a = f2{0.f, 0.f};
  a = __builtin_elementwise_fma(dec8(w.x, false), a0, a); a = __builtin_elementwise_fma(dec8(w.x, true), a1, a);
  a = __builtin_elementwise_fma(dec8(w.y, false), a2, a); a = __builtin_elementwise_fma(dec8(w.y, true), a3, a);
  a = __builtin_elementwise_fma(dec8(w.z, false), a4, a); a = __builtin_elementwise_fma(dec8(w.z, true), a5, a);
  a = __builtin_elementwise_fma(dec8(w.w, false), a6, a); a = __builtin_elementwise_fma(dec8(w.w, true), a7, a);
  return a.x + a.y;
}
#define DOT16(W) dot16(W, xf0, xf1, xf2, xf3, xf4, xf5, xf6, xf7)
__device__ __forceinline__ void phase_peer_act(const P& p, const u16* XN2, const char* tab, const int* IDX, const float* GATE, float* COEF, int ntok, char* lds) {
  const int tid = tid_(), lane = tid & 63, wave = tid >> 6;
  int* le = (int*)(lds + wave * 1536);
  float* lg = (float*)(le + 128);
  int* ls = le + 256;
  const int part = blockIdx.x & 7;
  const int wv = (blockIdx.x >> 3) * 8 + wave, nwv = (gridDim.x >> 3) * 8;
  const float* SU = (const float*)(tab + TAB_SU);
  const float* SV = (const float*)(tab + TAB_SV);
  const int q = lane >> 4;
  const bool hi = (lane & 32) != 0, b4 = (lane & 16) != 0;
  int i0 = 0, i1 = 0; float g0 = 0.f, g1 = 0.f; uint4 x0 = make_uint4(0, 0, 0, 0), x1 = x0;
  if (wv < ntok) {
    i0 = IDX[(size_t)wv * 128 + lane]; i1 = IDX[(size_t)wv * 128 + 64 + lane];
    g0 = GATE[(size_t)wv * 128 + lane]; g1 = GATE[(size_t)wv * 128 + 64 + lane];
    const u16* xr = XN2 + (size_t)wv * DM + lane * 16;
    x0 = *(const uint4*)xr; x1 = *(const uint4*)(xr + 8);
  }
  for (int tok = wv; tok < ntok; tok += nwv) {
    int ni0 = 0, ni1 = 0; float ng0 = 0.f, ng1 = 0.f; uint4 nx0 = make_uint4(0, 0, 0, 0), nx1 = nx0;
    const int nt = tok + nwv;
    if (nt < ntok) {
      ni0 = IDX[(size_t)nt * 128 + lane]; ni1 = IDX[(size_t)nt * 128 + 64 + lane];
      ng0 = GATE[(size_t)nt * 128 + lane]; ng1 = GATE[(size_t)nt * 128 + 64 + lane];
      const u16* xr = XN2 + (size_t)nt * DM + lane * 16;
      nx0 = *(const uint4*)xr; nx1 = *(const uint4*)(xr + 8);
    }
    const bool s0 = (i0 >> 11) == part, s1 = (i1 >> 11) == part;
    const unsigned long long m0 = __ballot(s0), m1 = __ballot(s1);
    const int c0 = __popcll(m0), cnt = c0 + __popcll(m1);
    const int p0 = __builtin_amdgcn_mbcnt_hi((unsigned)(m0 >> 32), __builtin_amdgcn_mbcnt_lo((unsigned)m0, 0));
    const int p1 = c0 + __builtin_amdgcn_mbcnt_hi((unsigned)(m1 >> 32), __builtin_amdgcn_mbcnt_lo((unsigned)m1, 0));
    if (s0) { le[p0] = i0; lg[p0] = g0; ls[p0] = lane; }
    if (s1) { le[p1] = i1; lg[p1] = g1; ls[p1] = 64 + lane; }
    const int cntp = (cnt + 3) & ~3;
    if (lane < cntp - cnt) { le[cnt + lane] = part << 11; lg[cnt + lane] = 0.f; ls[cnt + lane] = -1; }
    const f2 xf0 = f2{bflo(x0.x), bfhi(x0.x)}, xf1 = f2{bflo(x0.y), bfhi(x0.y)}, xf2 = f2{bflo(x0.z), bfhi(x0.z)}, xf3 = f2{bflo(x0.w), bfhi(x0.w)};
    const f2 xf4 = f2{bflo(x1.x), bfhi(x1.x)}, xf5 = f2{bflo(x1.y), bfhi(x1.y)}, xf6 = f2{bflo(x1.z), bfhi(x1.z)}, xf7 = f2{bflo(x1.w), bfhi(x1.w)};
    for (int base = 0; base < cntp; base += 24) {
      uint4 w[24];
      const int evl = le[base + (lane < 24 ? lane : 0)];
#pragma unroll
      for (int gq = 0; gq < 6; ++gq) {
        if (base + 4 * gq < cntp) {
#pragma unroll
          for (int k = 0; k < 4; ++k) {
            int e = __builtin_amdgcn_readlane(evl, 4 * gq + k);
            w[4 * gq + k] = *(const uint4*)(tab + (size_t)e * 1024 + lane * 16);
          }
        } else {
#pragma unroll
          for (int k = 0; k < 4; ++k) w[4 * gq + k] = make_uint4(0, 0, 0, 0);
        }
      }
#pragma unroll
      for (int gq = 0; gq < 6; ++gq) {
        if (base + 4 * gq < cntp) {
          float d0 = DOT16(w[4 * gq]), d1 = DOT16(w[4 * gq + 1]), d2 = DOT16(w[4 * gq + 2]), d3 = DOT16(w[4 * gq + 3]);
          float kA = swapsum32(d0, d2), kB = swapsum32(d1, d3);
          float kC = swapsum16(kA, kB);
          kC = red16(kC);
          const int j = base + 4 * gq + q;
          const int e = le[j]; const float gt = lg[j]; const int slot = ls[j];
          float act = kC * SU[e];
          float coef = gt * 0.5f * act * (1.f + erff(act * 0.70710678118654752f)) * SV[e];
          if ((lane & 15) == 0 && slot >= 0) COEF[(size_t)tok * 128 + slot] = coef;
        }
      }
    }
    i0 = ni0; i1 = ni1; g0 = ng0; g1 = ng1; x0 = nx0; x1 = nx1;
  }
}

__device__ __forceinline__ void phase_peer_sum(const P& p, int layer, const char* tab, const int* IDX, const float* COEF, int ntok, float* dummy_dst) {
  const int tid = tid_(), lane = tid & 63, wave = tid >> 6;
  const int sl = blockIdx.x & 7;
  const int wv = (blockIdx.x >> 3) * 8 + wave, nwv = (gridDim.x >> 3) * 8;
  const int g = lane >> 3, ch = lane & 7;
  const char* V8 = tab + TAB_V8 + (size_t)sl * 16384 * 128 + ch * 16;
  const float* mod = (const float*)(p.ws + O_MOD) + (size_t)layer * 9 * 6144;
  float* HC = (float*)(p.ws + O_HC);
  const bool b5 = (lane & 32) != 0, b4 = (lane & 16) != 0, b3 = (lane & 8) != 0;
  const int c = sl * 128 + ch * 16 + (b5 ? 8 : 0) + (b4 ? 4 : 0) + (b3 ? 2 : 0);
  uint4 ia, ib, ic, id; float4 ca, cb, cc, cd;
  ia = ib = ic = id = make_uint4(0, 0, 0, 0); ca = cb = cc = cd = make_float4(0, 0, 0, 0);
  if (wv < ntok) {
    const int* ip = IDX + (size_t)wv * 128 + g * 16;
    const float* cp = COEF + (size_t)wv * 128 + g * 16;
    ia = *(const uint4*)ip; ib = *(const uint4*)(ip + 4); ic = *(const uint4*)(ip + 8); id = *(const uint4*)(ip + 12);
    ca = *(const float4*)cp; cb = *(const float4*)(cp + 4); cc = *(const float4*)(cp + 8); cd = *(const float4*)(cp + 12);
  }
  for (int tok = wv; tok < ntok; tok += nwv) {
    const unsigned ev[16] = {ia.x, ia.y, ia.z, ia.w, ib.x, ib.y, ib.z, ib.w, ic.x, ic.y, ic.z, ic.w, id.x, id.y, id.z, id.w};
    const float cv[16] = {ca.x, ca.y, ca.z, ca.w, cb.x, cb.y, cb.z, cb.w, cc.x, cc.y, cc.z, cc.w, cd.x, cd.y, cd.z, cd.w};
    uint4 w[16];
#pragma unroll
    for (int i = 0; i < 16; ++i) w[i] = *(const uint4*)(V8 + (size_t)ev[i] * 128);
    float* dst = (dummy_dst ? dummy_dst + (size_t)tok * DM : (tok < NLAT ? p.out + (size_t)tok * DM : HC + (size_t)(tok - NLAT) * DM)) + c;
    float2 o = *(float2*)dst;
    const int nt = tok + nwv;
    if (nt < ntok) {
      const int* ip = IDX + (size_t)nt * 128 + g * 16;
      const float* cp = COEF + (size_t)nt * 128 + g * 16;
      ia = *(const uint4*)ip; ib = *(const uint4*)(ip + 4); ic = *(const uint4*)(ip + 8); id = *(const uint4*)(ip + 12);
      ca = *(const float4*)cp; cb = *(const float4*)(cp + 4); cc = *(const float4*)(cp + 8); cd = *(const float4*)(cp + 12);
    }
    f2 acc[8];
#pragma unroll
    for (int k = 0; k < 8; ++k) acc[k] = f2{0.f, 0.f};
#pragma unroll
    for (int i = 0; i < 16; ++i) {
      f2 c2 = f2{cv[i], cv[i]};
      acc[0] = __builtin_elementwise_fma(dec8(w[i].x, false), c2, acc[0]); acc[1] = __builtin_elementwise_fma(dec8(w[i].x, true), c2, acc[1]);
      acc[2] = __builtin_elementwise_fma(dec8(w[i].y, false), c2, acc[2]); acc[3] = __builtin_elementwise_fma(dec8(w[i].y, true), c2, acc[3]);
      acc[4] = __builtin_elementwise_fma(dec8(w[i].z, false), c2, acc[4]); acc[5] = __builtin_elementwise_fma(dec8(w[i].z, true), c2, acc[5]);
      acc[6] = __builtin_elementwise_fma(dec8(w[i].w, false), c2, acc[6]); acc[7] = __builtin_elementwise_fma(dec8(w[i].w, true), c2, acc[7]);
    }
    float r8[8];
#pragma unroll
    for (int k = 0; k < 4; ++k) {
      r8[2 * k] = swapsum32(acc[k].x, acc[4 + k].x);
      r8[2 * k + 1] = swapsum32(acc[k].y, acc[4 + k].y);
    }
    float r4[4];
#pragma unroll
    for (int k = 0; k < 4; ++k) r4[k] = swapsum16(r8[k], r8[4 + k]);
    float r2[2];
#pragma unroll
    for (int k = 0; k < 2; ++k) {
      float kx = b3 ? r4[2 + k] : r4[k], sx = b3 ? r4[k] : r4[2 + k];
      r2[k] = kx + dppf<0x128>(sx);
    }
    const int mi = tok < NLAT ? (tok >> 12) : 8;
    const float2 mv = *(const float2*)(mod + mi * 6144 + 5 * 1024 + c);
    o.x += mv.x * r2[0]; o.y += mv.y * r2[1];
    *(float2*)dst = o;
  }
}

__device__ __forceinline__ void phase_scan(const P& p, char* lds, bool dummy) {
  float* buf = (float*)lds;
  float* vbuf = (float*)(lds + 81920);
  u16* ybuf = (u16*)(lds + 81920 + 16384);
  const int tid = tid_(), lane = tid & 63, wave = tid >> 6;
  const int c = lane & 7, irow = wave * 8 + (lane >> 3);
  const u16* R = (const u16*)(p.ws + O_R);
  const u16* Kp = (const u16*)(p.ws + O_K);
  const u16* Vp = (const u16*)(p.ws + O_V);
  const int ps = tid >> 4, col4 = (tid & 15) * 4;
  for (int item = blockIdx.x; item < 256; item += gridDim.x) {
    const int dir = item & 1, hh = (item >> 1) & 15, b = item >> 5;
    char* WA = p.ws + (dir ? O_WA1 : O_WA0);
    float* BON = (float*)(p.ws + O_BONUS) + (size_t)dir * NLAT * 16;
    float kkc[4], kac[4], rkc[4];
#pragma unroll
    for (int e = 0; e < 4; ++e) {
      kkc[e] = p.in[20][hh * 64 + col4 + e];
      kac[e] = p.in[21][hh * 64 + col4 + e];
      rkc[e] = p.in[22][hh * 64 + col4 + e];
    }
    auto rowof = [&](int s) -> int {
      if (s < 256) { int pos = dir ? 255 - s : s; return NLAT + b * 256 + pos; }
      int u = s - 256; int pos = dir ? 4095 - u : u; return b * 4096 + pos;
    };
    uint2 pr, pk, pv; unsigned pw, pa; int prow;
    auto gload = [&](int ch) {
      prow = rowof(ch * 32 + ps);
      size_t o = (size_t)prow * 1024 + hh * 64 + col4;
      pr = *(const uint2*)(R + o); pk = *(const uint2*)(Kp + o); pv = *(const uint2*)(Vp + o);
      const char* wp = WA + (size_t)prow * 2048 + hh * 128;
      pw = *(const unsigned*)(wp + col4); pa = *(const unsigned*)(wp + 64 + col4);
    };
    auto prep = [&](int bi) {
      float rr[4] = {bflo(pr.x), bfhi(pr.x), bflo(pr.y), bfhi(pr.y)};
      float kq[4] = {bflo(pk.x), bfhi(pk.x), bflo(pk.y), bfhi(pk.y)};
      float4 vv = make_float4(bflo(pv.x), bfhi(pv.x), bflo(pv.y), bfhi(pv.y));
      float w[4], a[4], kr[4], kk[4], bb[4], kd[4];
      float ss = 0.f;
#pragma unroll
      for (int e = 0; e < 4; ++e) {
        w[e] = 0.5f + (float)((pw >> (8 * e)) & 255u) * (1.f / 510.f);
        a[e] = (float)((pa >> (8 * e)) & 255u) * (1.f / 255.f);
        kr[e] = kq[e] * kkc[e];
        ss += kr[e] * kr[e];
      }
      ss = red16(ss);
      float inv = rsqrtf(ss + 1e-12f);
      float bn = 0.f;
#pragma unroll
      for (int e = 0; e < 4; ++e) {
        kk[e] = kr[e] * inv;
        bb[e] = kk[e] * a[e];
        kd[e] = kq[e] * (1.f + (a[e] - 1.f) * kac[e]);
        bn += rr[e] * kd[e] * rkc[e];
      }
      bn = red16(bn);
      if ((tid & 15) == 0 && prow < NLAT) BON[(size_t)prow * 16 + hh] = bn;
      float* d = buf + bi * 10240 + ((ps * 8 + (col4 >> 3)) * 5) * 8 + (col4 & 7);
      *(float4*)(d) = make_float4(rr[0], rr[1], rr[2], rr[3]);
      *(float4*)(d + 8) = make_float4(w[0], w[1], w[2], w[3]);
      *(float4*)(d + 16) = make_float4(kk[0], kk[1], kk[2], kk[3]);
      *(float4*)(d + 24) = make_float4(bb[0], bb[1], bb[2], bb[3]);
      *(float4*)(d + 32) = make_float4(kd[0], kd[1], kd[2], kd[3]);
      *(float4*)(vbuf + bi * 2048 + ps * 64 + col4) = vv;
    };
    float S[8];
#pragma unroll
    for (int j = 0; j < 8; ++j) S[j] = 0.f;
    gload(0);
    prep(0);
    __syncthreads();
    for (int ch = 0; ch < 136; ++ch) {
      const int cur = ch & 1;
      if (ch + 1 < 136) gload(ch + 1);
      const float* bq = buf + cur * 10240 + c * 40;
      const float* vq = vbuf + cur * 2048 + irow;
      float4 nr0, nr1, nw0, nw1, nk0, nk1, nb0, nb1, nd0, nd1; float nvi;
      {
        const float* q = bq;
        nr0 = *(const float4*)(q); nr1 = *(const float4*)(q + 4); nw0 = *(const float4*)(q + 8); nw1 = *(const float4*)(q + 12);
        nk0 = *(const float4*)(q + 16); nk1 = *(const float4*)(q + 20); nb0 = *(const float4*)(q + 24); nb1 = *(const float4*)(q + 28);
        nd0 = *(const float4*)(q + 32); nd1 = *(const float4*)(q + 36); nvi = vq[0];
      }
#pragma unroll 4
      for (int t = 0; t < 32; ++t) {
        const float4 r0 = nr0, r1 = nr1, w0 = nw0, w1 = nw1, k0 = nk0, k1 = nk1, b0 = nb0, b1 = nb1, d0 = nd0, d1 = nd1;
        const float vi = nvi;
        if (t + 1 < 32) {
          const float* q = bq + (t + 1) * 320;
          nr0 = *(const float4*)(q); nr1 = *(const float4*)(q + 4); nw0 = *(const float4*)(q + 8); nw1 = *(const float4*)(q + 12);
          nk0 = *(const float4*)(q + 16); nk1 = *(const float4*)(q + 20); nb0 = *(const float4*)(q + 24); nb1 = *(const float4*)(q + 28);
          nd0 = *(const float4*)(q + 32); nd1 = *(const float4*)(q + 36); nvi = vq[(t + 1) * 64];
        }
        float sa = (S[0] * k0.x + S[1] * k0.y) + (S[2] * k0.z + S[3] * k0.w) + ((S[4] * k1.x + S[5] * k1.y) + (S[6] * k1.z + S[7] * k1.w));
        sa = red8(sa);
        S[0] = fmaf(S[0], w0.x, fmaf(-sa, b0.x, vi * d0.x));
        S[1] = fmaf(S[1], w0.y, fmaf(-sa, b0.y, vi * d0.y));
        S[2] = fmaf(S[2], w0.z, fmaf(-sa, b0.z, vi * d0.z));
        S[3] = fmaf(S[3], w0.w, fmaf(-sa, b0.w, vi * d0.w));
        S[4] = fmaf(S[4], w1.x, fmaf(-sa, b1.x, vi * d1.x));
        S[5] = fmaf(S[5], w1.y, fmaf(-sa, b1.y, vi * d1.y));
        S[6] = fmaf(S[6], w1.z, fmaf(-sa, b1.z, vi * d1.z));
        S[7] = fmaf(S[7], w1.w, fmaf(-sa, b1.w, vi * d1.w));
        float y = (S[0] * r0.x + S[1] * r0.y) + (S[2] * r0.z + S[3] * r0.w) + ((S[4] * r1.x + S[5] * r1.y) + (S[6] * r1.z + S[7] * r1.w));
        y = red8(y);
        if (c == 0) ybuf[t * 64 + irow] = f2bf(y);
      }
      __syncthreads();
      if (ch >= 8 && !dummy) {
        int row = rowof(ch * 32 + ps);
        uint2 yv = *(const uint2*)(ybuf + ps * 64 + col4);
        *(uint2*)(WA + (size_t)row * 2048 + hh * 128 + col4 * 2) = yv;
      }
      if (ch + 1 < 136) prep(cur ^ 1);
      __syncthreads();
    }
  }
}

__device__ __forceinline__ void phase_readout(const P& p) {
  const u16* Vp = (const u16*)(p.ws + O_V);
  const u16* G = (const u16*)(p.ws + O_G);
  u16* Z = (u16*)(p.ws + O_Z);
  const float* BON = (const float*)(p.ws + O_BONUS);
  const size_t gt = (size_t)blockIdx.x * NT + tid_(), gn = (size_t)gridDim.x * NT;
  for (size_t it = gt; it < (size_t)NLAT * 16 * 8; it += gn) {
    int sub = (int)(it & 7); size_t grp = it >> 3;
    int hh = (int)(grp & 15); int row = (int)(grp >> 4);
    uint4 y0 = *(const uint4*)(p.ws + O_WA0 + (size_t)row * 2048 + hh * 128 + sub * 16);
    uint4 y1 = *(const uint4*)(p.ws + O_WA1 + (size_t)row * 2048 + hh * 128 + sub * 16);
    float y[8] = {bflo(y0.x) + bflo(y1.x), bfhi(y0.x) + bfhi(y1.x), bflo(y0.y) + bflo(y1.y), bfhi(y0.y) + bfhi(y1.y),
                  bflo(y0.z) + bflo(y1.z), bfhi(y0.z) + bfhi(y1.z), bflo(y0.w) + bflo(y1.w), bfhi(y0.w) + bfhi(y1.w)};
    float s = 0.f;
#pragma unroll
    for (int e = 0; e < 8; ++e) s += y[e];
    float mean = red8(s) * (1.f / 64.f);
    float vs = 0.f;
#pragma unroll
    for (int e = 0; e < 8; ++e) { y[e] -= mean; vs += y[e] * y[e]; }
    float var = red8(vs) * (1.f / 64.f);
    float rs = rsqrtf(var + 64e-5f);
    float bonus = BON[(size_t)row * 16 + hh] + BON[(size_t)NLAT * 16 + (size_t)row * 16 + hh];
    int col = hh * 64 + sub * 8;
    uint4 vv = *(const uint4*)(Vp + (size_t)row * DM + col);
    uint4 gg = *(const uint4*)(G + (size_t)row * DM + col);
    float vf[8] = {bflo(vv.x), bfhi(vv.x), bflo(vv.y), bfhi(vv.y), bflo(vv.z), bfhi(vv.z), bflo(vv.w), bfhi(vv.w)};
    float gf[8] = {bflo(gg.x), bfhi(gg.x), bflo(gg.y), bfhi(gg.y), bflo(gg.z), bfhi(gg.z), bflo(gg.w), bfhi(gg.w)};
    float z[8];
#pragma unroll
    for (int e = 0; e < 8; ++e) z[e] = (y[e] * rs * p.in[29][col + e] + p.in[30][col + e] + bonus * vf[e]) * gf[e];
    uint4 ov; ov.x = pack2(z[0], z[1]); ov.y = pack2(z[2], z[3]); ov.z = pack2(z[4], z[5]); ov.w = pack2(z[6], z[7]);
    *(uint4*)(Z + (size_t)row * DM + col) = ov;
  }
}

__device__ __forceinline__ bool xcd_tile(int k, int Tm, int Tn, int& mt, int& nt) {
  const int x = blockIdx.x & 7, j = blockIdx.x >> 3, J = gridDim.x >> 3;
  const int u = j + J * k;
  if (u >= (Tm >> 3) * Tn) return false;
  mt = (u / Tn) * 8 + x; nt = u % Tn;
  return true;
}

#define XB_TMO      128
#define XB_XCNT(j)  (256  + 64 * (j))
#define XB_XSUB(j)  (1280 + 64 * (j))
#define XB_XGEN(j)  (2304 + 64 * (j))
#define XB_TOP      3328
#define XB_TOPGEN   3392
#define XCD_BAR_WORDS 3456
#define XB_SPIN_CAP (1u << 18)
#define LAS __attribute__((address_space(3)))
__device__ __forceinline__ unsigned xb_ld(unsigned* p)              { return __hip_atomic_load(p, __ATOMIC_RELAXED, __HIP_MEMORY_SCOPE_AGENT); }
__device__ __forceinline__ unsigned xb_add(unsigned* p, unsigned v) { return __hip_atomic_fetch_add(p, v, __ATOMIC_RELAXED, __HIP_MEMORY_SCOPE_AGENT); }
__device__ __forceinline__ unsigned xb_xcc_id() { return (unsigned)__builtin_amdgcn_s_getreg((3 << 11) | 20) & 0xFu; }
#define XB_SPIN(cond, bar) do { unsigned _sp = 0; while (cond) { __builtin_amdgcn_s_sleep(1); \
    if ((++_sp & 255u) == 0u) { if (xb_ld(&(bar)[XB_TMO])) break; if (_sp > XB_SPIN_CAP) { atomicAdd(&(bar)[XB_TMO], 1u); break; } } } } while (0)
struct XcdBarrier { unsigned* bar; unsigned x; volatile LAS unsigned* st; };
__device__ __forceinline__ XcdBarrier xcd_barrier_post(unsigned* bar, volatile LAS unsigned* st) {
  XcdBarrier b; b.bar = bar; b.x = xb_xcc_id(); b.st = st;
  if (tid_() == 0) (void)xb_add(&bar[XB_XCNT(b.x)], 1u);
  return b;
}
__device__ __forceinline__ void xcd_barrier_complete(unsigned* bar, unsigned x, unsigned& nloc, unsigned& nx) {
  const unsigned G = gridDim.x * gridDim.y * gridDim.z;
  unsigned sum, cnt, mine, sp = 0u;
  for (;;) {
    sum = 0u; cnt = 0u; mine = 0u;
#pragma unroll
    for (unsigned j = 0; j < 16; ++j) { const unsigned c = xb_ld(&bar[XB_XCNT(j)]); sum += c; cnt += (c > 0u) ? 1u : 0u; mine = (j == x) ? c : mine; }
    if (sum == G) break;
    __builtin_amdgcn_s_sleep(1);
    if ((++sp & 255u) == 0u) { if (xb_ld(&bar[XB_TMO])) break; if (sp > XB_SPIN_CAP) { atomicAdd(&bar[XB_TMO], 1u); break; } }
  }
  nloc = mine > 0u ? mine : 1u; nx = cnt > 0u ? cnt : 1u;
}
__device__ __forceinline__ void xcd_barrier(char* wsb, char* ldsb) {
#if defined(__HIP_DEVICE_COMPILE__)
  XcdBarrier b; b.bar = (unsigned*)(wsb + O_BAR); b.x = xb_xcc_id(); b.st = (volatile LAS unsigned*)(ldsb + LDS_BYTES - 16);
  asm volatile("s_waitcnt vmcnt(0)" ::: "memory");
  __syncthreads();
  if (tid_() == 0) {
    unsigned* bar = b.bar;
    __builtin_amdgcn_s_waitcnt(0);
    unsigned nloc = b.st[0], nx = b.st[1];
    if (nloc == 0u) { xcd_barrier_complete(bar, b.x, nloc, nx); b.st[0] = nloc; b.st[1] = nx; }
    const unsigned old = xb_add(&bar[XB_XSUB(b.x)], 1u);
    const unsigned gen = old / nloc;
    if (old + 1u == (gen + 1u) * nloc) {
      __builtin_amdgcn_fence(__ATOMIC_RELEASE, "agent");
      asm volatile("s_waitcnt vmcnt(0)" ::: "memory");
      const unsigned og = xb_add(&bar[XB_TOP], 1u);
      const unsigned tg = og / nx;
      if (og + 1u == (tg + 1u) * nx) xb_add(&bar[XB_TOPGEN], 1u);
      else XB_SPIN(xb_ld(&bar[XB_TOPGEN]) == tg, bar);
      __builtin_amdgcn_fence(__ATOMIC_ACQUIRE, "agent");
      xb_add(&bar[XB_XGEN(b.x)], 1u);
      asm volatile("s_waitcnt vmcnt(0)" ::: "memory");
    } else {
      XB_SPIN(xb_ld(&bar[XB_XGEN(b.x)]) == gen, bar);
      __builtin_amdgcn_fence(__ATOMIC_ACQUIRE, "agent");
      asm volatile("s_waitcnt vmcnt(0)" ::: "memory");
    }
  }
  __syncthreads();
#endif
}

__global__ void __launch_bounds__(NT) fwd_kernel(P p) {
  extern __shared__ __attribute__((aligned(16))) char lds[];
  cg::grid_group grid = cg::this_grid();
  char* ws = p.ws;
  const float* mod0 = (const float*)(ws + O_MOD);
  const float* mod1 = mod0 + 9 * 6144;
  volatile LAS unsigned* xst = (volatile LAS unsigned*)(lds + LDS_BYTES - 16);
  if (tid_() == 0) { xst[0] = 0u; xst[1] = 0u; }
  __syncthreads();
  (void)xcd_barrier_post((unsigned*)(p.ws + O_BAR), xst);
  for (int ph = p.ph_lo; ph < p.ph_hi; ++ph) {
    if (ph > p.ph_lo) {
      if (ph == p.ph_lo + 1) grid.sync();
      else xcd_barrier(p.ws, lds);
    }
    if (!((PHASE_MASK >> ph) & 1)) continue;
    const int nrep = ((REPEAT_MASK >> ph) & 1) ? 2 : 1;
    for (int rep = 0; rep < nrep; ++rep) {
    const bool dummy = rep + 1 < nrep;
    if (rep) grid.sync();
    switch (ph) {
      case 0: phase_prep(p, lds); break;
      case 1: phase_norm(p, p.in[0], p.in[2], p.in[6], 0, 0, TTOK, (u16*)(ws + O_XN)); break;
      case 2: {
        u16* hgg = (u16*)(ws + O_HGG); u16* Q = (u16*)(ws + O_Q); u16* KBp = (u16*)(ws + O_KB); u16* VT = (u16*)(ws + O_VT);
        for (int kq = 0, mt = 0, ntw = 0; xcd_tile(kq, 136, 10, mt, ntw); ++kq) {
          if (ntw < 8) {
            const int n0w = ntw * 256;
            u16* dbase; int dld;
            if (n0w < 1536) { dbase = hgg + n0w; dld = 1536; } else { dbase = Q + (n0w - 1536); dld = 512; }
            auto xf = [&](float v, int row, int col) -> float { return v; };
            auto dstf = [&](int row) -> u16* { return dbase + (size_t)row * dld; };
            gemm_tile256<false>((const u16*)(ws + O_XN), 1024, nullptr, (const u16*)(ws + O_WIN) + (size_t)n0w * 1024, 1024, 1024,
                                mt * 256, xf, dstf, (u16*)lds);
            continue;
          }
          int nt = 8 + ntw;
          int n0 = nt * 128;
          auto epi = [&](int row, int col, float v0, float v1, float v2, float v3) {
            int n = n0 + col;
            float v[4] = {v0, v1, v2, v3};
            if (n < 1536) {
#pragma unroll
              for (int j = 0; j < 4; ++j) hgg[(size_t)(row + j) * 1536 + n] = f2bf(v[j]);
            } else if (n < 2048) {
#pragma unroll
              for (int j = 0; j < 4; ++j) Q[(size_t)(row + j) * 512 + n - 1536] = f2bf(v[j]);
            } else if (n < 2176) {
#pragma unroll
              for (int j = 0; j < 4; ++j) KBp[(size_t)(row + j) * 128 + n - 2048] = f2bf(v[j]);
            } else {
              int kvh = (n - 2176) >> 6, d = (n - 2176) & 63;
              int b, pos;
              if (row < NLAT) { b = row >> 12; pos = 256 + (row & 4095); } else { b = (row - NLAT) >> 8; pos = (row - NLAT) & 255; }
              uint2 o; o.x = pack2(v0, v1); o.y = pack2(v2, v3);
              *(uint2*)(VT + ((size_t)((b * 2 + kvh) * 64 + d)) * 4352 + pos) = o;
            }
          };
          if (nt < 17) {
            u16* dbase; int dld;
            if (n0 < 1536) { dbase = hgg + n0; dld = 1536; } else if (n0 < 2048) { dbase = Q + (n0 - 1536); dld = 512; } else { dbase = KBp + (n0 - 2048); dld = 128; }
            auto xf = [&](float v, int row, int col) -> float { return v; };
            auto dstf = [&](int row) -> u16* { return dbase + (size_t)row * dld; };
            gemm_tile<false, 1>((const u16*)(ws + O_XN), 1024, nullptr, (const u16*)(ws + O_WIN) + (size_t)n0 * 1024, 1024, 1024,
                                mt * 256, xf, dstf, (u16*)lds);
          } else {
            gemm_tile<false, 0>((const u16*)(ws + O_XN), 1024, nullptr, (const u16*)(ws + O_WIN) + (size_t)n0 * 1024, 1024, 1024,
                                mt * 256, epi, 0, (u16*)lds);
          }
        }
      } break;
      case 3: phase_conv_qk(p); break;
      case 4: phase_attn(p, lds); break;
      case 5: {
        float* HC = (float*)(ws + O_HC);
        for (int kq = 0, mt = 0, nt = 0; xcd_tile(kq, 136, 8, mt, nt); ++kq) {
          int n0 = nt * 128;
          auto epi = [&](int row, int col, float v0, float v1, float v2, float v3) {
            int n = n0 + col;
            float v[4] = {v0, v1, v2, v3};
#pragma unroll
            for (int j = 0; j < 4; ++j) {
              int rw = row + j;
              if (rw < NLAT) {
                float g = mod0[(rw >> 12) * 6144 + 2048 + n];
                p.out[(size_t)rw * DM + n] = p.in[0][(size_t)rw * DM + n] + g * v[j];
              } else {
                float g = mod0[8 * 6144 + 2048 + n];
                HC[(size_t)(rw - NLAT) * DM + n] = p.in[2][(size_t)(rw - NLAT) * DM + n] + g * v[j];
              }
            }
          };
          gemm_tile<false, 0>((const u16*)(ws + O_XN), 1024, nullptr, (const u16*)(ws + O_WOUT) + (size_t)n0 * 1024, 1024, 1024,
                              mt * 256, epi, 0, (u16*)lds);
        }
      } break;
      case 6: phase_norm(p, p.out, (const float*)(ws + O_HC), p.in[7], 0, 3, TTOK, (u16*)(ws + O_XN)); break;
      case 7: case 18: {
        int layer = ph == 7 ? 0 : 1;
        int mtiles = layer == 0 ? 136 : 128;
        u16* PQ = (u16*)(ws + (layer == 0 ? O_PQ0 : O_PQ1));
        const u16* Wq = (const u16*)(ws + O_WQ) + (size_t)layer * 2048 * 1024;
        for (int kq = 0, mt = 0, nt = 0; xcd_tile(kq, mtiles, 8, mt, nt); ++kq) {
          int n0 = nt * 256;
          auto epi = [&](int row, int col, float v0, float v1, float v2, float v3) {
            int n = n0 + col;
            float v[4] = {v0, v1, v2, v3};
#pragma unroll
            for (int j = 0; j < 4; ++j) PQ[(size_t)(row + j) * 2048 + n] = f2bf(v[j]);
          };
          auto xf = [&](float v, int row, int col) -> float { return v; };
          auto dstf = [&](int row) -> u16* { return PQ + (size_t)row * 2048 + n0; };
          gemm_tile256<false>((const u16*)(ws + O_XN), 1024, nullptr, Wq + (size_t)n0 * 1024, 1024, 1024, mt * 256, xf, dstf, (u16*)lds);
        }
      } break;
      case 8: phase_peer_topk(p, 0, (const u16*)(ws + O_PQ0), TTOK, (int*)(ws + O_IDX0), (float*)(ws + O_GATE0), lds); break;
      case 9: phase_peer_act(p, (const u16*)(ws + O_XN), ws + O_TAB0, (const int*)(ws + O_IDX0), (const float*)(ws + O_GATE0),
                             (float*)(ws + O_COEF0), TTOK, lds); break;
      case 10: phase_peer_sum(p, 0, ws + O_TAB0, (const int*)(ws + O_IDX0), (const float*)(ws + O_COEF0), TTOK, dummy ? (float*)(ws + O_A2R) : nullptr); break;
      case 11: phase_norm(p, p.out, (const float*)(ws + O_HC), p.in[6] + 1024, 1, 0, TTOK, (u16*)(ws + O_XN)); break;
      case 12: {
        u16* LORA = (u16*)(ws + O_LORA);
        for (int kq = 0;; ++kq) {
          const int u = (blockIdx.x >> 3) + (gridDim.x >> 3) * kq;
          if (u >= 17 * 27) break;
          int mt, nt;
          if (u < 408) { int g = u / 136, rem = u % 136; mt = (rem >> 3) * 8 + (blockIdx.x & 7); nt = g * 8 + (rem & 7); }
          else { int v2 = u - 408; mt = (v2 / 3) * 8 + (blockIdx.x & 7); nt = 24 + v2 % 3; }
          const u16* Bp; int mixi; u16* dstp = nullptr; int kind;
          if (nt < 8) { Bp = (const u16*)(ws + O_WR) + (size_t)nt * 128 * 1024; mixi = 0; dstp = (u16*)(ws + O_R) + nt * 128; kind = 0; }
          else if (nt < 16) { Bp = (const u16*)(ws + O_WK) + (size_t)(nt - 8) * 128 * 1024; mixi = 2; dstp = (u16*)(ws + O_K) + (nt - 8) * 128; kind = 0; }
          else if (nt < 24) { Bp = (const u16*)(ws + O_WV) + (size_t)(nt - 16) * 128 * 1024; mixi = 3; dstp = (u16*)(ws + O_V) + (nt - 16) * 128; kind = 0; }
          else if (nt == 24) { Bp = (const u16*)(ws + O_W1); mixi = 1; kind = 1; }
          else if (nt == 25) { Bp = (const u16*)(ws + O_A1); mixi = 4; kind = 2; }
          else { Bp = (const u16*)(ws + O_G1); mixi = 5; kind = 3; }
          auto epi = [&](int row, int col, float v0, float v1, float v2, float v3) {
            float v[4] = {v0, v1, v2, v3};
            if (kind == 0) {
#pragma unroll
              for (int j = 0; j < 4; ++j) dstp[(size_t)(row + j) * 1024 + col] = f2bf(v[j]);
            } else if (kind == 1) {
#pragma unroll
              for (int j = 0; j < 4; ++j) LORA[(size_t)(row + j) * 384 + col] = f2bf(tanhf(v[j]));
            } else if (kind == 2) {
#pragma unroll
              for (int j = 0; j < 4; ++j) LORA[(size_t)(row + j) * 384 + 128 + col] = f2bf(v[j]);
            } else {
#pragma unroll
              for (int j = 0; j < 4; ++j) LORA[(size_t)(row + j) * 384 + 256 + col] = f2bf(sigmoidf_(v[j]));
            }
          };
          auto xf = [&](float v, int row, int col) -> float { return kind == 1 ? tanhf(v) : (kind == 3 ? sigmoidf_(v) : v); };
          u16* dbase = kind == 0 ? dstp : (LORA + (kind - 1) * 128);
          const int dld = kind == 0 ? 1024 : 384;
          auto dstf = [&](int row) -> u16* { return dbase + (size_t)row * dld; };
          gemm_tile<true, 1>((const u16*)(ws + O_XN), 1024, p.in[13] + mixi * 1024, Bp, 1024, 1024, mt * 256, xf, dstf, (u16*)lds);
        }
      } break;
      case 13: {
        const u16* LORA = (const u16*)(ws + O_LORA);
        u16* G = (u16*)(ws + O_G);
        for (int t = blockIdx.x; t < 136 * 40; t += gridDim.x) {
          int mt = t / 40, nt = t % 40;
          int grp = nt >> 3, n0 = (nt & 7) * 128;
          const u16* Ap; const u16* Bp; int K, ldb;
          if (grp < 2) { Ap = LORA + grp * 64; Bp = (const u16*)(ws + O_W2) + (size_t)grp * 65536 + (size_t)n0 * 64; K = 64; ldb = 64; }
          else if (grp < 4) { Ap = LORA + 128 + (grp - 2) * 64; Bp = (const u16*)(ws + O_A2) + (size_t)(grp - 2) * 65536 + (size_t)n0 * 64; K = 64; ldb = 64; }
          else { Ap = LORA + 256; Bp = (const u16*)(ws + O_G2) + (size_t)n0 * 128; K = 128; ldb = 128; }
          int d = grp & 1;
          u8* WA = (u8*)(ws + (d ? O_WA1 : O_WA0));
          auto epi = [&](int row, int col, float v0, float v1, float v2, float v3) {
            int n = n0 + col;
            float v[4] = {v0, v1, v2, v3};
            if (grp < 2) {
              float w0 = p.in[23][d * 1024 + n];
#pragma unroll
              for (int j = 0; j < 4; ++j) {
                float x = w0 + v[j];
                float dec = __expf(-0.6065306597126334f * sigmoidf_(x));
                float q = rintf((dec - 0.5f) * 510.f);
                q = fminf(fmaxf(q, 0.f), 255.f);
                WA[(size_t)(row + j) * 2048 + (n >> 6) * 128 + (n & 63)] = (u8)q;
              }
            } else if (grp < 4) {
              float a0 = p.in[26][d * 1024 + n];
#pragma unroll
              for (int j = 0; j < 4; ++j) {
                float a = sigmoidf_(a0 + v[j]);
                float q = fminf(fmaxf(rintf(a * 255.f), 0.f), 255.f);
                WA[(size_t)(row + j) * 2048 + (n >> 6) * 128 + 64 + (n & 63)] = (u8)q;
              }
            } else {
#pragma unroll
              for (int j = 0; j < 4; ++j) G[(size_t)(row + j) * 1024 + n] = f2bf(v[j]);
            }
          };
          if (grp < 4) {
            const float* b0p = (grp < 2 ? p.in[23] : p.in[26]) + d * 1024 + n0;
            auto q8 = [&](float v, int row, int col) -> unsigned {
              float x = b0p[col] + v;
              float qv;
              if (grp < 2) { float dec = __expf(-0.6065306597126334f * sigmoidf_(x)); qv = rintf((dec - 0.5f) * 510.f); }
              else { qv = rintf(sigmoidf_(x) * 255.f); }
              return (unsigned)fminf(fmaxf(qv, 0.f), 255.f);
            };
            auto dst8 = [&](int row, int c16) -> u8* {
              int n = n0 + c16 * 16;
              return WA + (size_t)row * 2048 + (n >> 6) * 128 + (grp < 2 ? 0 : 64) + (n & 63);
            };
            gemm_tile<false, 2>(Ap, 384, nullptr, Bp, ldb, K, mt * 256, q8, dst8, (u16*)lds);
          } else {
            auto xf = [&](float v, int row, int col) -> float { return v; };
            auto dstf = [&](int row) -> u16* { return G + (size_t)row * 1024 + n0; };
            gemm_tile<false, 1>(Ap, 384, nullptr, Bp, ldb, K, mt * 256, xf, dstf, (u16*)lds);
          }
        }
      } break;
      case 14: phase_scan(p, lds, dummy); break;
      case 15:
        phase_readout(p);
        convert_tab_fp8(p.in[33] + (size_t)16384 * 1024, p.in[34] + (size_t)16384 * 1024, ws + O_TAB1);
        break;
      case 16: {
        for (int kq = 0, mt = 0, nt = 0; xcd_tile(kq, 128, 8, mt, nt); ++kq) {
          int n0 = nt * 128;
          auto epi = [&](int row, int col, float v0, float v1, float v2, float v3) {
            int n = n0 + col;
            float v[4] = {v0, v1, v2, v3};
#pragma unroll
            for (int j = 0; j < 4; ++j) {
              int rw = row + j;
              float g = mod1[(rw >> 12) * 6144 + 2048 + n];
              p.out[(size_t)rw * DM + n] += g * v[j];
            }
          };
          gemm_tile<false, 0>((const u16*)(ws + O_Z), 1024, nullptr, (const u16*)(ws + O_WO) + (size_t)n0 * 1024, 1024, 1024,
                              mt * 256, epi, 0, (u16*)lds);
        }
      } break;
      case 17: phase_norm(p, p.out, nullptr, p.in[7] + 1024, 1, 3, NLAT, (u16*)(ws + O_XN)); break;
      case 19: phase_peer_topk(p, 1, (const u16*)(ws + O_PQ1), NLAT, (int*)(ws + O_IDX1), (float*)(ws + O_GATE1), lds); break;
      case 20: phase_peer_act(p, (const u16*)(ws + O_XN), ws + O_TAB1, (const int*)(ws + O_IDX1), (const float*)(ws + O_GATE1),
                              (float*)(ws + O_COEF1), NLAT, lds); break;
      case 21: phase_peer_sum(p, 1, ws + O_TAB1, (const int*)(ws + O_IDX1), (const float*)(ws + O_COEF1), NLAT, dummy ? (float*)(ws + O_A5R) : nullptr); break;
      default: break;
    }
    }
  }
}

extern "C" void kernel_launch(void* const* d_in, const int* in_sizes, int n_in, void* d_out, int out_size, void* d_ws,
                              size_t ws_size, hipStream_t stream) {
  static int grid = 0;
  if (grid == 0) {
    if (n_in != 35 || ws_size < WS_END) {
      fprintf(stderr, "kernel_launch: unexpected n_in %d or ws_size %zu (need %zu)\n", n_in, ws_size, (size_t)WS_END);
      grid = -1;
      return;
    }
    int dev = 0, cus = 0, per_cu = 0;
    hipGetDevice(&dev);
    hipDeviceGetAttribute(&cus, hipDeviceAttributeMultiprocessorCount, dev);
    hipFuncSetAttribute((const void*)fwd_kernel, hipFuncAttributeMaxDynamicSharedMemorySize, LDS_BYTES);
    hipOccupancyMaxActiveBlocksPerMultiprocessor(&per_cu, (const void*)fwd_kernel, NT, LDS_BYTES);
    (void)hipGetLastError();
    if (per_cu < 1) per_cu = 1;
    grid = (cus / 8) * 8;
    if (grid > cus * per_cu) grid = cus * per_cu;
  }
  if (grid < 0) return;
  P p{};
  for (int i = 0; i < 35; ++i) p.in[i] = (const float*)d_in[i];
  p.out = (float*)d_out;
  p.ws = (char*)d_ws;
#if N_LAUNCH_MODE == 0
  (void)hipMemsetAsync((char*)d_ws + O_BAR, 0, 16384, stream);
  p.ph_lo = 0; p.ph_hi = NPHASE;
  void* args[] = {&p};
  hipError_t e = hipLaunchCooperativeKernel((const void*)fwd_kernel, dim3(grid), dim3(NT), args, LDS_BYTES, stream);
  if (e != hipSuccess) fprintf(stderr, "cooperative launch failed: %s (grid %d)\n", hipGetErrorString(e), grid);
#else
  for (int ph = 0; ph < NPHASE; ++ph) {
    p.ph_lo = ph; p.ph_hi = ph + 1;
    hipLaunchKernelGGL(fwd_kernel, dim3(grid), dim3(NT), LDS_BYTES, stream, p);
  }
#endif
}
```

```cpp
#include <hip/hip_runtime.h>
#include <hip/hip_cooperative_groups.h>
#include <cstdio>
namespace cg = cooperative_groups;

#ifndef N_LAUNCH_MODE
#define N_LAUNCH_MODE 0
#endif

typedef unsigned short u16;
typedef unsigned char u8;
typedef __attribute__((ext_vector_type(8))) short bf16x8;
typedef __attribute__((ext_vector_type(16))) float f32x16;

#define NT 512
#define TTOK 34816
#define NLAT 32768
#define DM 1024
#define LDSS 72
#define LDS_BYTES 149504
#define NPHASE 22
#ifndef REPEAT_MASK
#define REPEAT_MASK 0
#endif
#ifndef PHASE_MASK
#define PHASE_MASK 0x3FFFFF
#endif

static constexpr size_t MiB = 1048576;
static constexpr size_t O_WIN = 0;
static constexpr size_t O_WOUT = O_WIN + 4718592;
static constexpr size_t O_WR = O_WOUT + 2097152;
static constexpr size_t O_WK = O_WR + 2097152;
static constexpr size_t O_WV = O_WK + 2097152;
static constexpr size_t O_WO = O_WV + 2097152;
static constexpr size_t O_G1 = O_WO + 2097152;
static constexpr size_t O_G2 = O_G1 + 262144;
static constexpr size_t O_W1 = O_G2 + 262144;
static constexpr size_t O_A1 = O_W1 + 262144;
static constexpr size_t O_W2 = O_A1 + 262144;
static constexpr size_t O_A2 = O_W2 + 262144;
static constexpr size_t O_WQ = O_A2 + 262144;
static constexpr size_t O_KEYS = O_WQ + 8388608;
static constexpr size_t O_MOD = O_KEYS + 1048576;
static constexpr size_t O_ROPE = O_MOD + 442368;
static constexpr size_t SZ = 68 * MiB;
static constexpr size_t O_A1R = 26 * MiB;
static constexpr size_t O_A2R = O_A1R + SZ;
static constexpr size_t O_A3R = O_A2R + SZ;
static constexpr size_t O_A4R = O_A3R + SZ;
static constexpr size_t O_A5R = O_A4R + SZ;
static constexpr size_t O_A6R = O_A5R + SZ;
static constexpr size_t O_A7R = O_A6R + SZ;
static constexpr size_t O_LORA = O_A7R;
static constexpr size_t O_BONUS = O_A7R + 26 * MiB;
static constexpr size_t O_BAR = O_BONUS + 4 * MiB;
static constexpr size_t WS_END = O_BAR + 1 * MiB;
static constexpr size_t O_XN = O_A1R;
static constexpr size_t O_HGG = O_A2R;
static constexpr size_t O_Q = O_A2R + 102 * MiB;
static constexpr size_t O_KB = O_A4R;
static constexpr size_t O_VT = O_A4R + 9 * MiB;
static constexpr size_t O_PQ0 = O_A2R;
static constexpr size_t O_TAB0 = O_A5R;
static constexpr size_t O_IDX0 = O_A6R;
static constexpr size_t O_GATE0 = O_A6R + 17 * MiB;
static constexpr size_t O_HC = O_A6R + 34 * MiB;
static constexpr size_t O_COEF0 = O_A6R + 42 * MiB;
static constexpr size_t O_R = O_A2R, O_K = O_A3R, O_V = O_A4R;
static constexpr size_t O_WA0 = O_A5R, O_WA1 = O_A6R;
static constexpr size_t O_G = O_A1R;
static constexpr size_t O_Z = O_A2R;
static constexpr size_t O_TAB1 = O_A3R;
static constexpr size_t O_PQ1 = O_A5R;
static constexpr size_t O_IDX1 = O_A4R;
static constexpr size_t O_GATE1 = O_A4R + 17 * MiB;
static constexpr size_t O_COEF1 = O_A4R + 34 * MiB;

struct P {
  const float* in[35];
  float* out;
  char* ws;
  int ph_lo, ph_hi;
};

typedef __bf16 bf16x2_t __attribute__((ext_vector_type(2)));
typedef float f32x2_t __attribute__((ext_vector_type(2)));
__device__ __forceinline__ u16 f2bf(float f) {
  __bf16 b = (__bf16)f;
  return __builtin_bit_cast(u16, b);
}
__device__ __forceinline__ float bf2f(u16 h) { return __uint_as_float(((unsigned)h) << 16); }
__device__ __forceinline__ float bflo(unsigned w) { return __uint_as_float(w << 16); }
__device__ __forceinline__ float bfhi(unsigned w) { return __uint_as_float(w & 0xFFFF0000u); }
__device__ __forceinline__ unsigned pack2(float a, float b) { f32x2_t v = {a, b}; bf16x2_t r = __builtin_convertvector(v, bf16x2_t); return __builtin_bit_cast(unsigned, r); }

__device__ __forceinline__ int tid_() { int t = __builtin_amdgcn_workitem_id_x(); asm volatile("" : "+v"(t)); return t; }
template <int CTRL>
__device__ __forceinline__ float dppf(float v) {
  return __builtin_bit_cast(float, __builtin_amdgcn_update_dpp(0, __builtin_bit_cast(int, v), CTRL, 0xF, 0xF, true));
}
__device__ __forceinline__ float red8(float v) {
  v += dppf<0xB1>(v); v += dppf<0x4E>(v); v += dppf<0x141>(v); return v;
}
__device__ __forceinline__ float red16(float v) { v = red8(v); v += dppf<0x140>(v); return v; }
__device__ __forceinline__ float swapsum32(float a, float b) {
  auto r = __builtin_amdgcn_permlane32_swap(__float_as_uint(a), __float_as_uint(b), false, false);
  return __uint_as_float(r[0]) + __uint_as_float(r[1]);
}
__device__ __forceinline__ float swapsum16(float a, float b) {
  auto r = __builtin_amdgcn_permlane16_swap(__float_as_uint(a), __float_as_uint(b), false, false);
  return __uint_as_float(r[0]) + __uint_as_float(r[1]);
}
__device__ __forceinline__ float swapmax32(float a) {
  auto r = __builtin_amdgcn_permlane32_swap(__float_as_uint(a), __float_as_uint(a), false, false);
  return fmaxf(__uint_as_float(r[0]), __uint_as_float(r[1]));
}
__device__ __forceinline__ float swapmax16(float a) {
  auto r = __builtin_amdgcn_permlane16_swap(__float_as_uint(a), __float_as_uint(a), false, false);
  return fmaxf(__uint_as_float(r[0]), __uint_as_float(r[1]));
}
__device__ __forceinline__ float wave_sum(float v) {
  v = red16(v);
  v = swapsum16(v, v); v = swapsum32(v, v);
  return v;
}
__device__ __forceinline__ float sigmoidf_(float x) { return 1.f / (1.f + __expf(-x)); }

template <bool MIX, int OM, class Epi, class Dst>
__device__ __forceinline__ void gemm_tile(const u16* __restrict__ A, int lda, const float* __restrict__ mu,
                                          const u16* __restrict__ B, int ldb, int K, int row0, Epi epi, Dst dstf, u16* lds) {
  u16* sA = lds;
  u16* sB = lds + 256 * LDSS;
  const int tid = tid_(), lane = tid & 63, wave = tid >> 6;
  const int wm = wave & 3, wn = wave >> 2;
  const int r = lane & 31, h = lane >> 5;
  const int kc = tid & 7, lr = tid >> 3;
  f32x16 acc[2][2];
#pragma unroll
  for (int i = 0; i < 2; ++i)
#pragma unroll
    for (int j = 0; j < 2; ++j)
#pragma unroll
      for (int g = 0; g < 16; ++g) acc[i][j][g] = 0.f;
  uint4 pa0, pa1, pa2, pa3, ps0, ps1, ps2, ps3, pb0, pb1;
  ps0 = ps1 = ps2 = ps3 = make_uint4(0, 0, 0, 0);
  float4 m0 = make_float4(0, 0, 0, 0), m1 = m0;
  auto nbr = [&](int row, int kg) -> int {
    if (row < NLAT) {
      int t = row & 4095; int gc = t & 63, gr = t >> 6; int qd = kg >> 8;
      if (qd == 0) return gc > 0 ? row - 1 : -1;
      if (qd == 1) return gc < 63 ? row + 1 : -1;
      if (qd == 2) return gr > 0 ? row - 64 : -1;
      return gr < 63 ? row + 64 : -1;
    } else {
      int t = (row - NLAT) & 255;
      if (kg < 512) return t > 0 ? row - 1 : -1;
      return t < 255 ? row + 1 : -1;
    }
  };
  auto ldA = [&](int i, int k0, uint4& a, uint4& sx) {
    int row = row0 + lr + 64 * i;
    a = *(const uint4*)(A + (size_t)row * lda + k0 + kc * 8);
    if (MIX) {
      int nr = nbr(row, k0 + kc * 8);
      if (nr >= 0) sx = *(const uint4*)(A + (size_t)nr * lda + k0 + kc * 8);
      else sx = make_uint4(0, 0, 0, 0);
    }
  };
  auto gload = [&](int k0) {
    ldA(0, k0, pa0, ps0); ldA(1, k0, pa1, ps1); ldA(2, k0, pa2, ps2); ldA(3, k0, pa3, ps3);
    if (MIX) {
      m0 = *(const float4*)(mu + k0 + kc * 8);
      m1 = *(const float4*)(mu + k0 + kc * 8 + 4);
    }
    pb0 = *(const uint4*)(B + (size_t)lr * ldb + k0 + kc * 8);
    pb1 = *(const uint4*)(B + (size_t)(lr + 64) * ldb + k0 + kc * 8);
  };
  auto mixw = [&](unsigned x, unsigned s, float ma, float mb) -> unsigned {
    float x0 = bflo(x), x1 = bfhi(x), s0 = bflo(s), s1 = bfhi(s);
    return pack2(x0 + (s0 - x0) * ma, x1 + (s1 - x1) * mb);
  };
  int bo = 0;
  auto stA = [&](int i, uint4 a, uint4 sx) {
    uint4 v = a;
    if (MIX) {
      v.x = mixw(a.x, sx.x, m0.x, m0.y);
      v.y = mixw(a.y, sx.y, m0.z, m0.w);
      v.z = mixw(a.z, sx.z, m1.x, m1.y);
      v.w = mixw(a.w, sx.w, m1.z, m1.w);
    }
    *(uint4*)(sA + bo + (lr + 64 * i) * LDSS + kc * 8) = v;
  };
  auto lstore = [&]() {
    stA(0, pa0, ps0); stA(1, pa1, ps1); stA(2, pa2, ps2); stA(3, pa3, ps3);
    *(uint4*)(sB + bo + lr * LDSS + kc * 8) = pb0;
    *(uint4*)(sB + bo + (lr + 64) * LDSS + kc * 8) = pb1;
  };
  constexpr int BUFE = (256 + 128) * LDSS;
  gload(0);
  bo = 0; lstore();
  if (64 < K) gload(64);
  __syncthreads();
  for (int k0 = 0; k0 < K; k0 += 64) {
    const int co = ((k0 >> 6) & 1) * BUFE;
    bf16x8 af[2], bfr[2], naf[2], nbf[2];
#pragma unroll
    for (int i = 0; i < 2; ++i) af[i] = *(const bf16x8*)(sA + co + (wm * 64 + i * 32 + r) * LDSS + h * 8);
#pragma unroll
    for (int j = 0; j < 2; ++j) bfr[j] = *(const bf16x8*)(sB + co + (wn * 64 + j * 32 + r) * LDSS + h * 8);
#pragma unroll
    for (int kk = 0; kk < 4; ++kk) {
      if (kk == 2 && k0 + 64 < K) {
        bo = BUFE - co; lstore();
        if (k0 + 128 < K) gload(k0 + 128);
      }
      if (kk < 3) {
#pragma unroll
        for (int i = 0; i < 2; ++i) naf[i] = *(const bf16x8*)(sA + co + (wm * 64 + i * 32 + r) * LDSS + (kk + 1) * 16 + h * 8);
#pragma unroll
        for (int j = 0; j < 2; ++j) nbf[j] = *(const bf16x8*)(sB + co + (wn * 64 + j * 32 + r) * LDSS + (kk + 1) * 16 + h * 8);
      }
#pragma unroll
      for (int i = 0; i < 2; ++i)
#pragma unroll
        for (int j = 0; j < 2; ++j) {
          if (OM == 0) acc[i][j] = __builtin_amdgcn_mfma_f32_32x32x16_bf16(af[i], bfr[j], acc[i][j], 0, 0, 0);
          else acc[i][j] = __builtin_amdgcn_mfma_f32_32x32x16_bf16(bfr[j], af[i], acc[i][j], 0, 0, 0);
        }
      if (kk < 3) {
#pragma unroll
        for (int i = 0; i < 2; ++i) af[i] = naf[i];
#pragma unroll
        for (int j = 0; j < 2; ++j) bfr[j] = nbf[j];
      }
    }
    __syncthreads();
  }
  if constexpr (OM == 0) {
#pragma unroll
    for (int i = 0; i < 2; ++i)
#pragma unroll
      for (int j = 0; j < 2; ++j)
#pragma unroll
        for (int g4 = 0; g4 < 4; ++g4) {
          int row = row0 + wm * 64 + i * 32 + 8 * g4 + 4 * h;
          int col = wn * 64 + j * 32 + r;
          epi(row, col, acc[i][j][g4 * 4 + 0], acc[i][j][g4 * 4 + 1], acc[i][j][g4 * 4 + 2], acc[i][j][g4 * 4 + 3]);
        }
  } else if constexpr (OM == 1) {
    u16* st = lds;
#pragma unroll
    for (int i = 0; i < 2; ++i)
#pragma unroll
      for (int j = 0; j < 2; ++j)
#pragma unroll
        for (int g4 = 0; g4 < 4; ++g4) {
          const int rl = wm * 64 + i * 32 + r, c0 = wn * 64 + j * 32 + 8 * g4 + 4 * h;
          uint2 o;
          o.x = pack2(epi(acc[i][j][g4 * 4 + 0], row0 + rl, c0 + 0), epi(acc[i][j][g4 * 4 + 1], row0 + rl, c0 + 1));
          o.y = pack2(epi(acc[i][j][g4 * 4 + 2], row0 + rl, c0 + 2), epi(acc[i][j][g4 * 4 + 3], row0 + rl, c0 + 3));
          *(uint2*)(st + rl * 136 + c0) = o;
        }
    __syncthreads();
#pragma unroll
    for (int q = 0; q < 8; ++q) {
      const int id = tid + NT * q, rl = id >> 4, c8 = id & 15;
      const uint4 v = *(const uint4*)(st + rl * 136 + c8 * 8);
      *(uint4*)(dstf(row0 + rl) + c8 * 8) = v;
    }
    __syncthreads();
  } else {
    u8* st = (u8*)lds;
#pragma unroll
    for (int i = 0; i < 2; ++i)
#pragma unroll
      for (int j = 0; j < 2; ++j)
#pragma unroll
        for (int g4 = 0; g4 < 4; ++g4) {
          const int rl = wm * 64 + i * 32 + r, c0 = wn * 64 + j * 32 + 8 * g4 + 4 * h;
          unsigned o = epi(acc[i][j][g4 * 4 + 0], row0 + rl, c0 + 0) | (epi(acc[i][j][g4 * 4 + 1], row0 + rl, c0 + 1) << 8) |
                       (epi(acc[i][j][g4 * 4 + 2], row0 + rl, c0 + 2) << 16) | (epi(acc[i][j][g4 * 4 + 3], row0 + rl, c0 + 3) << 24);
          *(unsigned*)(st + rl * 144 + c0) = o;
        }
    __syncthreads();
#pragma unroll
    for (int q = 0; q < 4; ++q) {
      const int id = tid + NT * q, rl = id >> 3, c16 = id & 7;
      const uint4 v = *(const uint4*)(st + rl * 144 + c16 * 16);
      *(uint4*)(dstf(row0 + rl, c16)) = v;
    }
    __syncthreads();
  }
}

template <bool MIX, class Epi, class Dst>
__device__ __forceinline__ void gemm_tile256(const u16* __restrict__ A, int lda, const float* __restrict__ mu,
                                             const u16* __restrict__ B, int ldb, int K, int row0, Epi epi, Dst dstf, u16* lds) {
  u16* sA = lds;
  u16* sB = lds + 256 * LDSS;
  const int tid = tid_(), lane = tid & 63, wave = tid >> 6;
  const int wm = wave & 1, wn = wave >> 1;
  const int r = lane & 31, h = lane >> 5;
  const int kc = tid & 7, lr = tid >> 3;
  f32x16 acc[4][2];
#pragma unroll
  for (int i = 0; i < 4; ++i)
#pragma unroll
    for (int j = 0; j < 2; ++j)
#pragma unroll
      for (int g = 0; g < 16; ++g) acc[i][j][g] = 0.f;
  uint4 pa0, pa1, pa2, pa3, ps0, ps1, ps2, ps3, pb0, pb1, pb2, pb3;
  ps0 = ps1 = ps2 = ps3 = make_uint4(0, 0, 0, 0);
  float4 m0 = make_float4(0, 0, 0, 0), m1 = m0;
  auto nbr = [&](int row, int kg) -> int {
    if (row < NLAT) {
      int t = row & 4095; int gc = t & 63, gr = t >> 6; int qd = kg >> 8;
      if (qd == 0) return gc > 0 ? row - 1 : -1;
      if (qd == 1) return gc < 63 ? row + 1 : -1;
      if (qd == 2) return gr > 0 ? row - 64 : -1;
      return gr < 63 ? row + 64 : -1;
    } else {
      int t = (row - NLAT) & 255;
      if (kg < 512) return t > 0 ? row - 1 : -1;
      return t < 255 ? row + 1 : -1;
    }
  };
  auto ldA = [&](int i, int k0, uint4& a, uint4& sx) {
    int row = row0 + lr + 64 * i;
    a = *(const uint4*)(A + (size_t)row * lda + k0 + kc * 8);
    if (MIX) {
      int nr = nbr(row, k0 + kc * 8);
      if (nr >= 0) sx = *(const uint4*)(A + (size_t)nr * lda + k0 + kc * 8);
      else sx = make_uint4(0, 0, 0, 0);
    }
  };
  auto gload = [&](int k0) {
    ldA(0, k0, pa0, ps0); ldA(1, k0, pa1, ps1); ldA(2, k0, pa2, ps2); ldA(3, k0, pa3, ps3);
    if (MIX) {
      m0 = *(const float4*)(mu + k0 + kc * 8);
      m1 = *(const float4*)(mu + k0 + kc * 8 + 4);
    }
    pb0 = *(const uint4*)(B + (size_t)lr * ldb + k0 + kc * 8);
    pb1 = *(const uint4*)(B + (size_t)(lr + 64) * ldb + k0 + kc * 8);
    pb2 = *(const uint4*)(B + (size_t)(lr + 128) * ldb + k0 + kc * 8);
    pb3 = *(const uint4*)(B + (size_t)(lr + 192) * ldb + k0 + kc * 8);
  };
  auto mixw = [&](unsigned x, unsigned s_, float ma, float mb) -> unsigned {
    float x0 = bflo(x), x1 = bfhi(x), s0 = bflo(s_), s1 = bfhi(s_);
    return pack2(x0 + (s0 - x0) * ma, x1 + (s1 - x1) * mb);
  };
  int bo = 0;
  auto stA = [&](int i, uint4 a, uint4 sx) {
    uint4 v = a;
    if (MIX) {
      v.x = mixw(a.x, sx.x, m0.x, m0.y);
      v.y = mixw(a.y, sx.y, m0.z, m0.w);
      v.z = mixw(a.z, sx.z, m1.x, m1.y);
      v.w = mixw(a.w, sx.w, m1.z, m1.w);
    }
    *(uint4*)(sA + bo + (lr + 64 * i) * LDSS + kc * 8) = v;
  };
  auto lstore = [&]() {
    stA(0, pa0, ps0); stA(1, pa1, ps1); stA(2, pa2, ps2); stA(3, pa3, ps3);
    *(uint4*)(sB + bo + lr * LDSS + kc * 8) = pb0;
    *(uint4*)(sB + bo + (lr + 64) * LDSS + kc * 8) = pb1;
    *(uint4*)(sB + bo + (lr + 128) * LDSS + kc * 8) = pb2;
    *(uint4*)(sB + bo + (lr + 192) * LDSS + kc * 8) = pb3;
  };
  constexpr int BUFE = 2 * 256 * LDSS;
  gload(0);
  bo = 0; lstore();
  if (64 < K) gload(64);
  __syncthreads();
  for (int k0 = 0; k0 < K; k0 += 64) {
    const int co = ((k0 >> 6) & 1) * BUFE;
    bf16x8 af[4], bfr[2], naf[4], nbf[2];
#pragma unroll
    for (int i = 0; i < 4; ++i) af[i] = *(const bf16x8*)(sA + co + (wm * 128 + i * 32 + r) * LDSS + h * 8);
#pragma unroll
    for (int j = 0; j < 2; ++j) bfr[j] = *(const bf16x8*)(sB + co + (wn * 64 + j * 32 + r) * LDSS + h * 8);
#pragma unroll
    for (int kk = 0; kk < 4; ++kk) {
      if (kk == 2 && k0 + 64 < K) {
        bo = BUFE - co; lstore();
        if (k0 + 128 < K) gload(k0 + 128);
      }
      if (kk < 3) {
#pragma unroll
        for (int i = 0; i < 4; ++i) naf[i] = *(const bf16x8*)(sA + co + (wm * 128 + i * 32 + r) * LDSS + (kk + 1) * 16 + h * 8);
#pragma unroll
        for (int j = 0; j < 2; ++j) nbf[j] = *(const bf16x8*)(sB + co + (wn * 64 + j * 32 + r) * LDSS + (kk + 1) * 16 + h * 8);
      }
#pragma unroll
      for (int i = 0; i < 4; ++i)
#pragma unroll
        for (int j = 0; j < 2; ++j) acc[i][j] = __builtin_amdgcn_mfma_f32_32x32x16_bf16(bfr[j], af[i], acc[i][j], 0, 0, 0);
      if (kk < 3) {
#pragma unroll
        for (int i = 0; i < 4; ++i) af[i] = naf[i];
#pragma unroll
        for (int j = 0; j < 2; ++j) bfr[j] = nbf[j];
      }
    }
    __syncthreads();
  }
  u16* st = lds;
#pragma unroll
  for (int half = 0; half < 2; ++half) {
    if ((wn >> 1) == half) {
#pragma unroll
      for (int i = 0; i < 4; ++i)
#pragma unroll
        for (int j = 0; j < 2; ++j)
#pragma unroll
          for (int g4 = 0; g4 < 4; ++g4) {
            const int rl = wm * 128 + i * 32 + r, cl = (wn & 1) * 64 + j * 32 + 8 * g4 + 4 * h, c0 = half * 128 + cl;
            uint2 o;
            o.x = pack2(epi(acc[i][j][g4 * 4 + 0], row0 + rl, c0 + 0), epi(acc[i][j][g4 * 4 + 1], row0 + rl, c0 + 1));
            o.y = pack2(epi(acc[i][j][g4 * 4 + 2], row0 + rl, c0 + 2), epi(acc[i][j][g4 * 4 + 3], row0 + rl, c0 + 3));
            *(uint2*)(st + rl * 136 + cl) = o;
          }
    }
    __syncthreads();
#pragma unroll
    for (int q = 0; q < 8; ++q) {
      const int id = tid + NT * q, rl = id >> 4, c8 = id & 15;
      const uint4 v = *(const uint4*)(st + rl * 136 + c8 * 8);
      *(uint4*)(dstf(row0 + rl) + half * 128 + c8 * 8) = v;
    }
    __syncthreads();
  }
}

__constant__ int TJOBS[18][5] = {
    {8, 0, 1024, 2304, (int)O_WIN},
    {12, 0, 1024, 1024, (int)O_WOUT},
    {14, 0, 1024, 1024, (int)O_WR},
    {15, 0, 1024, 1024, (int)O_WK},
    {16, 0, 1024, 1024, (int)O_WV},
    {17, 0, 1024, 1024, (int)O_WO},
    {18, 0, 1024, 128, (int)O_G1},
    {19, 0, 128, 1024, (int)O_G2},
    {24, 0, 1024, 64, (int)O_W1},
    {24, 65536, 1024, 64, (int)(O_W1 + 131072)},
    {27, 0, 1024, 64, (int)O_A1},
    {27, 65536, 1024, 64, (int)(O_A1 + 131072)},
    {25, 0, 64, 1024, (int)O_W2},
    {25, 65536, 64, 1024, (int)(O_W2 + 131072)},
    {28, 0, 64, 1024, (int)O_A2},
    {28, 65536, 64, 1024, (int)(O_A2 + 131072)},
    {31, 0, 1024, 2048, (int)O_WQ},
    {31, 2097152, 1024, 2048, (int)(O_WQ + 4194304)},
};

__device__ __forceinline__ void convert_bf16(const float* __restrict__ src, u16* __restrict__ dst, size_t n) {
  size_t n4 = n >> 2;
  for (size_t i = (size_t)blockIdx.x * NT + tid_(); i < n4; i += (size_t)gridDim.x * NT) {
    float4 v = ((const float4*)src)[i];
    uint2 o; o.x = pack2(v.x, v.y); o.y = pack2(v.z, v.w);
    ((uint2*)dst)[i] = o;
  }
}

__device__ __forceinline__ void convert_tab_fp8(const float* __restrict__ U, const float* __restrict__ V, char* tab);
__device__ __forceinline__ void phase_prep(const P& p, char* lds) {
  const int tid = tid_();
  float* fl = (float*)lds;
  for (int task = blockIdx.x; task < 192; task += gridDim.x) {
    int l = task / 96, cg_ = task % 96;
    float* sv = fl;
    float* red = fl + 9216;
    for (int i = tid; i < 9216; i += NT) {
      int v = i >> 10, k = i & 1023;
      float x = v < 8 ? p.in[1][v * 1024 + k] : p.in[3][k];
      sv[i] = x / (1.f + __expf(-x));
    }
    __syncthreads();
    int col = cg_ * 64 + (tid & 63), kg = tid >> 6;
    float acc[9];
#pragma unroll
    for (int v = 0; v < 9; ++v) acc[v] = 0.f;
    const float* W = p.in[4] + (size_t)l * 1024 * 6144 + col;
    for (int k = kg * 128; k < kg * 128 + 128; ++k) {
      float w = W[(size_t)k * 6144];
#pragma unroll
      for (int v = 0; v < 9; ++v) acc[v] += sv[v * 1024 + k] * w;
    }
#pragma unroll
    for (int v = 0; v < 9; ++v) red[(kg * 9 + v) * 64 + (tid & 63)] = acc[v];
    __syncthreads();
    if (tid < 576) {
      int v = tid >> 6, c = tid & 63;
      float s = p.in[5][l * 6144 + cg_ * 64 + c];
#pragma unroll
      for (int g = 0; g < 8; ++g) s += red[(g * 9 + v) * 64 + c];
      ((float*)(p.ws + O_MOD))[(l * 9 + v) * 6144 + cg_ * 64 + c] = s;
    }
    __syncthreads();
  }
  {
    int base = 0;
    for (int j = 0; j < 18; ++j) {
      int K = TJOBS[j][2], N = TJOBS[j][3];
      int tk = K >> 6, tn = N >> 6, nt = tk * tn;
      const float* src = p.in[TJOBS[j][0]] + TJOBS[j][1];
      u16* dst = (u16*)(p.ws + (size_t)(unsigned)TJOBS[j][4]);
      int first = (blockIdx.x + gridDim.x - (base % gridDim.x)) % gridDim.x;
      for (int t = first; t < nt; t += gridDim.x) {
        int k0 = (t / tn) * 64, n0 = (t % tn) * 64;
#pragma unroll
        for (int rep = 0; rep < 8; ++rep) {
          int idx = tid + NT * rep; int i = idx >> 6, jj = idx & 63;
          fl[i * 65 + jj] = src[(size_t)(k0 + i) * N + n0 + jj];
        }
        __syncthreads();
        int n = tid >> 3, c8 = tid & 7;
        uint4 o;
        o.x = pack2(fl[(c8 * 8 + 0) * 65 + n], fl[(c8 * 8 + 1) * 65 + n]);
        o.y = pack2(fl[(c8 * 8 + 2) * 65 + n], fl[(c8 * 8 + 3) * 65 + n]);
        o.z = pack2(fl[(c8 * 8 + 4) * 65 + n], fl[(c8 * 8 + 5) * 65 + n]);
        o.w = pack2(fl[(c8 * 8 + 6) * 65 + n], fl[(c8 * 8 + 7) * 65 + n]);
        *(uint4*)(dst + (size_t)(n0 + n) * K + k0 + c8 * 8) = o;
        __syncthreads();
      }
      base += nt;
    }
  }
  convert_bf16(p.in[32], (u16*)(p.ws + O_KEYS), (size_t)2 * 8 * 2 * 128 * 128);
  convert_tab_fp8(p.in[33], p.in[34], p.ws + O_TAB0);
  if (blockIdx.x == 0) {
    float* rope = (float*)(p.ws + O_ROPE);
    for (int i = tid; i < 1024; i += NT) {
      int pos = i >> 4, f = i & 15;
      float inv = exp2f(-(float)f * (13.287712379549449f / 16.f));
      float ang = (float)pos * inv;
      rope[i * 2] = cosf(ang);
      rope[i * 2 + 1] = sinf(ang);
    }
  }
}

__device__ __forceinline__ void phase_norm(const P& p, const float* srcL, const float* srcC, const float* gain, int layer, int shift_idx,
                           int nrows, u16* dst) {
  const int lane = tid_() & 63;
  const int gw = blockIdx.x * 8 + (tid_() >> 6), nw = gridDim.x * 8;
  const float* mod = (const float*)(p.ws + O_MOD) + (size_t)layer * 9 * 6144;
  for (int row = gw; row < nrows; row += nw) {
    const float* src = row < NLAT ? srcL + (size_t)row * DM : srcC + (size_t)(row - NLAT) * DM;
    int mi = row < NLAT ? (row >> 12) : 8;
    const float* sh = mod + mi * 6144 + shift_idx * 1024;
    const float* sc = sh + 1024;
    float4 v[4];
    float ss = 0.f;
#pragma unroll
    for (int i = 0; i < 4; ++i) {
      v[i] = *(const float4*)(src + i * 256 + lane * 4);
      ss += v[i].x * v[i].x + v[i].y * v[i].y + v[i].z * v[i].z + v[i].w * v[i].w;
    }
    ss = wave_sum(ss);
    float rs = rsqrtf(ss * (1.f / 1024.f) + 1e-6f);
#pragma unroll
    for (int i = 0; i < 4; ++i) {
      int c = i * 256 + lane * 4;
      float4 g = *(const float4*)(gain + c);
      float4 s1 = *(const float4*)(sc + c);
      float4 s0 = *(const float4*)(sh + c);
      float a = v[i].x * rs * g.x * (1.f + s1.x) + s0.x;
      float b = v[i].y * rs * g.y * (1.f + s1.y) + s0.y;
      float cc = v[i].z * rs * g.z * (1.f + s1.z) + s0.z;
      float d = v[i].w * rs * g.w * (1.f + s1.w) + s0.w;
      uint2 o; o.x = pack2(a, b); o.y = pack2(cc, d);
      *(uint2*)(dst + (size_t)row * DM + c) = o;
    }
  }
}

__device__ __forceinline__ void phase_conv_qk(const P& p) {
  const u16* hgg = (const u16*)(p.ws + O_HGG);
  u16* mix = (u16*)(p.ws + O_XN);
  const float* cw = p.in[9];
  const size_t gt = (size_t)blockIdx.x * NT + tid_(), gn = (size_t)gridDim.x * NT;
  for (size_t it = gt; it < (size_t)TTOK * 64; it += gn) {
    int row = (int)(it >> 6), c0 = (int)(it & 63) * 8;
    int t, len;
    if (row < NLAT) { t = row & 4095; len = 4096; } else { t = (row - NLAT) & 255; len = 256; }
    float pm[8], pc[8], pp[8];
    {
      const u16* b = hgg + (size_t)row * 1536;
      uint4 hh = *(const uint4*)(b + c0), gc = *(const uint4*)(b + 1024 + c0);
      pc[0] = bflo(hh.x) * bflo(gc.x); pc[1] = bfhi(hh.x) * bfhi(gc.x);
      pc[2] = bflo(hh.y) * bflo(gc.y); pc[3] = bfhi(hh.y) * bfhi(gc.y);
      pc[4] = bflo(hh.z) * bflo(gc.z); pc[5] = bfhi(hh.z) * bfhi(gc.z);
      pc[6] = bflo(hh.w) * bflo(gc.w); pc[7] = bfhi(hh.w) * bfhi(gc.w);
    }
    if (t > 0) {
      const u16* b = hgg + (size_t)(row - 1) * 1536;
      uint4 hh = *(const uint4*)(b + c0), gc = *(const uint4*)(b + 1024 + c0);
      pm[0] = bflo(hh.x) * bflo(gc.x); pm[1] = bfhi(hh.x) * bfhi(gc.x);
      pm[2] = bflo(hh.y) * bflo(gc.y); pm[3] = bfhi(hh.y) * bfhi(gc.y);
      pm[4] = bflo(hh.z) * bflo(gc.z); pm[5] = bfhi(hh.z) * bfhi(gc.z);
      pm[6] = bflo(hh.w) * bflo(gc.w); pm[7] = bfhi(hh.w) * bfhi(gc.w);
    } else {
#pragma unroll
      for (int e = 0; e < 8; ++e) pm[e] = 0.f;
    }
    if (t < len - 1) {
      const u16* b = hgg + (size_t)(row + 1) * 1536;
      uint4 hh = *(const uint4*)(b + c0), gc = *(const uint4*)(b + 1024 + c0);
      pp[0] = bflo(hh.x) * bflo(gc.x); pp[1] = bfhi(hh.x) * bfhi(gc.x);
      pp[2] = bflo(hh.y) * bflo(gc.y); pp[3] = bfhi(hh.y) * bfhi(gc.y);
      pp[4] = bflo(hh.z) * bflo(gc.z); pp[5] = bfhi(hh.z) * bfhi(gc.z);
      pp[6] = bflo(hh.w) * bflo(gc.w); pp[7] = bfhi(hh.w) * bfhi(gc.w);
    } else {
#pragma unroll
      for (int e = 0; e < 8; ++e) pp[e] = 0.f;
    }
    uint4 gbv = *(const uint4*)(hgg + (size_t)row * 1536 + 512 + c0);
    float gb[8] = {bflo(gbv.x), bfhi(gbv.x), bflo(gbv.y), bfhi(gbv.y), bflo(gbv.z), bfhi(gbv.z), bflo(gbv.w), bfhi(gbv.w)};
    float o[8];
#pragma unroll
    for (int e = 0; e < 8; ++e)
      o[e] = gb[e] * (cw[c0 + e] * pm[e] + cw[512 + c0 + e] * pc[e] + cw[1024 + c0 + e] * pp[e]);
    uint4 ov; ov.x = pack2(o[0], o[1]); ov.y = pack2(o[2], o[3]); ov.z = pack2(o[4], o[5]); ov.w = pack2(o[6], o[7]);
    *(uint4*)(mix + (size_t)row * DM + c0) = ov;
  }
  u16* Q = (u16*)(p.ws + O_Q);
  u16* KBp = (u16*)(p.ws + O_KB);
  const float* rope = (const float*)(p.ws + O_ROPE);
  const size_t ngroups = (size_t)TTOK * 10;
  for (size_t it = gt; it < ngroups * 8; it += gn) {
    size_t grp = it >> 3; int sub = (int)(it & 7);
    int row = (int)(grp / 10), hd = (int)(grp % 10);
    u16* ptr; const float* gain;
    if (hd < 8) { ptr = Q + (size_t)row * 512 + hd * 64 + sub * 8; gain = p.in[10]; }
    else { ptr = KBp + (size_t)row * 128 + (hd - 8) * 64 + sub * 8; gain = p.in[11]; }
    uint4 v = *(const uint4*)ptr;
    float x[8] = {bflo(v.x), bfhi(v.x), bflo(v.y), bfhi(v.y), bflo(v.z), bfhi(v.z), bflo(v.w), bfhi(v.w)};
    float ss = 0.f;
#pragma unroll
    for (int e = 0; e < 8; ++e) ss += x[e] * x[e];
    ss = red8(ss);
    float rs = rsqrtf(ss * (1.f / 64.f) + 1e-6f);
#pragma unroll
    for (int e = 0; e < 8; ++e) x[e] = x[e] * rs * gain[sub * 8 + e];
    if (row < NLAT) {
      int t = row & 4095; int gr = t >> 6, gc = t & 63;
#pragma unroll
      for (int e = 0; e < 4; ++e) {
        int pi = sub * 4 + e;
        int pos = pi < 16 ? gr : gc; int f = pi & 15;
        float c = rope[(pos * 16 + f) * 2], s = rope[(pos * 16 + f) * 2 + 1];
        float a = x[2 * e], b = x[2 * e + 1];
        x[2 * e] = a * c - b * s;
        x[2 * e + 1] = a * s + b * c;
      }
    }
    uint4 ov; ov.x = pack2(x[0], x[1]); ov.y = pack2(x[2], x[3]); ov.z = pack2(x[4], x[5]); ov.w = pack2(x[6], x[7]);
    *(uint4*)ptr = ov;
  }
}

__device__ __forceinline__ void phase_attn(const P& p, char* lds) {
  u16* sK = (u16*)lds;
  u16* sV = sK + 64 * LDSS;
  const u16* Q = (const u16*)(p.ws + O_Q);
  const u16* KBp = (const u16*)(p.ws + O_KB);
  const u16* VT = (const u16*)(p.ws + O_VT);
  u16* mix = (u16*)(p.ws + O_XN);
  const int tid = tid_(), lane = tid & 63, wave = tid >> 6;
  const int r = lane & 31, h = lane >> 5;
  const float cs = 0.125f * 1.4426950408889634f;
  for (int item = blockIdx.x; item < 1088; item += gridDim.x) {
    int b, qh, qrow0, nkt;
    if (item < 1024) { b = item >> 7; qh = (item >> 4) & 7; qrow0 = b * 4096 + (item & 15) * 256; nkt = 68; }
    else { int i2 = item - 1024; b = i2 >> 3; qh = i2 & 7; qrow0 = NLAT + b * 256; nkt = 4; }
    const int kvh = qh >> 2;
    const int qrow = qrow0 + wave * 32 + r;
    bf16x8 qf[4];
#pragma unroll
    for (int kk = 0; kk < 4; ++kk) qf[kk] = *(const bf16x8*)(Q + (size_t)qrow * 512 + qh * 64 + kk * 16 + h * 8);
    f32x16 o[2];
#pragma unroll
    for (int g = 0; g < 16; ++g) { o[0][g] = 0.f; o[1][g] = 0.f; }
    float m = -INFINITY, l = 0.f;
    const int lkey = tid >> 3, lch = tid & 7;
    uint4 ka, va;
    auto gl = [&](int kt) {
      int pos = kt * 64 + lkey;
      int krow = pos < 256 ? NLAT + b * 256 + pos : b * 4096 + pos - 256;
      ka = *(const uint4*)(KBp + (size_t)krow * 128 + kvh * 64 + lch * 8);
      va = *(const uint4*)(VT + ((size_t)((b * 2 + kvh) * 64 + lkey)) * 4352 + kt * 64 + lch * 8);
    };
    gl(0);
    for (int kt = 0; kt < nkt; ++kt) {
      *(uint4*)(sK + lkey * LDSS + lch * 8) = ka;
      *(uint4*)(sV + lkey * LDSS + lch * 8) = va;
      __syncthreads();
      if (kt + 1 < nkt) gl(kt + 1);
      f32x16 s[2];
#pragma unroll
      for (int g = 0; g < 16; ++g) { s[0][g] = 0.f; s[1][g] = 0.f; }
#pragma unroll
      for (int kb = 0; kb < 2; ++kb)
#pragma unroll
        for (int kk = 0; kk < 4; ++kk) {
          bf16x8 a = *(const bf16x8*)(sK + (kb * 32 + r) * LDSS + kk * 16 + h * 8);
          s[kb] = __builtin_amdgcn_mfma_f32_32x32x16_bf16(a, qf[kk], s[kb], 0, 0, 0);
        }
      float mx = s[0][0];
#pragma unroll
      for (int g = 0; g < 16; ++g) { mx = fmaxf(mx, s[0][g]); mx = fmaxf(mx, s[1][g]); }
      mx = swapmax32(mx);
      float mn = fmaxf(m, mx);
      float alpha = __builtin_amdgcn_exp2f((m - mn) * cs);
      m = mn;
      float mc = mn * cs, ps = 0.f;
#pragma unroll
      for (int kb = 0; kb < 2; ++kb)
#pragma unroll
        for (int g = 0; g < 16; ++g) { float e = __builtin_amdgcn_exp2f(s[kb][g] * cs - mc); s[kb][g] = e; ps += e; }
      l = l * alpha + ps;
#pragma unroll
      for (int g = 0; g < 16; ++g) { o[0][g] *= alpha; o[1][g] *= alpha; }
      bf16x8 pb[2][2];
#pragma unroll
      for (int kb = 0; kb < 2; ++kb)
#pragma unroll
        for (int c = 0; c < 2; ++c) {
          uint4 pk;
          pk.x = pack2(s[kb][8 * c + 0], s[kb][8 * c + 1]); pk.y = pack2(s[kb][8 * c + 2], s[kb][8 * c + 3]);
          pk.z = pack2(s[kb][8 * c + 4], s[kb][8 * c + 5]); pk.w = pack2(s[kb][8 * c + 6], s[kb][8 * c + 7]);
          pb[kb][c] = __builtin_bit_cast(bf16x8, pk);
        }
#pragma unroll
      for (int db = 0; db < 2; ++db)
#pragma unroll
        for (int kb = 0; kb < 2; ++kb)
#pragma unroll
          for (int c = 0; c < 2; ++c) {
            const u16* vp = sV + (db * 32 + r) * LDSS + kb * 32 + 16 * c + 4 * h;
            uint2 lo = *(const uint2*)vp, hi = *(const uint2*)(vp + 8);
            uint4 av = make_uint4(lo.x, lo.y, hi.x, hi.y);
            o[db] = __builtin_amdgcn_mfma_f32_32x32x16_bf16(__builtin_bit_cast(bf16x8, av), pb[kb][c], o[db], 0, 0, 0);
          }
      __syncthreads();
    }
    l = swapsum32(l, l);
    float inv = 1.f / l;
#pragma unroll
    for (int db = 0; db < 2; ++db)
#pragma unroll
      for (int g4 = 0; g4 < 4; ++g4) {
        int d = db * 32 + 8 * g4 + 4 * h;
        uint2 ov;
        ov.x = pack2(o[db][g4 * 4 + 0] * inv, o[db][g4 * 4 + 1] * inv);
        ov.y = pack2(o[db][g4 * 4 + 2] * inv, o[db][g4 * 4 + 3] * inv);
        *(uint2*)(mix + (size_t)qrow * DM + 512 + qh * 64 + d) = ov;
      }
  }
}

__device__ __forceinline__ int fkey(float f) { int b = __float_as_int(f); return b ^ ((b >> 31) & 0x7FFFFFFF); }
__device__ __forceinline__ float keyf(int k) { return __int_as_float(k ^ ((k >> 31) & 0x7FFFFFFF)); }

#define CE_DESC(a, b) { int hi__ = max(a, b); int lo__ = min(a, b); a = hi__; b = lo__; }
#define BITONIC_SORT16(r)                                                          \
  _Pragma("unroll") for (int k_ = 2; k_ <= 16; k_ <<= 1)                           \
    _Pragma("unroll") for (int j_ = k_ >> 1; j_ > 0; j_ >>= 1)                     \
      _Pragma("unroll") for (int i_ = 0; i_ < 16; ++i_) {                          \
        const int l_ = i_ ^ j_;                                                    \
        if (l_ > i_) { if ((i_ & k_) == 0) CE_DESC(r[i_], r[l_]) else CE_DESC(r[l_], r[i_]) } \
      }
#define BITONIC_MERGE16(r)                                                         \
  _Pragma("unroll") for (int j_ = 8; j_ > 0; j_ >>= 1)                             \
    _Pragma("unroll") for (int i_ = 0; i_ < 16; ++i_) {                            \
      const int l_ = i_ ^ j_;                                                      \
      if (l_ > i_) CE_DESC(r[i_], r[l_])                                           \
    }
#define XLANE_MERGE16(r, CTRL)                                                     \
  {                                                                                \
    int o_[16];                                                                    \
    _Pragma("unroll") for (int i_ = 0; i_ < 16; ++i_) o_[i_] = __builtin_amdgcn_update_dpp(0, r[15 - i_], CTRL, 0xF, 0xF, true); \
    _Pragma("unroll") for (int i_ = 0; i_ < 16; ++i_) r[i_] = max(r[i_], o_[i_]);  \
    BITONIC_MERGE16(r)                                                             \
  }
#define SCS 132
__device__ __forceinline__ void phase_peer_topk(const P& p, int layer, const u16* PQ, int ntok, int* IDX, float* GATE, char* lds) {
  float* sc = (float*)lds;
  int* lists = (int*)(lds + 2 * 64 * SCS * 4);
  u16* sq = (u16*)(lds + 2 * 64 * SCS * 4 + 8192);
  const int tid = tid_(), lane = tid & 63, wave = tid >> 6;
  const int r = lane & 31, h = lane >> 5;
  const u16* keys = (const u16*)(p.ws + O_KEYS) + (size_t)layer * 8 * 2 * 128 * 128;
  const int ntile = (ntok >> 6) * 8;
  for (int tile = blockIdx.x; tile < ntile; tile += gridDim.x) {
    int hd = tile & 7, row0 = (tile >> 3) * 64;
    {
#pragma unroll
      for (int q = 0; q < 4; ++q) {
        const int id = tid + NT * q, rw = id >> 5, c = id & 31;
        const uint4 v = *(const uint4*)(PQ + (size_t)(row0 + rw) * 2048 + hd * 256 + c * 8);
        *(uint4*)(sq + ((c >> 4) * 64 + rw) * 136 + (c & 15) * 8) = v;
      }
    }
    __syncthreads();
    {
      int pp = wave >> 2, kb = wave & 3;
      f32x16 acc[2];
#pragma unroll
      for (int g = 0; g < 16; ++g) { acc[0][g] = 0.f; acc[1][g] = 0.f; }
      const u16* kp = keys + ((size_t)(hd * 2 + pp) * 128 + kb * 32 + r) * 128 + h * 8;
      const u16* qp = sq + (pp * 64 + r) * 136 + h * 8;
#pragma unroll
      for (int kk = 0; kk < 8; ++kk) {
        bf16x8 bfr = *(const bf16x8*)(kp + kk * 16);
        bf16x8 a0 = *(const bf16x8*)(qp + kk * 16);
        bf16x8 a1 = *(const bf16x8*)(qp + 32 * 136 + kk * 16);
        acc[0] = __builtin_amdgcn_mfma_f32_32x32x16_bf16(a0, bfr, acc[0], 0, 0, 0);
        acc[1] = __builtin_amdgcn_mfma_f32_32x32x16_bf16(a1, bfr, acc[1], 0, 0, 0);
      }
#pragma unroll
      for (int mb = 0; mb < 2; ++mb)
#pragma unroll
        for (int g = 0; g < 16; ++g) {
          int tok = mb * 32 + (g & 3) + 8 * (g >> 2) + 4 * h;
          sc[(pp * 64 + tok) * SCS + kb * 32 + r] = acc[mb][g];
        }
    }
    __syncthreads();
    {
      const int row = tid >> 2, qd = tid & 3;
      const float* rowp = sc + row * SCS + qd;
      int A[16], B[16];
#pragma unroll
      for (int m = 0; m < 16; ++m) {
        A[m] = (fkey(rowp[4 * m]) & ~0x7F) | (127 - (4 * m + qd));
        B[m] = (fkey(rowp[64 + 4 * m]) & ~0x7F) | (127 - (64 + 4 * m + qd));
      }
      BITONIC_SORT16(A)
      BITONIC_SORT16(B)
#pragma unroll
      for (int i = 0; i < 16; ++i) A[i] = max(A[i], B[15 - i]);
      BITONIC_MERGE16(A)
      XLANE_MERGE16(A, 0xB1)
      XLANE_MERGE16(A, 0x4E)
      if (qd == 0) {
#pragma unroll
        for (int i = 0; i < 16; i += 4) *(int4*)(lists + row * 16 + i) = make_int4(A[i], A[i + 1], A[i + 2], A[i + 3]);
      }
    }
    __syncthreads();
    if (tid < 256) {
      const int tok = tid >> 2, q = tid & 3;
      float bq[16];
#pragma unroll
      for (int j = 0; j < 16; ++j) bq[j] = keyf(lists[(64 + tok) * 16 + j] & ~0x7F);
      int R[16];
#pragma unroll
      for (int i = 0; i < 16; ++i) R[i] = (int)0x80000000;
#pragma unroll
      for (int m = 0; m < 4; ++m) {
        const int i = q + 4 * m;
        const float ai = keyf(lists[tok * 16 + i] & ~0x7F);
        const int jmax = 16 / (i + 1);
        const int nj = m == 0 ? 16 : (m == 1 ? 3 : 1);
#pragma unroll
        for (int j = 0; j < nj; ++j) {
          int x = (fkey(ai + bq[j]) & ~0xFF) | (255 - (i * 16 + j));
          x = j < jmax ? x : (int)0x80000000;
#pragma unroll
          for (int t = 0; t < 16; ++t) { int hi_ = max(R[t], x); x = min(R[t], x); R[t] = hi_; }
        }
      }
      XLANE_MERGE16(R, 0xB1)
      XLANE_MERGE16(R, 0x4E)
      float sv[16];
      float mx = keyf(R[0] & ~0xFF), sum = 0.f;
#pragma unroll
      for (int t = 0; t < 16; ++t) { sv[t] = __expf(keyf(R[t] & ~0xFF) - mx); sum += sv[t]; }
      float inv = 1.f / sum;
      size_t ob = (size_t)(row0 + tok) * 128 + hd * 16;
#pragma unroll
      for (int t = 0; t < 16; ++t) {
        if ((t >> 2) == q) {
          int pos = 255 - (R[t] & 0xFF);
          int i1 = 127 - (lists[tok * 16 + (pos >> 4)] & 0x7F);
          int i2 = 127 - (lists[(64 + tok) * 16 + (pos & 15)] & 0x7F);
          IDX[ob + t] = i1 * 128 + i2;
          GATE[ob + t] = sv[t] * inv;
        }
      }
    }
    __syncthreads();
  }
}

typedef __attribute__((ext_vector_type(2))) float f2;
#define TAB_V8 (16 * MiB)
#define TAB_SU (32 * MiB)
#define TAB_SV (32 * MiB + 65536)
__device__ __forceinline__ float wave_max(float v) {
  v = fmaxf(v, dppf<0xB1>(v)); v = fmaxf(v, dppf<0x4E>(v)); v = fmaxf(v, dppf<0x141>(v)); v = fmaxf(v, dppf<0x140>(v));
  v = swapmax16(v); v = swapmax32(v);
  return v;
}
__device__ __forceinline__ void convert_tab_fp8(const float* __restrict__ U, const float* __restrict__ V, char* tab) {
  const int lane = tid_() & 63;
  const int gw = blockIdx.x * 8 + (tid_() >> 6), nw = gridDim.x * 8;
  for (int rr = gw; rr < 32768; rr += nw) {
    const int isv = rr >> 14, e = rr & 16383;
    const float* src = (isv ? V : U) + (size_t)e * 1024 + lane * 16;
    float4 v0 = *(const float4*)src, v1 = *(const float4*)(src + 4), v2 = *(const float4*)(src + 8), v3 = *(const float4*)(src + 12);
    float am = fmaxf(fmaxf(fmaxf(fabsf(v0.x), fabsf(v0.y)), fmaxf(fabsf(v0.z), fabsf(v0.w))),
                     fmaxf(fmaxf(fabsf(v1.x), fabsf(v1.y)), fmaxf(fabsf(v1.z), fabsf(v1.w))));
    am = fmaxf(am, fmaxf(fmaxf(fmaxf(fabsf(v2.x), fabsf(v2.y)), fmaxf(fabsf(v2.z), fabsf(v2.w))),
                         fmaxf(fmaxf(fabsf(v3.x), fabsf(v3.y)), fmaxf(fabsf(v3.z), fabsf(v3.w)))));
    am = wave_max(am);
    float sc = am > 0.f ? 448.f / am : 1.f;
    uint4 o;
    int t = 0;
    t = __builtin_amdgcn_cvt_pk_fp8_f32(v0.x * sc, v0.y * sc, t, false); t = __builtin_amdgcn_cvt_pk_fp8_f32(v0.z * sc, v0.w * sc, t, true); o.x = t;
    t = __builtin_amdgcn_cvt_pk_fp8_f32(v1.x * sc, v1.y * sc, t, false); t = __builtin_amdgcn_cvt_pk_fp8_f32(v1.z * sc, v1.w * sc, t, true); o.y = t;
    t = __builtin_amdgcn_cvt_pk_fp8_f32(v2.x * sc, v2.y * sc, t, false); t = __builtin_amdgcn_cvt_pk_fp8_f32(v2.z * sc, v2.w * sc, t, true); o.z = t;
    t = __builtin_amdgcn_cvt_pk_fp8_f32(v3.x * sc, v3.y * sc, t, false); t = __builtin_amdgcn_cvt_pk_fp8_f32(v3.z * sc, v3.w * sc, t, true); o.w = t;
    if (!isv) {
      *(uint4*)(tab + (size_t)e * 1024 + lane * 16) = o;
      if (lane == 0) ((float*)(tab + TAB_SU))[e] = am > 0.f ? am / 448.f : 1.f;
    } else {
      *(uint4*)(tab + TAB_V8 + ((size_t)(lane >> 3) * 16384 + e) * 128 + (lane & 7) * 16) = o;
      if (lane == 0) ((float*)(tab + TAB_SV))[e] = am > 0.f ? am / 448.f : 1.f;
    }
  }
}
__device__ __forceinline__ f2 dec8(unsigned w, bool hi) { return hi ? __builtin_amdgcn_cvt_pk_f32_fp8((int)w, true) : __builtin_amdgcn_cvt_pk_f32_fp8((int)w, false); }

__device__ __forceinline__ float dot16(uint4 w, f2 a0, f2 a1, f2 a2, f2 a3, f2 a4, f2 a5, f2 a6, f2 a7) {
  f2 a = f2{0.f, 0.f};
  a = __builtin_elementwise_fma(dec8(w.x, false), a0, a); a = __builtin_elementwise_fma(dec8(w.x, true), a1, a);
  a = __builtin_elementwise_fma(dec8(w.y, false), a2, a); a = __builtin_elementwise_fma(dec8(w.y, true), a3, a);
  a = __builtin_elementwise_fma(dec8(w.z, false), a4, a); a = __builtin_elementwise_fma(dec8(w.z, true), a5, a);
  a = __builtin_elementwise_fma(dec8(w.w, false), a6, a); a = __builtin_elementwise_fma(dec8(w.w, true), a7, a);
  return a.x + a.y;
}
#define DOT16(W) dot16(W, xf0, xf1, xf2, xf3, xf4, xf5, xf6, xf7)
__device__ __forceinline__ void phase_peer_act(const P& p, const u16* XN2, const char* tab, const int* IDX, const float* GATE, float* COEF, int ntok, char* lds) {
  const int tid = tid_(), lane = tid & 63, wave = tid >> 6;
  int* le = (int*)(lds + wave * 1536);
  float* lg = (float*)(le + 128);
  int* ls = le + 256;
  const int part = blockIdx.x & 7;
  const int wv = (blockIdx.x >> 3) * 8 + wave, nwv = (gridDim.x >> 3) * 8;
  const float* SU = (const float*)(tab + TAB_SU);
  const float* SV = (const float*)(tab + TAB_SV);
  const int q = lane >> 4;
  const bool hi = (lane & 32) != 0, b4 = (lane & 16) != 0;
  int i0 = 0, i1 = 0; float g0 = 0.f, g1 = 0.f; uint4 x0 = make_uint4(0, 0, 0, 0), x1 = x0;
  if (wv < ntok) {
    i0 = IDX[(size_t)wv * 128 + lane]; i1 = IDX[(size_t)wv * 128 + 64 + lane];
    g0 = GATE[(size_t)wv * 128 + lane]; g1 = GATE[(size_t)wv * 128 + 64 + lane];
    const u16* xr = XN2 + (size_t)wv * DM + lane * 16;
    x0 = *(const uint4*)xr; x1 = *(const uint4*)(xr + 8);
  }
  for (int tok = wv; tok < ntok; tok += nwv) {
    int ni0 = 0, ni1 = 0; float ng0 = 0.f, ng1 = 0.f; uint4 nx0 = make_uint4(0, 0, 0, 0), nx1 = nx0;
    const int nt = tok + nwv;
    if (nt < ntok) {
      ni0 = IDX[(size_t)nt * 128 + lane]; ni1 = IDX[(size_t)nt * 128 + 64 + lane];
      ng0 = GATE[(size_t)nt * 128 + lane]; ng1 = GATE[(size_t)nt * 128 + 64 + lane];
      const u16* xr = XN2 + (size_t)nt * DM + lane * 16;
      nx0 = *(const uint4*)xr; nx1 = *(const uint4*)(xr + 8);
    }
    const bool s0 = (i0 >> 11) == part, s1 = (i1 >> 11) == part;
    const unsigned long long m0 = __ballot(s0), m1 = __ballot(s1);
    const int c0 = __popcll(m0), cnt = c0 + __popcll(m1);
    const int p0 = __builtin_amdgcn_mbcnt_hi((unsigned)(m0 >> 32), __builtin_amdgcn_mbcnt_lo((unsigned)m0, 0));
    const int p1 = c0 + __builtin_amdgcn_mbcnt_hi((unsigned)(m1 >> 32), __builtin_amdgcn_mbcnt_lo((unsigned)m1, 0));
    if (s0) { le[p0] = i0; lg[p0] = g0; ls[p0] = lane; }
    if (s1) { le[p1] = i1; lg[p1] = g1; ls[p1] = 64 + lane; }
    const int cntp = (cnt + 3) & ~3;
    if (lane < cntp - cnt) { le[cnt + lane] = part << 11; lg[cnt + lane] = 0.f; ls[cnt + lane] = -1; }
    const f2 xf0 = f2{bflo(x0.x), bfhi(x0.x)}, xf1 = f2{bflo(x0.y), bfhi(x0.y)}, xf2 = f2{bflo(x0.z), bfhi(x0.z)}, xf3 = f2{bflo(x0.w), bfhi(x0.w)};
    const f2 xf4 = f2{bflo(x1.x), bfhi(x1.x)}, xf5 = f2{bflo(x1.y), bfhi(x1.y)}, xf6 = f2{bflo(x1.z), bfhi(x1.z)}, xf7 = f2{bflo(x1.w), bfhi(x1.w)};
    for (int base = 0; base < cntp; base += 24) {
      uint4 w[24];
      const int evl = le[base + (lane < 24 ? lane : 0)];
#pragma unroll
      for (int gq = 0; gq < 6; ++gq) {
        if (base + 4 * gq < cntp) {
#pragma unroll
          for (int k = 0; k < 4; ++k) {
            int e = __builtin_amdgcn_readlane(evl, 4 * gq + k);
            w[4 * gq + k] = *(const uint4*)(tab + (size_t)e * 1024 + lane * 16);
          }
        } else {
#pragma unroll
          for (int k = 0; k < 4; ++k) w[4 * gq + k] = make_uint4(0, 0, 0, 0);
        }
      }
      float my_act = 0.f;
#pragma unroll
      for (int gq = 0; gq < 6; ++gq) {
        if (base + 4 * gq < cntp) {
          float d0 = DOT16(w[4 * gq]), d1 = DOT16(w[4 * gq + 1]), d2 = DOT16(w[4 * gq + 2]), d3 = DOT16(w[4 * gq + 3]);
          float kA = swapsum32(d0, d2), kB = swapsum32(d1, d3);
          float kC = swapsum16(kA, kB);
          kC = red16(kC);
          if ((lane & 15) == gq) my_act = kC;
        }
      }
      {
        const int j = base + 4 * (lane & 15) + q;
        if ((lane & 15) < 6 && j < cntp) {
          const int e = le[j]; const float gt = lg[j]; const int slot = ls[j];
          if (slot >= 0) {
            float act = my_act * SU[e];
            COEF[(size_t)tok * 128 + slot] = gt * 0.5f * act * (1.f + erff(act * 0.70710678118654752f)) * SV[e];
          }
        }
      }
    }
    i0 = ni0; i1 = ni1; g0 = ng0; g1 = ng1; x0 = nx0; x1 = nx1;
  }
}

__device__ __forceinline__ void phase_peer_sum(const P& p, int layer, const char* tab, const int* IDX, const float* COEF, int ntok, float* dummy_dst) {
  const int tid = tid_(), lane = tid & 63, wave = tid >> 6;
  const int sl = blockIdx.x & 7;
  const int wv = (blockIdx.x >> 3) * 8 + wave, nwv = (gridDim.x >> 3) * 8;
  const int g = lane >> 3, ch = lane & 7;
  const char* V8 = tab + TAB_V8 + (size_t)sl * 16384 * 128 + ch * 16;
  const float* mod = (const float*)(p.ws + O_MOD) + (size_t)layer * 9 * 6144;
  float* HC = (float*)(p.ws + O_HC);
  const bool b5 = (lane & 32) != 0, b4 = (lane & 16) != 0, b3 = (lane & 8) != 0;
  const int c = sl * 128 + ch * 16 + (b5 ? 8 : 0) + (b4 ? 4 : 0) + (b3 ? 2 : 0);
  uint4 ia, ib, ic, id; float4 ca, cb, cc, cd;
  ia = ib = ic = id = make_uint4(0, 0, 0, 0); ca = cb = cc = cd = make_float4(0, 0, 0, 0);
  if (wv < ntok) {
    const int* ip = IDX + (size_t)wv * 128 + g * 16;
    const float* cp = COEF + (size_t)wv * 128 + g * 16;
    ia = *(const uint4*)ip; ib = *(const uint4*)(ip + 4); ic = *(const uint4*)(ip + 8); id = *(const uint4*)(ip + 12);
    ca = *(const float4*)cp; cb = *(const float4*)(cp + 4); cc = *(const float4*)(cp + 8); cd = *(const float4*)(cp + 12);
  }
  for (int tok = wv; tok < ntok; tok += nwv) {
    const unsigned ev[16] = {ia.x, ia.y, ia.z, ia.w, ib.x, ib.y, ib.z, ib.w, ic.x, ic.y, ic.z, ic.w, id.x, id.y, id.z, id.w};
    const float cv[16] = {ca.x, ca.y, ca.z, ca.w, cb.x, cb.y, cb.z, cb.w, cc.x, cc.y, cc.z, cc.w, cd.x, cd.y, cd.z, cd.w};
    uint4 w[16];
#pragma unroll
    for (int i = 0; i < 16; ++i) w[i] = *(const uint4*)(V8 + (size_t)ev[i] * 128);
    float* dst = (dummy_dst ? dummy_dst + (size_t)tok * DM : (tok < NLAT ? p.out + (size_t)tok * DM : HC + (size_t)(tok - NLAT) * DM)) + c;
    float2 o = *(float2*)dst;
    const int nt = tok + nwv;
    if (nt < ntok) {
      const int* ip = IDX + (size_t)nt * 128 + g * 16;
      const float* cp = COEF + (size_t)nt * 128 + g * 16;
      ia = *(const uint4*)ip; ib = *(const uint4*)(ip + 4); ic = *(const uint4*)(ip + 8); id = *(const uint4*)(ip + 12);
      ca = *(const float4*)cp; cb = *(const float4*)(cp + 4); cc = *(const float4*)(cp + 8); cd = *(const float4*)(cp + 12);
    }
    f2 acc[8];
#pragma unroll
    for (int k = 0; k < 8; ++k) acc[k] = f2{0.f, 0.f};
#pragma unroll
    for (int i = 0; i < 16; ++i) {
      f2 c2 = f2{cv[i], cv[i]};
      acc[0] = __builtin_elementwise_fma(dec8(w[i].x, false), c2, acc[0]); acc[1] = __builtin_elementwise_fma(dec8(w[i].x, true), c2, acc[1]);
      acc[2] = __builtin_elementwise_fma(dec8(w[i].y, false), c2, acc[2]); acc[3] = __builtin_elementwise_fma(dec8(w[i].y, true), c2, acc[3]);
      acc[4] = __builtin_elementwise_fma(dec8(w[i].z, false), c2, acc[4]); acc[5] = __builtin_elementwise_fma(dec8(w[i].z, true), c2, acc[5]);
      acc[6] = __builtin_elementwise_fma(dec8(w[i].w, false), c2, acc[6]); acc[7] = __builtin_elementwise_fma(dec8(w[i].w, true), c2, acc[7]);
    }
    float r8[8];
#pragma unroll
    for (int k = 0; k < 4; ++k) {
      r8[2 * k] = swapsum32(acc[k].x, acc[4 + k].x);
      r8[2 * k + 1] = swapsum32(acc[k].y, acc[4 + k].y);
    }
    float r4[4];
#pragma unroll
    for (int k = 0; k < 4; ++k) r4[k] = swapsum16(r8[k], r8[4 + k]);
    float r2[2];
#pragma unroll
    for (int k = 0; k < 2; ++k) {
      float kx = b3 ? r4[2 + k] : r4[k], sx = b3 ? r4[k] : r4[2 + k];
      r2[k] = kx + dppf<0x128>(sx);
    }
    const int mi = tok < NLAT ? (tok >> 12) : 8;
    const float2 mv = *(const float2*)(mod + mi * 6144 + 5 * 1024 + c);
    o.x += mv.x * r2[0]; o.y += mv.y * r2[1];
    *(float2*)dst = o;
  }
}

__device__ __forceinline__ void phase_scan(const P& p, char* lds, bool dummy) {
  float* buf = (float*)lds;
  float* vbuf = (float*)(lds + 81920);
  u16* ybuf = (u16*)(lds + 81920 + 16384);
  const int tid = tid_(), lane = tid & 63, wave = tid >> 6;
  const int c = lane & 7, irow = wave * 8 + (lane >> 3);
  const u16* R = (const u16*)(p.ws + O_R);
  const u16* Kp = (const u16*)(p.ws + O_K);
  const u16* Vp = (const u16*)(p.ws + O_V);
  const int ps = tid >> 4, col4 = (tid & 15) * 4;
  for (int item = blockIdx.x; item < 256; item += gridDim.x) {
    const int dir = item & 1, hh = (item >> 1) & 15, b = item >> 5;
    char* WA = p.ws + (dir ? O_WA1 : O_WA0);
    float* BON = (float*)(p.ws + O_BONUS) + (size_t)dir * NLAT * 16;
    float kkc[4], kac[4], rkc[4];
#pragma unroll
    for (int e = 0; e < 4; ++e) {
      kkc[e] = p.in[20][hh * 64 + col4 + e];
      kac[e] = p.in[21][hh * 64 + col4 + e];
      rkc[e] = p.in[22][hh * 64 + col4 + e];
    }
    auto rowof = [&](int s) -> int {
      if (s < 256) { int pos = dir ? 255 - s : s; return NLAT + b * 256 + pos; }
      int u = s - 256; int pos = dir ? 4095 - u : u; return b * 4096 + pos;
    };
    uint2 pr, pk, pv; unsigned pw, pa; int prow;
    auto gload = [&](int ch) {
      prow = rowof(ch * 32 + ps);
      size_t o = (size_t)prow * 1024 + hh * 64 + col4;
      pr = *(const uint2*)(R + o); pk = *(const uint2*)(Kp + o); pv = *(const uint2*)(Vp + o);
      const char* wp = WA + (size_t)prow * 2048 + hh * 128;
      pw = *(const unsigned*)(wp + col4); pa = *(const unsigned*)(wp + 64 + col4);
    };
    auto prep = [&](int bi) {
      float rr[4] = {bflo(pr.x), bfhi(pr.x), bflo(pr.y), bfhi(pr.y)};
      float kq[4] = {bflo(pk.x), bfhi(pk.x), bflo(pk.y), bfhi(pk.y)};
      float4 vv = make_float4(bflo(pv.x), bfhi(pv.x), bflo(pv.y), bfhi(pv.y));
      float w[4], a[4], kr[4], kk[4], bb[4], kd[4];
      float ss = 0.f;
#pragma unroll
      for (int e = 0; e < 4; ++e) {
        w[e] = 0.5f + (float)((pw >> (8 * e)) & 255u) * (1.f / 510.f);
        a[e] = (float)((pa >> (8 * e)) & 255u) * (1.f / 255.f);
        kr[e] = kq[e] * kkc[e];
        ss += kr[e] * kr[e];
      }
      ss = red16(ss);
      float inv = rsqrtf(ss + 1e-12f);
      float bn = 0.f;
#pragma unroll
      for (int e = 0; e < 4; ++e) {
        kk[e] = kr[e] * inv;
        bb[e] = kk[e] * a[e];
        kd[e] = kq[e] * (1.f + (a[e] - 1.f) * kac[e]);
        bn += rr[e] * kd[e] * rkc[e];
      }
      bn = red16(bn);
      if ((tid & 15) == 0 && prow < NLAT) BON[(size_t)prow * 16 + hh] = bn;
      float* d = buf + bi * 10240 + ((ps * 8 + (col4 >> 3)) * 5) * 8 + (col4 & 7);
      *(float4*)(d) = make_float4(rr[0], rr[1], rr[2], rr[3]);
      *(float4*)(d + 8) = make_float4(w[0], w[1], w[2], w[3]);
      *(float4*)(d + 16) = make_float4(kk[0], kk[1], kk[2], kk[3]);
      *(float4*)(d + 24) = make_float4(bb[0], bb[1], bb[2], bb[3]);
      *(float4*)(d + 32) = make_float4(kd[0], kd[1], kd[2], kd[3]);
      *(float4*)(vbuf + bi * 2048 + ps * 64 + col4) = vv;
    };
    float S[8];
#pragma unroll
    for (int j = 0; j < 8; ++j) S[j] = 0.f;
    gload(0);
    prep(0);
    __syncthreads();
    for (int ch = 0; ch < 136; ++ch) {
      const int cur = ch & 1;
      if (ch + 1 < 136) gload(ch + 1);
      const float* bq = buf + cur * 10240 + c * 40;
      const float* vq = vbuf + cur * 2048 + irow;
      float4 nr0, nr1, nw0, nw1, nk0, nk1, nb0, nb1, nd0, nd1; float nvi;
      {
        const float* q = bq;
        nr0 = *(const float4*)(q); nr1 = *(const float4*)(q + 4); nw0 = *(const float4*)(q + 8); nw1 = *(const float4*)(q + 12);
        nk0 = *(const float4*)(q + 16); nk1 = *(const float4*)(q + 20); nb0 = *(const float4*)(q + 24); nb1 = *(const float4*)(q + 28);
        nd0 = *(const float4*)(q + 32); nd1 = *(const float4*)(q + 36); nvi = vq[0];
      }
#pragma unroll 4
      for (int t = 0; t < 32; ++t) {
        const float4 r0 = nr0, r1 = nr1, w0 = nw0, w1 = nw1, k0 = nk0, k1 = nk1, b0 = nb0, b1 = nb1, d0 = nd0, d1 = nd1;
        const float vi = nvi;
        if (t + 1 < 32) {
          const float* q = bq + (t + 1) * 320;
          nr0 = *(const float4*)(q); nr1 = *(const float4*)(q + 4); nw0 = *(const float4*)(q + 8); nw1 = *(const float4*)(q + 12);
          nk0 = *(const float4*)(q + 16); nk1 = *(const float4*)(q + 20); nb0 = *(const float4*)(q + 24); nb1 = *(const float4*)(q + 28);
          nd0 = *(const float4*)(q + 32); nd1 = *(const float4*)(q + 36); nvi = vq[(t + 1) * 64];
        }
        float sa = (S[0] * k0.x + S[1] * k0.y) + (S[2] * k0.z + S[3] * k0.w) + ((S[4] * k1.x + S[5] * k1.y) + (S[6] * k1.z + S[7] * k1.w));
        sa = red8(sa);
        S[0] = fmaf(S[0], w0.x, fmaf(-sa, b0.x, vi * d0.x));
        S[1] = fmaf(S[1], w0.y, fmaf(-sa, b0.y, vi * d0.y));
        S[2] = fmaf(S[2], w0.z, fmaf(-sa, b0.z, vi * d0.z));
        S[3] = fmaf(S[3], w0.w, fmaf(-sa, b0.w, vi * d0.w));
        S[4] = fmaf(S[4], w1.x, fmaf(-sa, b1.x, vi * d1.x));
        S[5] = fmaf(S[5], w1.y, fmaf(-sa, b1.y, vi * d1.y));
        S[6] = fmaf(S[6], w1.z, fmaf(-sa, b1.z, vi * d1.z));
        S[7] = fmaf(S[7], w1.w, fmaf(-sa, b1.w, vi * d1.w));
        float y = (S[0] * r0.x + S[1] * r0.y) + (S[2] * r0.z + S[3] * r0.w) + ((S[4] * r1.x + S[5] * r1.y) + (S[6] * r1.z + S[7] * r1.w));
        y = red8(y);
        if (c == 0) ybuf[t * 64 + irow] = f2bf(y);
      }
      __syncthreads();
      if (ch >= 8 && !dummy) {
        int row = rowof(ch * 32 + ps);
        uint2 yv = *(const uint2*)(ybuf + ps * 64 + col4);
        *(uint2*)(WA + (size_t)row * 2048 + hh * 128 + col4 * 2) = yv;
      }
      if (ch + 1 < 136) prep(cur ^ 1);
      __syncthreads();
    }
  }
}

__device__ __forceinline__ void phase_readout(const P& p) {
  const u16* Vp = (const u16*)(p.ws + O_V);
  const u16* G = (const u16*)(p.ws + O_G);
  u16* Z = (u16*)(p.ws + O_Z);
  const float* BON = (const float*)(p.ws + O_BONUS);
  const size_t gt = (size_t)blockIdx.x * NT + tid_(), gn = (size_t)gridDim.x * NT;
  for (size_t it = gt; it < (size_t)NLAT * 16 * 8; it += gn) {
    int sub = (int)(it & 7); size_t grp = it >> 3;
    int hh = (int)(grp & 15); int row = (int)(grp >> 4);
    uint4 y0 = *(const uint4*)(p.ws + O_WA0 + (size_t)row * 2048 + hh * 128 + sub * 16);
    uint4 y1 = *(const uint4*)(p.ws + O_WA1 + (size_t)row * 2048 + hh * 128 + sub * 16);
    float y[8] = {bflo(y0.x) + bflo(y1.x), bfhi(y0.x) + bfhi(y1.x), bflo(y0.y) + bflo(y1.y), bfhi(y0.y) + bfhi(y1.y),
                  bflo(y0.z) + bflo(y1.z), bfhi(y0.z) + bfhi(y1.z), bflo(y0.w) + bflo(y1.w), bfhi(y0.w) + bfhi(y1.w)};
    float s = 0.f;
#pragma unroll
    for (int e = 0; e < 8; ++e) s += y[e];
    float mean = red8(s) * (1.f / 64.f);
    float vs = 0.f;
#pragma unroll
    for (int e = 0; e < 8; ++e) { y[e] -= mean; vs += y[e] * y[e]; }
    float var = red8(vs) * (1.f / 64.f);
    float rs = rsqrtf(var + 64e-5f);
    float bonus = BON[(size_t)row * 16 + hh] + BON[(size_t)NLAT * 16 + (size_t)row * 16 + hh];
    int col = hh * 64 + sub * 8;
    uint4 vv = *(const uint4*)(Vp + (size_t)row * DM + col);
    uint4 gg = *(const uint4*)(G + (size_t)row * DM + col);
    float vf[8] = {bflo(vv.x), bfhi(vv.x), bflo(vv.y), bfhi(vv.y), bflo(vv.z), bfhi(vv.z), bflo(vv.w), bfhi(vv.w)};
    float gf[8] = {bflo(gg.x), bfhi(gg.x), bflo(gg.y), bfhi(gg.y), bflo(gg.z), bfhi(gg.z), bflo(gg.w), bfhi(gg.w)};
    float z[8];
#pragma unroll
    for (int e = 0; e < 8; ++e) z[e] = (y[e] * rs * p.in[29][col + e] + p.in[30][col + e] + bonus * vf[e]) * gf[e];
    uint4 ov; ov.x = pack2(z[0], z[1]); ov.y = pack2(z[2], z[3]); ov.z = pack2(z[4], z[5]); ov.w = pack2(z[6], z[7]);
    *(uint4*)(Z + (size_t)row * DM + col) = ov;
  }
}

__device__ __forceinline__ bool xcd_tile(int k, int Tm, int Tn, int& mt, int& nt) {
  const int x = blockIdx.x & 7, j = blockIdx.x >> 3, J = gridDim.x >> 3;
  const int u = j + J * k;
  if (u >= (Tm >> 3) * Tn) return false;
  mt = (u / Tn) * 8 + x; nt = u % Tn;
  return true;
}

#define XB_TMO      128
#define XB_XCNT(j)  (256  + 64 * (j))
#define XB_XSUB(j)  (1280 + 64 * (j))
#define XB_XGEN(j)  (2304 + 64 * (j))
#define XB_TOP      3328
#define XB_TOPGEN   3392
#define XCD_BAR_WORDS 3456
#define XB_SPIN_CAP (1u << 18)
#define LAS __attribute__((address_space(3)))
__device__ __forceinline__ unsigned xb_ld(unsigned* p)              { return __hip_atomic_load(p, __ATOMIC_RELAXED, __HIP_MEMORY_SCOPE_AGENT); }
__device__ __forceinline__ unsigned xb_add(unsigned* p, unsigned v) { return __hip_atomic_fetch_add(p, v, __ATOMIC_RELAXED, __HIP_MEMORY_SCOPE_AGENT); }
__device__ __forceinline__ unsigned xb_xcc_id() { return (unsigned)__builtin_amdgcn_s_getreg((3 << 11) | 20) & 0xFu; }
#define XB_SPIN(cond, bar) do { unsigned _sp = 0; while (cond) { __builtin_amdgcn_s_sleep(1); \
    if ((++_sp & 255u) == 0u) { if (xb_ld(&(bar)[XB_TMO])) break; if (_sp > XB_SPIN_CAP) { atomicAdd(&(bar)[XB_TMO], 1u); break; } } } } while (0)
struct XcdBarrier { unsigned* bar; unsigned x; volatile LAS unsigned* st; };
__device__ __forceinline__ XcdBarrier xcd_barrier_post(unsigned* bar, volatile LAS unsigned* st) {
  XcdBarrier b; b.bar = bar; b.x = xb_xcc_id(); b.st = st;
  if (tid_() == 0) (void)xb_add(&bar[XB_XCNT(b.x)], 1u);
  return b;
}
__device__ __forceinline__ void xcd_barrier_complete(unsigned* bar, unsigned x, unsigned& nloc, unsigned& nx) {
  const unsigned G = gridDim.x * gridDim.y * gridDim.z;
  unsigned sum, cnt, mine, sp = 0u;
  for (;;) {
    sum = 0u; cnt = 0u; mine = 0u;
#pragma unroll
    for (unsigned j = 0; j < 16; ++j) { const unsigned c = xb_ld(&bar[XB_XCNT(j)]); sum += c; cnt += (c > 0u) ? 1u : 0u; mine = (j == x) ? c : mine; }
    if (sum == G) break;
    __builtin_amdgcn_s_sleep(1);
    if ((++sp & 255u) == 0u) { if (xb_ld(&bar[XB_TMO])) break; if (sp > XB_SPIN_CAP) { atomicAdd(&bar[XB_TMO], 1u); break; } }
  }
  nloc = mine > 0u ? mine : 1u; nx = cnt > 0u ? cnt : 1u;
}
__device__ __forceinline__ void xcd_barrier(char* wsb, char* ldsb) {
#if defined(__HIP_DEVICE_COMPILE__)
  XcdBarrier b; b.bar = (unsigned*)(wsb + O_BAR); b.x = xb_xcc_id(); b.st = (volatile LAS unsigned*)(ldsb + LDS_BYTES - 16);
  asm volatile("s_waitcnt vmcnt(0)" ::: "memory");
  __syncthreads();
  if (tid_() == 0) {
    unsigned* bar = b.bar;
    __builtin_amdgcn_s_waitcnt(0);
    unsigned nloc = b.st[0], nx = b.st[1];
    if (nloc == 0u) { xcd_barrier_complete(bar, b.x, nloc, nx); b.st[0] = nloc; b.st[1] = nx; }
    const unsigned old = xb_add(&bar[XB_XSUB(b.x)], 1u);
    const unsigned gen = old / nloc;
    if (old + 1u == (gen + 1u) * nloc) {
      __builtin_amdgcn_fence(__ATOMIC_RELEASE, "agent");
      asm volatile("s_waitcnt vmcnt(0)" ::: "memory");
      const unsigned og = xb_add(&bar[XB_TOP], 1u);
      const unsigned tg = og / nx;
      if (og + 1u == (tg + 1u) * nx) xb_add(&bar[XB_TOPGEN], 1u);
      else XB_SPIN(xb_ld(&bar[XB_TOPGEN]) == tg, bar);
      __builtin_amdgcn_fence(__ATOMIC_ACQUIRE, "agent");
      xb_add(&bar[XB_XGEN(b.x)], 1u);
      asm volatile("s_waitcnt vmcnt(0)" ::: "memory");
    } else {
      XB_SPIN(xb_ld(&bar[XB_XGEN(b.x)]) == gen, bar);
      __builtin_amdgcn_fence(__ATOMIC_ACQUIRE, "agent");
      asm volatile("s_waitcnt vmcnt(0)" ::: "memory");
    }
  }
  __syncthreads();
#endif
}

__global__ void __launch_bounds__(NT) fwd_kernel(P p) {
  extern __shared__ __attribute__((aligned(16))) char lds[];
  cg::grid_group grid = cg::this_grid();
  char* ws = p.ws;
  const float* mod0 = (const float*)(ws + O_MOD);
  const float* mod1 = mod0 + 9 * 6144;
  volatile LAS unsigned* xst = (volatile LAS unsigned*)(lds + LDS_BYTES - 16);
  if (tid_() == 0) { xst[0] = 0u; xst[1] = 0u; }
  __syncthreads();
  (void)xcd_barrier_post((unsigned*)(p.ws + O_BAR), xst);
  for (int ph = p.ph_lo; ph < p.ph_hi; ++ph) {
    if (ph > p.ph_lo) {
      if (p.ph_hi < 0) grid.sync();
      xcd_barrier(p.ws, lds);
    }
    if (!((PHASE_MASK >> ph) & 1)) continue;
    const int nrep = ((REPEAT_MASK >> ph) & 1) ? 2 : 1;
    for (int rep = 0; rep < nrep; ++rep) {
    const bool dummy = rep + 1 < nrep;
    if (rep) grid.sync();
    switch (ph) {
      case 0: phase_prep(p, lds); break;
      case 1: phase_norm(p, p.in[0], p.in[2], p.in[6], 0, 0, TTOK, (u16*)(ws + O_XN)); break;
      case 2: {
        u16* hgg = (u16*)(ws + O_HGG); u16* Q = (u16*)(ws + O_Q); u16* KBp = (u16*)(ws + O_KB); u16* VT = (u16*)(ws + O_VT);
        for (int kq = 0, mt = 0, ntw = 0; xcd_tile(kq, 136, 10, mt, ntw); ++kq) {
          if (ntw < 8) {
            const int n0w = ntw * 256;
            u16* dbase; int dld;
            if (n0w < 1536) { dbase = hgg + n0w; dld = 1536; } else { dbase = Q + (n0w - 1536); dld = 512; }
            auto xf = [&](float v, int row, int col) -> float { return v; };
            auto dstf = [&](int row) -> u16* { return dbase + (size_t)row * dld; };
            gemm_tile256<false>((const u16*)(ws + O_XN), 1024, nullptr, (const u16*)(ws + O_WIN) + (size_t)n0w * 1024, 1024, 1024,
                                mt * 256, xf, dstf, (u16*)lds);
            continue;
          }
          int nt = 8 + ntw;
          int n0 = nt * 128;
          auto epi = [&](int row, int col, float v0, float v1, float v2, float v3) {
            int n = n0 + col;
            float v[4] = {v0, v1, v2, v3};
            if (n < 1536) {
#pragma unroll
              for (int j = 0; j < 4; ++j) hgg[(size_t)(row + j) * 1536 + n] = f2bf(v[j]);
            } else if (n < 2048) {
#pragma unroll
              for (int j = 0; j < 4; ++j) Q[(size_t)(row + j) * 512 + n - 1536] = f2bf(v[j]);
            } else if (n < 2176) {
#pragma unroll
              for (int j = 0; j < 4; ++j) KBp[(size_t)(row + j) * 128 + n - 2048] = f2bf(v[j]);
            } else {
              int kvh = (n - 2176) >> 6, d = (n - 2176) & 63;
              int b, pos;
              if (row < NLAT) { b = row >> 12; pos = 256 + (row & 4095); } else { b = (row - NLAT) >> 8; pos = (row - NLAT) & 255; }
              uint2 o; o.x = pack2(v0, v1); o.y = pack2(v2, v3);
              *(uint2*)(VT + ((size_t)((b * 2 + kvh) * 64 + d)) * 4352 + pos) = o;
            }
          };
          if (nt < 17) {
            u16* dbase; int dld;
            if (n0 < 1536) { dbase = hgg + n0; dld = 1536; } else if (n0 < 2048) { dbase = Q + (n0 - 1536); dld = 512; } else { dbase = KBp + (n0 - 2048); dld = 128; }
            auto xf = [&](float v, int row, int col) -> float { return v; };
            auto dstf = [&](int row) -> u16* { return dbase + (size_t)row * dld; };
            gemm_tile<false, 1>((const u16*)(ws + O_XN), 1024, nullptr, (const u16*)(ws + O_WIN) + (size_t)n0 * 1024, 1024, 1024,
                                mt * 256, xf, dstf, (u16*)lds);
          } else {
            gemm_tile<false, 0>((const u16*)(ws + O_XN), 1024, nullptr, (const u16*)(ws + O_WIN) + (size_t)n0 * 1024, 1024, 1024,
                                mt * 256, epi, 0, (u16*)lds);
          }
        }
      } break;
      case 3: phase_conv_qk(p); break;
      case 4: phase_attn(p, lds); break;
      case 5: {
        float* HC = (float*)(ws + O_HC);
        for (int kq = 0, mt = 0, nt = 0; xcd_tile(kq, 136, 8, mt, nt); ++kq) {
          int n0 = nt * 128;
          auto epi = [&](int row, int col, float v0, float v1, float v2, float v3) {
            int n = n0 + col;
            float v[4] = {v0, v1, v2, v3};
#pragma unroll
            for (int j = 0; j < 4; ++j) {
              int rw = row + j;
              if (rw < NLAT) {
                float g = mod0[(rw >> 12) * 6144 + 2048 + n];
                p.out[(size_t)rw * DM + n] = p.in[0][(size_t)rw * DM + n] + g * v[j];
              } else {
                float g = mod0[8 * 6144 + 2048 + n];
                HC[(size_t)(rw - NLAT) * DM + n] = p.in[2][(size_t)(rw - NLAT) * DM + n] + g * v[j];
              }
            }
          };
          gemm_tile<false, 0>((const u16*)(ws + O_XN), 1024, nullptr, (const u16*)(ws + O_WOUT) + (size_t)n0 * 1024, 1024, 1024,
                              mt * 256, epi, 0, (u16*)lds);
        }
      } break;
      case 6: phase_norm(p, p.out, (const float*)(ws + O_HC), p.in[7], 0, 3, TTOK, (u16*)(ws + O_XN)); break;
      case 7: case 18: {
        int layer = ph == 7 ? 0 : 1;
        int mtiles = layer == 0 ? 136 : 128;
        u16* PQ = (u16*)(ws + (layer == 0 ? O_PQ0 : O_PQ1));
        const u16* Wq = (const u16*)(ws + O_WQ) + (size_t)layer * 2048 * 1024;
        for (int kq = 0, mt = 0, nt = 0; xcd_tile(kq, mtiles, 8, mt, nt); ++kq) {
          int n0 = nt * 256;
          auto epi = [&](int row, int col, float v0, float v1, float v2, float v3) {
            int n = n0 + col;
            float v[4] = {v0, v1, v2, v3};
#pragma unroll
            for (int j = 0; j < 4; ++j) PQ[(size_t)(row + j) * 2048 + n] = f2bf(v[j]);
          };
          auto xf = [&](float v, int row, int col) -> float { return v; };
          auto dstf = [&](int row) -> u16* { return PQ + (size_t)row * 2048 + n0; };
          gemm_tile256<false>((const u16*)(ws + O_XN), 1024, nullptr, Wq + (size_t)n0 * 1024, 1024, 1024, mt * 256, xf, dstf, (u16*)lds);
        }
      } break;
      case 8: phase_peer_topk(p, 0, (const u16*)(ws + O_PQ0), TTOK, (int*)(ws + O_IDX0), (float*)(ws + O_GATE0), lds); break;
      case 9: phase_peer_act(p, (const u16*)(ws + O_XN), ws + O_TAB0, (const int*)(ws + O_IDX0), (const float*)(ws + O_GATE0),
                             (float*)(ws + O_COEF0), TTOK, lds); break;
      case 10: phase_peer_sum(p, 0, ws + O_TAB0, (const int*)(ws + O_IDX0), (const float*)(ws + O_COEF0), TTOK, dummy ? (float*)(ws + O_A2R) : nullptr); break;
      case 11: phase_norm(p, p.out, (const float*)(ws + O_HC), p.in[6] + 1024, 1, 0, TTOK, (u16*)(ws + O_XN)); break;
      case 12: {
        u16* LORA = (u16*)(ws + O_LORA);
        for (int kq = 0;; ++kq) {
          const int u = (blockIdx.x >> 3) + (gridDim.x >> 3) * kq;
          if (u >= 17 * 27) break;
          int mt, nt;
          if (u < 408) { int g = u / 136, rem = u % 136; mt = (rem >> 3) * 8 + (blockIdx.x & 7); nt = g * 8 + (rem & 7); }
          else { int v2 = u - 408; mt = (v2 / 3) * 8 + (blockIdx.x & 7); nt = 24 + v2 % 3; }
          const u16* Bp; int mixi; u16* dstp = nullptr; int kind;
          if (nt < 8) { Bp = (const u16*)(ws + O_WR) + (size_t)nt * 128 * 1024; mixi = 0; dstp = (u16*)(ws + O_R) + nt * 128; kind = 0; }
          else if (nt < 16) { Bp = (const u16*)(ws + O_WK) + (size_t)(nt - 8) * 128 * 1024; mixi = 2; dstp = (u16*)(ws + O_K) + (nt - 8) * 128; kind = 0; }
          else if (nt < 24) { Bp = (const u16*)(ws + O_WV) + (size_t)(nt - 16) * 128 * 1024; mixi = 3; dstp = (u16*)(ws + O_V) + (nt - 16) * 128; kind = 0; }
          else if (nt == 24) { Bp = (const u16*)(ws + O_W1); mixi = 1; kind = 1; }
          else if (nt == 25) { Bp = (const u16*)(ws + O_A1); mixi = 4; kind = 2; }
          else { Bp = (const u16*)(ws + O_G1); mixi = 5; kind = 3; }
          auto epi = [&](int row, int col, float v0, float v1, float v2, float v3) {
            float v[4] = {v0, v1, v2, v3};
            if (kind == 0) {
#pragma unroll
              for (int j = 0; j < 4; ++j) dstp[(size_t)(row + j) * 1024 + col] = f2bf(v[j]);
            } else if (kind == 1) {
#pragma unroll
              for (int j = 0; j < 4; ++j) LORA[(size_t)(row + j) * 384 + col] = f2bf(tanhf(v[j]));
            } else if (kind == 2) {
#pragma unroll
              for (int j = 0; j < 4; ++j) LORA[(size_t)(row + j) * 384 + 128 + col] = f2bf(v[j]);
            } else {
#pragma unroll
              for (int j = 0; j < 4; ++j) LORA[(size_t)(row + j) * 384 + 256 + col] = f2bf(sigmoidf_(v[j]));
            }
          };
          auto xf = [&](float v, int row, int col) -> float { return kind == 1 ? tanhf(v) : (kind == 3 ? sigmoidf_(v) : v); };
          u16* dbase = kind == 0 ? dstp : (LORA + (kind - 1) * 128);
          const int dld = kind == 0 ? 1024 : 384;
          auto dstf = [&](int row) -> u16* { return dbase + (size_t)row * dld; };
          gemm_tile<true, 1>((const u16*)(ws + O_XN), 1024, p.in[13] + mixi * 1024, Bp, 1024, 1024, mt * 256, xf, dstf, (u16*)lds);
        }
      } break;
      case 13: {
        const u16* LORA = (const u16*)(ws + O_LORA);
        u16* G = (u16*)(ws + O_G);
        for (int t = blockIdx.x; t < 136 * 40; t += gridDim.x) {
          int mt = t / 40, nt = t % 40;
          int grp = nt >> 3, n0 = (nt & 7) * 128;
          const u16* Ap; const u16* Bp; int K, ldb;
          if (grp < 2) { Ap = LORA + grp * 64; Bp = (const u16*)(ws + O_W2) + (size_t)grp * 65536 + (size_t)n0 * 64; K = 64; ldb = 64; }
          else if (grp < 4) { Ap = LORA + 128 + (grp - 2) * 64; Bp = (const u16*)(ws + O_A2) + (size_t)(grp - 2) * 65536 + (size_t)n0 * 64; K = 64; ldb = 64; }
          else { Ap = LORA + 256; Bp = (const u16*)(ws + O_G2) + (size_t)n0 * 128; K = 128; ldb = 128; }
          int d = grp & 1;
          u8* WA = (u8*)(ws + (d ? O_WA1 : O_WA0));
          auto epi = [&](int row, int col, float v0, float v1, float v2, float v3) {
            int n = n0 + col;
            float v[4] = {v0, v1, v2, v3};
            if (grp < 2) {
              float w0 = p.in[23][d * 1024 + n];
#pragma unroll
              for (int j = 0; j < 4; ++j) {
                float x = w0 + v[j];
                float dec = __expf(-0.6065306597126334f * sigmoidf_(x));
                float q = rintf((dec - 0.5f) * 510.f);
                q = fminf(fmaxf(q, 0.f), 255.f);
                WA[(size_t)(row + j) * 2048 + (n >> 6) * 128 + (n & 63)] = (u8)q;
              }
            } else if (grp < 4) {
              float a0 = p.in[26][d * 1024 + n];
#pragma unroll
              for (int j = 0; j < 4; ++j) {
                float a = sigmoidf_(a0 + v[j]);
                float q = fminf(fmaxf(rintf(a * 255.f), 0.f), 255.f);
                WA[(size_t)(row + j) * 2048 + (n >> 6) * 128 + 64 + (n & 63)] = (u8)q;
              }
            } else {
#pragma unroll
              for (int j = 0; j < 4; ++j) G[(size_t)(row + j) * 1024 + n] = f2bf(v[j]);
            }
          };
          if (grp < 4) {
            const float* b0p = (grp < 2 ? p.in[23] : p.in[26]) + d * 1024 + n0;
            auto q8 = [&](float v, int row, int col) -> unsigned {
              float x = b0p[col] + v;
              float qv;
              if (grp < 2) { float dec = __expf(-0.6065306597126334f * sigmoidf_(x)); qv = rintf((dec - 0.5f) * 510.f); }
              else { qv = rintf(sigmoidf_(x) * 255.f); }
              return (unsigned)fminf(fmaxf(qv, 0.f), 255.f);
            };
            auto dst8 = [&](int row, int c16) -> u8* {
              int n = n0 + c16 * 16;
              return WA + (size_t)row * 2048 + (n >> 6) * 128 + (grp < 2 ? 0 : 64) + (n & 63);
            };
            gemm_tile<false, 2>(Ap, 384, nullptr, Bp, ldb, K, mt * 256, q8, dst8, (u16*)lds);
          } else {
            auto xf = [&](float v, int row, int col) -> float { return v; };
            auto dstf = [&](int row) -> u16* { return G + (size_t)row * 1024 + n0; };
            gemm_tile<false, 1>(Ap, 384, nullptr, Bp, ldb, K, mt * 256, xf, dstf, (u16*)lds);
          }
        }
      } break;
      case 14: phase_scan(p, lds, dummy); break;
      case 15:
        phase_readout(p);
        convert_tab_fp8(p.in[33] + (size_t)16384 * 1024, p.in[34] + (size_t)16384 * 1024, ws + O_TAB1);
        break;
      case 16: {
        for (int kq = 0, mt = 0, nt = 0; xcd_tile(kq, 128, 8, mt, nt); ++kq) {
          int n0 = nt * 128;
          auto epi = [&](int row, int col, float v0, float v1, float v2, float v3) {
            int n = n0 + col;
            float v[4] = {v0, v1, v2, v3};
#pragma unroll
            for (int j = 0; j < 4; ++j) {
              int rw = row + j;
              float g = mod1[(rw >> 12) * 6144 + 2048 + n];
              p.out[(size_t)rw * DM + n] += g * v[j];
            }
          };
          gemm_tile<false, 0>((const u16*)(ws + O_Z), 1024, nullptr, (const u16*)(ws + O_WO) + (size_t)n0 * 1024, 1024, 1024,
                              mt * 256, epi, 0, (u16*)lds);
        }
      } break;
      case 17: phase_norm(p, p.out, nullptr, p.in[7] + 1024, 1, 3, NLAT, (u16*)(ws + O_XN)); break;
      case 19: phase_peer_topk(p, 1, (const u16*)(ws + O_PQ1), NLAT, (int*)(ws + O_IDX1), (float*)(ws + O_GATE1), lds); break;
      case 20: phase_peer_act(p, (const u16*)(ws + O_XN), ws + O_TAB1, (const int*)(ws + O_IDX1), (const float*)(ws + O_GATE1),
                              (float*)(ws + O_COEF1), NLAT, lds); break;
      case 21: phase_peer_sum(p, 1, ws + O_TAB1, (const int*)(ws + O_IDX1), (const float*)(ws + O_COEF1), NLAT, dummy ? (float*)(ws + O_A5R) : nullptr); break;
      default: break;
    }
    }
  }
}

extern "C" void kernel_launch(void* const* d_in, const int* in_sizes, int n_in, void* d_out, int out_size, void* d_ws,
                              size_t ws_size, hipStream_t stream) {
  static int grid = 0;
  if (grid == 0) {
    if (n_in != 35 || ws_size < WS_END) {
      fprintf(stderr, "kernel_launch: unexpected n_in %d or ws_size %zu (need %zu)\n", n_in, ws_size, (size_t)WS_END);
      grid = -1;
      return;
    }
    int dev = 0, cus = 0, per_cu = 0;
    hipGetDevice(&dev);
    hipDeviceGetAttribute(&cus, hipDeviceAttributeMultiprocessorCount, dev);
    hipFuncSetAttribute((const void*)fwd_kernel, hipFuncAttributeMaxDynamicSharedMemorySize, LDS_BYTES);
    hipOccupancyMaxActiveBlocksPerMultiprocessor(&per_cu, (const void*)fwd_kernel, NT, LDS_BYTES);
    (void)hipGetLastError();
    if (per_cu < 1) per_cu = 1;
    grid = (cus / 8) * 8;
    if (grid > cus * per_cu) grid = cus * per_cu;
  }
  if (grid < 0) return;
  P p{};
  for (int i = 0; i < 35; ++i) p.in[i] = (const float*)d_in[i];
  p.out = (float*)d_out;
  p.ws = (char*)d_ws;
#if N_LAUNCH_MODE == 0
  (void)hipMemsetAsync((char*)d_ws + O_BAR, 0, 16384, stream);
  p.ph_lo = 0; p.ph_hi = NPHASE;
  void* args[] = {&p};
  hipError_t e = hipLaunchCooperativeKernel((const void*)fwd_kernel, dim3(grid), dim3(NT), args, LDS_BYTES, stream);
  if (e != hipSuccess) fprintf(stderr, "cooperative launch failed: %s (grid %d)\n", hipGetErrorString(e), grid);
#else
  for (int ph = 0; ph < NPHASE; ++ph) {
    p.ph_lo = ph; p.ph_hi = ph + 1;
    hipLaunchKernelGGL(fwd_kernel, dim3(grid), dim3(NT), LDS_BYTES, stream, p);
  }
#endif
}
```

```cpp
#include <hip/hip_runtime.h>
#include <hip/hip_cooperative_groups.h>
#include <cstdio>
namespace cg = cooperative_groups;

#ifndef N_LAUNCH_MODE
#define N_LAUNCH_MODE 0
#endif

typedef unsigned short u16;
typedef unsigned char u8;
typedef __attribute__((ext_vector_type(8))) short bf16x8;
typedef __attribute__((ext_vector_type(16))) float f32x16;

#define NT 512
#define TTOK 34816
#define NLAT 32768
#define DM 1024
#define LDSS 72
#define LDS_BYTES 149504
#define NPHASE 22
#ifndef REPEAT_MASK
#define REPEAT_MASK 0
#endif
#ifndef PHASE_MASK
#define PHASE_MASK 0x3FFFFF
#endif

static constexpr size_t MiB = 1048576;
static constexpr size_t O_WIN = 0;
static constexpr size_t O_WOUT = O_WIN + 4718592;
static constexpr size_t O_WR = O_WOUT + 2097152;
static constexpr size_t O_WK = O_WR + 2097152;
static constexpr size_t O_WV = O_WK + 2097152;
static constexpr size_t O_WO = O_WV + 2097152;
static constexpr size_t O_G1 = O_WO + 2097152;
static constexpr size_t O_G2 = O_G1 + 262144;
static constexpr size_t O_W1 = O_G2 + 262144;
static constexpr size_t O_A1 = O_W1 + 262144;
static constexpr size_t O_W2 = O_A1 + 262144;
static constexpr size_t O_A2 = O_W2 + 262144;
static constexpr size_t O_WQ = O_A2 + 262144;
static constexpr size_t O_KEYS = O_WQ + 8388608;
static constexpr size_t O_MOD = O_KEYS + 1048576;
static constexpr size_t O_ROPE = O_MOD + 442368;
static constexpr size_t SZ = 68 * MiB;
static constexpr size_t O_A1R = 26 * MiB;
static constexpr size_t O_A2R = O_A1R + SZ;
static constexpr size_t O_A3R = O_A2R + SZ;
static constexpr size_t O_A4R = O_A3R + SZ;
static constexpr size_t O_A5R = O_A4R + SZ;
static constexpr size_t O_A6R = O_A5R + SZ;
static constexpr size_t O_A7R = O_A6R + SZ;
static constexpr size_t O_LORA = O_A7R;
static constexpr size_t O_BONUS = O_A7R + 26 * MiB;
static constexpr size_t O_BAR = O_BONUS + 4 * MiB;
static constexpr size_t WS_END = O_BAR + 1 * MiB;
static constexpr size_t O_XN = O_A1R;
static constexpr size_t O_HGG = O_A2R;
static constexpr size_t O_Q = O_A2R + 102 * MiB;
static constexpr size_t O_KB = O_A4R;
static constexpr size_t O_VT = O_A4R + 9 * MiB;
static constexpr size_t O_PQ0 = O_A2R;
static constexpr size_t O_TAB0 = O_A5R;
static constexpr size_t O_IDX0 = O_A6R;
static constexpr size_t O_GATE0 = O_A6R + 17 * MiB;
static constexpr size_t O_HC = O_A6R + 34 * MiB;
static constexpr size_t O_COEF0 = O_A6R + 42 * MiB;
static constexpr size_t O_R = O_A2R, O_K = O_A3R, O_V = O_A4R;
static constexpr size_t O_WA0 = O_A5R, O_WA1 = O_A6R;
static constexpr size_t O_G = O_A1R;
static constexpr size_t O_Z = O_A2R;
static constexpr size_t O_TAB1 = O_A3R;
static constexpr size_t O_PQ1 = O_A5R;
static constexpr size_t O_IDX1 = O_A4R;
static constexpr size_t O_GATE1 = O_A4R + 17 * MiB;
static constexpr size_t O_COEF1 = O_A4R + 34 * MiB;

struct P {
  const float* in[35];
  float* out;
  char* ws;
  int ph_lo, ph_hi;
};

typedef __bf16 bf16x2_t __attribute__((ext_vector_type(2)));
typedef float f32x2_t __attribute__((ext_vector_type(2)));
__device__ __forceinline__ u16 f2bf(float f) {
  __bf16 b = (__bf16)f;
  return __builtin_bit_cast(u16, b);
}
__device__ __forceinline__ float bf2f(u16 h) { return __uint_as_float(((unsigned)h) << 16); }
__device__ __forceinline__ float bflo(unsigned w) { return __uint_as_float(w << 16); }
__device__ __forceinline__ float bfhi(unsigned w) { return __uint_as_float(w & 0xFFFF0000u); }
__device__ __forceinline__ unsigned pack2(float a, float b) { f32x2_t v = {a, b}; bf16x2_t r = __builtin_convertvector(v, bf16x2_t); return __builtin_bit_cast(unsigned, r); }

__device__ __forceinline__ int tid_() { int t = __builtin_amdgcn_workitem_id_x(); asm volatile("" : "+v"(t)); return t; }
template <int CTRL>
__device__ __forceinline__ float dppf(float v) {
  return __builtin_bit_cast(float, __builtin_amdgcn_update_dpp(0, __builtin_bit_cast(int, v), CTRL, 0xF, 0xF, true));
}
__device__ __forceinline__ float red8(float v) {
  v += dppf<0xB1>(v); v += dppf<0x4E>(v); v += dppf<0x141>(v); return v;
}
__device__ __forceinline__ float red16(float v) { v = red8(v); v += dppf<0x140>(v); return v; }
__device__ __forceinline__ float swapsum32(float a, float b) {
  auto r = __builtin_amdgcn_permlane32_swap(__float_as_uint(a), __float_as_uint(b), false, false);
  return __uint_as_float(r[0]) + __uint_as_float(r[1]);
}
__device__ __forceinline__ float swapsum16(float a, float b) {
  auto r = __builtin_amdgcn_permlane16_swap(__float_as_uint(a), __float_as_uint(b), false, false);
  return __uint_as_float(r[0]) + __uint_as_float(r[1]);
}
__device__ __forceinline__ float swapmax32(float a) {
  auto r = __builtin_amdgcn_permlane32_swap(__float_as_uint(a), __float_as_uint(a), false, false);
  return fmaxf(__uint_as_float(r[0]), __uint_as_float(r[1]));
}
__device__ __forceinline__ float swapmax16(float a) {
  auto r = __builtin_amdgcn_permlane16_swap(__float_as_uint(a), __float_as_uint(a), false, false);
  return fmaxf(__uint_as_float(r[0]), __uint_as_float(r[1]));
}
__device__ __forceinline__ float wave_sum(float v) {
  v = red16(v);
  v = swapsum16(v, v); v = swapsum32(v, v);
  return v;
}
__device__ __forceinline__ float sigmoidf_(float x) { return 1.f / (1.f + __expf(-x)); }

template <bool MIX, int OM, class Epi, class Dst>
__device__ __forceinline__ void gemm_tile(const u16* __restrict__ A, int lda, const float* __restrict__ mu,
                                          const u16* __restrict__ B, int ldb, int K, int row0, Epi epi, Dst dstf, u16* lds) {
  u16* sA = lds;
  u16* sB = lds + 256 * LDSS;
  const int tid = tid_(), lane = tid & 63, wave = tid >> 6;
  const int wm = wave & 3, wn = wave >> 2;
  const int r = lane & 31, h = lane >> 5;
  const int kc = tid & 7, lr = tid >> 3;
  f32x16 acc[2][2];
#pragma unroll
  for (int i = 0; i < 2; ++i)
#pragma unroll
    for (int j = 0; j < 2; ++j)
#pragma unroll
      for (int g = 0; g < 16; ++g) acc[i][j][g] = 0.f;
  uint4 pa0, pa1, pa2, pa3, ps0, ps1, ps2, ps3, pb0, pb1;
  ps0 = ps1 = ps2 = ps3 = make_uint4(0, 0, 0, 0);
  float4 m0 = make_float4(0, 0, 0, 0), m1 = m0;
  auto nbr = [&](int row, int kg) -> int {
    if (row < NLAT) {
      int t = row & 4095; int gc = t & 63, gr = t >> 6; int qd = kg >> 8;
      if (qd == 0) return gc > 0 ? row - 1 : -1;
      if (qd == 1) return gc < 63 ? row + 1 : -1;
      if (qd == 2) return gr > 0 ? row - 64 : -1;
      return gr < 63 ? row + 64 : -1;
    } else {
      int t = (row - NLAT) & 255;
      if (kg < 512) return t > 0 ? row - 1 : -1;
      return t < 255 ? row + 1 : -1;
    }
  };
  auto ldA = [&](int i, int k0, uint4& a, uint4& sx) {
    int row = row0 + lr + 64 * i;
    a = *(const uint4*)(A + (size_t)row * lda + k0 + kc * 8);
    if (MIX) {
      int nr = nbr(row, k0 + kc * 8);
      if (nr >= 0) sx = *(const uint4*)(A + (size_t)nr * lda + k0 + kc * 8);
      else sx = make_uint4(0, 0, 0, 0);
    }
  };
  auto gload = [&](int k0) {
    ldA(0, k0, pa0, ps0); ldA(1, k0, pa1, ps1); ldA(2, k0, pa2, ps2); ldA(3, k0, pa3, ps3);
    if (MIX) {
      m0 = *(const float4*)(mu + k0 + kc * 8);
      m1 = *(const float4*)(mu + k0 + kc * 8 + 4);
    }
    pb0 = *(const uint4*)(B + (size_t)lr * ldb + k0 + kc * 8);
    pb1 = *(const uint4*)(B + (size_t)(lr + 64) * ldb + k0 + kc * 8);
  };
  auto mixw = [&](unsigned x, unsigned s, float ma, float mb) -> unsigned {
    float x0 = bflo(x), x1 = bfhi(x), s0 = bflo(s), s1 = bfhi(s);
    return pack2(x0 + (s0 - x0) * ma, x1 + (s1 - x1) * mb);
  };
  int bo = 0;
  auto stA = [&](int i, uint4 a, uint4 sx) {
    uint4 v = a;
    if (MIX) {
      v.x = mixw(a.x, sx.x, m0.x, m0.y);
      v.y = mixw(a.y, sx.y, m0.z, m0.w);
      v.z = mixw(a.z, sx.z, m1.x, m1.y);
      v.w = mixw(a.w, sx.w, m1.z, m1.w);
    }
    *(uint4*)(sA + bo + (lr + 64 * i) * LDSS + kc * 8) = v;
  };
  auto lstore = [&]() {
    stA(0, pa0, ps0); stA(1, pa1, ps1); stA(2, pa2, ps2); stA(3, pa3, ps3);
    *(uint4*)(sB + bo + lr * LDSS + kc * 8) = pb0;
    *(uint4*)(sB + bo + (lr + 64) * LDSS + kc * 8) = pb1;
  };
  constexpr int BUFE = (256 + 128) * LDSS;
  gload(0);
  bo = 0; lstore();
  if (64 < K) gload(64);
  __syncthreads();
  for (int k0 = 0; k0 < K; k0 += 64) {
    const int co = ((k0 >> 6) & 1) * BUFE;
    bf16x8 af[2], bfr[2], naf[2], nbf[2];
#pragma unroll
    for (int i = 0; i < 2; ++i) af[i] = *(const bf16x8*)(sA + co + (wm * 64 + i * 32 + r) * LDSS + h * 8);
#pragma unroll
    for (int j = 0; j < 2; ++j) bfr[j] = *(const bf16x8*)(sB + co + (wn * 64 + j * 32 + r) * LDSS + h * 8);
#pragma unroll
    for (int kk = 0; kk < 4; ++kk) {
      if (kk == 2 && k0 + 64 < K) {
        bo = BUFE - co; lstore();
        if (k0 + 128 < K) gload(k0 + 128);
      }
      if (kk < 3) {
#pragma unroll
        for (int i = 0; i < 2; ++i) naf[i] = *(const bf16x8*)(sA + co + (wm * 64 + i * 32 + r) * LDSS + (kk + 1) * 16 + h * 8);
#pragma unroll
        for (int j = 0; j < 2; ++j) nbf[j] = *(const bf16x8*)(sB + co + (wn * 64 + j * 32 + r) * LDSS + (kk + 1) * 16 + h * 8);
      }
#pragma unroll
      for (int i = 0; i < 2; ++i)
#pragma unroll
        for (int j = 0; j < 2; ++j) {
          if (OM == 0) acc[i][j] = __builtin_amdgcn_mfma_f32_32x32x16_bf16(af[i], bfr[j], acc[i][j], 0, 0, 0);
          else acc[i][j] = __builtin_amdgcn_mfma_f32_32x32x16_bf16(bfr[j], af[i], acc[i][j], 0, 0, 0);
        }
      if (kk < 3) {
#pragma unroll
        for (int i = 0; i < 2; ++i) af[i] = naf[i];
#pragma unroll
        for (int j = 0; j < 2; ++j) bfr[j] = nbf[j];
      }
    }
    __syncthreads();
  }
  if constexpr (OM == 0) {
#pragma unroll
    for (int i = 0; i < 2; ++i)
#pragma unroll
      for (int j = 0; j < 2; ++j)
#pragma unroll
        for (int g4 = 0; g4 < 4; ++g4) {
          int row = row0 + wm * 64 + i * 32 + 8 * g4 + 4 * h;
          int col = wn * 64 + j * 32 + r;
          epi(row, col, acc[i][j][g4 * 4 + 0], acc[i][j][g4 * 4 + 1], acc[i][j][g4 * 4 + 2], acc[i][j][g4 * 4 + 3]);
        }
  } else if constexpr (OM == 1) {
    u16* st = lds;
#pragma unroll
    for (int i = 0; i < 2; ++i)
#pragma unroll
      for (int j = 0; j < 2; ++j)
#pragma unroll
        for (int g4 = 0; g4 < 4; ++g4) {
          const int rl = wm * 64 + i * 32 + r, c0 = wn * 64 + j * 32 + 8 * g4 + 4 * h;
          uint2 o;
          o.x = pack2(epi(acc[i][j][g4 * 4 + 0], row0 + rl, c0 + 0), epi(acc[i][j][g4 * 4 + 1], row0 + rl, c0 + 1));
          o.y = pack2(epi(acc[i][j][g4 * 4 + 2], row0 + rl, c0 + 2), epi(acc[i][j][g4 * 4 + 3], row0 + rl, c0 + 3));
          *(uint2*)(st + rl * 136 + c0) = o;
        }
    __syncthreads();
#pragma unroll
    for (int q = 0; q < 8; ++q) {
      const int id = tid + NT * q, rl = id >> 4, c8 = id & 15;
      const uint4 v = *(const uint4*)(st + rl * 136 + c8 * 8);
      *(uint4*)(dstf(row0 + rl) + c8 * 8) = v;
    }
    __syncthreads();
  } else {
    u8* st = (u8*)lds;
#pragma unroll
    for (int i = 0; i < 2; ++i)
#pragma unroll
      for (int j = 0; j < 2; ++j)
#pragma unroll
        for (int g4 = 0; g4 < 4; ++g4) {
          const int rl = wm * 64 + i * 32 + r, c0 = wn * 64 + j * 32 + 8 * g4 + 4 * h;
          unsigned o = epi(acc[i][j][g4 * 4 + 0], row0 + rl, c0 + 0) | (epi(acc[i][j][g4 * 4 + 1], row0 + rl, c0 + 1) << 8) |
                       (epi(acc[i][j][g4 * 4 + 2], row0 + rl, c0 + 2) << 16) | (epi(acc[i][j][g4 * 4 + 3], row0 + rl, c0 + 3) << 24);
          *(unsigned*)(st + rl * 144 + c0) = o;
        }
    __syncthreads();
#pragma unroll
    for (int q = 0; q < 4; ++q) {
      const int id = tid + NT * q, rl = id >> 3, c16 = id & 7;
      const uint4 v = *(const uint4*)(st + rl * 144 + c16 * 16);
      *(uint4*)(dstf(row0 + rl, c16)) = v;
    }
    __syncthreads();
  }
}

template <bool MIX, class Epi, class Dst>
__device__ __forceinline__ void gemm_tile256(const u16* __restrict__ A, int lda, const float* __restrict__ mu,
                                             const u16* __restrict__ B, int ldb, int K, int row0, Epi epi, Dst dstf, u16* lds) {
  u16* sA = lds;
  u16* sB = lds + 256 * LDSS;
  const int tid = tid_(), lane = tid & 63, wave = tid >> 6;
  const int wm = wave & 1, wn = wave >> 1;
  const int r = lane & 31, h = lane >> 5;
  const int kc = tid & 7, lr = tid >> 3;
  f32x16 acc[4][2];
#pragma unroll
  for (int i = 0; i < 4; ++i)
#pragma unroll
    for (int j = 0; j < 2; ++j)
#pragma unroll
      for (int g = 0; g < 16; ++g) acc[i][j][g] = 0.f;
  uint4 pa0, pa1, pa2, pa3, ps0, ps1, ps2, ps3, pb0, pb1, pb2, pb3;
  ps0 = ps1 = ps2 = ps3 = make_uint4(0, 0, 0, 0);
  float4 m0 = make_float4(0, 0, 0, 0), m1 = m0;
  auto nbr = [&](int row, int kg) -> int {
    if (row < NLAT) {
      int t = row & 4095; int gc = t & 63, gr = t >> 6; int qd = kg >> 8;
      if (qd == 0) return gc > 0 ? row - 1 : -1;
      if (qd == 1) return gc < 63 ? row + 1 : -1;
      if (qd == 2) return gr > 0 ? row - 64 : -1;
      return gr < 63 ? row + 64 : -1;
    } else {
      int t = (row - NLAT) & 255;
      if (kg < 512) return t > 0 ? row - 1 : -1;
      return t < 255 ? row + 1 : -1;
    }
  };
  auto ldA = [&](int i, int k0, uint4& a, uint4& sx) {
    int row = row0 + lr + 64 * i;
    a = *(const uint4*)(A + (size_t)row * lda + k0 + kc * 8);
    if (MIX) {
      int nr = nbr(row, k0 + kc * 8);
      if (nr >= 0) sx = *(const uint4*)(A + (size_t)nr * lda + k0 + kc * 8);
      else sx = make_uint4(0, 0, 0, 0);
    }
  };
  auto gload = [&](int k0) {
    ldA(0, k0, pa0, ps0); ldA(1, k0, pa1, ps1); ldA(2, k0, pa2, ps2); ldA(3, k0, pa3, ps3);
    if (MIX) {
      m0 = *(const float4*)(mu + k0 + kc * 8);
      m1 = *(const float4*)(mu + k0 + kc * 8 + 4);
    }
    pb0 = *(const uint4*)(B + (size_t)lr * ldb + k0 + kc * 8);
    pb1 = *(const uint4*)(B + (size_t)(lr + 64) * ldb + k0 + kc * 8);
    pb2 = *(const uint4*)(B + (size_t)(lr + 128) * ldb + k0 + kc * 8);
    pb3 = *(const uint4*)(B + (size_t)(lr + 192) * ldb + k0 + kc * 8);
  };
  auto mixw = [&](unsigned x, unsigned s_, float ma, float mb) -> unsigned {
    float x0 = bflo(x), x1 = bfhi(x), s0 = bflo(s_), s1 = bfhi(s_);
    return pack2(x0 + (s0 - x0) * ma, x1 + (s1 - x1) * mb);
  };
  int bo = 0;
  auto stA = [&](int i, uint4 a, uint4 sx) {
    uint4 v = a;
    if (MIX) {
      v.x = mixw(a.x, sx.x, m0.x, m0.y);
      v.y = mixw(a.y, sx.y, m0.z, m0.w);
      v.z = mixw(a.z, sx.z, m1.x, m1.y);
      v.w = mixw(a.w, sx.w, m1.z, m1.w);
    }
    *(uint4*)(sA + bo + (lr + 64 * i) * LDSS + kc * 8) = v;
  };
  auto lstore = [&]() {
    stA(0, pa0, ps0); stA(1, pa1, ps1); stA(2, pa2, ps2); stA(3, pa3, ps3);
    *(uint4*)(sB + bo + lr * LDSS + kc * 8) = pb0;
    *(uint4*)(sB + bo + (lr + 64) * LDSS + kc * 8) = pb1;
    *(uint4*)(sB + bo + (lr + 128) * LDSS + kc * 8) = pb2;
    *(uint4*)(sB + bo + (lr + 192) * LDSS + kc * 8) = pb3;
  };
  constexpr int BUFE = 2 * 256 * LDSS;
  gload(0);
  bo = 0; lstore();
  if (64 < K) gload(64);
  __syncthreads();
  for (int k0 = 0; k0 < K; k0 += 64) {
    const int co = ((k0 >> 6) & 1) * BUFE;
    bf16x8 af[4], bfr[2], naf[4], nbf[2];
#pragma unroll
    for (int i = 0; i < 4; ++i) af[i] = *(const bf16x8*)(sA + co + (wm * 128 + i * 32 + r) * LDSS + h * 8);
#pragma unroll
    for (int j = 0; j < 2; ++j) bfr[j] = *(const bf16x8*)(sB + co + (wn * 64 + j * 32 + r) * LDSS + h * 8);
#pragma unroll
    for (int kk = 0; kk < 4; ++kk) {
      if (kk == 2 && k0 + 64 < K) {
        bo = BUFE - co; lstore();
        if (k0 + 128 < K) gload(k0 + 128);
      }
      if (kk < 3) {
#pragma unroll
        for (int i = 0; i < 4; ++i) naf[i] = *(const bf16x8*)(sA + co + (wm * 128 + i * 32 + r) * LDSS + (kk + 1) * 16 + h * 8);
#pragma unroll
        for (int j = 0; j < 2; ++j) nbf[j] = *(const bf16x8*)(sB + co + (wn * 64 + j * 32 + r) * LDSS + (kk + 1) * 16 + h * 8);
      }
#pragma unroll
      for (int i = 0; i < 4; ++i)
#pragma unroll
        for (int j = 0; j < 2; ++j) acc[i][j] = __builtin_amdgcn_mfma_f32_32x32x16_bf16(bfr[j], af[i], acc[i][j], 0, 0, 0);
      if (kk < 3) {
#pragma unroll
        for (int i = 0; i < 4; ++i) af[i] = naf[i];
#pragma unroll
        for (int j = 0; j < 2; ++j) bfr[j] = nbf[j];
      }
    }
    __syncthreads();
  }
  u16* st = lds;
#pragma unroll
  for (int half = 0; half < 2; ++half) {
    if ((wn >> 1) == half) {
#pragma unroll
      for (int i = 0; i < 4; ++i)
#pragma unroll
        for (int j = 0; j < 2; ++j)
#pragma unroll
          for (int g4 = 0; g4 < 4; ++g4) {
            const int rl = wm * 128 + i * 32 + r, cl = (wn & 1) * 64 + j * 32 + 8 * g4 + 4 * h, c0 = half * 128 + cl;
            uint2 o;
            o.x = pack2(epi(acc[i][j][g4 * 4 + 0], row0 + rl, c0 + 0), epi(acc[i][j][g4 * 4 + 1], row0 + rl, c0 + 1));
            o.y = pack2(epi(acc[i][j][g4 * 4 + 2], row0 + rl, c0 + 2), epi(acc[i][j][g4 * 4 + 3], row0 + rl, c0 + 3));
            *(uint2*)(st + rl * 136 + cl) = o;
          }
    }
    __syncthreads();
#pragma unroll
    for (int q = 0; q < 8; ++q) {
      const int id = tid + NT * q, rl = id >> 4, c8 = id & 15;
      const uint4 v = *(const uint4*)(st + rl * 136 + c8 * 8);
      *(uint4*)(dstf(row0 + rl) + half * 128 + c8 * 8) = v;
    }
    __syncthreads();
  }
}

__constant__ int TJOBS[18][5] = {
    {8, 0, 1024, 2304, (int)O_WIN},
    {12, 0, 1024, 1024, (int)O_WOUT},
    {14, 0, 1024, 1024, (int)O_WR},
    {15, 0, 1024, 1024, (int)O_WK},
    {16, 0, 1024, 1024, (int)O_WV},
    {17, 0, 1024, 1024, (int)O_WO},
    {18, 0, 1024, 128, (int)O_G1},
    {19, 0, 128, 1024, (int)O_G2},
    {24, 0, 1024, 64, (int)O_W1},
    {24, 65536, 1024, 64, (int)(O_W1 + 131072)},
    {27, 0, 1024, 64, (int)O_A1},
    {27, 65536, 1024, 64, (int)(O_A1 + 131072)},
    {25, 0, 64, 1024, (int)O_W2},
    {25, 65536, 64, 1024, (int)(O_W2 + 131072)},
    {28, 0, 64, 1024, (int)O_A2},
    {28, 65536, 64, 1024, (int)(O_A2 + 131072)},
    {31, 0, 1024, 2048, (int)O_WQ},
    {31, 2097152, 1024, 2048, (int)(O_WQ + 4194304)},
};

__device__ __forceinline__ void convert_bf16(const float* __restrict__ src, u16* __restrict__ dst, size_t n) {
  size_t n4 = n >> 2;
  for (size_t i = (size_t)blockIdx.x * NT + tid_(); i < n4; i += (size_t)gridDim.x * NT) {
    float4 v = ((const float4*)src)[i];
    uint2 o; o.x = pack2(v.x, v.y); o.y = pack2(v.z, v.w);
    ((uint2*)dst)[i] = o;
  }
}

__device__ __forceinline__ void convert_tab_fp8(const float* __restrict__ U, const float* __restrict__ V, char* tab);
__device__ __forceinline__ void phase_prep(const P& p, char* lds) {
  const int tid = tid_();
  float* fl = (float*)lds;
  for (int task = blockIdx.x; task < 192; task += gridDim.x) {
    int l = task / 96, cg_ = task % 96;
    float* sv = fl;
    float* red = fl + 9216;
    for (int i = tid; i < 9216; i += NT) {
      int v = i >> 10, k = i & 1023;
      float x = v < 8 ? p.in[1][v * 1024 + k] : p.in[3][k];
      sv[i] = x / (1.f + __expf(-x));
    }
    __syncthreads();
    int col = cg_ * 64 + (tid & 63), kg = tid >> 6;
    float acc[9];
#pragma unroll
    for (int v = 0; v < 9; ++v) acc[v] = 0.f;
    const float* W = p.in[4] + (size_t)l * 1024 * 6144 + col;
    for (int k = kg * 128; k < kg * 128 + 128; ++k) {
      float w = W[(size_t)k * 6144];
#pragma unroll
      for (int v = 0; v < 9; ++v) acc[v] += sv[v * 1024 + k] * w;
    }
#pragma unroll
    for (int v = 0; v < 9; ++v) red[(kg * 9 + v) * 64 + (tid & 63)] = acc[v];
    __syncthreads();
    if (tid < 576) {
      int v = tid >> 6, c = tid & 63;
      float s = p.in[5][l * 6144 + cg_ * 64 + c];
#pragma unroll
      for (int g = 0; g < 8; ++g) s += red[(g * 9 + v) * 64 + c];
      ((float*)(p.ws + O_MOD))[(l * 9 + v) * 6144 + cg_ * 64 + c] = s;
    }
    __syncthreads();
  }
  {
    int base = 0;
    for (int j = 0; j < 18; ++j) {
      int K = TJOBS[j][2], N = TJOBS[j][3];
      int tk = K >> 6, tn = N >> 6, nt = tk * tn;
      const float* src = p.in[TJOBS[j][0]] + TJOBS[j][1];
      u16* dst = (u16*)(p.ws + (size_t)(unsigned)TJOBS[j][4]);
      int first = (blockIdx.x + gridDim.x - (base % gridDim.x)) % gridDim.x;
      for (int t = first; t < nt; t += gridDim.x) {
        int k0 = (t / tn) * 64, n0 = (t % tn) * 64;
#pragma unroll
        for (int rep = 0; rep < 8; ++rep) {
          int idx = tid + NT * rep; int i = idx >> 6, jj = idx & 63;
          fl[i * 65 + jj] = src[(size_t)(k0 + i) * N + n0 + jj];
        }
        __syncthreads();
        int n = tid >> 3, c8 = tid & 7;
        uint4 o;
        o.x = pack2(fl[(c8 * 8 + 0) * 65 + n], fl[(c8 * 8 + 1) * 65 + n]);
        o.y = pack2(fl[(c8 * 8 + 2) * 65 + n], fl[(c8 * 8 + 3) * 65 + n]);
        o.z = pack2(fl[(c8 * 8 + 4) * 65 + n], fl[(c8 * 8 + 5) * 65 + n]);
        o.w = pack2(fl[(c8 * 8 + 6) * 65 + n], fl[(c8 * 8 + 7) * 65 + n]);
        *(uint4*)(dst + (size_t)(n0 + n) * K + k0 + c8 * 8) = o;
        __syncthreads();
      }
      base += nt;
    }
  }
  convert_bf16(p.in[32], (u16*)(p.ws + O_KEYS), (size_t)2 * 8 * 2 * 128 * 128);
  convert_tab_fp8(p.in[33], p.in[34], p.ws + O_TAB0);
  if (blockIdx.x == 0) {
    float* rope = (float*)(p.ws + O_ROPE);
    for (int i = tid; i < 1024; i += NT) {
      int pos = i >> 4, f = i & 15;
      float inv = exp2f(-(float)f * (13.287712379549449f / 16.f));
      float ang = (float)pos * inv;
      rope[i * 2] = cosf(ang);
      rope[i * 2 + 1] = sinf(ang);
    }
  }
}

__device__ __forceinline__ void phase_norm(const P& p, const float* srcL, const float* srcC, const float* gain, int layer, int shift_idx,
                           int nrows, u16* dst) {
  const int lane = tid_() & 63;
  const int gw = blockIdx.x * 8 + (tid_() >> 6), nw = gridDim.x * 8;
  const float* mod = (const float*)(p.ws + O_MOD) + (size_t)layer * 9 * 6144;
  for (int row = gw; row < nrows; row += nw) {
    const float* src = row < NLAT ? srcL + (size_t)row * DM : srcC + (size_t)(row - NLAT) * DM;
    int mi = row < NLAT ? (row >> 12) : 8;
    const float* sh = mod + mi * 6144 + shift_idx * 1024;
    const float* sc = sh + 1024;
    float4 v[4], gq[4], s1q[4], s0q[4];
    float ss = 0.f;
#pragma unroll
    for (int i = 0; i < 4; ++i) {
      v[i] = *(const float4*)(src + i * 256 + lane * 4);
      gq[i] = *(const float4*)(gain + i * 256 + lane * 4);
      s1q[i] = *(const float4*)(sc + i * 256 + lane * 4);
      s0q[i] = *(const float4*)(sh + i * 256 + lane * 4);
    }
#pragma unroll
    for (int i = 0; i < 4; ++i) ss += v[i].x * v[i].x + v[i].y * v[i].y + v[i].z * v[i].z + v[i].w * v[i].w;
    ss = wave_sum(ss);
    float rs = rsqrtf(ss * (1.f / 1024.f) + 1e-6f);
#pragma unroll
    for (int i = 0; i < 4; ++i) {
      int c = i * 256 + lane * 4;
      const float4 g = gq[i], s1 = s1q[i], s0 = s0q[i];
      float a = v[i].x * rs * g.x * (1.f + s1.x) + s0.x;
      float b = v[i].y * rs * g.y * (1.f + s1.y) + s0.y;
      float cc = v[i].z * rs * g.z * (1.f + s1.z) + s0.z;
      float d = v[i].w * rs * g.w * (1.f + s1.w) + s0.w;
      uint2 o; o.x = pack2(a, b); o.y = pack2(cc, d);
      *(uint2*)(dst + (size_t)row * DM + c) = o;
    }
  }
}

__device__ __forceinline__ void phase_conv_qk(const P& p) {
  const u16* hgg = (const u16*)(p.ws + O_HGG);
  u16* mix = (u16*)(p.ws + O_XN);
  const float* cw = p.in[9];
  const size_t gt = (size_t)blockIdx.x * NT + tid_(), gn = (size_t)gridDim.x * NT;
  for (size_t it = gt; it < (size_t)TTOK * 64; it += gn) {
    int row = (int)(it >> 6), c0 = (int)(it & 63) * 8;
    int t, len;
    if (row < NLAT) { t = row & 4095; len = 4096; } else { t = (row - NLAT) & 255; len = 256; }
    float pm[8], pc[8], pp[8];
    {
      const u16* b = hgg + (size_t)row * 1536;
      uint4 hh = *(const uint4*)(b + c0), gc = *(const uint4*)(b + 1024 + c0);
      pc[0] = bflo(hh.x) * bflo(gc.x); pc[1] = bfhi(hh.x) * bfhi(gc.x);
      pc[2] = bflo(hh.y) * bflo(gc.y); pc[3] = bfhi(hh.y) * bfhi(gc.y);
      pc[4] = bflo(hh.z) * bflo(gc.z); pc[5] = bfhi(hh.z) * bfhi(gc.z);
      pc[6] = bflo(hh.w) * bflo(gc.w); pc[7] = bfhi(hh.w) * bfhi(gc.w);
    }
    if (t > 0) {
      const u16* b = hgg + (size_t)(row - 1) * 1536;
      uint4 hh = *(const uint4*)(b + c0), gc = *(const uint4*)(b + 1024 + c0);
      pm[0] = bflo(hh.x) * bflo(gc.x); pm[1] = bfhi(hh.x) * bfhi(gc.x);
      pm[2] = bflo(hh.y) * bflo(gc.y); pm[3] = bfhi(hh.y) * bfhi(gc.y);
      pm[4] = bflo(hh.z) * bflo(gc.z); pm[5] = bfhi(hh.z) * bfhi(gc.z);
      pm[6] = bflo(hh.w) * bflo(gc.w); pm[7] = bfhi(hh.w) * bfhi(gc.w);
    } else {
#pragma unroll
      for (int e = 0; e < 8; ++e) pm[e] = 0.f;
    }
    if (t < len - 1) {
      const u16* b = hgg + (size_t)(row + 1) * 1536;
      uint4 hh = *(const uint4*)(b + c0), gc = *(const uint4*)(b + 1024 + c0);
      pp[0] = bflo(hh.x) * bflo(gc.x); pp[1] = bfhi(hh.x) * bfhi(gc.x);
      pp[2] = bflo(hh.y) * bflo(gc.y); pp[3] = bfhi(hh.y) * bfhi(gc.y);
      pp[4] = bflo(hh.z) * bflo(gc.z); pp[5] = bfhi(hh.z) * bfhi(gc.z);
      pp[6] = bflo(hh.w) * bflo(gc.w); pp[7] = bfhi(hh.w) * bfhi(gc.w);
    } else {
#pragma unroll
      for (int e = 0; e < 8; ++e) pp[e] = 0.f;
    }
    uint4 gbv = *(const uint4*)(hgg + (size_t)row * 1536 + 512 + c0);
    float gb[8] = {bflo(gbv.x), bfhi(gbv.x), bflo(gbv.y), bfhi(gbv.y), bflo(gbv.z), bfhi(gbv.z), bflo(gbv.w), bfhi(gbv.w)};
    float o[8];
#pragma unroll
    for (int e = 0; e < 8; ++e)
      o[e] = gb[e] * (cw[c0 + e] * pm[e] + cw[512 + c0 + e] * pc[e] + cw[1024 + c0 + e] * pp[e]);
    uint4 ov; ov.x = pack2(o[0], o[1]); ov.y = pack2(o[2], o[3]); ov.z = pack2(o[4], o[5]); ov.w = pack2(o[6], o[7]);
    *(uint4*)(mix + (size_t)row * DM + c0) = ov;
  }
  u16* Q = (u16*)(p.ws + O_Q);
  u16* KBp = (u16*)(p.ws + O_KB);
  const float* rope = (const float*)(p.ws + O_ROPE);
  const size_t ngroups = (size_t)TTOK * 10;
  for (size_t it = gt; it < ngroups * 8; it += gn) {
    size_t grp = it >> 3; int sub = (int)(it & 7);
    int row = (int)(grp / 10), hd = (int)(grp % 10);
    u16* ptr; const float* gain;
    if (hd < 8) { ptr = Q + (size_t)row * 512 + hd * 64 + sub * 8; gain = p.in[10]; }
    else { ptr = KBp + (size_t)row * 128 + (hd - 8) * 64 + sub * 8; gain = p.in[11]; }
    uint4 v = *(const uint4*)ptr;
    float x[8] = {bflo(v.x), bfhi(v.x), bflo(v.y), bfhi(v.y), bflo(v.z), bfhi(v.z), bflo(v.w), bfhi(v.w)};
    float ss = 0.f;
#pragma unroll
    for (int e = 0; e < 8; ++e) ss += x[e] * x[e];
    ss = red8(ss);
    float rs = rsqrtf(ss * (1.f / 64.f) + 1e-6f);
#pragma unroll
    for (int e = 0; e < 8; ++e) x[e] = x[e] * rs * gain[sub * 8 + e];
    if (row < NLAT) {
      int t = row & 4095; int gr = t >> 6, gc = t & 63;
#pragma unroll
      for (int e = 0; e < 4; ++e) {
        int pi = sub * 4 + e;
        int pos = pi < 16 ? gr : gc; int f = pi & 15;
        float c = rope[(pos * 16 + f) * 2], s = rope[(pos * 16 + f) * 2 + 1];
        float a = x[2 * e], b = x[2 * e + 1];
        x[2 * e] = a * c - b * s;
        x[2 * e + 1] = a * s + b * c;
      }
    }
    uint4 ov; ov.x = pack2(x[0], x[1]); ov.y = pack2(x[2], x[3]); ov.z = pack2(x[4], x[5]); ov.w = pack2(x[6], x[7]);
    *(uint4*)ptr = ov;
  }
}

__device__ __forceinline__ void phase_attn(const P& p, char* lds) {
  u16* sK = (u16*)lds;
  u16* sV = sK + 64 * LDSS;
  const u16* Q = (const u16*)(p.ws + O_Q);
  const u16* KBp = (const u16*)(p.ws + O_KB);
  const u16* VT = (const u16*)(p.ws + O_VT);
  u16* mix = (u16*)(p.ws + O_XN);
  const int tid = tid_(), lane = tid & 63, wave = tid >> 6;
  const int r = lane & 31, h = lane >> 5;
  const float cs = 0.125f * 1.4426950408889634f;
  for (int item = blockIdx.x; item < 1088; item += gridDim.x) {
    int b, qh, qrow0, nkt;
    if (item < 1024) { b = item >> 7; qh = (item >> 4) & 7; qrow0 = b * 4096 + (item & 15) * 256; nkt = 68; }
    else { int i2 = item - 1024; b = i2 >> 3; qh = i2 & 7; qrow0 = NLAT + b * 256; nkt = 4; }
    const int kvh = qh >> 2;
    const int qrow = qrow0 + wave * 32 + r;
    bf16x8 qf[4];
#pragma unroll
    for (int kk = 0; kk < 4; ++kk) qf[kk] = *(const bf16x8*)(Q + (size_t)qrow * 512 + qh * 64 + kk * 16 + h * 8);
    f32x16 o[2];
#pragma unroll
    for (int g = 0; g < 16; ++g) { o[0][g] = 0.f; o[1][g] = 0.f; }
    float m = -INFINITY, l = 0.f;
    const int lkey = tid >> 3, lch = tid & 7;
    uint4 ka, va;
    auto gl = [&](int kt) {
      int pos = kt * 64 + lkey;
      int krow = pos < 256 ? NLAT + b * 256 + pos : b * 4096 + pos - 256;
      ka = *(const uint4*)(KBp + (size_t)krow * 128 + kvh * 64 + lch * 8);
      va = *(const uint4*)(VT + ((size_t)((b * 2 + kvh) * 64 + lkey)) * 4352 + kt * 64 + lch * 8);
    };
    gl(0);
    for (int kt = 0; kt < nkt; ++kt) {
      *(uint4*)(sK + lkey * LDSS + lch * 8) = ka;
      *(uint4*)(sV + lkey * LDSS + lch * 8) = va;
      __syncthreads();
      if (kt + 1 < nkt) gl(kt + 1);
      f32x16 s[2];
#pragma unroll
      for (int g = 0; g < 16; ++g) { s[0][g] = 0.f; s[1][g] = 0.f; }
#pragma unroll
      for (int kb = 0; kb < 2; ++kb)
#pragma unroll
        for (int kk = 0; kk < 4; ++kk) {
          bf16x8 a = *(const bf16x8*)(sK + (kb * 32 + r) * LDSS + kk * 16 + h * 8);
          s[kb] = __builtin_amdgcn_mfma_f32_32x32x16_bf16(a, qf[kk], s[kb], 0, 0, 0);
        }
      float mx = s[0][0];
#pragma unroll
      for (int g = 0; g < 16; ++g) { mx = fmaxf(mx, s[0][g]); mx = fmaxf(mx, s[1][g]); }
      mx = swapmax32(mx);
      float mn = fmaxf(m, mx);
      float alpha = __builtin_amdgcn_exp2f((m - mn) * cs);
      m = mn;
      float mc = mn * cs, ps = 0.f;
#pragma unroll
      for (int kb = 0; kb < 2; ++kb)
#pragma unroll
        for (int g = 0; g < 16; ++g) { float e = __builtin_amdgcn_exp2f(s[kb][g] * cs - mc); s[kb][g] = e; ps += e; }
      l = l * alpha + ps;
#pragma unroll
      for (int g = 0; g < 16; ++g) { o[0][g] *= alpha; o[1][g] *= alpha; }
      bf16x8 pb[2][2];
#pragma unroll
      for (int kb = 0; kb < 2; ++kb)
#pragma unroll
        for (int c = 0; c < 2; ++c) {
          uint4 pk;
          pk.x = pack2(s[kb][8 * c + 0], s[kb][8 * c + 1]); pk.y = pack2(s[kb][8 * c + 2], s[kb][8 * c + 3]);
          pk.z = pack2(s[kb][8 * c + 4], s[kb][8 * c + 5]); pk.w = pack2(s[kb][8 * c + 6], s[kb][8 * c + 7]);
          pb[kb][c] = __builtin_bit_cast(bf16x8, pk);
        }
#pragma unroll
      for (int db = 0; db < 2; ++db)
#pragma unroll
        for (int kb = 0; kb < 2; ++kb)
#pragma unroll
          for (int c = 0; c < 2; ++c) {
            const u16* vp = sV + (db * 32 + r) * LDSS + kb * 32 + 16 * c + 4 * h;
            uint2 lo = *(const uint2*)vp, hi = *(const uint2*)(vp + 8);
            uint4 av = make_uint4(lo.x, lo.y, hi.x, hi.y);
            o[db] = __builtin_amdgcn_mfma_f32_32x32x16_bf16(__builtin_bit_cast(bf16x8, av), pb[kb][c], o[db], 0, 0, 0);
          }
      __syncthreads();
    }
    l = swapsum32(l, l);
    float inv = 1.f / l;
#pragma unroll
    for (int db = 0; db < 2; ++db)
#pragma unroll
      for (int g4 = 0; g4 < 4; ++g4) {
        int d = db * 32 + 8 * g4 + 4 * h;
        uint2 ov;
        ov.x = pack2(o[db][g4 * 4 + 0] * inv, o[db][g4 * 4 + 1] * inv);
        ov.y = pack2(o[db][g4 * 4 + 2] * inv, o[db][g4 * 4 + 3] * inv);
        *(uint2*)(mix + (size_t)qrow * DM + 512 + qh * 64 + d) = ov;
      }
  }
}

__device__ __forceinline__ int fkey(float f) { int b = __float_as_int(f); return b ^ ((b >> 31) & 0x7FFFFFFF); }
__device__ __forceinline__ float keyf(int k) { return __int_as_float(k ^ ((k >> 31) & 0x7FFFFFFF)); }

#define CE_DESC(a, b) { int hi__ = max(a, b); int lo__ = min(a, b); a = hi__; b = lo__; }
#define BITONIC_SORT16(r)                                                          \
  _Pragma("unroll") for (int k_ = 2; k_ <= 16; k_ <<= 1)                           \
    _Pragma("unroll") for (int j_ = k_ >> 1; j_ > 0; j_ >>= 1)                     \
      _Pragma("unroll") for (int i_ = 0; i_ < 16; ++i_) {                          \
        const int l_ = i_ ^ j_;                                                    \
        if (l_ > i_) { if ((i_ & k_) == 0) CE_DESC(r[i_], r[l_]) else CE_DESC(r[l_], r[i_]) } \
      }
#define BITONIC_MERGE16(r)                                                         \
  _Pragma("unroll") for (int j_ = 8; j_ > 0; j_ >>= 1)                             \
    _Pragma("unroll") for (int i_ = 0; i_ < 16; ++i_) {                            \
      const int l_ = i_ ^ j_;                                                      \
      if (l_ > i_) CE_DESC(r[i_], r[l_])                                           \
    }
#define XLANE_MERGE16(r, CTRL)                                                     \
  {                                                                                \
    int o_[16];                                                                    \
    _Pragma("unroll") for (int i_ = 0; i_ < 16; ++i_) o_[i_] = __builtin_amdgcn_update_dpp(0, r[15 - i_], CTRL, 0xF, 0xF, true); \
    _Pragma("unroll") for (int i_ = 0; i_ < 16; ++i_) r[i_] = max(r[i_], o_[i_]);  \
    BITONIC_MERGE16(r)                                                             \
  }
#define SCS 132
__device__ __forceinline__ void phase_peer_topk(const P& p, int layer, const u16* PQ, int ntok, int* IDX, float* GATE, char* lds) {
  float* sc = (float*)lds;
  int* lists = (int*)(lds + 2 * 64 * SCS * 4);
  u16* sq = (u16*)(lds + 2 * 64 * SCS * 4 + 8192);
  const int tid = tid_(), lane = tid & 63, wave = tid >> 6;
  const int r = lane & 31, h = lane >> 5;
  const u16* keys = (const u16*)(p.ws + O_KEYS) + (size_t)layer * 8 * 2 * 128 * 128;
  const int ntile = (ntok >> 6) * 8;
  for (int tile = blockIdx.x; tile < ntile; tile += gridDim.x) {
    int hd = tile & 7, row0 = (tile >> 3) * 64;
    {
#pragma unroll
      for (int q = 0; q < 4; ++q) {
        const int id = tid + NT * q, rw = id >> 5, c = id & 31;
        const uint4 v = *(const uint4*)(PQ + (size_t)(row0 + rw) * 2048 + hd * 256 + c * 8);
        *(uint4*)(sq + ((c >> 4) * 64 + rw) * 136 + (c & 15) * 8) = v;
      }
    }
    __syncthreads();
    {
      int pp = wave >> 2, kb = wave & 3;
      f32x16 acc[2];
#pragma unroll
      for (int g = 0; g < 16; ++g) { acc[0][g] = 0.f; acc[1][g] = 0.f; }
      const u16* kp = keys + ((size_t)(hd * 2 + pp) * 128 + kb * 32 + r) * 128 + h * 8;
      const u16* qp = sq + (pp * 64 + r) * 136 + h * 8;
#pragma unroll
      for (int kk = 0; kk < 8; ++kk) {
        bf16x8 bfr = *(const bf16x8*)(kp + kk * 16);
        bf16x8 a0 = *(const bf16x8*)(qp + kk * 16);
        bf16x8 a1 = *(const bf16x8*)(qp + 32 * 136 + kk * 16);
        acc[0] = __builtin_amdgcn_mfma_f32_32x32x16_bf16(a0, bfr, acc[0], 0, 0, 0);
        acc[1] = __builtin_amdgcn_mfma_f32_32x32x16_bf16(a1, bfr, acc[1], 0, 0, 0);
      }
#pragma unroll
      for (int mb = 0; mb < 2; ++mb)
#pragma unroll
        for (int g = 0; g < 16; ++g) {
          int tok = mb * 32 + (g & 3) + 8 * (g >> 2) + 4 * h;
          sc[(pp * 64 + tok) * SCS + kb * 32 + r] = acc[mb][g];
        }
    }
    __syncthreads();
    {
      const int row = tid >> 2, qd = tid & 3;
      const float* rowp = sc + row * SCS + qd;
      int A[16], B[16];
#pragma unroll
      for (int m = 0; m < 16; ++m) {
        A[m] = (fkey(rowp[4 * m]) & ~0x7F) | (127 - (4 * m + qd));
        B[m] = (fkey(rowp[64 + 4 * m]) & ~0x7F) | (127 - (64 + 4 * m + qd));
      }
      BITONIC_SORT16(A)
      BITONIC_SORT16(B)
#pragma unroll
      for (int i = 0; i < 16; ++i) A[i] = max(A[i], B[15 - i]);
      BITONIC_MERGE16(A)
      XLANE_MERGE16(A, 0xB1)
      XLANE_MERGE16(A, 0x4E)
      if (qd == 0) {
#pragma unroll
        for (int i = 0; i < 16; i += 4) *(int4*)(lists + row * 16 + i) = make_int4(A[i], A[i + 1], A[i + 2], A[i + 3]);
      }
    }
    __syncthreads();
    if (tid < 256) {
      const int tok = tid >> 2, q = tid & 3;
      float bq[16];
#pragma unroll
      for (int j = 0; j < 16; ++j) bq[j] = keyf(lists[(64 + tok) * 16 + j] & ~0x7F);
      int R[16];
#pragma unroll
      for (int i = 0; i < 16; ++i) R[i] = (int)0x80000000;
#pragma unroll
      for (int m = 0; m < 4; ++m) {
        const int i = q + 4 * m;
        const float ai = keyf(lists[tok * 16 + i] & ~0x7F);
        const int jmax = 16 / (i + 1);
        const int nj = m == 0 ? 16 : (m == 1 ? 3 : 1);
#pragma unroll
        for (int j = 0; j < nj; ++j) {
          int x = (fkey(ai + bq[j]) & ~0xFF) | (255 - (i * 16 + j));
          x = j < jmax ? x : (int)0x80000000;
#pragma unroll
          for (int t = 0; t < 16; ++t) { int hi_ = max(R[t], x); x = min(R[t], x); R[t] = hi_; }
        }
      }
      XLANE_MERGE16(R, 0xB1)
      XLANE_MERGE16(R, 0x4E)
      float sv[16];
      float mx = keyf(R[0] & ~0xFF), sum = 0.f;
#pragma unroll
      for (int t = 0; t < 16; ++t) { sv[t] = __expf(keyf(R[t] & ~0xFF) - mx); sum += sv[t]; }
      float inv = 1.f / sum;
      size_t ob = (size_t)(row0 + tok) * 128 + hd * 16;
#pragma unroll
      for (int t = 0; t < 16; ++t) {
        if ((t >> 2) == q) {
          int pos = 255 - (R[t] & 0xFF);
          int i1 = 127 - (lists[tok * 16 + (pos >> 4)] & 0x7F);
          int i2 = 127 - (lists[(64 + tok) * 16 + (pos & 15)] & 0x7F);
          IDX[ob + t] = i1 * 128 + i2;
          GATE[ob + t] = sv[t] * inv;
        }
      }
    }
    __syncthreads();
  }
}

typedef __attribute__((ext_vector_type(2))) float f2;
#define TAB_V8 (16 * MiB)
#define TAB_SU (32 * MiB)
#define TAB_SV (32 * MiB + 65536)
__device__ __forceinline__ float wave_max(float v) {
  v = fmaxf(v, dppf<0xB1>(v)); v = fmaxf(v, dppf<0x4E>(v)); v = fmaxf(v, dppf<0x141>(v)); v = fmaxf(v, dppf<0x140>(v));
  v = swapmax16(v); v = swapmax32(v);
  return v;
}
__device__ __forceinline__ void convert_tab_fp8(const float* __restrict__ U, const float* __restrict__ V, char* tab) {
  const int lane = tid_() & 63;
  const int gw = blockIdx.x * 8 + (tid_() >> 6), nw = gridDim.x * 8;
  for (int rr = gw; rr < 32768; rr += nw) {
    const int isv = rr >> 14, e = rr & 16383;
    const float* src = (isv ? V : U) + (size_t)e * 1024 + lane * 16;
    float4 v0 = *(const float4*)src, v1 = *(const float4*)(src + 4), v2 = *(const float4*)(src + 8), v3 = *(const float4*)(src + 12);
    float am = fmaxf(fmaxf(fmaxf(fabsf(v0.x), fabsf(v0.y)), fmaxf(fabsf(v0.z), fabsf(v0.w))),
                     fmaxf(fmaxf(fabsf(v1.x), fabsf(v1.y)), fmaxf(fabsf(v1.z), fabsf(v1.w))));
    am = fmaxf(am, fmaxf(fmaxf(fmaxf(fabsf(v2.x), fabsf(v2.y)), fmaxf(fabsf(v2.z), fabsf(v2.w))),
                         fmaxf(fmaxf(fabsf(v3.x), fabsf(v3.y)), fmaxf(fabsf(v3.z), fabsf(v3.w)))));
    am = wave_max(am);
    float sc = am > 0.f ? 448.f / am : 1.f;
    uint4 o;
    int t = 0;
    t = __builtin_amdgcn_cvt_pk_fp8_f32(v0.x * sc, v0.y * sc, t, false); t = __builtin_amdgcn_cvt_pk_fp8_f32(v0.z * sc, v0.w * sc, t, true); o.x = t;
    t = __builtin_amdgcn_cvt_pk_fp8_f32(v1.x * sc, v1.y * sc, t, false); t = __builtin_amdgcn_cvt_pk_fp8_f32(v1.z * sc, v1.w * sc, t, true); o.y = t;
    t = __builtin_amdgcn_cvt_pk_fp8_f32(v2.x * sc, v2.y * sc, t, false); t = __builtin_amdgcn_cvt_pk_fp8_f32(v2.z * sc, v2.w * sc, t, true); o.z = t;
    t = __builtin_amdgcn_cvt_pk_fp8_f32(v3.x * sc, v3.y * sc, t, false); t = __builtin_amdgcn_cvt_pk_fp8_f32(v3.z * sc, v3.w * sc, t, true); o.w = t;
    if (!isv) {
      *(uint4*)(tab + (size_t)e * 1024 + lane * 16) = o;
      if (lane == 0) ((float*)(tab + TAB_SU))[e] = am > 0.f ? am / 448.f : 1.f;
    } else {
      *(uint4*)(tab + TAB_V8 + ((size_t)(lane >> 3) * 16384 + e) * 128 + (lane & 7) * 16) = o;
      if (lane == 0) ((float*)(tab + TAB_SV))[e] = am > 0.f ? am / 448.f : 1.f;
    }
  }
}
__device__ __forceinline__ f2 dec8(unsigned w, bool hi) { return hi ? __builtin_amdgcn_cvt_pk_f32_fp8((int)w, true) : __builtin_amdgcn_cvt_pk_f32_fp8((int)w, false); }

__device__ __forceinline__ float dot16(uint4 w, f2 a0, f2 a1, f2 a2, f2 a3, f2 a4, f2 a5, f2 a6, f2 a7) {
  f2 a = f2{0.f, 0.f};
  a = __builtin_elementwise_fma(dec8(w.x, false), a0, a); a = __builtin_elementwise_fma(dec8(w.x, true), a1, a);
  a = __builtin_elementwise_fma(dec8(w.y, false), a2, a); a = __builtin_elementwise_fma(dec8(w.y, true), a3, a);
  a = __builtin_elementwise_fma(dec8(w.z, false), a4, a); a = __builtin_elementwise_fma(dec8(w.z, true), a5, a);
  a = __builtin_elementwise_fma(dec8(w.w, false), a6, a); a = __builtin_elementwise_fma(dec8(w.w, true), a7, a);
  return a.x + a.y;
}
#define DOT16(W) dot16(W, xf0, xf1, xf2, xf3, xf4, xf5, xf6, xf7)
__device__ __forceinline__ void phase_peer_act(const P& p, const u16* XN2, const char* tab, const int* IDX, const float* GATE, float* COEF, int ntok, char* lds) {
  const int tid = tid_(), lane = tid & 63, wave = tid >> 6;
  int* le = (int*)(lds + wave * 1536);
  float* lg = (float*)(le + 128);
  int* ls = le + 256;
  const int part = blockIdx.x & 7;
  const int wv = (blockIdx.x >> 3) * 8 + wave, nwv = (gridDim.x >> 3) * 8;
  const float* SU = (const float*)(tab + TAB_SU);
  const float* SV = (const float*)(tab + TAB_SV);
  const int q = lane >> 4;
  const bool hi = (lane & 32) != 0, b4 = (lane & 16) != 0;
  int i0 = 0, i1 = 0; float g0 = 0.f, g1 = 0.f; uint4 x0 = make_uint4(0, 0, 0, 0), x1 = x0;
  if (wv < ntok) {
    i0 = IDX[(size_t)wv * 128 + lane]; i1 = IDX[(size_t)wv * 128 + 64 + lane];
    g0 = GATE[(size_t)wv * 128 + lane]; g1 = GATE[(size_t)wv * 128 + 64 + lane];
    const u16* xr = XN2 + (size_t)wv * DM + lane * 16;
    x0 = *(const uint4*)xr; x1 = *(const uint4*)(xr + 8);
  }
  for (int tok = wv; tok < ntok; tok += nwv) {
    int ni0 = 0, ni1 = 0; float ng0 = 0.f, ng1 = 0.f; uint4 nx0 = make_uint4(0, 0, 0, 0), nx1 = nx0;
    const int nt = tok + nwv;
    if (nt < ntok) {
      ni0 = IDX[(size_t)nt * 128 + lane]; ni1 = IDX[(size_t)nt * 128 + 64 + lane];
      ng0 = GATE[(size_t)nt * 128 + lane]; ng1 = GATE[(size_t)nt * 128 + 64 + lane];
      const u16* xr = XN2 + (size_t)nt * DM + lane * 16;
      nx0 = *(const uint4*)xr; nx1 = *(const uint4*)(xr + 8);
    }
    const bool s0 = (i0 >> 11) == part, s1 = (i1 >> 11) == part;
    const unsigned long long m0 = __ballot(s0), m1 = __ballot(s1);
    const int c0 = __popcll(m0), cnt = c0 + __popcll(m1);
    const int p0 = __builtin_amdgcn_mbcnt_hi((unsigned)(m0 >> 32), __builtin_amdgcn_mbcnt_lo((unsigned)m0, 0));
    const int p1 = c0 + __builtin_amdgcn_mbcnt_hi((unsigned)(m1 >> 32), __builtin_amdgcn_mbcnt_lo((unsigned)m1, 0));
    if (s0) { le[p0] = i0; lg[p0] = g0; ls[p0] = lane; }
    if (s1) { le[p1] = i1; lg[p1] = g1; ls[p1] = 64 + lane; }
    const int cntp = (cnt + 3) & ~3;
    if (lane < cntp - cnt) { le[cnt + lane] = part << 11; lg[cnt + lane] = 0.f; ls[cnt + lane] = -1; }
    const f2 xf0 = f2{bflo(x0.x), bfhi(x0.x)}, xf1 = f2{bflo(x0.y), bfhi(x0.y)}, xf2 = f2{bflo(x0.z), bfhi(x0.z)}, xf3 = f2{bflo(x0.w), bfhi(x0.w)};
    const f2 xf4 = f2{bflo(x1.x), bfhi(x1.x)}, xf5 = f2{bflo(x1.y), bfhi(x1.y)}, xf6 = f2{bflo(x1.z), bfhi(x1.z)}, xf7 = f2{bflo(x1.w), bfhi(x1.w)};
    for (int base = 0; base < cntp; base += 24) {
      uint4 w[24];
      const int evl = le[base + (lane < 24 ? lane : 0)];
#pragma unroll
      for (int gq = 0; gq < 6; ++gq) {
        if (base + 4 * gq < cntp) {
#pragma unroll
          for (int k = 0; k < 4; ++k) {
            int e = __builtin_amdgcn_readlane(evl, 4 * gq + k);
            w[4 * gq + k] = *(const uint4*)(tab + (size_t)e * 1024 + lane * 16);
          }
        } else {
#pragma unroll
          for (int k = 0; k < 4; ++k) w[4 * gq + k] = make_uint4(0, 0, 0, 0);
        }
      }
      float my_act = 0.f;
      const int jmine = base + 4 * (lane & 15) + q;
      const bool mine = (lane & 15) < 6 && jmine < cntp;
      int e_m = part << 11, slot_m = -1; float gt_m = 0.f, su_m = 0.f, sv_m = 0.f;
      if (mine) { e_m = le[jmine]; gt_m = lg[jmine]; slot_m = ls[jmine]; su_m = SU[e_m]; sv_m = SV[e_m]; }
#pragma unroll
      for (int gq = 0; gq < 6; ++gq) {
        if (base + 4 * gq < cntp) {
          float d0 = DOT16(w[4 * gq]), d1 = DOT16(w[4 * gq + 1]), d2 = DOT16(w[4 * gq + 2]), d3 = DOT16(w[4 * gq + 3]);
          float kA = swapsum32(d0, d2), kB = swapsum32(d1, d3);
          float kC = swapsum16(kA, kB);
          kC = red16(kC);
          if ((lane & 15) == gq) my_act = kC;
        }
      }
      {
        if (mine && slot_m >= 0) {
          float act = my_act * su_m;
          COEF[(size_t)tok * 128 + slot_m] = gt_m * 0.5f * act * (1.f + erff(act * 0.70710678118654752f)) * sv_m;
        }
      }
    }
    i0 = ni0; i1 = ni1; g0 = ng0; g1 = ng1; x0 = nx0; x1 = nx1;
  }
}

__device__ __forceinline__ void phase_peer_sum(const P& p, int layer, const char* tab, const int* IDX, const float* COEF, int ntok, float* dummy_dst) {
  const int tid = tid_(), lane = tid & 63, wave = tid >> 6;
  const int sl = blockIdx.x & 7;
  const int wv = (blockIdx.x >> 3) * 8 + wave, nwv = (gridDim.x >> 3) * 8;
  const int g = lane >> 3, ch = lane & 7;
  const char* V8 = tab + TAB_V8 + (size_t)sl * 16384 * 128 + ch * 16;
  const float* mod = (const float*)(p.ws + O_MOD) + (size_t)layer * 9 * 6144;
  float* HC = (float*)(p.ws + O_HC);
  const bool b5 = (lane & 32) != 0, b4 = (lane & 16) != 0, b3 = (lane & 8) != 0;
  const int c = sl * 128 + ch * 16 + (b5 ? 8 : 0) + (b4 ? 4 : 0) + (b3 ? 2 : 0);
  uint4 ia, ib, ic, id; float4 ca, cb, cc, cd;
  ia = ib = ic = id = make_uint4(0, 0, 0, 0); ca = cb = cc = cd = make_float4(0, 0, 0, 0);
  if (wv < ntok) {
    const int* ip = IDX + (size_t)wv * 128 + g * 16;
    const float* cp = COEF + (size_t)wv * 128 + g * 16;
    ia = *(const uint4*)ip; ib = *(const uint4*)(ip + 4); ic = *(const uint4*)(ip + 8); id = *(const uint4*)(ip + 12);
    ca = *(const float4*)cp; cb = *(const float4*)(cp + 4); cc = *(const float4*)(cp + 8); cd = *(const float4*)(cp + 12);
  }
  for (int tok = wv; tok < ntok; tok += nwv) {
    const unsigned ev[16] = {ia.x, ia.y, ia.z, ia.w, ib.x, ib.y, ib.z, ib.w, ic.x, ic.y, ic.z, ic.w, id.x, id.y, id.z, id.w};
    const float cv[16] = {ca.x, ca.y, ca.z, ca.w, cb.x, cb.y, cb.z, cb.w, cc.x, cc.y, cc.z, cc.w, cd.x, cd.y, cd.z, cd.w};
    uint4 w[16];
#pragma unroll
    for (int i = 0; i < 16; ++i) w[i] = *(const uint4*)(V8 + (size_t)ev[i] * 128);
    float* dst = (dummy_dst ? dummy_dst + (size_t)tok * DM : (tok < NLAT ? p.out + (size_t)tok * DM : HC + (size_t)(tok - NLAT) * DM)) + c;
    float2 o = *(float2*)dst;
    const int mi = tok < NLAT ? (tok >> 12) : 8;
    const float2 mv = *(const float2*)(mod + mi * 6144 + 5 * 1024 + c);
    const int nt = tok + nwv;
    if (nt < ntok) {
      const int* ip = IDX + (size_t)nt * 128 + g * 16;
      const float* cp = COEF + (size_t)nt * 128 + g * 16;
      ia = *(const uint4*)ip; ib = *(const uint4*)(ip + 4); ic = *(const uint4*)(ip + 8); id = *(const uint4*)(ip + 12);
      ca = *(const float4*)cp; cb = *(const float4*)(cp + 4); cc = *(const float4*)(cp + 8); cd = *(const float4*)(cp + 12);
    }
    f2 acc[8];
#pragma unroll
    for (int k = 0; k < 8; ++k) acc[k] = f2{0.f, 0.f};
#pragma unroll
    for (int i = 0; i < 16; ++i) {
      f2 c2 = f2{cv[i], cv[i]};
      acc[0] = __builtin_elementwise_fma(dec8(w[i].x, false), c2, acc[0]); acc[1] = __builtin_elementwise_fma(dec8(w[i].x, true), c2, acc[1]);
      acc[2] = __builtin_elementwise_fma(dec8(w[i].y, false), c2, acc[2]); acc[3] = __builtin_elementwise_fma(dec8(w[i].y, true), c2, acc[3]);
      acc[4] = __builtin_elementwise_fma(dec8(w[i].z, false), c2, acc[4]); acc[5] = __builtin_elementwise_fma(dec8(w[i].z, true), c2, acc[5]);
      acc[6] = __builtin_elementwise_fma(dec8(w[i].w, false), c2, acc[6]); acc[7] = __builtin_elementwise_fma(dec8(w[i].w, true), c2, acc[7]);
    }
    float r8[8];
#pragma unroll
    for (int k = 0; k < 4; ++k) {
      r8[2 * k] = swapsum32(acc[k].x, acc[4 + k].x);
      r8[2 * k + 1] = swapsum32(acc[k].y, acc[4 + k].y);
    }
    float r4[4];
#pragma unroll
    for (int k = 0; k < 4; ++k) r4[k] = swapsum16(r8[k], r8[4 + k]);
    float r2[2];
#pragma unroll
    for (int k = 0; k < 2; ++k) {
      float kx = b3 ? r4[2 + k] : r4[k], sx = b3 ? r4[k] : r4[2 + k];
      r2[k] = kx + dppf<0x128>(sx);
    }
    o.x += mv.x * r2[0]; o.y += mv.y * r2[1];
    *(float2*)dst = o;
  }
}

__device__ __forceinline__ void phase_scan(const P& p, char* lds, bool dummy) {
  float* buf = (float*)lds;
  float* vbuf = (float*)(lds + 81920);
  u16* ybuf = (u16*)(lds + 81920 + 16384);
  const int tid = tid_(), lane = tid & 63, wave = tid >> 6;
  const int c = lane & 7, irow = wave * 8 + (lane >> 3);
  const u16* R = (const u16*)(p.ws + O_R);
  const u16* Kp = (const u16*)(p.ws + O_K);
  const u16* Vp = (const u16*)(p.ws + O_V);
  const int ps = tid >> 4, col4 = (tid & 15) * 4;
  for (int item = blockIdx.x; item < 256; item += gridDim.x) {
    const int dir = item & 1, hh = (item >> 1) & 15, b = item >> 5;
    char* WA = p.ws + (dir ? O_WA1 : O_WA0);
    float* BON = (float*)(p.ws + O_BONUS) + (size_t)dir * NLAT * 16;
    float kkc[4], kac[4], rkc[4];
#pragma unroll
    for (int e = 0; e < 4; ++e) {
      kkc[e] = p.in[20][hh * 64 + col4 + e];
      kac[e] = p.in[21][hh * 64 + col4 + e];
      rkc[e] = p.in[22][hh * 64 + col4 + e];
    }
    auto rowof = [&](int s) -> int {
      if (s < 256) { int pos = dir ? 255 - s : s; return NLAT + b * 256 + pos; }
      int u = s - 256; int pos = dir ? 4095 - u : u; return b * 4096 + pos;
    };
    uint2 pr, pk, pv; unsigned pw, pa; int prow;
    auto gload = [&](int ch) {
      prow = rowof(ch * 32 + ps);
      size_t o = (size_t)prow * 1024 + hh * 64 + col4;
      pr = *(const uint2*)(R + o); pk = *(const uint2*)(Kp + o); pv = *(const uint2*)(Vp + o);
      const char* wp = WA + (size_t)prow * 2048 + hh * 128;
      pw = *(const unsigned*)(wp + col4); pa = *(const unsigned*)(wp + 64 + col4);
    };
    auto prep = [&](int bi) {
      float rr[4] = {bflo(pr.x), bfhi(pr.x), bflo(pr.y), bfhi(pr.y)};
      float kq[4] = {bflo(pk.x), bfhi(pk.x), bflo(pk.y), bfhi(pk.y)};
      float4 vv = make_float4(bflo(pv.x), bfhi(pv.x), bflo(pv.y), bfhi(pv.y));
      float w[4], a[4], kr[4], kk[4], bb[4], kd[4];
      float ss = 0.f;
#pragma unroll
      for (int e = 0; e < 4; ++e) {
        w[e] = 0.5f + (float)((pw >> (8 * e)) & 255u) * (1.f / 510.f);
        a[e] = (float)((pa >> (8 * e)) & 255u) * (1.f / 255.f);
        kr[e] = kq[e] * kkc[e];
        ss += kr[e] * kr[e];
      }
      ss = red16(ss);
      float inv = rsqrtf(ss + 1e-12f);
      float bn = 0.f;
#pragma unroll
      for (int e = 0; e < 4; ++e) {
        kk[e] = kr[e] * inv;
        bb[e] = kk[e] * a[e];
        kd[e] = kq[e] * (1.f + (a[e] - 1.f) * kac[e]);
        bn += rr[e] * kd[e] * rkc[e];
      }
      bn = red16(bn);
      if ((tid & 15) == 0 && prow < NLAT) BON[(size_t)prow * 16 + hh] = bn;
      float* d = buf + bi * 10240 + ((ps * 8 + (col4 >> 3)) * 5) * 8 + (col4 & 7);
      *(float4*)(d) = make_float4(rr[0], rr[1], rr[2], rr[3]);
      *(float4*)(d + 8) = make_float4(w[0], w[1], w[2], w[3]);
      *(float4*)(d + 16) = make_float4(kk[0], kk[1], kk[2], kk[3]);
      *(float4*)(d + 24) = make_float4(bb[0], bb[1], bb[2], bb[3]);
      *(float4*)(d + 32) = make_float4(kd[0], kd[1], kd[2], kd[3]);
      *(float4*)(vbuf + bi * 2048 + ps * 64 + col4) = vv;
    };
    float S[8];
#pragma unroll
    for (int j = 0; j < 8; ++j) S[j] = 0.f;
    gload(0);
    prep(0);
    __syncthreads();
    for (int ch = 0; ch < 136; ++ch) {
      const int cur = ch & 1;
      if (ch + 1 < 136) gload(ch + 1);
      const float* bq = buf + cur * 10240 + c * 40;
      const float* vq = vbuf + cur * 2048 + irow;
      float4 nr0, nr1, nw0, nw1, nk0, nk1, nb0, nb1, nd0, nd1; float nvi;
      {
        const float* q = bq;
        nr0 = *(const float4*)(q); nr1 = *(const float4*)(q + 4); nw0 = *(const float4*)(q + 8); nw1 = *(const float4*)(q + 12);
        nk0 = *(const float4*)(q + 16); nk1 = *(const float4*)(q + 20); nb0 = *(const float4*)(q + 24); nb1 = *(const float4*)(q + 28);
        nd0 = *(const float4*)(q + 32); nd1 = *(const float4*)(q + 36); nvi = vq[0];
      }
#pragma unroll 4
      for (int t = 0; t < 32; ++t) {
        const float4 r0 = nr0, r1 = nr1, w0 = nw0, w1 = nw1, k0 = nk0, k1 = nk1, b0 = nb0, b1 = nb1, d0 = nd0, d1 = nd1;
        const float vi = nvi;
        if (t + 1 < 32) {
          const float* q = bq + (t + 1) * 320;
          nr0 = *(const float4*)(q); nr1 = *(const float4*)(q + 4); nw0 = *(const float4*)(q + 8); nw1 = *(const float4*)(q + 12);
          nk0 = *(const float4*)(q + 16); nk1 = *(const float4*)(q + 20); nb0 = *(const float4*)(q + 24); nb1 = *(const float4*)(q + 28);
          nd0 = *(const float4*)(q + 32); nd1 = *(const float4*)(q + 36); nvi = vq[(t + 1) * 64];
        }
        float sa = (S[0] * k0.x + S[1] * k0.y) + (S[2] * k0.z + S[3] * k0.w) + ((S[4] * k1.x + S[5] * k1.y) + (S[6] * k1.z + S[7] * k1.w));
        sa = red8(sa);
        S[0] = fmaf(S[0], w0.x, fmaf(-sa, b0.x, vi * d0.x));
        S[1] = fmaf(S[1], w0.y, fmaf(-sa, b0.y, vi * d0.y));
        S[2] = fmaf(S[2], w0.z, fmaf(-sa, b0.z, vi * d0.z));
        S[3] = fmaf(S[3], w0.w, fmaf(-sa, b0.w, vi * d0.w));
        S[4] = fmaf(S[4], w1.x, fmaf(-sa, b1.x, vi * d1.x));
        S[5] = fmaf(S[5], w1.y, fmaf(-sa, b1.y, vi * d1.y));
        S[6] = fmaf(S[6], w1.z, fmaf(-sa, b1.z, vi * d1.z));
        S[7] = fmaf(S[7], w1.w, fmaf(-sa, b1.w, vi * d1.w));
        float y = (S[0] * r0.x + S[1] * r0.y) + (S[2] * r0.z + S[3] * r0.w) + ((S[4] * r1.x + S[5] * r1.y) + (S[6] * r1.z + S[7] * r1.w));
        y = red8(y);
        if (c == 0) ybuf[t * 64 + irow] = f2bf(y);
      }
      __syncthreads();
      if (ch >= 8 && !dummy) {
        int row = rowof(ch * 32 + ps);
        uint2 yv = *(const uint2*)(ybuf + ps * 64 + col4);
        *(uint2*)(WA + (size_t)row * 2048 + hh * 128 + col4 * 2) = yv;
      }
      if (ch + 1 < 136) prep(cur ^ 1);
      __syncthreads();
    }
  }
}

__device__ __forceinline__ void phase_readout(const P& p) {
  const u16* Vp = (const u16*)(p.ws + O_V);
  const u16* G = (const u16*)(p.ws + O_G);
  u16* Z = (u16*)(p.ws + O_Z);
  const float* BON = (const float*)(p.ws + O_BONUS);
  const size_t gt = (size_t)blockIdx.x * NT + tid_(), gn = (size_t)gridDim.x * NT;
  for (size_t it = gt; it < (size_t)NLAT * 16 * 8; it += gn) {
    int sub = (int)(it & 7); size_t grp = it >> 3;
    int hh = (int)(grp & 15); int row = (int)(grp >> 4);
    uint4 y0 = *(const uint4*)(p.ws + O_WA0 + (size_t)row * 2048 + hh * 128 + sub * 16);
    uint4 y1 = *(const uint4*)(p.ws + O_WA1 + (size_t)row * 2048 + hh * 128 + sub * 16);
    const int col = hh * 64 + sub * 8;
    const float bonus0 = BON[(size_t)row * 16 + hh], bonus1 = BON[(size_t)NLAT * 16 + (size_t)row * 16 + hh];
    const uint4 vv = *(const uint4*)(Vp + (size_t)row * DM + col);
    const uint4 gg = *(const uint4*)(G + (size_t)row * DM + col);
    const float4 gw0 = *(const float4*)(p.in[29] + col), gw1 = *(const float4*)(p.in[29] + col + 4);
    const float4 gb0 = *(const float4*)(p.in[30] + col), gb1 = *(const float4*)(p.in[30] + col + 4);
    float y[8] = {bflo(y0.x) + bflo(y1.x), bfhi(y0.x) + bfhi(y1.x), bflo(y0.y) + bflo(y1.y), bfhi(y0.y) + bfhi(y1.y),
                  bflo(y0.z) + bflo(y1.z), bfhi(y0.z) + bfhi(y1.z), bflo(y0.w) + bflo(y1.w), bfhi(y0.w) + bfhi(y1.w)};
    float s = 0.f;
#pragma unroll
    for (int e = 0; e < 8; ++e) s += y[e];
    float mean = red8(s) * (1.f / 64.f);
    float vs = 0.f;
#pragma unroll
    for (int e = 0; e < 8; ++e) { y[e] -= mean; vs += y[e] * y[e]; }
    float var = red8(vs) * (1.f / 64.f);
    float rs = rsqrtf(var + 64e-5f);
    const float bonus = bonus0 + bonus1;
    float vf[8] = {bflo(vv.x), bfhi(vv.x), bflo(vv.y), bfhi(vv.y), bflo(vv.z), bfhi(vv.z), bflo(vv.w), bfhi(vv.w)};
    float gf[8] = {bflo(gg.x), bfhi(gg.x), bflo(gg.y), bfhi(gg.y), bflo(gg.z), bfhi(gg.z), bflo(gg.w), bfhi(gg.w)};
    float z[8];
    const float gwv[8] = {gw0.x, gw0.y, gw0.z, gw0.w, gw1.x, gw1.y, gw1.z, gw1.w};
    const float gbv[8] = {gb0.x, gb0.y, gb0.z, gb0.w, gb1.x, gb1.y, gb1.z, gb1.w};
#pragma unroll
    for (int e = 0; e < 8; ++e) z[e] = (y[e] * rs * gwv[e] + gbv[e] + bonus * vf[e]) * gf[e];
    uint4 ov; ov.x = pack2(z[0], z[1]); ov.y = pack2(z[2], z[3]); ov.z = pack2(z[4], z[5]); ov.w = pack2(z[6], z[7]);
    *(uint4*)(Z + (size_t)row * DM + col) = ov;
  }
}

__device__ __forceinline__ bool xcd_tile(int k, int Tm, int Tn, int& mt, int& nt) {
  const int x = blockIdx.x & 7, j = blockIdx.x >> 3, J = gridDim.x >> 3;
  const int u = j + J * k;
  if (u >= (Tm >> 3) * Tn) return false;
  mt = (u / Tn) * 8 + x; nt = u % Tn;
  return true;
}

#define XB_TMO      128
#define XB_XCNT(j)  (256  + 64 * (j))
#define XB_XSUB(j)  (1280 + 64 * (j))
#define XB_XGEN(j)  (2304 + 64 * (j))
#define XB_TOP      3328
#define XB_TOPGEN   3392
#define XCD_BAR_WORDS 3456
#define XB_SPIN_CAP (1u << 18)
#define LAS __attribute__((address_space(3)))
__device__ __forceinline__ unsigned xb_ld(unsigned* p)              { return __hip_atomic_load(p, __ATOMIC_RELAXED, __HIP_MEMORY_SCOPE_AGENT); }
__device__ __forceinline__ unsigned xb_add(unsigned* p, unsigned v) { return __hip_atomic_fetch_add(p, v, __ATOMIC_RELAXED, __HIP_MEMORY_SCOPE_AGENT); }
__device__ __forceinline__ unsigned xb_xcc_id() { return (unsigned)__builtin_amdgcn_s_getreg((3 << 11) | 20) & 0xFu; }
#define XB_SPIN(cond, bar) do { unsigned _sp = 0; while (cond) { __builtin_amdgcn_s_sleep(1); \
    if ((++_sp & 255u) == 0u) { if (xb_ld(&(bar)[XB_TMO])) break; if (_sp > XB_SPIN_CAP) { atomicAdd(&(bar)[XB_TMO], 1u); break; } } } } while (0)
struct XcdBarrier { unsigned* bar; unsigned x; volatile LAS unsigned* st; };
__device__ __forceinline__ XcdBarrier xcd_barrier_post(unsigned* bar, volatile LAS unsigned* st) {
  XcdBarrier b; b.bar = bar; b.x = xb_xcc_id(); b.st = st;
  if (tid_() == 0) (void)xb_add(&bar[XB_XCNT(b.x)], 1u);
  return b;
}
__device__ __forceinline__ void xcd_barrier_complete(unsigned* bar, unsigned x, unsigned& nloc, unsigned& nx) {
  const unsigned G = gridDim.x * gridDim.y * gridDim.z;
  unsigned sum, cnt, mine, sp = 0u;
  for (;;) {
    sum = 0u; cnt = 0u; mine = 0u;
#pragma unroll
    for (unsigned j = 0; j < 16; ++j) { const unsigned c = xb_ld(&bar[XB_XCNT(j)]); sum += c; cnt += (c > 0u) ? 1u : 0u; mine = (j == x) ? c : mine; }
    if (sum == G) break;
    __builtin_amdgcn_s_sleep(1);
    if ((++sp & 255u) == 0u) { if (xb_ld(&bar[XB_TMO])) break; if (sp > XB_SPIN_CAP) { atomicAdd(&bar[XB_TMO], 1u); break; } }
  }
  nloc = mine > 0u ? mine : 1u; nx = cnt > 0u ? cnt : 1u;
}
__device__ __forceinline__ void xcd_barrier(char* wsb, char* ldsb) {
#if defined(__HIP_DEVICE_COMPILE__)
  XcdBarrier b; b.bar = (unsigned*)(wsb + O_BAR); b.x = xb_xcc_id(); b.st = (volatile LAS unsigned*)(ldsb + LDS_BYTES - 16);
  asm volatile("s_waitcnt vmcnt(0)" ::: "memory");
  __syncthreads();
  if (tid_() == 0) {
    unsigned* bar = b.bar;
    __builtin_amdgcn_s_waitcnt(0);
    unsigned nloc = b.st[0], nx = b.st[1];
    if (nloc == 0u) { xcd_barrier_complete(bar, b.x, nloc, nx); b.st[0] = nloc; b.st[1] = nx; }
    const unsigned old = xb_add(&bar[XB_XSUB(b.x)], 1u);
    const unsigned gen = old / nloc;
    if (old + 1u == (gen + 1u) * nloc) {
      __builtin_amdgcn_fence(__ATOMIC_RELEASE, "agent");
      asm volatile("s_waitcnt vmcnt(0)" ::: "memory");
      const unsigned og = xb_add(&bar[XB_TOP], 1u);
      const unsigned tg = og / nx;
      if (og + 1u == (tg + 1u) * nx) xb_add(&bar[XB_TOPGEN], 1u);
      else XB_SPIN(xb_ld(&bar[XB_TOPGEN]) == tg, bar);
      __builtin_amdgcn_fence(__ATOMIC_ACQUIRE, "agent");
      xb_add(&bar[XB_XGEN(b.x)], 1u);
      asm volatile("s_waitcnt vmcnt(0)" ::: "memory");
    } else {
      XB_SPIN(xb_ld(&bar[XB_XGEN(b.x)]) == gen, bar);
      __builtin_amdgcn_fence(__ATOMIC_ACQUIRE, "agent");
      asm volatile("s_waitcnt vmcnt(0)" ::: "memory");
    }
  }
  __syncthreads();
#endif
}

__global__ void __launch_bounds__(NT) fwd_kernel(P p) {
  extern __shared__ __attribute__((aligned(16))) char lds[];
  cg::grid_group grid = cg::this_grid();
  char* ws = p.ws;
  const float* mod0 = (const float*)(ws + O_MOD);
  const float* mod1 = mod0 + 9 * 6144;
  volatile LAS unsigned* xst = (volatile LAS unsigned*)(lds + LDS_BYTES - 16);
  if (tid_() == 0) { xst[0] = 0u; xst[1] = 0u; }
  __syncthreads();
  (void)xcd_barrier_post((unsigned*)(p.ws + O_BAR), xst);
  for (int ph = p.ph_lo; ph < p.ph_hi; ++ph) {
    if (ph > p.ph_lo) {
      if (p.ph_hi < 0) grid.sync();
      xcd_barrier(p.ws, lds);
    }
    if (!((PHASE_MASK >> ph) & 1)) continue;
    const int nrep = ((REPEAT_MASK >> ph) & 1) ? 2 : 1;
    for (int rep = 0; rep < nrep; ++rep) {
    const bool dummy = rep + 1 < nrep;
    if (rep) grid.sync();
    switch (ph) {
      case 0: phase_prep(p, lds); break;
      case 1: phase_norm(p, p.in[0], p.in[2], p.in[6], 0, 0, TTOK, (u16*)(ws + O_XN)); break;
      case 2: {
        u16* hgg = (u16*)(ws + O_HGG); u16* Q = (u16*)(ws + O_Q); u16* KBp = (u16*)(ws + O_KB); u16* VT = (u16*)(ws + O_VT);
        for (int kq = 0, mt = 0, ntw = 0; xcd_tile(kq, 136, 10, mt, ntw); ++kq) {
          if (ntw < 8) {
            const int n0w = ntw * 256;
            u16* dbase; int dld;
            if (n0w < 1536) { dbase = hgg + n0w; dld = 1536; } else { dbase = Q + (n0w - 1536); dld = 512; }
            auto xf = [&](float v, int row, int col) -> float { return v; };
            auto dstf = [&](int row) -> u16* { return dbase + (size_t)row * dld; };
            gemm_tile256<false>((const u16*)(ws + O_XN), 1024, nullptr, (const u16*)(ws + O_WIN) + (size_t)n0w * 1024, 1024, 1024,
                                mt * 256, xf, dstf, (u16*)lds);
            continue;
          }
          int nt = 8 + ntw;
          int n0 = nt * 128;
          auto epi = [&](int row, int col, float v0, float v1, float v2, float v3) {
            int n = n0 + col;
            float v[4] = {v0, v1, v2, v3};
            if (n < 1536) {
#pragma unroll
              for (int j = 0; j < 4; ++j) hgg[(size_t)(row + j) * 1536 + n] = f2bf(v[j]);
            } else if (n < 2048) {
#pragma unroll
              for (int j = 0; j < 4; ++j) Q[(size_t)(row + j) * 512 + n - 1536] = f2bf(v[j]);
            } else if (n < 2176) {
#pragma unroll
              for (int j = 0; j < 4; ++j) KBp[(size_t)(row + j) * 128 + n - 2048] = f2bf(v[j]);
            } else {
              int kvh = (n - 2176) >> 6, d = (n - 2176) & 63;
              int b, pos;
              if (row < NLAT) { b = row >> 12; pos = 256 + (row & 4095); } else { b = (row - NLAT) >> 8; pos = (row - NLAT) & 255; }
              uint2 o; o.x = pack2(v0, v1); o.y = pack2(v2, v3);
              *(uint2*)(VT + ((size_t)((b * 2 + kvh) * 64 + d)) * 4352 + pos) = o;
            }
          };
          if (nt < 17) {
            u16* dbase; int dld;
            if (n0 < 1536) { dbase = hgg + n0; dld = 1536; } else if (n0 < 2048) { dbase = Q + (n0 - 1536); dld = 512; } else { dbase = KBp + (n0 - 2048); dld = 128; }
            auto xf = [&](float v, int row, int col) -> float { return v; };
            auto dstf = [&](int row) -> u16* { return dbase + (size_t)row * dld; };
            gemm_tile<false, 1>((const u16*)(ws + O_XN), 1024, nullptr, (const u16*)(ws + O_WIN) + (size_t)n0 * 1024, 1024, 1024,
                                mt * 256, xf, dstf, (u16*)lds);
          } else {
            gemm_tile<false, 0>((const u16*)(ws + O_XN), 1024, nullptr, (const u16*)(ws + O_WIN) + (size_t)n0 * 1024, 1024, 1024,
                                mt * 256, epi, 0, (u16*)lds);
          }
        }
      } break;
      case 3: phase_conv_qk(p); break;
      case 4: phase_attn(p, lds); break;
      case 5: {
        float* HC = (float*)(ws + O_HC);
        for (int kq = 0, mt = 0, nt = 0; xcd_tile(kq, 136, 8, mt, nt); ++kq) {
          int n0 = nt * 128;
          auto epi = [&](int row, int col, float v0, float v1, float v2, float v3) {
            int n = n0 + col;
            float v[4] = {v0, v1, v2, v3};
#pragma unroll
            for (int j = 0; j < 4; ++j) {
              int rw = row + j;
              if (rw < NLAT) {
                float g = mod0[(rw >> 12) * 6144 + 2048 + n];
                p.out[(size_t)rw * DM + n] = p.in[0][(size_t)rw * DM + n] + g * v[j];
              } else {
                float g = mod0[8 * 6144 + 2048 + n];
                HC[(size_t)(rw - NLAT) * DM + n] = p.in[2][(size_t)(rw - NLAT) * DM + n] + g * v[j];
              }
            }
          };
          gemm_tile<false, 0>((const u16*)(ws + O_XN), 1024, nullptr, (const u16*)(ws + O_WOUT) + (size_t)n0 * 1024, 1024, 1024,
                              mt * 256, epi, 0, (u16*)lds);
        }
      } break;
      case 6: phase_norm(p, p.out, (const float*)(ws + O_HC), p.in[7], 0, 3, TTOK, (u16*)(ws + O_XN)); break;
      case 7: case 18: {
        int layer = ph == 7 ? 0 : 1;
        int mtiles = layer == 0 ? 136 : 128;
        u16* PQ = (u16*)(ws + (layer == 0 ? O_PQ0 : O_PQ1));
        const u16* Wq = (const u16*)(ws + O_WQ) + (size_t)layer * 2048 * 1024;
        for (int kq = 0, mt = 0, nt = 0; xcd_tile(kq, mtiles, 8, mt, nt); ++kq) {
          int n0 = nt * 256;
          auto epi = [&](int row, int col, float v0, float v1, float v2, float v3) {
            int n = n0 + col;
            float v[4] = {v0, v1, v2, v3};
#pragma unroll
            for (int j = 0; j < 4; ++j) PQ[(size_t)(row + j) * 2048 + n] = f2bf(v[j]);
          };
          auto xf = [&](float v, int row, int col) -> float { return v; };
          auto dstf = [&](int row) -> u16* { return PQ + (size_t)row * 2048 + n0; };
          gemm_tile256<false>((const u16*)(ws + O_XN), 1024, nullptr, Wq + (size_t)n0 * 1024, 1024, 1024, mt * 256, xf, dstf, (u16*)lds);
        }
      } break;
      case 8: phase_peer_topk(p, 0, (const u16*)(ws + O_PQ0), TTOK, (int*)(ws + O_IDX0), (float*)(ws + O_GATE0), lds); break;
      case 9: phase_peer_act(p, (const u16*)(ws + O_XN), ws + O_TAB0, (const int*)(ws + O_IDX0), (const float*)(ws + O_GATE0),
                             (float*)(ws + O_COEF0), TTOK, lds); break;
      case 10: phase_peer_sum(p, 0, ws + O_TAB0, (const int*)(ws + O_IDX0), (const float*)(ws + O_COEF0), TTOK, dummy ? (float*)(ws + O_A2R) : nullptr); break;
      case 11: phase_norm(p, p.out, (const float*)(ws + O_HC), p.in[6] + 1024, 1, 0, TTOK, (u16*)(ws + O_XN)); break;
      case 12: {
        u16* LORA = (u16*)(ws + O_LORA);
        for (int kq = 0;; ++kq) {
          const int u = (blockIdx.x >> 3) + (gridDim.x >> 3) * kq;
          if (u >= 17 * 27) break;
          int mt, nt;
          if (u < 408) { int g = u / 136, rem = u % 136; mt = (rem >> 3) * 8 + (blockIdx.x & 7); nt = g * 8 + (rem & 7); }
          else { int v2 = u - 408; mt = (v2 / 3) * 8 + (blockIdx.x & 7); nt = 24 + v2 % 3; }
          const u16* Bp; int mixi; u16* dstp = nullptr; int kind;
          if (nt < 8) { Bp = (const u16*)(ws + O_WR) + (size_t)nt * 128 * 1024; mixi = 0; dstp = (u16*)(ws + O_R) + nt * 128; kind = 0; }
          else if (nt < 16) { Bp = (const u16*)(ws + O_WK) + (size_t)(nt - 8) * 128 * 1024; mixi = 2; dstp = (u16*)(ws + O_K) + (nt - 8) * 128; kind = 0; }
          else if (nt < 24) { Bp = (const u16*)(ws + O_WV) + (size_t)(nt - 16) * 128 * 1024; mixi = 3; dstp = (u16*)(ws + O_V) + (nt - 16) * 128; kind = 0; }
          else if (nt == 24) { Bp = (const u16*)(ws + O_W1); mixi = 1; kind = 1; }
          else if (nt == 25) { Bp = (const u16*)(ws + O_A1); mixi = 4; kind = 2; }
          else { Bp = (const u16*)(ws + O_G1); mixi = 5; kind = 3; }
          auto epi = [&](int row, int col, float v0, float v1, float v2, float v3) {
            float v[4] = {v0, v1, v2, v3};
            if (kind == 0) {
#pragma unroll
              for (int j = 0; j < 4; ++j) dstp[(size_t)(row + j) * 1024 + col] = f2bf(v[j]);
            } else if (kind == 1) {
#pragma unroll
              for (int j = 0; j < 4; ++j) LORA[(size_t)(row + j) * 384 + col] = f2bf(tanhf(v[j]));
            } else if (kind == 2) {
#pragma unroll
              for (int j = 0; j < 4; ++j) LORA[(size_t)(row + j) * 384 + 128 + col] = f2bf(v[j]);
            } else {
#pragma unroll
              for (int j = 0; j < 4; ++j) LORA[(size_t)(row + j) * 384 + 256 + col] = f2bf(sigmoidf_(v[j]));
            }
          };
          auto xf = [&](float v, int row, int col) -> float { return kind == 1 ? tanhf(v) : (kind == 3 ? sigmoidf_(v) : v); };
          u16* dbase = kind == 0 ? dstp : (LORA + (kind - 1) * 128);
          const int dld = kind == 0 ? 1024 : 384;
          auto dstf = [&](int row) -> u16* { return dbase + (size_t)row * dld; };
          gemm_tile<true, 1>((const u16*)(ws + O_XN), 1024, p.in[13] + mixi * 1024, Bp, 1024, 1024, mt * 256, xf, dstf, (u16*)lds);
        }
      } break;
      case 13: {
        const u16* LORA = (const u16*)(ws + O_LORA);
        u16* G = (u16*)(ws + O_G);
        for (int t = blockIdx.x; t < 136 * 40; t += gridDim.x) {
          int mt = t / 40, nt = t % 40;
          int grp = nt >> 3, n0 = (nt & 7) * 128;
          const u16* Ap; const u16* Bp; int K, ldb;
          if (grp < 2) { Ap = LORA + grp * 64; Bp = (const u16*)(ws + O_W2) + (size_t)grp * 65536 + (size_t)n0 * 64; K = 64; ldb = 64; }
          else if (grp < 4) { Ap = LORA + 128 + (grp - 2) * 64; Bp = (const u16*)(ws + O_A2) + (size_t)(grp - 2) * 65536 + (size_t)n0 * 64; K = 64; ldb = 64; }
          else { Ap = LORA + 256; Bp = (const u16*)(ws + O_G2) + (size_t)n0 * 128; K = 128; ldb = 128; }
          int d = grp & 1;
          u8* WA = (u8*)(ws + (d ? O_WA1 : O_WA0));
          auto epi = [&](int row, int col, float v0, float v1, float v2, float v3) {
            int n = n0 + col;
            float v[4] = {v0, v1, v2, v3};
            if (grp < 2) {
              float w0 = p.in[23][d * 1024 + n];
#pragma unroll
              for (int j = 0; j < 4; ++j) {
                float x = w0 + v[j];
                float dec = __expf(-0.6065306597126334f * sigmoidf_(x));
                float q = rintf((dec - 0.5f) * 510.f);
                q = fminf(fmaxf(q, 0.f), 255.f);
                WA[(size_t)(row + j) * 2048 + (n >> 6) * 128 + (n & 63)] = (u8)q;
              }
            } else if (grp < 4) {
              float a0 = p.in[26][d * 1024 + n];
#pragma unroll
              for (int j = 0; j < 4; ++j) {
                float a = sigmoidf_(a0 + v[j]);
                float q = fminf(fmaxf(rintf(a * 255.f), 0.f), 255.f);
                WA[(size_t)(row + j) * 2048 + (n >> 6) * 128 + 64 + (n & 63)] = (u8)q;
              }
            } else {
#pragma unroll
              for (int j = 0; j < 4; ++j) G[(size_t)(row + j) * 1024 + n] = f2bf(v[j]);
            }
          };
          if (grp < 4) {
            const float* b0p = (grp < 2 ? p.in[23] : p.in[26]) + d * 1024 + n0;
            auto q8 = [&](float v, int row, int col) -> unsigned {
              float x = b0p[col] + v;
              float qv;
              if (grp < 2) { float dec = __expf(-0.6065306597126334f * sigmoidf_(x)); qv = rintf((dec - 0.5f) * 510.f); }
              else { qv = rintf(sigmoidf_(x) * 255.f); }
              return (unsigned)fminf(fmaxf(qv, 0.f), 255.f);
            };
            auto dst8 = [&](int row, int c16) -> u8* {
              int n = n0 + c16 * 16;
              return WA + (size_t)row * 2048 + (n >> 6) * 128 + (grp < 2 ? 0 : 64) + (n & 63);
            };
            gemm_tile<false, 2>(Ap, 384, nullptr, Bp, ldb, K, mt * 256, q8, dst8, (u16*)lds);
          } else {
            auto xf = [&](float v, int row, int col) -> float { return v; };
            auto dstf = [&](int row) -> u16* { return G + (size_t)row * 1024 + n0; };
            gemm_tile<false, 1>(Ap, 384, nullptr, Bp, ldb, K, mt * 256, xf, dstf, (u16*)lds);
          }
        }
      } break;
      case 14: phase_scan(p, lds, dummy); break;
      case 15:
        phase_readout(p);
        convert_tab_fp8(p.in[33] + (size_t)16384 * 1024, p.in[34] + (size_t)16384 * 1024, ws + O_TAB1);
        break;
      case 16: {
        for (int kq = 0, mt = 0, nt = 0; xcd_tile(kq, 128, 8, mt, nt); ++kq) {
          int n0 = nt * 128;
          auto epi = [&](int row, int col, float v0, float v1, float v2, float v3) {
            int n = n0 + col;
            float v[4] = {v0, v1, v2, v3};
#pragma unroll
            for (int j = 0; j < 4; ++j) {
              int rw = row + j;
              float g = mod1[(rw >> 12) * 6144 + 2048 + n];
              p.out[(size_t)rw * DM + n] += g * v[j];
            }
          };
          gemm_tile<false, 0>((const u16*)(ws + O_Z), 1024, nullptr, (const u16*)(ws + O_WO) + (size_t)n0 * 1024, 1024, 1024,
                              mt * 256, epi, 0, (u16*)lds);
        }
      } break;
      case 17: phase_norm(p, p.out, nullptr, p.in[7] + 1024, 1, 3, NLAT, (u16*)(ws + O_XN)); break;
      case 19: phase_peer_topk(p, 1, (const u16*)(ws + O_PQ1), NLAT, (int*)(ws + O_IDX1), (float*)(ws + O_GATE1), lds); break;
      case 20: phase_peer_act(p, (const u16*)(ws + O_XN), ws + O_TAB1, (const int*)(ws + O_IDX1), (const float*)(ws + O_GATE1),
                              (float*)(ws + O_COEF1), NLAT, lds); break;
      case 21: phase_peer_sum(p, 1, ws + O_TAB1, (const int*)(ws + O_IDX1), (const float*)(ws + O_COEF1), NLAT, dummy ? (float*)(ws + O_A5R) : nullptr); break;
      default: break;
    }
    }
  }
}

extern "C" void kernel_launch(void* const* d_in, const int* in_sizes, int n_in, void* d_out, int out_size, void* d_ws,
                              size_t ws_size, hipStream_t stream) {
  static int grid = 0;
  if (grid == 0) {
    if (n_in != 35 || ws_size < WS_END) {
      fprintf(stderr, "kernel_launch: unexpected n_in %d or ws_size %zu (need %zu)\n", n_in, ws_size, (size_t)WS_END);
      grid = -1;
      return;
    }
    int dev = 0, cus = 0, per_cu = 0;
    hipGetDevice(&dev);
    hipDeviceGetAttribute(&cus, hipDeviceAttributeMultiprocessorCount, dev);
    hipFuncSetAttribute((const void*)fwd_kernel, hipFuncAttributeMaxDynamicSharedMemorySize, LDS_BYTES);
    hipOccupancyMaxActiveBlocksPerMultiprocessor(&per_cu, (const void*)fwd_kernel, NT, LDS_BYTES);
    (void)hipGetLastError();
    if (per_cu < 1) per_cu = 1;
    grid = (cus / 8) * 8;
    if (grid > cus * per_cu) grid = cus * per_cu;
  }
  if (grid < 0) return;
  P p{};
  for (int i = 0; i < 35; ++i) p.in[i] = (const float*)d_in[i];
  p.out = (float*)d_out;
  p.ws = (char*)d_ws;
#if N_LAUNCH_MODE == 0
  (void)hipMemsetAsync((char*)d_ws + O_BAR, 0, 16384, stream);
  p.ph_lo = 0; p.ph_hi = NPHASE;
  void* args[] = {&p};
  hipError_t e = hipLaunchCooperativeKernel((const void*)fwd_kernel, dim3(grid), dim3(NT), args, LDS_BYTES, stream);
  if (e != hipSuccess) fprintf(stderr, "cooperative launch failed: %s (grid %d)\n", hipGetErrorString(e), grid);
#else
  for (int ph = 0; ph < NPHASE; ++ph) {
    p.ph_lo = ph; p.ph_hi = ph + 1;
    hipLaunchKernelGGL(fwd_kernel, dim3(grid), dim3(NT), LDS_BYTES, stream, p);
  }
#endif
}
```

```cpp
#include <hip/hip_runtime.h>
#include <hip/hip_cooperative_groups.h>
#include <cstdio>
namespace cg = cooperative_groups;

#ifndef N_LAUNCH_MODE
#define N_LAUNCH_MODE 0
#endif

typedef unsigned short u16;
typedef unsigned char u8;
typedef __attribute__((ext_vector_type(8))) short bf16x8;
typedef __attribute__((ext_vector_type(16))) float f32x16;

#define NT 512
#define TTOK 34816
#define NLAT 32768
#define DM 1024
#define LDSS 72
#define LDS_BYTES 149504
#define NPHASE 22
#ifndef REPEAT_MASK
#define REPEAT_MASK 0
#endif
#ifndef PHASE_MASK
#define PHASE_MASK 0x3FFFFF
#endif

static constexpr size_t MiB = 1048576;
static constexpr size_t O_WIN = 0;
static constexpr size_t O_WOUT = O_WIN + 4718592;
static constexpr size_t O_WR = O_WOUT + 2097152;
static constexpr size_t O_WK = O_WR + 2097152;
static constexpr size_t O_WV = O_WK + 2097152;
static constexpr size_t O_WO = O_WV + 2097152;
static constexpr size_t O_G1 = O_WO + 2097152;
static constexpr size_t O_G2 = O_G1 + 262144;
static constexpr size_t O_W1 = O_G2 + 262144;
static constexpr size_t O_A1 = O_W1 + 262144;
static constexpr size_t O_W2 = O_A1 + 262144;
static constexpr size_t O_A2 = O_W2 + 262144;
static constexpr size_t O_WQ = O_A2 + 262144;
static constexpr size_t O_KEYS = O_WQ + 8388608;
static constexpr size_t O_MOD = O_KEYS + 1048576;
static constexpr size_t O_ROPE = O_MOD + 442368;
static constexpr size_t SZ = 68 * MiB;
static constexpr size_t O_A1R = 26 * MiB;
static constexpr size_t O_A2R = O_A1R + SZ;
static constexpr size_t O_A3R = O_A2R + SZ;
static constexpr size_t O_A4R = O_A3R + SZ;
static constexpr size_t O_A5R = O_A4R + SZ;
static constexpr size_t O_A6R = O_A5R + SZ;
static constexpr size_t O_A7R = O_A6R + SZ;
static constexpr size_t O_LORA = O_A7R;
static constexpr size_t O_BONUS = O_A7R + 26 * MiB;
static constexpr size_t O_BAR = O_BONUS + 4 * MiB;
static constexpr size_t WS_END = O_BAR + 1 * MiB;
static constexpr size_t O_XN = O_A1R;
static constexpr size_t O_HGG = O_A2R;
static constexpr size_t O_Q = O_A2R + 102 * MiB;
static constexpr size_t O_KB = O_A4R;
static constexpr size_t O_VT = O_A4R + 9 * MiB;
static constexpr size_t O_PQ0 = O_A2R;
static constexpr size_t O_TAB0 = O_A5R;
static constexpr size_t O_IDX0 = O_A6R;
static constexpr size_t O_GATE0 = O_A6R + 17 * MiB;
static constexpr size_t O_HC = O_A6R + 34 * MiB;
static constexpr size_t O_COEF0 = O_A6R + 42 * MiB;
static constexpr size_t O_R = O_A2R, O_K = O_A3R, O_V = O_A4R;
static constexpr size_t O_WA0 = O_A5R, O_WA1 = O_A6R;
static constexpr size_t O_G = O_A1R;
static constexpr size_t O_Z = O_A2R;
static constexpr size_t O_TAB1 = O_A3R;
static constexpr size_t O_PQ1 = O_A5R;
static constexpr size_t O_IDX1 = O_A4R;
static constexpr size_t O_GATE1 = O_A4R + 17 * MiB;
static constexpr size_t O_COEF1 = O_A4R + 34 * MiB;

struct P {
  const float* in[35];
  float* out;
  char* ws;
  int ph_lo, ph_hi;
};

typedef __bf16 bf16x2_t __attribute__((ext_vector_type(2)));
typedef float f32x2_t __attribute__((ext_vector_type(2)));
__device__ __forceinline__ u16 f2bf(float f) {
  __bf16 b = (__bf16)f;
  return __builtin_bit_cast(u16, b);
}
__device__ __forceinline__ float bf2f(u16 h) { return __uint_as_float(((unsigned)h) << 16); }
__device__ __forceinline__ float bflo(unsigned w) { return __uint_as_float(w << 16); }
__device__ __forceinline__ float bfhi(unsigned w) { return __uint_as_float(w & 0xFFFF0000u); }
__device__ __forceinline__ unsigned pack2(float a, float b) { f32x2_t v = {a, b}; bf16x2_t r = __builtin_convertvector(v, bf16x2_t); return __builtin_bit_cast(unsigned, r); }

__device__ __forceinline__ int tid_() { int t = __builtin_amdgcn_workitem_id_x(); asm volatile("" : "+v"(t)); return t; }
template <int CTRL>
__device__ __forceinline__ float dppf(float v) {
  return __builtin_bit_cast(float, __builtin_amdgcn_update_dpp(0, __builtin_bit_cast(int, v), CTRL, 0xF, 0xF, true));
}
__device__ __forceinline__ float red8(float v) {
  v += dppf<0xB1>(v); v += dppf<0x4E>(v); v += dppf<0x141>(v); return v;
}
__device__ __forceinline__ float red16(float v) { v = red8(v); v += dppf<0x140>(v); return v; }
__device__ __forceinline__ float swapsum32(float a, float b) {
  auto r = __builtin_amdgcn_permlane32_swap(__float_as_uint(a), __float_as_uint(b), false, false);
  return __uint_as_float(r[0]) + __uint_as_float(r[1]);
}
__device__ __forceinline__ float swapsum16(float a, float b) {
  auto r = __builtin_amdgcn_permlane16_swap(__float_as_uint(a), __float_as_uint(b), false, false);
  return __uint_as_float(r[0]) + __uint_as_float(r[1]);
}
__device__ __forceinline__ float swapmax32(float a) {
  auto r = __builtin_amdgcn_permlane32_swap(__float_as_uint(a), __float_as_uint(a), false, false);
  return fmaxf(__uint_as_float(r[0]), __uint_as_float(r[1]));
}
__device__ __forceinline__ float swapmax16(float a) {
  auto r = __builtin_amdgcn_permlane16_swap(__float_as_uint(a), __float_as_uint(a), false, false);
  return fmaxf(__uint_as_float(r[0]), __uint_as_float(r[1]));
}
__device__ __forceinline__ float wave_sum(float v) {
  v = red16(v);
  v = swapsum16(v, v); v = swapsum32(v, v);
  return v;
}
__device__ __forceinline__ float sigmoidf_(float x) { return 1.f / (1.f + __expf(-x)); }

template <bool MIX, int OM, class Epi, class Dst>
__device__ __forceinline__ void gemm_tile(const u16* __restrict__ A, int lda, const float* __restrict__ mu,
                                          const u16* __restrict__ B, int ldb, int K, int row0, Epi epi, Dst dstf, u16* lds) {
  u16* sA = lds;
  u16* sB = lds + 256 * LDSS;
  const int tid = tid_(), lane = tid & 63, wave = tid >> 6;
  const int wm = wave & 3, wn = wave >> 2;
  const int r = lane & 31, h = lane >> 5;
  const int kc = tid & 7, lr = tid >> 3;
  f32x16 acc[2][2];
#pragma unroll
  for (int i = 0; i < 2; ++i)
#pragma unroll
    for (int j = 0; j < 2; ++j)
#pragma unroll
      for (int g = 0; g < 16; ++g) acc[i][j][g] = 0.f;
  uint4 pa0, pa1, pa2, pa3, ps0, ps1, ps2, ps3, pb0, pb1;
  ps0 = ps1 = ps2 = ps3 = make_uint4(0, 0, 0, 0);
  float4 m0 = make_float4(0, 0, 0, 0), m1 = m0;
  auto nbr = [&](int row, int kg) -> int {
    if (row < NLAT) {
      int t = row & 4095; int gc = t & 63, gr = t >> 6; int qd = kg >> 8;
      if (qd == 0) return gc > 0 ? row - 1 : -1;
      if (qd == 1) return gc < 63 ? row + 1 : -1;
      if (qd == 2) return gr > 0 ? row - 64 : -1;
      return gr < 63 ? row + 64 : -1;
    } else {
      int t = (row - NLAT) & 255;
      if (kg < 512) return t > 0 ? row - 1 : -1;
      return t < 255 ? row + 1 : -1;
    }
  };
  auto ldA = [&](int i, int k0, uint4& a, uint4& sx) {
    int row = row0 + lr + 64 * i;
    a = *(const uint4*)(A + (size_t)row * lda + k0 + kc * 8);
    if (MIX) {
      int nr = nbr(row, k0 + kc * 8);
      if (nr >= 0) sx = *(const uint4*)(A + (size_t)nr * lda + k0 + kc * 8);
      else sx = make_uint4(0, 0, 0, 0);
    }
  };
  auto gload = [&](int k0) {
    ldA(0, k0, pa0, ps0); ldA(1, k0, pa1, ps1); ldA(2, k0, pa2, ps2); ldA(3, k0, pa3, ps3);
    if (MIX) {
      m0 = *(const float4*)(mu + k0 + kc * 8);
      m1 = *(const float4*)(mu + k0 + kc * 8 + 4);
    }
    pb0 = *(const uint4*)(B + (size_t)lr * ldb + k0 + kc * 8);
    pb1 = *(const uint4*)(B + (size_t)(lr + 64) * ldb + k0 + kc * 8);
  };
  auto mixw = [&](unsigned x, unsigned s, float ma, float mb) -> unsigned {
    float x0 = bflo(x), x1 = bfhi(x), s0 = bflo(s), s1 = bfhi(s);
    return pack2(x0 + (s0 - x0) * ma, x1 + (s1 - x1) * mb);
  };
  int bo = 0;
  auto stA = [&](int i, uint4 a, uint4 sx) {
    uint4 v = a;
    if (MIX) {
      v.x = mixw(a.x, sx.x, m0.x, m0.y);
      v.y = mixw(a.y, sx.y, m0.z, m0.w);
      v.z = mixw(a.z, sx.z, m1.x, m1.y);
      v.w = mixw(a.w, sx.w, m1.z, m1.w);
    }
    *(uint4*)(sA + bo + (lr + 64 * i) * LDSS + kc * 8) = v;
  };
  auto lstore = [&]() {
    stA(0, pa0, ps0); stA(1, pa1, ps1); stA(2, pa2, ps2); stA(3, pa3, ps3);
    *(uint4*)(sB + bo + lr * LDSS + kc * 8) = pb0;
    *(uint4*)(sB + bo + (lr + 64) * LDSS + kc * 8) = pb1;
  };
  constexpr int BUFE = (256 + 128) * LDSS;
  gload(0);
  bo = 0; lstore();
  if (64 < K) gload(64);
  __syncthreads();
  for (int k0 = 0; k0 < K; k0 += 64) {
    const int co = ((k0 >> 6) & 1) * BUFE;
    bf16x8 af[2], bfr[2], naf[2], nbf[2];
#pragma unroll
    for (int i = 0; i < 2; ++i) af[i] = *(const bf16x8*)(sA + co + (wm * 64 + i * 32 + r) * LDSS + h * 8);
#pragma unroll
    for (int j = 0; j < 2; ++j) bfr[j] = *(const bf16x8*)(sB + co + (wn * 64 + j * 32 + r) * LDSS + h * 8);
#pragma unroll
    for (int kk = 0; kk < 4; ++kk) {
      if (kk == 2 && k0 + 64 < K) {
        bo = BUFE - co; lstore();
        if (k0 + 128 < K) gload(k0 + 128);
      }
      if (kk < 3) {
#pragma unroll
        for (int i = 0; i < 2; ++i) naf[i] = *(const bf16x8*)(sA + co + (wm * 64 + i * 32 + r) * LDSS + (kk + 1) * 16 + h * 8);
#pragma unroll
        for (int j = 0; j < 2; ++j) nbf[j] = *(const bf16x8*)(sB + co + (wn * 64 + j * 32 + r) * LDSS + (kk + 1) * 16 + h * 8);
      }
#pragma unroll
      for (int i = 0; i < 2; ++i)
#pragma unroll
        for (int j = 0; j < 2; ++j) {
          if (OM == 0) acc[i][j] = __builtin_amdgcn_mfma_f32_32x32x16_bf16(af[i], bfr[j], acc[i][j], 0, 0, 0);
          else acc[i][j] = __builtin_amdgcn_mfma_f32_32x32x16_bf16(bfr[j], af[i], acc[i][j], 0, 0, 0);
        }
      if (kk < 3) {
#pragma unroll
        for (int i = 0; i < 2; ++i) af[i] = naf[i];
#pragma unroll
        for (int j = 0; j < 2; ++j) bfr[j] = nbf[j];
      }
    }
    __syncthreads();
  }
  if constexpr (OM == 0) {
#pragma unroll
    for (int i = 0; i < 2; ++i)
#pragma unroll
      for (int j = 0; j < 2; ++j)
#pragma unroll
        for (int g4 = 0; g4 < 4; ++g4) {
          int row = row0 + wm * 64 + i * 32 + 8 * g4 + 4 * h;
          int col = wn * 64 + j * 32 + r;
          epi(row, col, acc[i][j][g4 * 4 + 0], acc[i][j][g4 * 4 + 1], acc[i][j][g4 * 4 + 2], acc[i][j][g4 * 4 + 3]);
        }
  } else if constexpr (OM == 1) {
    u16* st = lds;
#pragma unroll
    for (int i = 0; i < 2; ++i)
#pragma unroll
      for (int j = 0; j < 2; ++j)
#pragma unroll
        for (int g4 = 0; g4 < 4; ++g4) {
          const int rl = wm * 64 + i * 32 + r, c0 = wn * 64 + j * 32 + 8 * g4 + 4 * h;
          uint2 o;
          o.x = pack2(epi(acc[i][j][g4 * 4 + 0], row0 + rl, c0 + 0), epi(acc[i][j][g4 * 4 + 1], row0 + rl, c0 + 1));
          o.y = pack2(epi(acc[i][j][g4 * 4 + 2], row0 + rl, c0 + 2), epi(acc[i][j][g4 * 4 + 3], row0 + rl, c0 + 3));
          *(uint2*)(st + rl * 136 + c0) = o;
        }
    __syncthreads();
#pragma unroll
    for (int q = 0; q < 8; ++q) {
      const int id = tid + NT * q, rl = id >> 4, c8 = id & 15;
      const uint4 v = *(const uint4*)(st + rl * 136 + c8 * 8);
      *(uint4*)(dstf(row0 + rl) + c8 * 8) = v;
    }
    __syncthreads();
  } else if constexpr (OM == 3) {
    float* st = (float*)lds;
#pragma unroll
    for (int i = 0; i < 2; ++i)
#pragma unroll
      for (int j = 0; j < 2; ++j)
#pragma unroll
        for (int g4 = 0; g4 < 4; ++g4) {
          const int rl = wm * 64 + i * 32 + r, c0 = wn * 64 + j * 32 + 8 * g4 + 4 * h;
          *(float4*)(st + rl * 132 + c0) = make_float4(acc[i][j][g4 * 4 + 0], acc[i][j][g4 * 4 + 1], acc[i][j][g4 * 4 + 2], acc[i][j][g4 * 4 + 3]);
        }
    __syncthreads();
    {
      const int c4 = tid & 31;
      const float4 gt = *(const float4*)(epi(row0) + c4 * 4);
      float4 ov[16];
#pragma unroll
      for (int q = 0; q < 16; ++q) ov[q] = *(const float4*)(dstf(row0 + (tid >> 5) + 16 * q, 0) + c4 * 4);
#pragma unroll
      for (int q = 0; q < 16; ++q) {
        const int rl = (tid >> 5) + 16 * q;
        const float4 a = *(const float4*)(st + rl * 132 + c4 * 4);
        float4 o = ov[q];
        o.x += gt.x * a.x; o.y += gt.y * a.y; o.z += gt.z * a.z; o.w += gt.w * a.w;
        *(float4*)(dstf(row0 + rl, 1) + c4 * 4) = o;
      }
    }
    __syncthreads();
  } else {
    u8* st = (u8*)lds;
#pragma unroll
    for (int i = 0; i < 2; ++i)
#pragma unroll
      for (int j = 0; j < 2; ++j)
#pragma unroll
        for (int g4 = 0; g4 < 4; ++g4) {
          const int rl = wm * 64 + i * 32 + r, c0 = wn * 64 + j * 32 + 8 * g4 + 4 * h;
          unsigned o = epi(acc[i][j][g4 * 4 + 0], row0 + rl, c0 + 0) | (epi(acc[i][j][g4 * 4 + 1], row0 + rl, c0 + 1) << 8) |
                       (epi(acc[i][j][g4 * 4 + 2], row0 + rl, c0 + 2) << 16) | (epi(acc[i][j][g4 * 4 + 3], row0 + rl, c0 + 3) << 24);
          *(unsigned*)(st + rl * 144 + c0) = o;
        }
    __syncthreads();
#pragma unroll
    for (int q = 0; q < 4; ++q) {
      const int id = tid + NT * q, rl = id >> 3, c16 = id & 7;
      const uint4 v = *(const uint4*)(st + rl * 144 + c16 * 16);
      *(uint4*)(dstf(row0 + rl, c16)) = v;
    }
    __syncthreads();
  }
}

template <bool MIX, class Epi, class Dst>
__device__ __forceinline__ void gemm_tile256(const u16* __restrict__ A, int lda, const float* __restrict__ mu,
                                             const u16* __restrict__ B, int ldb, int K, int row0, Epi epi, Dst dstf, u16* lds) {
  u16* sA = lds;
  u16* sB = lds + 256 * LDSS;
  const int tid = tid_(), lane = tid & 63, wave = tid >> 6;
  const int wm = wave & 1, wn = wave >> 1;
  const int r = lane & 31, h = lane >> 5;
  const int kc = tid & 7, lr = tid >> 3;
  f32x16 acc[4][2];
#pragma unroll
  for (int i = 0; i < 4; ++i)
#pragma unroll
    for (int j = 0; j < 2; ++j)
#pragma unroll
      for (int g = 0; g < 16; ++g) acc[i][j][g] = 0.f;
  uint4 pa0, pa1, pa2, pa3, ps0, ps1, ps2, ps3, pb0, pb1, pb2, pb3;
  ps0 = ps1 = ps2 = ps3 = make_uint4(0, 0, 0, 0);
  float4 m0 = make_float4(0, 0, 0, 0), m1 = m0;
  auto nbr = [&](int row, int kg) -> int {
    if (row < NLAT) {
      int t = row & 4095; int gc = t & 63, gr = t >> 6; int qd = kg >> 8;
      if (qd == 0) return gc > 0 ? row - 1 : -1;
      if (qd == 1) return gc < 63 ? row + 1 : -1;
      if (qd == 2) return gr > 0 ? row - 64 : -1;
      return gr < 63 ? row + 64 : -1;
    } else {
      int t = (row - NLAT) & 255;
      if (kg < 512) return t > 0 ? row - 1 : -1;
      return t < 255 ? row + 1 : -1;
    }
  };
  auto ldA = [&](int i, int k0, uint4& a, uint4& sx) {
    int row = row0 + lr + 64 * i;
    a = *(const uint4*)(A + (size_t)row * lda + k0 + kc * 8);
    if (MIX) {
      int nr = nbr(row, k0 + kc * 8);
      if (nr >= 0) sx = *(const uint4*)(A + (size_t)nr * lda + k0 + kc * 8);
      else sx = make_uint4(0, 0, 0, 0);
    }
  };
  auto gload = [&](int k0) {
    ldA(0, k0, pa0, ps0); ldA(1, k0, pa1, ps1); ldA(2, k0, pa2, ps2); ldA(3, k0, pa3, ps3);
    if (MIX) {
      m0 = *(const float4*)(mu + k0 + kc * 8);
      m1 = *(const float4*)(mu + k0 + kc * 8 + 4);
    }
    pb0 = *(const uint4*)(B + (size_t)lr * ldb + k0 + kc * 8);
    pb1 = *(const uint4*)(B + (size_t)(lr + 64) * ldb + k0 + kc * 8);
    pb2 = *(const uint4*)(B + (size_t)(lr + 128) * ldb + k0 + kc * 8);
    pb3 = *(const uint4*)(B + (size_t)(lr + 192) * ldb + k0 + kc * 8);
  };
  auto mixw = [&](unsigned x, unsigned s_, float ma, float mb) -> unsigned {
    float x0 = bflo(x), x1 = bfhi(x), s0 = bflo(s_), s1 = bfhi(s_);
    return pack2(x0 + (s0 - x0) * ma, x1 + (s1 - x1) * mb);
  };
  int bo = 0;
  auto stA = [&](int i, uint4 a, uint4 sx) {
    uint4 v = a;
    if (MIX) {
      v.x = mixw(a.x, sx.x, m0.x, m0.y);
      v.y = mixw(a.y, sx.y, m0.z, m0.w);
      v.z = mixw(a.z, sx.z, m1.x, m1.y);
      v.w = mixw(a.w, sx.w, m1.z, m1.w);
    }
    *(uint4*)(sA + bo + (lr + 64 * i) * LDSS + kc * 8) = v;
  };
  auto lstore = [&]() {
    stA(0, pa0, ps0); stA(1, pa1, ps1); stA(2, pa2, ps2); stA(3, pa3, ps3);
    *(uint4*)(sB + bo + lr * LDSS + kc * 8) = pb0;
    *(uint4*)(sB + bo + (lr + 64) * LDSS + kc * 8) = pb1;
    *(uint4*)(sB + bo + (lr + 128) * LDSS + kc * 8) = pb2;
    *(uint4*)(sB + bo + (lr + 192) * LDSS + kc * 8) = pb3;
  };
  constexpr int BUFE = 2 * 256 * LDSS;
  gload(0);
  bo = 0; lstore();
  if (64 < K) gload(64);
  __syncthreads();
  for (int k0 = 0; k0 < K; k0 += 64) {
    const int co = ((k0 >> 6) & 1) * BUFE;
    bf16x8 af[4], bfr[2], naf[4], nbf[2];
#pragma unroll
    for (int i = 0; i < 4; ++i) af[i] = *(const bf16x8*)(sA + co + (wm * 128 + i * 32 + r) * LDSS + h * 8);
#pragma unroll
    for (int j = 0; j < 2; ++j) bfr[j] = *(const bf16x8*)(sB + co + (wn * 64 + j * 32 + r) * LDSS + h * 8);
#pragma unroll
    for (int kk = 0; kk < 4; ++kk) {
      if (kk == 2 && k0 + 64 < K) {
        bo = BUFE - co; lstore();
        if (k0 + 128 < K) gload(k0 + 128);
      }
      if (kk < 3) {
#pragma unroll
        for (int i = 0; i < 4; ++i) naf[i] = *(const bf16x8*)(sA + co + (wm * 128 + i * 32 + r) * LDSS + (kk + 1) * 16 + h * 8);
#pragma unroll
        for (int j = 0; j < 2; ++j) nbf[j] = *(const bf16x8*)(sB + co + (wn * 64 + j * 32 + r) * LDSS + (kk + 1) * 16 + h * 8);
      }
#pragma unroll
      for (int i = 0; i < 4; ++i)
#pragma unroll
        for (int j = 0; j < 2; ++j) acc[i][j] = __builtin_amdgcn_mfma_f32_32x32x16_bf16(bfr[j], af[i], acc[i][j], 0, 0, 0);
      if (kk < 3) {
#pragma unroll
        for (int i = 0; i < 4; ++i) af[i] = naf[i];
#pragma unroll
        for (int j = 0; j < 2; ++j) bfr[j] = nbf[j];
      }
    }
    __syncthreads();
  }
  u16* st = lds;
#pragma unroll
  for (int half = 0; half < 2; ++half) {
    if ((wn >> 1) == half) {
#pragma unroll
      for (int i = 0; i < 4; ++i)
#pragma unroll
        for (int j = 0; j < 2; ++j)
#pragma unroll
          for (int g4 = 0; g4 < 4; ++g4) {
            const int rl = wm * 128 + i * 32 + r, cl = (wn & 1) * 64 + j * 32 + 8 * g4 + 4 * h, c0 = half * 128 + cl;
            uint2 o;
            o.x = pack2(epi(acc[i][j][g4 * 4 + 0], row0 + rl, c0 + 0), epi(acc[i][j][g4 * 4 + 1], row0 + rl, c0 + 1));
            o.y = pack2(epi(acc[i][j][g4 * 4 + 2], row0 + rl, c0 + 2), epi(acc[i][j][g4 * 4 + 3], row0 + rl, c0 + 3));
            *(uint2*)(st + rl * 136 + cl) = o;
          }
    }
    __syncthreads();
#pragma unroll
    for (int q = 0; q < 8; ++q) {
      const int id = tid + NT * q, rl = id >> 4, c8 = id & 15;
      const uint4 v = *(const uint4*)(st + rl * 136 + c8 * 8);
      *(uint4*)(dstf(row0 + rl) + half * 128 + c8 * 8) = v;
    }
    __syncthreads();
  }
}

__constant__ int TJOBS[18][5] = {
    {8, 0, 1024, 2304, (int)O_WIN},
    {12, 0, 1024, 1024, (int)O_WOUT},
    {14, 0, 1024, 1024, (int)O_WR},
    {15, 0, 1024, 1024, (int)O_WK},
    {16, 0, 1024, 1024, (int)O_WV},
    {17, 0, 1024, 1024, (int)O_WO},
    {18, 0, 1024, 128, (int)O_G1},
    {19, 0, 128, 1024, (int)O_G2},
    {24, 0, 1024, 64, (int)O_W1},
    {24, 65536, 1024, 64, (int)(O_W1 + 131072)},
    {27, 0, 1024, 64, (int)O_A1},
    {27, 65536, 1024, 64, (int)(O_A1 + 131072)},
    {25, 0, 64, 1024, (int)O_W2},
    {25, 65536, 64, 1024, (int)(O_W2 + 131072)},
    {28, 0, 64, 1024, (int)O_A2},
    {28, 65536, 64, 1024, (int)(O_A2 + 131072)},
    {31, 0, 1024, 2048, (int)O_WQ},
    {31, 2097152, 1024, 2048, (int)(O_WQ + 4194304)},
};

__device__ __forceinline__ void convert_bf16(const float* __restrict__ src, u16* __restrict__ dst, size_t n) {
  size_t n4 = n >> 2;
  for (size_t i = (size_t)blockIdx.x * NT + tid_(); i < n4; i += (size_t)gridDim.x * NT) {
    float4 v = ((const float4*)src)[i];
    uint2 o; o.x = pack2(v.x, v.y); o.y = pack2(v.z, v.w);
    ((uint2*)dst)[i] = o;
  }
}

__device__ __forceinline__ void convert_tab_fp8(const float* __restrict__ U, const float* __restrict__ V, char* tab);
__device__ __forceinline__ void phase_prep(const P& p, char* lds) {
  const int tid = tid_();
  float* fl = (float*)lds;
  for (int task = blockIdx.x; task < 192; task += gridDim.x) {
    int l = task / 96, cg_ = task % 96;
    float* sv = fl;
    float* red = fl + 9216;
    for (int i = tid; i < 9216; i += NT) {
      int v = i >> 10, k = i & 1023;
      float x = v < 8 ? p.in[1][v * 1024 + k] : p.in[3][k];
      sv[i] = x / (1.f + __expf(-x));
    }
    __syncthreads();
    int col = cg_ * 64 + (tid & 63), kg = tid >> 6;
    float acc[9];
#pragma unroll
    for (int v = 0; v < 9; ++v) acc[v] = 0.f;
    const float* W = p.in[4] + (size_t)l * 1024 * 6144 + col;
    for (int k = kg * 128; k < kg * 128 + 128; ++k) {
      float w = W[(size_t)k * 6144];
#pragma unroll
      for (int v = 0; v < 9; ++v) acc[v] += sv[v * 1024 + k] * w;
    }
#pragma unroll
    for (int v = 0; v < 9; ++v) red[(kg * 9 + v) * 64 + (tid & 63)] = acc[v];
    __syncthreads();
    if (tid < 576) {
      int v = tid >> 6, c = tid & 63;
      float s = p.in[5][l * 6144 + cg_ * 64 + c];
#pragma unroll
      for (int g = 0; g < 8; ++g) s += red[(g * 9 + v) * 64 + c];
      ((float*)(p.ws + O_MOD))[(l * 9 + v) * 6144 + cg_ * 64 + c] = s;
    }
    __syncthreads();
  }
  {
    int base = 0;
    for (int j = 0; j < 18; ++j) {
      int K = TJOBS[j][2], N = TJOBS[j][3];
      int tk = K >> 6, tn = N >> 6, nt = tk * tn;
      const float* src = p.in[TJOBS[j][0]] + TJOBS[j][1];
      u16* dst = (u16*)(p.ws + (size_t)(unsigned)TJOBS[j][4]);
      int first = (blockIdx.x + gridDim.x - (base % gridDim.x)) % gridDim.x;
      for (int t = first; t < nt; t += gridDim.x) {
        int k0 = (t / tn) * 64, n0 = (t % tn) * 64;
#pragma unroll
        for (int rep = 0; rep < 8; ++rep) {
          int idx = tid + NT * rep; int i = idx >> 6, jj = idx & 63;
          fl[i * 65 + jj] = src[(size_t)(k0 + i) * N + n0 + jj];
        }
        __syncthreads();
        int n = tid >> 3, c8 = tid & 7;
        uint4 o;
        o.x = pack2(fl[(c8 * 8 + 0) * 65 + n], fl[(c8 * 8 + 1) * 65 + n]);
        o.y = pack2(fl[(c8 * 8 + 2) * 65 + n], fl[(c8 * 8 + 3) * 65 + n]);
        o.z = pack2(fl[(c8 * 8 + 4) * 65 + n], fl[(c8 * 8 + 5) * 65 + n]);
        o.w = pack2(fl[(c8 * 8 + 6) * 65 + n], fl[(c8 * 8 + 7) * 65 + n]);
        *(uint4*)(dst + (size_t)(n0 + n) * K + k0 + c8 * 8) = o;
        __syncthreads();
      }
      base += nt;
    }
  }
  convert_bf16(p.in[32], (u16*)(p.ws + O_KEYS), (size_t)2 * 8 * 2 * 128 * 128);
  convert_tab_fp8(p.in[33], p.in[34], p.ws + O_TAB0);
  if (blockIdx.x == 0) {
    float* rope = (float*)(p.ws + O_ROPE);
    for (int i = tid; i < 1024; i += NT) {
      int pos = i >> 4, f = i & 15;
      float inv = exp2f(-(float)f * (13.287712379549449f / 16.f));
      float ang = (float)pos * inv;
      rope[i * 2] = cosf(ang);
      rope[i * 2 + 1] = sinf(ang);
    }
  }
}

__device__ __forceinline__ void phase_norm(const P& p, const float* srcL, const float* srcC, const float* gain, int layer, int shift_idx,
                           int nrows, u16* dst) {
  const int lane = tid_() & 63;
  const int gw = blockIdx.x * 8 + (tid_() >> 6), nw = gridDim.x * 8;
  const float* mod = (const float*)(p.ws + O_MOD) + (size_t)layer * 9 * 6144;
  for (int row = gw; row < nrows; row += nw) {
    const float* src = row < NLAT ? srcL + (size_t)row * DM : srcC + (size_t)(row - NLAT) * DM;
    int mi = row < NLAT ? (row >> 12) : 8;
    const float* sh = mod + mi * 6144 + shift_idx * 1024;
    const float* sc = sh + 1024;
    float4 v[4], gq[4], s1q[4], s0q[4];
    float ss = 0.f;
#pragma unroll
    for (int i = 0; i < 4; ++i) {
      v[i] = *(const float4*)(src + i * 256 + lane * 4);
      gq[i] = *(const float4*)(gain + i * 256 + lane * 4);
      s1q[i] = *(const float4*)(sc + i * 256 + lane * 4);
      s0q[i] = *(const float4*)(sh + i * 256 + lane * 4);
    }
#pragma unroll
    for (int i = 0; i < 4; ++i) ss += v[i].x * v[i].x + v[i].y * v[i].y + v[i].z * v[i].z + v[i].w * v[i].w;
    ss = wave_sum(ss);
    float rs = rsqrtf(ss * (1.f / 1024.f) + 1e-6f);
#pragma unroll
    for (int i = 0; i < 4; ++i) {
      int c = i * 256 + lane * 4;
      const float4 g = gq[i], s1 = s1q[i], s0 = s0q[i];
      float a = v[i].x * rs * g.x * (1.f + s1.x) + s0.x;
      float b = v[i].y * rs * g.y * (1.f + s1.y) + s0.y;
      float cc = v[i].z * rs * g.z * (1.f + s1.z) + s0.z;
      float d = v[i].w * rs * g.w * (1.f + s1.w) + s0.w;
      uint2 o; o.x = pack2(a, b); o.y = pack2(cc, d);
      *(uint2*)(dst + (size_t)row * DM + c) = o;
    }
  }
}

__device__ __forceinline__ void phase_conv_qk(const P& p) {
  const u16* hgg = (const u16*)(p.ws + O_HGG);
  u16* mix = (u16*)(p.ws + O_XN);
  const float* cw = p.in[9];
  const size_t gt = (size_t)blockIdx.x * NT + tid_(), gn = (size_t)gridDim.x * NT;
  for (size_t it = gt; it < (size_t)TTOK * 64; it += gn) {
    int row = (int)(it >> 6), c0 = (int)(it & 63) * 8;
    int t, len;
    if (row < NLAT) { t = row & 4095; len = 4096; } else { t = (row - NLAT) & 255; len = 256; }
    float pm[8], pc[8], pp[8];
    {
      const u16* b = hgg + (size_t)row * 1536;
      uint4 hh = *(const uint4*)(b + c0), gc = *(const uint4*)(b + 1024 + c0);
      pc[0] = bflo(hh.x) * bflo(gc.x); pc[1] = bfhi(hh.x) * bfhi(gc.x);
      pc[2] = bflo(hh.y) * bflo(gc.y); pc[3] = bfhi(hh.y) * bfhi(gc.y);
      pc[4] = bflo(hh.z) * bflo(gc.z); pc[5] = bfhi(hh.z) * bfhi(gc.z);
      pc[6] = bflo(hh.w) * bflo(gc.w); pc[7] = bfhi(hh.w) * bfhi(gc.w);
    }
    if (t > 0) {
      const u16* b = hgg + (size_t)(row - 1) * 1536;
      uint4 hh = *(const uint4*)(b + c0), gc = *(const uint4*)(b + 1024 + c0);
      pm[0] = bflo(hh.x) * bflo(gc.x); pm[1] = bfhi(hh.x) * bfhi(gc.x);
      pm[2] = bflo(hh.y) * bflo(gc.y); pm[3] = bfhi(hh.y) * bfhi(gc.y);
      pm[4] = bflo(hh.z) * bflo(gc.z); pm[5] = bfhi(hh.z) * bfhi(gc.z);
      pm[6] = bflo(hh.w) * bflo(gc.w); pm[7] = bfhi(hh.w) * bfhi(gc.w);
    } else {
#pragma unroll
      for (int e = 0; e < 8; ++e) pm[e] = 0.f;
    }
    if (t < len - 1) {
      const u16* b = hgg + (size_t)(row + 1) * 1536;
      uint4 hh = *(const uint4*)(b + c0), gc = *(const uint4*)(b + 1024 + c0);
      pp[0] = bflo(hh.x) * bflo(gc.x); pp[1] = bfhi(hh.x) * bfhi(gc.x);
      pp[2] = bflo(hh.y) * bflo(gc.y); pp[3] = bfhi(hh.y) * bfhi(gc.y);
      pp[4] = bflo(hh.z) * bflo(gc.z); pp[5] = bfhi(hh.z) * bfhi(gc.z);
      pp[6] = bflo(hh.w) * bflo(gc.w); pp[7] = bfhi(hh.w) * bfhi(gc.w);
    } else {
#pragma unroll
      for (int e = 0; e < 8; ++e) pp[e] = 0.f;
    }
    uint4 gbv = *(const uint4*)(hgg + (size_t)row * 1536 + 512 + c0);
    float gb[8] = {bflo(gbv.x), bfhi(gbv.x), bflo(gbv.y), bfhi(gbv.y), bflo(gbv.z), bfhi(gbv.z), bflo(gbv.w), bfhi(gbv.w)};
    float o[8];
#pragma unroll
    for (int e = 0; e < 8; ++e)
      o[e] = gb[e] * (cw[c0 + e] * pm[e] + cw[512 + c0 + e] * pc[e] + cw[1024 + c0 + e] * pp[e]);
    uint4 ov; ov.x = pack2(o[0], o[1]); ov.y = pack2(o[2], o[3]); ov.z = pack2(o[4], o[5]); ov.w = pack2(o[6], o[7]);
    *(uint4*)(mix + (size_t)row * DM + c0) = ov;
  }
  u16* Q = (u16*)(p.ws + O_Q);
  u16* KBp = (u16*)(p.ws + O_KB);
  const float* rope = (const float*)(p.ws + O_ROPE);
  const size_t ngroups = (size_t)TTOK * 10;
  for (size_t it = gt; it < ngroups * 8; it += gn) {
    size_t grp = it >> 3; int sub = (int)(it & 7);
    int row = (int)(grp / 10), hd = (int)(grp % 10);
    u16* ptr; const float* gain;
    if (hd < 8) { ptr = Q + (size_t)row * 512 + hd * 64 + sub * 8; gain = p.in[10]; }
    else { ptr = KBp + (size_t)row * 128 + (hd - 8) * 64 + sub * 8; gain = p.in[11]; }
    uint4 v = *(const uint4*)ptr;
    float x[8] = {bflo(v.x), bfhi(v.x), bflo(v.y), bfhi(v.y), bflo(v.z), bfhi(v.z), bflo(v.w), bfhi(v.w)};
    float ss = 0.f;
#pragma unroll
    for (int e = 0; e < 8; ++e) ss += x[e] * x[e];
    ss = red8(ss);
    float rs = rsqrtf(ss * (1.f / 64.f) + 1e-6f);
#pragma unroll
    for (int e = 0; e < 8; ++e) x[e] = x[e] * rs * gain[sub * 8 + e];
    if (row < NLAT) {
      int t = row & 4095; int gr = t >> 6, gc = t & 63;
#pragma unroll
      for (int e = 0; e < 4; ++e) {
        int pi = sub * 4 + e;
        int pos = pi < 16 ? gr : gc; int f = pi & 15;
        float c = rope[(pos * 16 + f) * 2], s = rope[(pos * 16 + f) * 2 + 1];
        float a = x[2 * e], b = x[2 * e + 1];
        x[2 * e] = a * c - b * s;
        x[2 * e + 1] = a * s + b * c;
      }
    }
    uint4 ov; ov.x = pack2(x[0], x[1]); ov.y = pack2(x[2], x[3]); ov.z = pack2(x[4], x[5]); ov.w = pack2(x[6], x[7]);
    *(uint4*)ptr = ov;
  }
}

__device__ __forceinline__ void phase_attn(const P& p, char* lds) {
  u16* sK = (u16*)lds;
  u16* sV = sK + 64 * LDSS;
  const u16* Q = (const u16*)(p.ws + O_Q);
  const u16* KBp = (const u16*)(p.ws + O_KB);
  const u16* VT = (const u16*)(p.ws + O_VT);
  u16* mix = (u16*)(p.ws + O_XN);
  const int tid = tid_(), lane = tid & 63, wave = tid >> 6;
  const int r = lane & 31, h = lane >> 5;
  const float cs = 0.125f * 1.4426950408889634f;
  for (int item = blockIdx.x; item < 1088; item += gridDim.x) {
    int b, qh, qrow0, nkt;
    if (item < 1024) { b = item >> 7; qh = (item >> 4) & 7; qrow0 = b * 4096 + (item & 15) * 256; nkt = 68; }
    else { int i2 = item - 1024; b = i2 >> 3; qh = i2 & 7; qrow0 = NLAT + b * 256; nkt = 4; }
    const int kvh = qh >> 2;
    const int qrow = qrow0 + wave * 32 + r;
    bf16x8 qf[4];
#pragma unroll
    for (int kk = 0; kk < 4; ++kk) qf[kk] = *(const bf16x8*)(Q + (size_t)qrow * 512 + qh * 64 + kk * 16 + h * 8);
    f32x16 o[2];
#pragma unroll
    for (int g = 0; g < 16; ++g) { o[0][g] = 0.f; o[1][g] = 0.f; }
    float m = -INFINITY, l = 0.f;
    const int lkey = tid >> 3, lch = tid & 7;
    uint4 ka, va;
    auto gl = [&](int kt) {
      int pos = kt * 64 + lkey;
      int krow = pos < 256 ? NLAT + b * 256 + pos : b * 4096 + pos - 256;
      ka = *(const uint4*)(KBp + (size_t)krow * 128 + kvh * 64 + lch * 8);
      va = *(const uint4*)(VT + ((size_t)((b * 2 + kvh) * 64 + lkey)) * 4352 + kt * 64 + lch * 8);
    };
    gl(0);
    for (int kt = 0; kt < nkt; ++kt) {
      *(uint4*)(sK + lkey * LDSS + lch * 8) = ka;
      *(uint4*)(sV + lkey * LDSS + lch * 8) = va;
      __syncthreads();
      if (kt + 1 < nkt) gl(kt + 1);
      f32x16 s[2];
#pragma unroll
      for (int g = 0; g < 16; ++g) { s[0][g] = 0.f; s[1][g] = 0.f; }
#pragma unroll
      for (int kb = 0; kb < 2; ++kb)
#pragma unroll
        for (int kk = 0; kk < 4; ++kk) {
          bf16x8 a = *(const bf16x8*)(sK + (kb * 32 + r) * LDSS + kk * 16 + h * 8);
          s[kb] = __builtin_amdgcn_mfma_f32_32x32x16_bf16(a, qf[kk], s[kb], 0, 0, 0);
        }
      float mx = s[0][0];
#pragma unroll
      for (int g = 0; g < 16; ++g) { mx = fmaxf(mx, s[0][g]); mx = fmaxf(mx, s[1][g]); }
      mx = swapmax32(mx);
      float mn = fmaxf(m, mx);
      float alpha = __builtin_amdgcn_exp2f((m - mn) * cs);
      m = mn;
      float mc = mn * cs, ps = 0.f;
#pragma unroll
      for (int kb = 0; kb < 2; ++kb)
#pragma unroll
        for (int g = 0; g < 16; ++g) { float e = __builtin_amdgcn_exp2f(s[kb][g] * cs - mc); s[kb][g] = e; ps += e; }
      l = l * alpha + ps;
#pragma unroll
      for (int g = 0; g < 16; ++g) { o[0][g] *= alpha; o[1][g] *= alpha; }
      bf16x8 pb[2][2];
#pragma unroll
      for (int kb = 0; kb < 2; ++kb)
#pragma unroll
        for (int c = 0; c < 2; ++c) {
          uint4 pk;
          pk.x = pack2(s[kb][8 * c + 0], s[kb][8 * c + 1]); pk.y = pack2(s[kb][8 * c + 2], s[kb][8 * c + 3]);
          pk.z = pack2(s[kb][8 * c + 4], s[kb][8 * c + 5]); pk.w = pack2(s[kb][8 * c + 6], s[kb][8 * c + 7]);
          pb[kb][c] = __builtin_bit_cast(bf16x8, pk);
        }
#pragma unroll
      for (int db = 0; db < 2; ++db)
#pragma unroll
        for (int kb = 0; kb < 2; ++kb)
#pragma unroll
          for (int c = 0; c < 2; ++c) {
            const u16* vp = sV + (db * 32 + r) * LDSS + kb * 32 + 16 * c + 4 * h;
            uint2 lo = *(const uint2*)vp, hi = *(const uint2*)(vp + 8);
            uint4 av = make_uint4(lo.x, lo.y, hi.x, hi.y);
            o[db] = __builtin_amdgcn_mfma_f32_32x32x16_bf16(__builtin_bit_cast(bf16x8, av), pb[kb][c], o[db], 0, 0, 0);
          }
      __syncthreads();
    }
    l = swapsum32(l, l);
    float inv = 1.f / l;
#pragma unroll
    for (int db = 0; db < 2; ++db)
#pragma unroll
      for (int g4 = 0; g4 < 4; ++g4) {
        int d = db * 32 + 8 * g4 + 4 * h;
        uint2 ov;
        ov.x = pack2(o[db][g4 * 4 + 0] * inv, o[db][g4 * 4 + 1] * inv);
        ov.y = pack2(o[db][g4 * 4 + 2] * inv, o[db][g4 * 4 + 3] * inv);
        *(uint2*)(mix + (size_t)qrow * DM + 512 + qh * 64 + d) = ov;
      }
  }
}

__device__ __forceinline__ int fkey(float f) { int b = __float_as_int(f); return b ^ ((b >> 31) & 0x7FFFFFFF); }
__device__ __forceinline__ float keyf(int k) { return __int_as_float(k ^ ((k >> 31) & 0x7FFFFFFF)); }

#define CE_DESC(a, b) { int hi__ = max(a, b); int lo__ = min(a, b); a = hi__; b = lo__; }
#define BITONIC_SORT16(r)                                                          \
  _Pragma("unroll") for (int k_ = 2; k_ <= 16; k_ <<= 1)                           \
    _Pragma("unroll") for (int j_ = k_ >> 1; j_ > 0; j_ >>= 1)                     \
      _Pragma("unroll") for (int i_ = 0; i_ < 16; ++i_) {                          \
        const int l_ = i_ ^ j_;                                                    \
        if (l_ > i_) { if ((i_ & k_) == 0) CE_DESC(r[i_], r[l_]) else CE_DESC(r[l_], r[i_]) } \
      }
#define BITONIC_MERGE16(r)                                                         \
  _Pragma("unroll") for (int j_ = 8; j_ > 0; j_ >>= 1)                             \
    _Pragma("unroll") for (int i_ = 0; i_ < 16; ++i_) {                            \
      const int l_ = i_ ^ j_;                                                      \
      if (l_ > i_) CE_DESC(r[i_], r[l_])                                           \
    }
#define XLANE_MERGE16(r, CTRL)                                                     \
  {                                                                                \
    int o_[16];                                                                    \
    _Pragma("unroll") for (int i_ = 0; i_ < 16; ++i_) o_[i_] = __builtin_amdgcn_update_dpp(0, r[15 - i_], CTRL, 0xF, 0xF, true); \
    _Pragma("unroll") for (int i_ = 0; i_ < 16; ++i_) r[i_] = max(r[i_], o_[i_]);  \
    BITONIC_MERGE16(r)                                                             \
  }
#define SCS 132
__device__ __forceinline__ void phase_peer_topk(const P& p, int layer, const u16* PQ, int ntok, int* IDX, float* GATE, char* lds) {
  float* sc = (float*)lds;
  int* lists = (int*)(lds + 2 * 64 * SCS * 4);
  u16* sq = (u16*)(lds + 2 * 64 * SCS * 4 + 8192);
  const int tid = tid_(), lane = tid & 63, wave = tid >> 6;
  const int r = lane & 31, h = lane >> 5;
  const u16* keys = (const u16*)(p.ws + O_KEYS) + (size_t)layer * 8 * 2 * 128 * 128;
  const int ntile = (ntok >> 6) * 8;
  for (int tile = blockIdx.x; tile < ntile; tile += gridDim.x) {
    int hd = tile & 7, row0 = (tile >> 3) * 64;
    {
#pragma unroll
      for (int q = 0; q < 4; ++q) {
        const int id = tid + NT * q, rw = id >> 5, c = id & 31;
        const uint4 v = *(const uint4*)(PQ + (size_t)(row0 + rw) * 2048 + hd * 256 + c * 8);
        *(uint4*)(sq + ((c >> 4) * 64 + rw) * 136 + (c & 15) * 8) = v;
      }
    }
    __syncthreads();
    {
      int pp = wave >> 2, kb = wave & 3;
      f32x16 acc[2];
#pragma unroll
      for (int g = 0; g < 16; ++g) { acc[0][g] = 0.f; acc[1][g] = 0.f; }
      const u16* kp = keys + ((size_t)(hd * 2 + pp) * 128 + kb * 32 + r) * 128 + h * 8;
      const u16* qp = sq + (pp * 64 + r) * 136 + h * 8;
#pragma unroll
      for (int kk = 0; kk < 8; ++kk) {
        bf16x8 bfr = *(const bf16x8*)(kp + kk * 16);
        bf16x8 a0 = *(const bf16x8*)(qp + kk * 16);
        bf16x8 a1 = *(const bf16x8*)(qp + 32 * 136 + kk * 16);
        acc[0] = __builtin_amdgcn_mfma_f32_32x32x16_bf16(a0, bfr, acc[0], 0, 0, 0);
        acc[1] = __builtin_amdgcn_mfma_f32_32x32x16_bf16(a1, bfr, acc[1], 0, 0, 0);
      }
#pragma unroll
      for (int mb = 0; mb < 2; ++mb)
#pragma unroll
        for (int g = 0; g < 16; ++g) {
          int tok = mb * 32 + (g & 3) + 8 * (g >> 2) + 4 * h;
          sc[(pp * 64 + tok) * SCS + kb * 32 + r] = acc[mb][g];
        }
    }
    __syncthreads();
    {
      const int row = tid >> 2, qd = tid & 3;
      const float* rowp = sc + row * SCS + qd;
      int A[16], B[16];
#pragma unroll
      for (int m = 0; m < 16; ++m) {
        A[m] = (fkey(rowp[4 * m]) & ~0x7F) | (127 - (4 * m + qd));
        B[m] = (fkey(rowp[64 + 4 * m]) & ~0x7F) | (127 - (64 + 4 * m + qd));
      }
      BITONIC_SORT16(A)
      BITONIC_SORT16(B)
#pragma unroll
      for (int i = 0; i < 16; ++i) A[i] = max(A[i], B[15 - i]);
      BITONIC_MERGE16(A)
      XLANE_MERGE16(A, 0xB1)
      XLANE_MERGE16(A, 0x4E)
      if (qd == 0) {
#pragma unroll
        for (int i = 0; i < 16; i += 4) *(int4*)(lists + row * 16 + i) = make_int4(A[i], A[i + 1], A[i + 2], A[i + 3]);
      }
    }
    __syncthreads();
    if (tid < 256) {
      const int tok = tid >> 2, q = tid & 3;
      float bq[16];
#pragma unroll
      for (int j = 0; j < 16; ++j) bq[j] = keyf(lists[(64 + tok) * 16 + j] & ~0x7F);
      int R[16];
#pragma unroll
      for (int i = 0; i < 16; ++i) R[i] = (int)0x80000000;
#pragma unroll
      for (int m = 0; m < 4; ++m) {
        const int i = q + 4 * m;
        const float ai = keyf(lists[tok * 16 + i] & ~0x7F);
        const int jmax = 16 / (i + 1);
        const int nj = m == 0 ? 16 : (m == 1 ? 3 : 1);
#pragma unroll
        for (int j = 0; j < nj; ++j) {
          int x = (fkey(ai + bq[j]) & ~0xFF) | (255 - (i * 16 + j));
          x = j < jmax ? x : (int)0x80000000;
#pragma unroll
          for (int t = 0; t < 16; ++t) { int hi_ = max(R[t], x); x = min(R[t], x); R[t] = hi_; }
        }
      }
      XLANE_MERGE16(R, 0xB1)
      XLANE_MERGE16(R, 0x4E)
      float sv[16];
      float mx = keyf(R[0] & ~0xFF), sum = 0.f;
#pragma unroll
      for (int t = 0; t < 16; ++t) { sv[t] = __expf(keyf(R[t] & ~0xFF) - mx); sum += sv[t]; }
      float inv = 1.f / sum;
      size_t ob = (size_t)(row0 + tok) * 128 + hd * 16;
#pragma unroll
      for (int t = 0; t < 16; ++t) {
        if ((t >> 2) == q) {
          int pos = 255 - (R[t] & 0xFF);
          int i1 = 127 - (lists[tok * 16 + (pos >> 4)] & 0x7F);
          int i2 = 127 - (lists[(64 + tok) * 16 + (pos & 15)] & 0x7F);
          IDX[ob + t] = i1 * 128 + i2;
          GATE[ob + t] = sv[t] * inv;
        }
      }
    }
    __syncthreads();
  }
}

typedef __attribute__((ext_vector_type(2))) float f2;
#define TAB_V8 (16 * MiB)
#define TAB_SU (32 * MiB)
#define TAB_SV (32 * MiB + 65536)
__device__ __forceinline__ float wave_max(float v) {
  v = fmaxf(v, dppf<0xB1>(v)); v = fmaxf(v, dppf<0x4E>(v)); v = fmaxf(v, dppf<0x141>(v)); v = fmaxf(v, dppf<0x140>(v));
  v = swapmax16(v); v = swapmax32(v);
  return v;
}
__device__ __forceinline__ void convert_tab_fp8(const float* __restrict__ U, const float* __restrict__ V, char* tab) {
  const int lane = tid_() & 63;
  const int gw = blockIdx.x * 8 + (tid_() >> 6), nw = gridDim.x * 8;
  for (int rr = gw; rr < 32768; rr += nw) {
    const int isv = rr >> 14, e = rr & 16383;
    const float* src = (isv ? V : U) + (size_t)e * 1024 + lane * 16;
    float4 v0 = *(const float4*)src, v1 = *(const float4*)(src + 4), v2 = *(const float4*)(src + 8), v3 = *(const float4*)(src + 12);
    float am = fmaxf(fmaxf(fmaxf(fabsf(v0.x), fabsf(v0.y)), fmaxf(fabsf(v0.z), fabsf(v0.w))),
                     fmaxf(fmaxf(fabsf(v1.x), fabsf(v1.y)), fmaxf(fabsf(v1.z), fabsf(v1.w))));
    am = fmaxf(am, fmaxf(fmaxf(fmaxf(fabsf(v2.x), fabsf(v2.y)), fmaxf(fabsf(v2.z), fabsf(v2.w))),
                         fmaxf(fmaxf(fabsf(v3.x), fabsf(v3.y)), fmaxf(fabsf(v3.z), fabsf(v3.w)))));
    am = wave_max(am);
    float sc = am > 0.f ? 448.f / am : 1.f;
    uint4 o;
    int t = 0;
    t = __builtin_amdgcn_cvt_pk_fp8_f32(v0.x * sc, v0.y * sc, t, false); t = __builtin_amdgcn_cvt_pk_fp8_f32(v0.z * sc, v0.w * sc, t, true); o.x = t;
    t = __builtin_amdgcn_cvt_pk_fp8_f32(v1.x * sc, v1.y * sc, t, false); t = __builtin_amdgcn_cvt_pk_fp8_f32(v1.z * sc, v1.w * sc, t, true); o.y = t;
    t = __builtin_amdgcn_cvt_pk_fp8_f32(v2.x * sc, v2.y * sc, t, false); t = __builtin_amdgcn_cvt_pk_fp8_f32(v2.z * sc, v2.w * sc, t, true); o.z = t;
    t = __builtin_amdgcn_cvt_pk_fp8_f32(v3.x * sc, v3.y * sc, t, false); t = __builtin_amdgcn_cvt_pk_fp8_f32(v3.z * sc, v3.w * sc, t, true); o.w = t;
    if (!isv) {
      *(uint4*)(tab + (size_t)e * 1024 + lane * 16) = o;
      if (lane == 0) ((float*)(tab + TAB_SU))[e] = am > 0.f ? am / 448.f : 1.f;
    } else {
      *(uint4*)(tab + TAB_V8 + ((size_t)(lane >> 3) * 16384 + e) * 128 + (lane & 7) * 16) = o;
      if (lane == 0) ((float*)(tab + TAB_SV))[e] = am > 0.f ? am / 448.f : 1.f;
    }
  }
}
__device__ __forceinline__ f2 dec8(unsigned w, bool hi) { return hi ? __builtin_amdgcn_cvt_pk_f32_fp8((int)w, true) : __builtin_amdgcn_cvt_pk_f32_fp8((int)w, false); }

__device__ __forceinline__ float dot16(uint4 w, f2 a0, f2 a1, f2 a2, f2 a3, f2 a4, f2 a5, f2 a6, f2 a7) {
  f2 a = f2{0.f, 0.f};
  a = __builtin_elementwise_fma(dec8(w.x, false), a0, a); a = __builtin_elementwise_fma(dec8(w.x, true), a1, a);
  a = __builtin_elementwise_fma(dec8(w.y, false), a2, a); a = __builtin_elementwise_fma(dec8(w.y, true), a3, a);
  a = __builtin_elementwise_fma(dec8(w.z, false), a4, a); a = __builtin_elementwise_fma(dec8(w.z, true), a5, a);
  a = __builtin_elementwise_fma(dec8(w.w, false), a6, a); a = __builtin_elementwise_fma(dec8(w.w, true), a7, a);
  return a.x + a.y;
}
#define DOT16(W) dot16(W, xf0, xf1, xf2, xf3, xf4, xf5, xf6, xf7)
__device__ __forceinline__ void phase_peer_act(const P& p, const u16* XN2, const char* tab, const int* IDX, const float* GATE, float* COEF, int ntok, char* lds) {
  const int tid = tid_(), lane = tid & 63, wave = tid >> 6;
  int* le = (int*)(lds + wave * 1536);
  float* lg = (float*)(le + 128);
  int* ls = le + 256;
  const int part = blockIdx.x & 7;
  const int wv = (blockIdx.x >> 3) * 8 + wave, nwv = (gridDim.x >> 3) * 8;
  const float* SU = (const float*)(tab + TAB_SU);
  const float* SV = (const float*)(tab + TAB_SV);
  const int q = lane >> 4;
  const bool hi = (lane & 32) != 0, b4 = (lane & 16) != 0;
  int i0 = 0, i1 = 0; float g0 = 0.f, g1 = 0.f; uint4 x0 = make_uint4(0, 0, 0, 0), x1 = x0;
  if (wv < ntok) {
    i0 = IDX[(size_t)wv * 128 + lane]; i1 = IDX[(size_t)wv * 128 + 64 + lane];
    g0 = GATE[(size_t)wv * 128 + lane]; g1 = GATE[(size_t)wv * 128 + 64 + lane];
    const u16* xr = XN2 + (size_t)wv * DM + lane * 16;
    x0 = *(const uint4*)xr; x1 = *(const uint4*)(xr + 8);
  }
  for (int tok = wv; tok < ntok; tok += nwv) {
    int ni0 = 0, ni1 = 0; float ng0 = 0.f, ng1 = 0.f; uint4 nx0 = make_uint4(0, 0, 0, 0), nx1 = nx0;
    const int nt = tok + nwv;
    if (nt < ntok) {
      ni0 = IDX[(size_t)nt * 128 + lane]; ni1 = IDX[(size_t)nt * 128 + 64 + lane];
      ng0 = GATE[(size_t)nt * 128 + lane]; ng1 = GATE[(size_t)nt * 128 + 64 + lane];
      const u16* xr = XN2 + (size_t)nt * DM + lane * 16;
      nx0 = *(const uint4*)xr; nx1 = *(const uint4*)(xr + 8);
    }
    const bool s0 = (i0 >> 11) == part, s1 = (i1 >> 11) == part;
    const unsigned long long m0 = __ballot(s0), m1 = __ballot(s1);
    const int c0 = __popcll(m0), cnt = c0 + __popcll(m1);
    const int p0 = __builtin_amdgcn_mbcnt_hi((unsigned)(m0 >> 32), __builtin_amdgcn_mbcnt_lo((unsigned)m0, 0));
    const int p1 = c0 + __builtin_amdgcn_mbcnt_hi((unsigned)(m1 >> 32), __builtin_amdgcn_mbcnt_lo((unsigned)m1, 0));
    if (s0) { le[p0] = i0; lg[p0] = g0; ls[p0] = lane; }
    if (s1) { le[p1] = i1; lg[p1] = g1; ls[p1] = 64 + lane; }
    const int cntp = (cnt + 3) & ~3;
    if (lane < cntp - cnt) { le[cnt + lane] = part << 11; lg[cnt + lane] = 0.f; ls[cnt + lane] = -1; }
    const f2 xf0 = f2{bflo(x0.x), bfhi(x0.x)}, xf1 = f2{bflo(x0.y), bfhi(x0.y)}, xf2 = f2{bflo(x0.z), bfhi(x0.z)}, xf3 = f2{bflo(x0.w), bfhi(x0.w)};
    const f2 xf4 = f2{bflo(x1.x), bfhi(x1.x)}, xf5 = f2{bflo(x1.y), bfhi(x1.y)}, xf6 = f2{bflo(x1.z), bfhi(x1.z)}, xf7 = f2{bflo(x1.w), bfhi(x1.w)};
    for (int base = 0; base < cntp; base += 24) {
      uint4 w[24];
      const int evl = le[base + (lane < 24 ? lane : 0)];
#pragma unroll
      for (int gq = 0; gq < 6; ++gq) {
        if (base + 4 * gq < cntp) {
#pragma unroll
          for (int k = 0; k < 4; ++k) {
            int e = __builtin_amdgcn_readlane(evl, 4 * gq + k);
            w[4 * gq + k] = *(const uint4*)(tab + (size_t)e * 1024 + lane * 16);
          }
        } else {
#pragma unroll
          for (int k = 0; k < 4; ++k) w[4 * gq + k] = make_uint4(0, 0, 0, 0);
        }
      }
      float my_act = 0.f;
      const int jmine = base + 4 * (lane & 15) + q;
      const bool mine = (lane & 15) < 6 && jmine < cntp;
      int e_m = part << 11, slot_m = -1; float gt_m = 0.f, su_m = 0.f, sv_m = 0.f;
      if (mine) { e_m = le[jmine]; gt_m = lg[jmine]; slot_m = ls[jmine]; su_m = SU[e_m]; sv_m = SV[e_m]; }
#pragma unroll
      for (int gq = 0; gq < 6; ++gq) {
        if (base + 4 * gq < cntp) {
          float d0 = DOT16(w[4 * gq]), d1 = DOT16(w[4 * gq + 1]), d2 = DOT16(w[4 * gq + 2]), d3 = DOT16(w[4 * gq + 3]);
          float kA = swapsum32(d0, d2), kB = swapsum32(d1, d3);
          float kC = swapsum16(kA, kB);
          kC = red16(kC);
          if ((lane & 15) == gq) my_act = kC;
        }
      }
      {
        if (mine && slot_m >= 0) {
          float act = my_act * su_m;
          COEF[(size_t)tok * 128 + slot_m] = gt_m * 0.5f * act * (1.f + erff(act * 0.70710678118654752f)) * sv_m;
        }
      }
    }
    i0 = ni0; i1 = ni1; g0 = ng0; g1 = ng1; x0 = nx0; x1 = nx1;
  }
}

__device__ __forceinline__ void phase_peer_sum(const P& p, int layer, const char* tab, const int* IDX, const float* COEF, int ntok, float* dummy_dst) {
  const int tid = tid_(), lane = tid & 63, wave = tid >> 6;
  const int sl = blockIdx.x & 7;
  const int wv = (blockIdx.x >> 3) * 8 + wave, nwv = (gridDim.x >> 3) * 8;
  const int g = lane >> 3, ch = lane & 7;
  const char* V8 = tab + TAB_V8 + (size_t)sl * 16384 * 128 + ch * 16;
  const float* mod = (const float*)(p.ws + O_MOD) + (size_t)layer * 9 * 6144;
  float* HC = (float*)(p.ws + O_HC);
  const bool b5 = (lane & 32) != 0, b4 = (lane & 16) != 0, b3 = (lane & 8) != 0;
  const int c = sl * 128 + ch * 16 + (b5 ? 8 : 0) + (b4 ? 4 : 0) + (b3 ? 2 : 0);
  uint4 ia, ib, ic, id; float4 ca, cb, cc, cd;
  ia = ib = ic = id = make_uint4(0, 0, 0, 0); ca = cb = cc = cd = make_float4(0, 0, 0, 0);
  if (wv < ntok) {
    const int* ip = IDX + (size_t)wv * 128 + g * 16;
    const float* cp = COEF + (size_t)wv * 128 + g * 16;
    ia = *(const uint4*)ip; ib = *(const uint4*)(ip + 4); ic = *(const uint4*)(ip + 8); id = *(const uint4*)(ip + 12);
    ca = *(const float4*)cp; cb = *(const float4*)(cp + 4); cc = *(const float4*)(cp + 8); cd = *(const float4*)(cp + 12);
  }
  for (int tok = wv; tok < ntok; tok += nwv) {
    const unsigned ev[16] = {ia.x, ia.y, ia.z, ia.w, ib.x, ib.y, ib.z, ib.w, ic.x, ic.y, ic.z, ic.w, id.x, id.y, id.z, id.w};
    const float cv[16] = {ca.x, ca.y, ca.z, ca.w, cb.x, cb.y, cb.z, cb.w, cc.x, cc.y, cc.z, cc.w, cd.x, cd.y, cd.z, cd.w};
    uint4 w[16];
#pragma unroll
    for (int i = 0; i < 16; ++i) w[i] = *(const uint4*)(V8 + (size_t)ev[i] * 128);
    float* dst = (dummy_dst ? dummy_dst + (size_t)tok * DM : (tok < NLAT ? p.out + (size_t)tok * DM : HC + (size_t)(tok - NLAT) * DM)) + c;
    float2 o = *(float2*)dst;
    const int mi = tok < NLAT ? (tok >> 12) : 8;
    const float2 mv = *(const float2*)(mod + mi * 6144 + 5 * 1024 + c);
    const int nt = tok + nwv;
    if (nt < ntok) {
      const int* ip = IDX + (size_t)nt * 128 + g * 16;
      const float* cp = COEF + (size_t)nt * 128 + g * 16;
      ia = *(const uint4*)ip; ib = *(const uint4*)(ip + 4); ic = *(const uint4*)(ip + 8); id = *(const uint4*)(ip + 12);
      ca = *(const float4*)cp; cb = *(const float4*)(cp + 4); cc = *(const float4*)(cp + 8); cd = *(const float4*)(cp + 12);
    }
    f2 acc[8];
#pragma unroll
    for (int k = 0; k < 8; ++k) acc[k] = f2{0.f, 0.f};
#pragma unroll
    for (int i = 0; i < 16; ++i) {
      f2 c2 = f2{cv[i], cv[i]};
      acc[0] = __builtin_elementwise_fma(dec8(w[i].x, false), c2, acc[0]); acc[1] = __builtin_elementwise_fma(dec8(w[i].x, true), c2, acc[1]);
      acc[2] = __builtin_elementwise_fma(dec8(w[i].y, false), c2, acc[2]); acc[3] = __builtin_elementwise_fma(dec8(w[i].y, true), c2, acc[3]);
      acc[4] = __builtin_elementwise_fma(dec8(w[i].z, false), c2, acc[4]); acc[5] = __builtin_elementwise_fma(dec8(w[i].z, true), c2, acc[5]);
      acc[6] = __builtin_elementwise_fma(dec8(w[i].w, false), c2, acc[6]); acc[7] = __builtin_elementwise_fma(dec8(w[i].w, true), c2, acc[7]);
    }
    float r8[8];
#pragma unroll
    for (int k = 0; k < 4; ++k) {
      r8[2 * k] = swapsum32(acc[k].x, acc[4 + k].x);
      r8[2 * k + 1] = swapsum32(acc[k].y, acc[4 + k].y);
    }
    float r4[4];
#pragma unroll
    for (int k = 0; k < 4; ++k) r4[k] = swapsum16(r8[k], r8[4 + k]);
    float r2[2];
#pragma unroll
    for (int k = 0; k < 2; ++k) {
      float kx = b3 ? r4[2 + k] : r4[k], sx = b3 ? r4[k] : r4[2 + k];
      r2[k] = kx + dppf<0x128>(sx);
    }
    o.x += mv.x * r2[0]; o.y += mv.y * r2[1];
    *(float2*)dst = o;
  }
}

__device__ __forceinline__ void phase_scan(const P& p, char* lds, bool dummy) {
  float* buf = (float*)lds;
  float* vbuf = (float*)(lds + 81920);
  u16* ybuf = (u16*)(lds + 81920 + 16384);
  const int tid = tid_(), lane = tid & 63, wave = tid >> 6;
  const int c = lane & 7, irow = wave * 8 + (lane >> 3);
  const u16* R = (const u16*)(p.ws + O_R);
  const u16* Kp = (const u16*)(p.ws + O_K);
  const u16* Vp = (const u16*)(p.ws + O_V);
  const int ps = tid >> 4, col4 = (tid & 15) * 4;
  for (int item = blockIdx.x; item < 256; item += gridDim.x) {
    const int dir = item & 1, hh = (item >> 1) & 15, b = item >> 5;
    char* WA = p.ws + (dir ? O_WA1 : O_WA0);
    float* BON = (float*)(p.ws + O_BONUS) + (size_t)dir * NLAT * 16;
    float kkc[4], kac[4], rkc[4];
#pragma unroll
    for (int e = 0; e < 4; ++e) {
      kkc[e] = p.in[20][hh * 64 + col4 + e];
      kac[e] = p.in[21][hh * 64 + col4 + e];
      rkc[e] = p.in[22][hh * 64 + col4 + e];
    }
    auto rowof = [&](int s) -> int {
      if (s < 256) { int pos = dir ? 255 - s : s; return NLAT + b * 256 + pos; }
      int u = s - 256; int pos = dir ? 4095 - u : u; return b * 4096 + pos;
    };
    uint2 pr, pk, pv; unsigned pw, pa; int prow;
    auto gload = [&](int ch) {
      prow = rowof(ch * 32 + ps);
      size_t o = (size_t)prow * 1024 + hh * 64 + col4;
      pr = *(const uint2*)(R + o); pk = *(const uint2*)(Kp + o); pv = *(const uint2*)(Vp + o);
      const char* wp = WA + (size_t)prow * 2048 + hh * 128;
      pw = *(const unsigned*)(wp + col4); pa = *(const unsigned*)(wp + 64 + col4);
    };
    auto prep = [&](int bi) {
      float rr[4] = {bflo(pr.x), bfhi(pr.x), bflo(pr.y), bfhi(pr.y)};
      float kq[4] = {bflo(pk.x), bfhi(pk.x), bflo(pk.y), bfhi(pk.y)};
      float4 vv = make_float4(bflo(pv.x), bfhi(pv.x), bflo(pv.y), bfhi(pv.y));
      float w[4], a[4], kr[4], kk[4], bb[4], kd[4];
      float ss = 0.f;
#pragma unroll
      for (int e = 0; e < 4; ++e) {
        w[e] = 0.5f + (float)((pw >> (8 * e)) & 255u) * (1.f / 510.f);
        a[e] = (float)((pa >> (8 * e)) & 255u) * (1.f / 255.f);
        kr[e] = kq[e] * kkc[e];
        ss += kr[e] * kr[e];
      }
      ss = red16(ss);
      float inv = rsqrtf(ss + 1e-12f);
      float bn = 0.f;
#pragma unroll
      for (int e = 0; e < 4; ++e) {
        kk[e] = kr[e] * inv;
        bb[e] = kk[e] * a[e];
        kd[e] = kq[e] * (1.f + (a[e] - 1.f) * kac[e]);
        bn += rr[e] * kd[e] * rkc[e];
      }
      bn = red16(bn);
      if ((tid & 15) == 0 && prow < NLAT) BON[(size_t)prow * 16 + hh] = bn;
      float* d = buf + bi * 10240 + ((ps * 8 + (col4 >> 3)) * 5) * 8 + (col4 & 7);
      *(float4*)(d) = make_float4(rr[0], rr[1], rr[2], rr[3]);
      *(float4*)(d + 8) = make_float4(w[0], w[1], w[2], w[3]);
      *(float4*)(d + 16) = make_float4(kk[0], kk[1], kk[2], kk[3]);
      *(float4*)(d + 24) = make_float4(bb[0], bb[1], bb[2], bb[3]);
      *(float4*)(d + 32) = make_float4(kd[0], kd[1], kd[2], kd[3]);
      *(float4*)(vbuf + bi * 2048 + ps * 64 + col4) = vv;
    };
    float S[8];
#pragma unroll
    for (int j = 0; j < 8; ++j) S[j] = 0.f;
    gload(0);
    prep(0);
    __syncthreads();
    for (int ch = 0; ch < 136; ++ch) {
      const int cur = ch & 1;
      if (ch + 1 < 136) gload(ch + 1);
      const float* bq = buf + cur * 10240 + c * 40;
      const float* vq = vbuf + cur * 2048 + irow;
      float4 nr0, nr1, nw0, nw1, nk0, nk1, nb0, nb1, nd0, nd1; float nvi;
      {
        const float* q = bq;
        nr0 = *(const float4*)(q); nr1 = *(const float4*)(q + 4); nw0 = *(const float4*)(q + 8); nw1 = *(const float4*)(q + 12);
        nk0 = *(const float4*)(q + 16); nk1 = *(const float4*)(q + 20); nb0 = *(const float4*)(q + 24); nb1 = *(const float4*)(q + 28);
        nd0 = *(const float4*)(q + 32); nd1 = *(const float4*)(q + 36); nvi = vq[0];
      }
#pragma unroll 4
      for (int t = 0; t < 32; ++t) {
        const float4 r0 = nr0, r1 = nr1, w0 = nw0, w1 = nw1, k0 = nk0, k1 = nk1, b0 = nb0, b1 = nb1, d0 = nd0, d1 = nd1;
        const float vi = nvi;
        if (t + 1 < 32) {
          const float* q = bq + (t + 1) * 320;
          nr0 = *(const float4*)(q); nr1 = *(const float4*)(q + 4); nw0 = *(const float4*)(q + 8); nw1 = *(const float4*)(q + 12);
          nk0 = *(const float4*)(q + 16); nk1 = *(const float4*)(q + 20); nb0 = *(const float4*)(q + 24); nb1 = *(const float4*)(q + 28);
          nd0 = *(const float4*)(q + 32); nd1 = *(const float4*)(q + 36); nvi = vq[(t + 1) * 64];
        }
        float sa = (S[0] * k0.x + S[1] * k0.y) + (S[2] * k0.z + S[3] * k0.w) + ((S[4] * k1.x + S[5] * k1.y) + (S[6] * k1.z + S[7] * k1.w));
        sa = red8(sa);
        S[0] = fmaf(S[0], w0.x, fmaf(-sa, b0.x, vi * d0.x));
        S[1] = fmaf(S[1], w0.y, fmaf(-sa, b0.y, vi * d0.y));
        S[2] = fmaf(S[2], w0.z, fmaf(-sa, b0.z, vi * d0.z));
        S[3] = fmaf(S[3], w0.w, fmaf(-sa, b0.w, vi * d0.w));
        S[4] = fmaf(S[4], w1.x, fmaf(-sa, b1.x, vi * d1.x));
        S[5] = fmaf(S[5], w1.y, fmaf(-sa, b1.y, vi * d1.y));
        S[6] = fmaf(S[6], w1.z, fmaf(-sa, b1.z, vi * d1.z));
        S[7] = fmaf(S[7], w1.w, fmaf(-sa, b1.w, vi * d1.w));
        float y = (S[0] * r0.x + S[1] * r0.y) + (S[2] * r0.z + S[3] * r0.w) + ((S[4] * r1.x + S[5] * r1.y) + (S[6] * r1.z + S[7] * r1.w));
        y = red8(y);
        if (c == 0) ybuf[t * 64 + irow] = f2bf(y);
      }
      __syncthreads();
      if (ch >= 8 && !dummy) {
        int row = rowof(ch * 32 + ps);
        uint2 yv = *(const uint2*)(ybuf + ps * 64 + col4);
        *(uint2*)(WA + (size_t)row * 2048 + hh * 128 + col4 * 2) = yv;
      }
      if (ch + 1 < 136) prep(cur ^ 1);
      __syncthreads();
    }
  }
}

__device__ __forceinline__ void phase_readout(const P& p) {
  const u16* Vp = (const u16*)(p.ws + O_V);
  const u16* G = (const u16*)(p.ws + O_G);
  u16* Z = (u16*)(p.ws + O_Z);
  const float* BON = (const float*)(p.ws + O_BONUS);
  const size_t gt = (size_t)blockIdx.x * NT + tid_(), gn = (size_t)gridDim.x * NT;
  for (size_t it = gt; it < (size_t)NLAT * 16 * 8; it += gn) {
    int sub = (int)(it & 7); size_t grp = it >> 3;
    int hh = (int)(grp & 15); int row = (int)(grp >> 4);
    uint4 y0 = *(const uint4*)(p.ws + O_WA0 + (size_t)row * 2048 + hh * 128 + sub * 16);
    uint4 y1 = *(const uint4*)(p.ws + O_WA1 + (size_t)row * 2048 + hh * 128 + sub * 16);
    const int col = hh * 64 + sub * 8;
    const float bonus0 = BON[(size_t)row * 16 + hh], bonus1 = BON[(size_t)NLAT * 16 + (size_t)row * 16 + hh];
    const uint4 vv = *(const uint4*)(Vp + (size_t)row * DM + col);
    const uint4 gg = *(const uint4*)(G + (size_t)row * DM + col);
    const float4 gw0 = *(const float4*)(p.in[29] + col), gw1 = *(const float4*)(p.in[29] + col + 4);
    const float4 gb0 = *(const float4*)(p.in[30] + col), gb1 = *(const float4*)(p.in[30] + col + 4);
    float y[8] = {bflo(y0.x) + bflo(y1.x), bfhi(y0.x) + bfhi(y1.x), bflo(y0.y) + bflo(y1.y), bfhi(y0.y) + bfhi(y1.y),
                  bflo(y0.z) + bflo(y1.z), bfhi(y0.z) + bfhi(y1.z), bflo(y0.w) + bflo(y1.w), bfhi(y0.w) + bfhi(y1.w)};
    float s = 0.f;
#pragma unroll
    for (int e = 0; e < 8; ++e) s += y[e];
    float mean = red8(s) * (1.f / 64.f);
    float vs = 0.f;
#pragma unroll
    for (int e = 0; e < 8; ++e) { y[e] -= mean; vs += y[e] * y[e]; }
    float var = red8(vs) * (1.f / 64.f);
    float rs = rsqrtf(var + 64e-5f);
    const float bonus = bonus0 + bonus1;
    float vf[8] = {bflo(vv.x), bfhi(vv.x), bflo(vv.y), bfhi(vv.y), bflo(vv.z), bfhi(vv.z), bflo(vv.w), bfhi(vv.w)};
    float gf[8] = {bflo(gg.x), bfhi(gg.x), bflo(gg.y), bfhi(gg.y), bflo(gg.z), bfhi(gg.z), bflo(gg.w), bfhi(gg.w)};
    float z[8];
    const float gwv[8] = {gw0.x, gw0.y, gw0.z, gw0.w, gw1.x, gw1.y, gw1.z, gw1.w};
    const float gbv[8] = {gb0.x, gb0.y, gb0.z, gb0.w, gb1.x, gb1.y, gb1.z, gb1.w};
#pragma unroll
    for (int e = 0; e < 8; ++e) z[e] = (y[e] * rs * gwv[e] + gbv[e] + bonus * vf[e]) * gf[e];
    uint4 ov; ov.x = pack2(z[0], z[1]); ov.y = pack2(z[2], z[3]); ov.z = pack2(z[4], z[5]); ov.w = pack2(z[6], z[7]);
    *(uint4*)(Z + (size_t)row * DM + col) = ov;
  }
}

__device__ __forceinline__ bool xcd_tile(int k, int Tm, int Tn, int& mt, int& nt) {
  const int x = blockIdx.x & 7, j = blockIdx.x >> 3, J = gridDim.x >> 3;
  const int u = j + J * k;
  if (u >= (Tm >> 3) * Tn) return false;
  mt = (u / Tn) * 8 + x; nt = u % Tn;
  return true;
}

#define XB_TMO      128
#define XB_XCNT(j)  (256  + 64 * (j))
#define XB_XSUB(j)  (1280 + 64 * (j))
#define XB_XGEN(j)  (2304 + 64 * (j))
#define XB_TOP      3328
#define XB_TOPGEN   3392
#define XCD_BAR_WORDS 3456
#define XB_SPIN_CAP (1u << 18)
#define LAS __attribute__((address_space(3)))
__device__ __forceinline__ unsigned xb_ld(unsigned* p)              { return __hip_atomic_load(p, __ATOMIC_RELAXED, __HIP_MEMORY_SCOPE_AGENT); }
__device__ __forceinline__ unsigned xb_add(unsigned* p, unsigned v) { return __hip_atomic_fetch_add(p, v, __ATOMIC_RELAXED, __HIP_MEMORY_SCOPE_AGENT); }
__device__ __forceinline__ unsigned xb_xcc_id() { return (unsigned)__builtin_amdgcn_s_getreg((3 << 11) | 20) & 0xFu; }
#define XB_SPIN(cond, bar) do { unsigned _sp = 0; while (cond) { __builtin_amdgcn_s_sleep(1); \
    if ((++_sp & 255u) == 0u) { if (xb_ld(&(bar)[XB_TMO])) break; if (_sp > XB_SPIN_CAP) { atomicAdd(&(bar)[XB_TMO], 1u); break; } } } } while (0)
struct XcdBarrier { unsigned* bar; unsigned x; volatile LAS unsigned* st; };
__device__ __forceinline__ XcdBarrier xcd_barrier_post(unsigned* bar, volatile LAS unsigned* st) {
  XcdBarrier b; b.bar = bar; b.x = xb_xcc_id(); b.st = st;
  if (tid_() == 0) (void)xb_add(&bar[XB_XCNT(b.x)], 1u);
  return b;
}
__device__ __forceinline__ void xcd_barrier_complete(unsigned* bar, unsigned x, unsigned& nloc, unsigned& nx) {
  const unsigned G = gridDim.x * gridDim.y * gridDim.z;
  unsigned sum, cnt, mine, sp = 0u;
  for (;;) {
    sum = 0u; cnt = 0u; mine = 0u;
#pragma unroll
    for (unsigned j = 0; j < 16; ++j) { const unsigned c = xb_ld(&bar[XB_XCNT(j)]); sum += c; cnt += (c > 0u) ? 1u : 0u; mine = (j == x) ? c : mine; }
    if (sum == G) break;
    __builtin_amdgcn_s_sleep(1);
    if ((++sp & 255u) == 0u) { if (xb_ld(&bar[XB_TMO])) break; if (sp > XB_SPIN_CAP) { atomicAdd(&bar[XB_TMO], 1u); break; } }
  }
  nloc = mine > 0u ? mine : 1u; nx = cnt > 0u ? cnt : 1u;
}
__device__ __forceinline__ void xcd_barrier(char* wsb, char* ldsb) {
#if defined(__HIP_DEVICE_COMPILE__)
  XcdBarrier b; b.bar = (unsigned*)(wsb + O_BAR); b.x = xb_xcc_id(); b.st = (volatile LAS unsigned*)(ldsb + LDS_BYTES - 16);
  asm volatile("s_waitcnt vmcnt(0)" ::: "memory");
  __syncthreads();
  if (tid_() == 0) {
    unsigned* bar = b.bar;
    __builtin_amdgcn_s_waitcnt(0);
    unsigned nloc = b.st[0], nx = b.st[1];
    if (nloc == 0u) { xcd_barrier_complete(bar, b.x, nloc, nx); b.st[0] = nloc; b.st[1] = nx; }
    const unsigned old = xb_add(&bar[XB_XSUB(b.x)], 1u);
    const unsigned gen = old / nloc;
    if (old + 1u == (gen + 1u) * nloc) {
      __builtin_amdgcn_fence(__ATOMIC_RELEASE, "agent");
      asm volatile("s_waitcnt vmcnt(0)" ::: "memory");
      const unsigned og = xb_add(&bar[XB_TOP], 1u);
      const unsigned tg = og / nx;
      if (og + 1u == (tg + 1u) * nx) xb_add(&bar[XB_TOPGEN], 1u);
      else XB_SPIN(xb_ld(&bar[XB_TOPGEN]) == tg, bar);
      __builtin_amdgcn_fence(__ATOMIC_ACQUIRE, "agent");
      xb_add(&bar[XB_XGEN(b.x)], 1u);
      asm volatile("s_waitcnt vmcnt(0)" ::: "memory");
    } else {
      XB_SPIN(xb_ld(&bar[XB_XGEN(b.x)]) == gen, bar);
      __builtin_amdgcn_fence(__ATOMIC_ACQUIRE, "agent");
      asm volatile("s_waitcnt vmcnt(0)" ::: "memory");
    }
  }
  __syncthreads();
#endif
}

__global__ void __launch_bounds__(NT) fwd_kernel(P p) {
  extern __shared__ __attribute__((aligned(16))) char lds[];
  cg::grid_group grid = cg::this_grid();
  char* ws = p.ws;
  const float* mod0 = (const float*)(ws + O_MOD);
  const float* mod1 = mod0 + 9 * 6144;
  volatile LAS unsigned* xst = (volatile LAS unsigned*)(lds + LDS_BYTES - 16);
  if (tid_() == 0) { xst[0] = 0u; xst[1] = 0u; }
  __syncthreads();
  (void)xcd_barrier_post((unsigned*)(p.ws + O_BAR), xst);
  for (int ph = p.ph_lo; ph < p.ph_hi; ++ph) {
    if (ph > p.ph_lo) {
      if (p.ph_hi < 0) grid.sync();
      xcd_barrier(p.ws, lds);
    }
    if (!((PHASE_MASK >> ph) & 1)) continue;
    const int nrep = ((REPEAT_MASK >> ph) & 1) ? 2 : 1;
    for (int rep = 0; rep < nrep; ++rep) {
    const bool dummy = rep + 1 < nrep;
    if (rep) grid.sync();
    switch (ph) {
      case 0: phase_prep(p, lds); break;
      case 1: phase_norm(p, p.in[0], p.in[2], p.in[6], 0, 0, TTOK, (u16*)(ws + O_XN)); break;
      case 2: {
        u16* hgg = (u16*)(ws + O_HGG); u16* Q = (u16*)(ws + O_Q); u16* KBp = (u16*)(ws + O_KB); u16* VT = (u16*)(ws + O_VT);
        for (int kq = 0, mt = 0, ntw = 0; xcd_tile(kq, 136, 10, mt, ntw); ++kq) {
          if (ntw < 8) {
            const int n0w = ntw * 256;
            u16* dbase; int dld;
            if (n0w < 1536) { dbase = hgg + n0w; dld = 1536; } else { dbase = Q + (n0w - 1536); dld = 512; }
            auto xf = [&](float v, int row, int col) -> float { return v; };
            auto dstf = [&](int row) -> u16* { return dbase + (size_t)row * dld; };
            gemm_tile256<false>((const u16*)(ws + O_XN), 1024, nullptr, (const u16*)(ws + O_WIN) + (size_t)n0w * 1024, 1024, 1024,
                                mt * 256, xf, dstf, (u16*)lds);
            continue;
          }
          int nt = 8 + ntw;
          int n0 = nt * 128;
          auto epi = [&](int row, int col, float v0, float v1, float v2, float v3) {
            int n = n0 + col;
            float v[4] = {v0, v1, v2, v3};
            if (n < 1536) {
#pragma unroll
              for (int j = 0; j < 4; ++j) hgg[(size_t)(row + j) * 1536 + n] = f2bf(v[j]);
            } else if (n < 2048) {
#pragma unroll
              for (int j = 0; j < 4; ++j) Q[(size_t)(row + j) * 512 + n - 1536] = f2bf(v[j]);
            } else if (n < 2176) {
#pragma unroll
              for (int j = 0; j < 4; ++j) KBp[(size_t)(row + j) * 128 + n - 2048] = f2bf(v[j]);
            } else {
              int kvh = (n - 2176) >> 6, d = (n - 2176) & 63;
              int b, pos;
              if (row < NLAT) { b = row >> 12; pos = 256 + (row & 4095); } else { b = (row - NLAT) >> 8; pos = (row - NLAT) & 255; }
              uint2 o; o.x = pack2(v0, v1); o.y = pack2(v2, v3);
              *(uint2*)(VT + ((size_t)((b * 2 + kvh) * 64 + d)) * 4352 + pos) = o;
            }
          };
          if (nt < 17) {
            u16* dbase; int dld;
            if (n0 < 1536) { dbase = hgg + n0; dld = 1536; } else if (n0 < 2048) { dbase = Q + (n0 - 1536); dld = 512; } else { dbase = KBp + (n0 - 2048); dld = 128; }
            auto xf = [&](float v, int row, int col) -> float { return v; };
            auto dstf = [&](int row) -> u16* { return dbase + (size_t)row * dld; };
            gemm_tile<false, 1>((const u16*)(ws + O_XN), 1024, nullptr, (const u16*)(ws + O_WIN) + (size_t)n0 * 1024, 1024, 1024,
                                mt * 256, xf, dstf, (u16*)lds);
          } else {
            gemm_tile<false, 0>((const u16*)(ws + O_XN), 1024, nullptr, (const u16*)(ws + O_WIN) + (size_t)n0 * 1024, 1024, 1024,
                                mt * 256, epi, 0, (u16*)lds);
          }
        }
      } break;
      case 3: phase_conv_qk(p); break;
      case 4: phase_attn(p, lds); break;
      case 5: {
        float* HC = (float*)(ws + O_HC);
        for (int kq = 0, mt = 0, nt = 0; xcd_tile(kq, 136, 8, mt, nt); ++kq) {
          int n0 = nt * 128;
          auto epi = [&](int row, int col, float v0, float v1, float v2, float v3) {
            int n = n0 + col;
            float v[4] = {v0, v1, v2, v3};
#pragma unroll
            for (int j = 0; j < 4; ++j) {
              int rw = row + j;
              if (rw < NLAT) {
                float g = mod0[(rw >> 12) * 6144 + 2048 + n];
                p.out[(size_t)rw * DM + n] = p.in[0][(size_t)rw * DM + n] + g * v[j];
              } else {
                float g = mod0[8 * 6144 + 2048 + n];
                HC[(size_t)(rw - NLAT) * DM + n] = p.in[2][(size_t)(rw - NLAT) * DM + n] + g * v[j];
              }
            }
          };
          {
            const int r0 = mt * 256;
            const float* gvec = mod0 + (r0 < NLAT ? (r0 >> 12) : 8) * 6144 + 2048 + n0;
            auto gatef = [&](int row) -> const float* { return gvec; };
            auto rowp = [&](int row, int wr) -> float* {
              if (row < NLAT) return (wr ? p.out : (float*)p.in[0]) + (size_t)row * DM + n0;
              return (wr ? HC : (float*)p.in[2]) + (size_t)(row - NLAT) * DM + n0;
            };
            gemm_tile<false, 3>((const u16*)(ws + O_XN), 1024, nullptr, (const u16*)(ws + O_WOUT) + (size_t)n0 * 1024, 1024, 1024,
                                r0, gatef, rowp, (u16*)lds);
          }
        }
      } break;
      case 6: phase_norm(p, p.out, (const float*)(ws + O_HC), p.in[7], 0, 3, TTOK, (u16*)(ws + O_XN)); break;
      case 7: case 18: {
        int layer = ph == 7 ? 0 : 1;
        int mtiles = layer == 0 ? 136 : 128;
        u16* PQ = (u16*)(ws + (layer == 0 ? O_PQ0 : O_PQ1));
        const u16* Wq = (const u16*)(ws + O_WQ) + (size_t)layer * 2048 * 1024;
        for (int kq = 0, mt = 0, nt = 0; xcd_tile(kq, mtiles, 8, mt, nt); ++kq) {
          int n0 = nt * 256;
          auto epi = [&](int row, int col, float v0, float v1, float v2, float v3) {
            int n = n0 + col;
            float v[4] = {v0, v1, v2, v3};
#pragma unroll
            for (int j = 0; j < 4; ++j) PQ[(size_t)(row + j) * 2048 + n] = f2bf(v[j]);
          };
          auto xf = [&](float v, int row, int col) -> float { return v; };
          auto dstf = [&](int row) -> u16* { return PQ + (size_t)row * 2048 + n0; };
          gemm_tile256<false>((const u16*)(ws + O_XN), 1024, nullptr, Wq + (size_t)n0 * 1024, 1024, 1024, mt * 256, xf, dstf, (u16*)lds);
        }
      } break;
      case 8: phase_peer_topk(p, 0, (const u16*)(ws + O_PQ0), TTOK, (int*)(ws + O_IDX0), (float*)(ws + O_GATE0), lds); break;
      case 9: phase_peer_act(p, (const u16*)(ws + O_XN), ws + O_TAB0, (const int*)(ws + O_IDX0), (const float*)(ws + O_GATE0),
                             (float*)(ws + O_COEF0), TTOK, lds); break;
      case 10: phase_peer_sum(p, 0, ws + O_TAB0, (const int*)(ws + O_IDX0), (const float*)(ws + O_COEF0), TTOK, dummy ? (float*)(ws + O_A2R) : nullptr); break;
      case 11: phase_norm(p, p.out, (const float*)(ws + O_HC), p.in[6] + 1024, 1, 0, TTOK, (u16*)(ws + O_XN)); break;
      case 12: {
        u16* LORA = (u16*)(ws + O_LORA);
        for (int kq = 0;; ++kq) {
          const int u = (blockIdx.x >> 3) + (gridDim.x >> 3) * kq;
          if (u >= 17 * 27) break;
          int mt, nt;
          if (u < 408) { int g = u / 136, rem = u % 136; mt = (rem >> 3) * 8 + (blockIdx.x & 7); nt = g * 8 + (rem & 7); }
          else { int v2 = u - 408; mt = (v2 / 3) * 8 + (blockIdx.x & 7); nt = 24 + v2 % 3; }
          const u16* Bp; int mixi; u16* dstp = nullptr; int kind;
          if (nt < 8) { Bp = (const u16*)(ws + O_WR) + (size_t)nt * 128 * 1024; mixi = 0; dstp = (u16*)(ws + O_R) + nt * 128; kind = 0; }
          else if (nt < 16) { Bp = (const u16*)(ws + O_WK) + (size_t)(nt - 8) * 128 * 1024; mixi = 2; dstp = (u16*)(ws + O_K) + (nt - 8) * 128; kind = 0; }
          else if (nt < 24) { Bp = (const u16*)(ws + O_WV) + (size_t)(nt - 16) * 128 * 1024; mixi = 3; dstp = (u16*)(ws + O_V) + (nt - 16) * 128; kind = 0; }
          else if (nt == 24) { Bp = (const u16*)(ws + O_W1); mixi = 1; kind = 1; }
          else if (nt == 25) { Bp = (const u16*)(ws + O_A1); mixi = 4; kind = 2; }
          else { Bp = (const u16*)(ws + O_G1); mixi = 5; kind = 3; }
          auto epi = [&](int row, int col, float v0, float v1, float v2, float v3) {
            float v[4] = {v0, v1, v2, v3};
            if (kind == 0) {
#pragma unroll
              for (int j = 0; j < 4; ++j) dstp[(size_t)(row + j) * 1024 + col] = f2bf(v[j]);
            } else if (kind == 1) {
#pragma unroll
              for (int j = 0; j < 4; ++j) LORA[(size_t)(row + j) * 384 + col] = f2bf(tanhf(v[j]));
            } else if (kind == 2) {
#pragma unroll
              for (int j = 0; j < 4; ++j) LORA[(size_t)(row + j) * 384 + 128 + col] = f2bf(v[j]);
            } else {
#pragma unroll
              for (int j = 0; j < 4; ++j) LORA[(size_t)(row + j) * 384 + 256 + col] = f2bf(sigmoidf_(v[j]));
            }
          };
          auto xf = [&](float v, int row, int col) -> float { return kind == 1 ? tanhf(v) : (kind == 3 ? sigmoidf_(v) : v); };
          u16* dbase = kind == 0 ? dstp : (LORA + (kind - 1) * 128);
          const int dld = kind == 0 ? 1024 : 384;
          auto dstf = [&](int row) -> u16* { return dbase + (size_t)row * dld; };
          gemm_tile<true, 1>((const u16*)(ws + O_XN), 1024, p.in[13] + mixi * 1024, Bp, 1024, 1024, mt * 256, xf, dstf, (u16*)lds);
        }
      } break;
      case 13: {
        const u16* LORA = (const u16*)(ws + O_LORA);
        u16* G = (u16*)(ws + O_G);
        for (int t = blockIdx.x; t < 136 * 40; t += gridDim.x) {
          int mt = t / 40, nt = t % 40;
          int grp = nt >> 3, n0 = (nt & 7) * 128;
          const u16* Ap; const u16* Bp; int K, ldb;
          if (grp < 2) { Ap = LORA + grp * 64; Bp = (const u16*)(ws + O_W2) + (size_t)grp * 65536 + (size_t)n0 * 64; K = 64; ldb = 64; }
          else if (grp < 4) { Ap = LORA + 128 + (grp - 2) * 64; Bp = (const u16*)(ws + O_A2) + (size_t)(grp - 2) * 65536 + (size_t)n0 * 64; K = 64; ldb = 64; }
          else { Ap = LORA + 256; Bp = (const u16*)(ws + O_G2) + (size_t)n0 * 128; K = 128; ldb = 128; }
          int d = grp & 1;
          u8* WA = (u8*)(ws + (d ? O_WA1 : O_WA0));
          auto epi = [&](int row, int col, float v0, float v1, float v2, float v3) {
            int n = n0 + col;
            float v[4] = {v0, v1, v2, v3};
            if (grp < 2) {
              float w0 = p.in[23][d * 1024 + n];
#pragma unroll
              for (int j = 0; j < 4; ++j) {
                float x = w0 + v[j];
                float dec = __expf(-0.6065306597126334f * sigmoidf_(x));
                float q = rintf((dec - 0.5f) * 510.f);
                q = fminf(fmaxf(q, 0.f), 255.f);
                WA[(size_t)(row + j) * 2048 + (n >> 6) * 128 + (n & 63)] = (u8)q;
              }
            } else if (grp < 4) {
              float a0 = p.in[26][d * 1024 + n];
#pragma unroll
              for (int j = 0; j < 4; ++j) {
                float a = sigmoidf_(a0 + v[j]);
                float q = fminf(fmaxf(rintf(a * 255.f), 0.f), 255.f);
                WA[(size_t)(row + j) * 2048 + (n >> 6) * 128 + 64 + (n & 63)] = (u8)q;
              }
            } else {
#pragma unroll
              for (int j = 0; j < 4; ++j) G[(size_t)(row + j) * 1024 + n] = f2bf(v[j]);
            }
          };
          if (grp < 4) {
            const float* b0p = (grp < 2 ? p.in[23] : p.in[26]) + d * 1024 + n0;
            auto q8 = [&](float v, int row, int col) -> unsigned {
              float x = b0p[col] + v;
              float qv;
              if (grp < 2) { float dec = __expf(-0.6065306597126334f * sigmoidf_(x)); qv = rintf((dec - 0.5f) * 510.f); }
              else { qv = rintf(sigmoidf_(x) * 255.f); }
              return (unsigned)fminf(fmaxf(qv, 0.f), 255.f);
            };
            auto dst8 = [&](int row, int c16) -> u8* {
              int n = n0 + c16 * 16;
              return WA + (size_t)row * 2048 + (n >> 6) * 128 + (grp < 2 ? 0 : 64) + (n & 63);
            };
            gemm_tile<false, 2>(Ap, 384, nullptr, Bp, ldb, K, mt * 256, q8, dst8, (u16*)lds);
          } else {
            auto xf = [&](float v, int row, int col) -> float { return v; };
            auto dstf = [&](int row) -> u16* { return G + (size_t)row * 1024 + n0; };
            gemm_tile<false, 1>(Ap, 384, nullptr, Bp, ldb, K, mt * 256, xf, dstf, (u16*)lds);
          }
        }
      } break;
      case 14: phase_scan(p, lds, dummy); break;
      case 15:
        phase_readout(p);
        convert_tab_fp8(p.in[33] + (size_t)16384 * 1024, p.in[34] + (size_t)16384 * 1024, ws + O_TAB1);
        break;
      case 16: {
        for (int kq = 0, mt = 0, nt = 0; xcd_tile(kq, 128, 8, mt, nt); ++kq) {
          int n0 = nt * 128;
          auto epi = [&](int row, int col, float v0, float v1, float v2, float v3) {
            int n = n0 + col;
            float v[4] = {v0, v1, v2, v3};
#pragma unroll
            for (int j = 0; j < 4; ++j) {
              int rw = row + j;
              float g = mod1[(rw >> 12) * 6144 + 2048 + n];
              p.out[(size_t)rw * DM + n] += g * v[j];
            }
          };
          {
            const int r0 = mt * 256;
            const float* gvec = mod1 + (r0 >> 12) * 6144 + 2048 + n0;
            auto gatef = [&](int row) -> const float* { return gvec; };
            auto rowp = [&](int row, int wr) -> float* { return p.out + (size_t)row * DM + n0; };
            gemm_tile<false, 3>((const u16*)(ws + O_Z), 1024, nullptr, (const u16*)(ws + O_WO) + (size_t)n0 * 1024, 1024, 1024,
                                r0, gatef, rowp, (u16*)lds);
          }
        }
      } break;
      case 17: phase_norm(p, p.out, nullptr, p.in[7] + 1024, 1, 3, NLAT, (u16*)(ws + O_XN)); break;
      case 19: phase_peer_topk(p, 1, (const u16*)(ws + O_PQ1), NLAT, (int*)(ws + O_IDX1), (float*)(ws + O_GATE1), lds); break;
      case 20: phase_peer_act(p, (const u16*)(ws + O_XN), ws + O_TAB1, (const int*)(ws + O_IDX1), (const float*)(ws + O_GATE1),
                              (float*)(ws + O_COEF1), NLAT, lds); break;
      case 21: phase_peer_sum(p, 1, ws + O_TAB1, (const int*)(ws + O_IDX1), (const float*)(ws + O_COEF1), NLAT, dummy ? (float*)(ws + O_A5R) : nullptr); break;
      default: break;
    }
    }
  }
}

extern "C" void kernel_launch(void* const* d_in, const int* in_sizes, int n_in, void* d_out, int out_size, void* d_ws,
                              size_t ws_size, hipStream_t stream) {
  static int grid = 0;
  if (grid == 0) {
    if (n_in != 35 || ws_size < WS_END) {
      fprintf(stderr, "kernel_launch: unexpected n_in %d or ws_size %zu (need %zu)\n", n_in, ws_size, (size_t)WS_END);
      grid = -1;
      return;
    }
    int dev = 0, cus = 0, per_cu = 0;
    hipGetDevice(&dev);
    hipDeviceGetAttribute(&cus, hipDeviceAttributeMultiprocessorCount, dev);
    hipFuncSetAttribute((const void*)fwd_kernel, hipFuncAttributeMaxDynamicSharedMemorySize, LDS_BYTES);
    hipOccupancyMaxActiveBlocksPerMultiprocessor(&per_cu, (const void*)fwd_kernel, NT, LDS_BYTES);
    (void)hipGetLastError();
    if (per_cu < 1) per_cu = 1;
    grid = (cus / 8) * 8;
    if (grid > cus * per_cu) grid = cus * per_cu;
  }
  if (grid < 0) return;
  P p{};
  for (int i = 0; i < 35; ++i) p.in[i] = (const float*)d_in[i];
  p.out = (float*)d_out;
  p.ws = (char*)d_ws;
#if N_LAUNCH_MODE == 0
  (void)hipMemsetAsync((char*)d_ws + O_BAR, 0, 16384, stream);
  p.ph_lo = 0; p.ph_hi = NPHASE;
  void* args[] = {&p};
  hipError_t e = hipLaunchCooperativeKernel((const void*)fwd_kernel, dim3(grid), dim3(NT), args, LDS_BYTES, stream);
  if (e != hipSuccess) fprintf(stderr, "cooperative launch failed: %s (grid %d)\n", hipGetErrorString(e), grid);
#else
  for (int ph = 0; ph < NPHASE; ++ph) {
    p.ph_lo = ph; p.ph_hi = ph + 1;
    hipLaunchKernelGGL(fwd_kernel, dim3(grid), dim3(NT), LDS_BYTES, stream, p);
  }
#endif
}
```
